# Optimizing an MI355X kernel written in HIP

```python
import math
import jax
import jax.numpy as jnp
from jax import lax
import numpy as np

D_MODEL = 2048
BATCH = 2
SEQ = 4096
DEPTH = 4

HEAD_DIM = 128
N_MIX_HEADS = D_MODEL // HEAD_DIM
A_Q_HEADS = N_MIX_HEADS // 4
A_KV_HEADS = max(1, A_Q_HEADS // 2)
A_GROUP = A_Q_HEADS // A_KV_HEADS
A_RADIUS = 128
B_PAIRS = ((128, 1), (512, 4), (2048, 16))
B_N_GROUPS = len(B_PAIRS)
B_HEADS_PER_GROUP = (N_MIX_HEADS - A_Q_HEADS) // B_N_GROUPS
B_KV_HEADS = B_HEADS_PER_GROUP
AB_IN_WIDTH = HEAD_DIM * (A_Q_HEADS + 2 * A_KV_HEADS + B_N_GROUPS * B_HEADS_PER_GROUP + 2 * B_KV_HEADS)
AB_OUT_WIDTH = HEAD_DIM * (A_Q_HEADS + B_HEADS_PER_GROUP)
C_HEADS = D_MODEL // (2 * HEAD_DIM)
C_IN_WIDTH = 3 * D_MODEL
D_FF = (D_MODEL * 43 // 16 + 127) // 128 * 128
CONV_WIDTH = 3
QBLOCK = 128
EPS = 1e-6
NEG_INF = -1e30
N_EVEN = (DEPTH + 1) // 2
N_ODD = DEPTH // 2

kernel_name = "hybrid_local_dilated_diff_encoder"


def rms_norm(x, g):
    xf = x.astype(jnp.float32)
    y = xf * lax.rsqrt(jnp.mean(xf * xf, axis=-1, keepdims=True) + EPS)
    return (y * g.astype(jnp.float32)).astype(x.dtype)


def alibi_slopes(n):
    return 2.0 ** (-8.0 * jnp.arange(1, n + 1, dtype=jnp.float32) / n)


def banded_attention(q, k, v, radius, slopes, step, sink=None):
    z, length, hk, g, dh = q.shape
    nb = -(-length // radius)
    pad = nb * radius - length
    qb = jnp.pad(q, ((0, 0), (0, pad), (0, 0), (0, 0), (0, 0))).reshape(z, nb, radius, hk, g, dh)
    kv_pad = ((0, 0), (radius, radius + pad), (0, 0), (0, 0))

    def windows(t):
        tb = jnp.pad(t, kv_pad).reshape(z, nb + 2, radius, hk, dh)
        return jnp.concatenate([tb[:, :-2], tb[:, 1:-1], tb[:, 2:]], axis=2)

    kw, vw = windows(k), windows(v)
    s = jnp.einsum('znqhgd,znkhd->znhgqk', qb, kw).astype(jnp.float32) * (dh ** -0.5)
    qpos = jnp.arange(nb * radius).reshape(nb, radius)
    kpos = jnp.arange(nb)[:, None] * radius - radius + jnp.arange(3 * radius)[None, :]
    dist = jnp.abs(kpos[:, None, :] - qpos[:, :, None])
    valid = (dist <= radius) & (kpos >= 0)[:, None, :] & (kpos < length)[:, None, :]
    bias = -(slopes.astype(jnp.float32)[None, :, :, None, None]
             * (step * dist).astype(jnp.float32)[:, None, None])
    s = jnp.where(valid[:, None, None], s + bias, NEG_INF)
    m = s.max(axis=-1)
    if sink is not None:
        sk = sink.astype(jnp.float32)[None, None, :, :, None]
        m = jnp.maximum(m, sk)
    p = jnp.exp(s - m[..., None])
    den = p.sum(axis=-1)
    if sink is not None:
        den = den + jnp.exp(sk - m)
    o = jnp.einsum('znhgqk,znkhd->znqhgd', p.astype(v.dtype), vw).astype(jnp.float32)
    den_t = jnp.transpose(den, (0, 1, 4, 2, 3))
    lse_t = jnp.transpose(m + jnp.log(den), (0, 1, 4, 2, 3))
    o = (o / den_t[..., None]).reshape(z, nb * radius, hk, g, dh)[:, :length]
    lse = lse_t.reshape(z, nb * radius, hk, g)[:, :length]
    return o.astype(q.dtype), lse


def fold_stride(t, d):
    b, s = t.shape[0], t.shape[1]
    rest = t.shape[2:]
    t = jnp.moveaxis(t.reshape((b, s // d, d) + rest), 2, 1)
    return t.reshape((b * d, s // d) + rest)


def unfold_stride(t, d, b):
    l = t.shape[1]
    rest = t.shape[2:]
    t = jnp.moveaxis(t.reshape((b, d, l) + rest), 1, 2)
    return t.reshape((b, l * d) + rest)


def local_dilated_mixer(h, w_in, w_out, sink):
    b, s, _ = h.shape
    proj = h @ w_in
    sizes = [A_Q_HEADS * HEAD_DIM, A_KV_HEADS * HEAD_DIM, A_KV_HEADS * HEAD_DIM,
             B_N_GROUPS * B_HEADS_PER_GROUP * HEAD_DIM, B_KV_HEADS * HEAD_DIM, B_KV_HEADS * HEAD_DIM]
    idx = [sum(sizes[:i + 1]) for i in range(len(sizes) - 1)]
    qa, ka, va, qb, kb, vb = jnp.split(proj, idx, axis=-1)
    slopes = alibi_slopes(N_MIX_HEADS)

    qa = qa.reshape(b, s, A_KV_HEADS, A_GROUP, HEAD_DIM)
    ka = ka.reshape(b, s, A_KV_HEADS, HEAD_DIM)
    va = va.reshape(b, s, A_KV_HEADS, HEAD_DIM)
    oa, _ = banded_attention(qa, ka, va, A_RADIUS, slopes[:A_Q_HEADS].reshape(A_KV_HEADS, A_GROUP), 1,
                             sink=sink.reshape(A_KV_HEADS, A_GROUP))
    oa = oa.reshape(b, s, A_Q_HEADS * HEAD_DIM)

    qb = qb.reshape(b, s, B_N_GROUPS, B_HEADS_PER_GROUP, HEAD_DIM)
    kb = kb.reshape(b, s, B_KV_HEADS, HEAD_DIM)
    vb = vb.reshape(b, s, B_KV_HEADS, HEAD_DIM)
    outs, lses = [], []
    for gi, (window, dil) in enumerate(B_PAIRS):
        radius = window // (2 * dil)
        start = A_Q_HEADS + gi * B_HEADS_PER_GROUP
        sl = slopes[start:start + B_HEADS_PER_GROUP][:, None]
        o, lse = banded_attention(fold_stride(qb[:, :, gi], dil)[:, :, :, None, :],
                                  fold_stride(kb, dil), fold_stride(vb, dil), radius, sl, dil)
        outs.append(unfold_stride(o[:, :, :, 0], dil, b))
        lses.append(unfold_stride(lse[..., 0], dil, b))
    wts = jax.nn.softmax(jnp.stack(lses, axis=0), axis=0)
    ob = jnp.sum(wts[..., None] * jnp.stack(outs, axis=0).astype(jnp.float32), axis=0)
    ob = ob.astype(h.dtype).reshape(b, s, B_HEADS_PER_GROUP * HEAD_DIM)
    return jnp.concatenate([oa, ob], axis=-1) @ w_out


def diff_attention(h, w_in, w_out, lam_params, subln_g, lambda_init):
    b, s, _ = h.shape
    q, k, v = jnp.split(h @ w_in, 3, axis=-1)
    q = q.reshape(b, s, C_HEADS, 2, HEAD_DIM)
    k = k.reshape(b, s, C_HEADS, 2, HEAD_DIM)
    v = v.reshape(b, s, C_HEADS, 2 * HEAD_DIM)
    lp = lam_params.astype(jnp.float32)
    lam = jnp.exp(jnp.sum(lp[0] * lp[1])) - jnp.exp(jnp.sum(lp[2] * lp[3])) + lambda_init
    slopes = alibi_slopes(C_HEADS)
    nb = s // QBLOCK
    qblocks = jnp.moveaxis(q.reshape(b, nb, QBLOCK, C_HEADS, 2, HEAD_DIM), 1, 0)
    kpos = jnp.arange(s)
    scale = HEAD_DIM ** -0.5

    def block(args):
        qblk, start = args
        sc = jnp.einsum('bqhjd,bkhjd->bhjqk', qblk, k).astype(jnp.float32) * scale
        qpos = start + jnp.arange(QBLOCK)
        dist = jnp.abs(qpos[:, None] - kpos[None, :]).astype(jnp.float32)
        sc = sc - slopes[None, :, None, None, None] * dist
        a = jax.nn.softmax(sc, axis=-1)
        attn = a[:, :, 0] - lam * a[:, :, 1]
        return jnp.einsum('bhqk,bkhe->bqhe', attn.astype(v.dtype), v)

    o = lax.map(block, (qblocks, jnp.arange(nb) * QBLOCK))
    o = jnp.moveaxis(o, 0, 1).reshape(b, s, C_HEADS, 2 * HEAD_DIM)
    o = rms_norm(o, subln_g) * (1.0 - lambda_init)
    return o.reshape(b, s, D_MODEL) @ w_out


def conv_ffn(h, w_up, conv_w, conv_b, w_down):
    gate, up = jnp.split(h @ w_up, 2, axis=-1)
    gp = jnp.pad(gate, ((0, 0), (1, 1), (0, 0)))
    gate = gp[:, :-2] * conv_w[0] + gp[:, 1:-1] * conv_w[1] + gp[:, 2:] * conv_w[2] + conv_b
    return (jax.nn.gelu(gate, approximate=True) * up) @ w_down


def setup_inputs(seed: int = 0) -> dict:
    key = jax.random.key(seed)
    ks = jax.random.split(key, 16)

    def nrm(k, shape, scale):
        return jax.random.normal(k, shape, jnp.float32) * scale

    return {
        "x": nrm(ks[0], (BATCH, SEQ, D_MODEL), 1.0),
        "c": nrm(ks[1], (BATCH, D_MODEL), 1.0),
        "ada_w": nrm(ks[2], (DEPTH, D_MODEL, 6 * D_MODEL), D_MODEL ** -0.5),
        "ada_b": nrm(ks[3], (DEPTH, 6 * D_MODEL), 0.02),
        "norm_g": 1.0 + nrm(ks[4], (DEPTH, 4, D_MODEL), 0.02),
        "ab_w_in": nrm(ks[5], (N_EVEN, D_MODEL, AB_IN_WIDTH), D_MODEL ** -0.5),
        "ab_w_out": nrm(ks[6], (N_EVEN, AB_OUT_WIDTH, D_MODEL), AB_OUT_WIDTH ** -0.5),
        "a_sink": nrm(ks[7], (N_EVEN, A_Q_HEADS), 0.5),
        "c_w_in": nrm(ks[8], (N_ODD, D_MODEL, C_IN_WIDTH), D_MODEL ** -0.5),
        "c_w_out": nrm(ks[9], (N_ODD, D_MODEL, D_MODEL), D_MODEL ** -0.5),
        "c_lambda": nrm(ks[10], (N_ODD, 4, HEAD_DIM), 0.1),
        "c_subln_g": 1.0 + nrm(ks[11], (N_ODD, 2 * HEAD_DIM), 0.02),
        "ffn_w_up": nrm(ks[12], (DEPTH, D_MODEL, 2 * D_FF), D_MODEL ** -0.5),
        "ffn_conv_w": nrm(ks[13], (DEPTH, CONV_WIDTH, D_FF), CONV_WIDTH ** -0.5),
        "ffn_conv_b": nrm(ks[14], (DEPTH, D_FF), 0.02),
        "ffn_w_down": nrm(ks[15], (DEPTH, D_FF, D_MODEL), D_FF ** -0.5),
    }


def reference(x, c, ada_w, ada_b, norm_g, ab_w_in, ab_w_out, a_sink, c_w_in, c_w_out,
              c_lambda, c_subln_g, ffn_w_up, ffn_conv_w, ffn_conv_b, ffn_w_down):
    cond = jax.nn.silu(c)
    for layer in range(DEPTH):
        mod = cond @ ada_w[layer] + ada_b[layer]
        sh1, sc1, g1, sh2, sc2, g2 = [m[:, None, :] for m in jnp.split(mod, 6, axis=-1)]
        h = rms_norm(x, norm_g[layer, 0]) * (1.0 + sc1) + sh1
        j = layer // 2
        if layer % 2 == 0:
            y = local_dilated_mixer(h, ab_w_in[j], ab_w_out[j], a_sink[j])
        else:
            lambda_init = 0.8 - 0.6 * math.exp(-0.3 * layer)
            y = diff_attention(h, c_w_in[j], c_w_out[j], c_lambda[j], c_subln_g[j], lambda_init)
        x = x + g1 * rms_norm(y, norm_g[layer, 1])
        h = rms_norm(x, norm_g[layer, 2]) * (1.0 + sc2) + sh2
        y = conv_ffn(h, ffn_w_up[layer], ffn_conv_w[layer], ffn_conv_b[layer], ffn_w_down[layer])
        x = x + g2 * rms_norm(y, norm_g[layer, 3])
    return x
```

```cpp
#include <hip/hip_runtime.h>
#include <cstdio>
#include <cstdint>
namespace pg8 {
#define PG8_LAS __attribute__((address_space(3)))
typedef unsigned short bf16_t;
typedef short bf16x8 __attribute__((ext_vector_type(8)));
typedef float f32x4 __attribute__((ext_vector_type(4)));
typedef unsigned u32x4 __attribute__((ext_vector_type(4)));
constexpr int BM = 256, BK = 64, HALF = 128, HTB = HALF * BK * 2  , STAGE_BYTES = 8 * HTB, NXCD = 8, WGM = 8;

__host__ __device__ __forceinline__ int lds_byte(int r, int c) { const int st = (r >> 4) * 2 + (c >> 5), rr = r & 15, cc = c & 31, ob = rr * 64 + cc * 2; return st * 1024 + (ob ^ (((ob >> 9) & 1) << 5)); }
__host__ __device__ __forceinline__ void stage_rc(int b, int& R, int& C) { const int st = b / 1024, sb = b % 1024, swz = sb ^ (((sb >> 9) & 1) << 5); R = (st >> 1) * 16 + swz / 64; C = (st & 1) * 32 + (swz % 64) / 2; }
__host__ __device__ __forceinline__ int perm32(int rho) { const int n = rho >> 4, i = rho & 15; return 8 * (i >> 2) + 4 * n + (i & 3); }

struct Unit { int pm, pn; };
struct Gemm { const bf16_t* A; const bf16_t* Bt; int M, N, K; };

struct StaticOrder {
    int nM, nN, nwg, G, c;
    __host__ __device__ void init(int M, int N, int G_, int c_) { nM = M / BM; nN = N / BM; nwg = nM * nN; G = G_; c = c_; }
    __host__ __device__ bool next(int i, Unit& u) const {
        const long L = (long)i * G + c; if (L >= nwg) return false;
        int wgid = (int)L; { const int q = nwg / NXCD, r = nwg % NXCD, xcd = wgid % NXCD, off = wgid / NXCD; wgid = (xcd < r ? xcd * (q + 1) : r * (q + 1) + (xcd - r) * q) + off; }
        const int nig = WGM * nN, gid = wgid / nig, fm = gid * WGM, gsz = (nM - fm) < WGM ? (nM - fm) : WGM;
        u.pm = fm + ((wgid % nig) % gsz); u.pn = (wgid % nig) / gsz; return true;
    }
    __device__ __forceinline__ void a_ready(const Unit&) const {}
    __device__ __forceinline__ void done(const Unit&) const {}
};

__device__ __forceinline__ unsigned cvt_pk_bf16(float lo, float hi) { unsigned r; asm volatile("v_cvt_pk_bf16_f32 %0, %1, %2" : "=v"(r) : "v"(lo), "v"(hi)); return r; }
typedef float f32x2 __attribute__((ext_vector_type(2)));
__device__ __forceinline__ f32x2 gelu_pk(f32x2 v) {
    const f32x2 av = __builtin_elementwise_abs(v), d = av * 0.2316418882f + 1.0f;
    f32x2 t; t.x = __builtin_amdgcn_rcpf(d.x); t.y = __builtin_amdgcn_rcpf(d.y);
    f32x2 q = t * 0.5307027145f + (-0.7265760135f); q = q * t + 0.7107068705f; q = q * t + (-0.142248368f); q = q * t + 0.127414796f; q = q * t;
    const f32x2 s = (v * v) * (-0.72134752044f);
    f32x2 e; e.x = __builtin_amdgcn_exp2f(s.x); e.y = __builtin_amdgcn_exp2f(s.y);
    const f32x2 m = v * (q * e), r = v - m;
    f32x2 o; o.x = v.x < 0.f ? m.x : r.x; o.y = v.y < 0.f ? m.y : r.y; return o;
}

template <int ACT  > struct EpiBf16 {
    static constexpr bool PERM = true, AFTER_DRAIN = false; static_assert(ACT == 0 || ACT == 1, "EpiBf16: ACT is 0 (none) or 1 (gelu_pk)");
    bf16_t* O; int ldc; const float* bias; int split_cols; size_t split_stride; float scale0;
    __device__ __forceinline__ void operator()(const f32x4 (&acc)[2][2][4][2], const Unit& u, int wr, int wc, int fr, int fq) const {
        const int row0 = u.pm * BM + wr * 64 + fr; int colt = u.pn * BM; bf16_t* base = O;
        float sc = 1.f; if (split_cols) { const int t = colt / split_cols; base += (size_t)t * split_stride; colt -= t * split_cols; if (t == 0) sc = scale0; }
        const int col0 = colt + wc * 32 + 8 * fq, bcol0 = u.pn * BM + wc * 32 + 8 * fq;
        f32x4 bv[2][2];
#pragma unroll
        for (int bj = 0; bj < 2; ++bj)
#pragma unroll
            for (int n = 0; n < 2; ++n) bv[bj][n] = bias ? *(const f32x4*)(bias + bcol0 + bj * HALF + 4 * n) : (f32x4){0.f, 0.f, 0.f, 0.f};
#pragma unroll
        for (int ai = 0; ai < 2; ++ai)
#pragma unroll
            for (int m = 0; m < 4; ++m) { bf16_t* rowp = base + (size_t)(row0 + ai * HALF + m * 16) * ldc + col0;
#pragma unroll
                for (int bj = 0; bj < 2; ++bj) { f32x4 v0 = acc[ai][bj][m][0] + bv[bj][0], v1 = acc[ai][bj][m][1] + bv[bj][1];
                    if (ACT == 1) { f32x2 a = gelu_pk((f32x2){v0[0], v0[1]}), b = gelu_pk((f32x2){v0[2], v0[3]}), c = gelu_pk((f32x2){v1[0], v1[1]}), d = gelu_pk((f32x2){v1[2], v1[3]});
                        v0 = (f32x4){a.x, a.y, b.x, b.y}; v1 = (f32x4){c.x, c.y, d.x, d.y}; }
                    v0 = v0 * sc; v1 = v1 * sc; u32x4 w; w.x = cvt_pk_bf16(v0[0], v0[1]); w.y = cvt_pk_bf16(v0[2], v0[3]); w.z = cvt_pk_bf16(v1[0], v1[1]); w.w = cvt_pk_bf16(v1[2], v1[3]);
                    *(u32x4*)(rowp + bj * HALF) = w; } }
    }
};
struct EpiF32 {
    static constexpr bool PERM = false, AFTER_DRAIN = false;
    float* C; int ldc; const float* bias;
    __device__ __forceinline__ void operator()(const f32x4 (&acc)[2][2][4][2], const Unit& u, int wr, int wc, int fr, int fq) const {
        const int row0 = u.pm * BM + wr * 64 + fr, col0 = u.pn * BM + wc * 32 + 4 * fq;
        f32x4 bv[2][2];
#pragma unroll
        for (int bj = 0; bj < 2; ++bj)
#pragma unroll
            for (int n = 0; n < 2; ++n) bv[bj][n] = bias ? *(const f32x4*)(bias + col0 + bj * HALF + n * 16) : (f32x4){0.f, 0.f, 0.f, 0.f};
#pragma unroll
        for (int ai = 0; ai < 2; ++ai)
#pragma unroll
            for (int m = 0; m < 4; ++m) { float* rowp = C + (size_t)(row0 + ai * HALF + m * 16) * ldc + col0;
#pragma unroll
                for (int bj = 0; bj < 2; ++bj)
#pragma unroll
                    for (int n = 0; n < 2; ++n) *(f32x4*)(rowp + bj * HALF + n * 16) = acc[ai][bj][m][n] + bv[bj][n]; }
    }
};
template <class Epi, class Sched, bool ALIGN_EPI = false, bool SP2 = false>
__device__ __forceinline__ void gemm_phase(PG8_LAS unsigned char* lds, const Gemm g, const Sched& S, const Epi& E) {
    int tid_ = threadIdx.x; asm volatile("" : "+v"(tid_));
    const int tid = tid_, wid = __builtin_amdgcn_readfirstlane(tid >> 6), lane = tid & 63, wr = wid >> 2, wc = wid & 3, fr = lane & 15, fq = lane >> 4;
    const int K = g.K, nt = K / BK;
    unsigned voffA[2], voffB[2];
#pragma unroll
    for (int i = 0; i < 2; ++i) { int R, C; stage_rc(tid * 16 + i * 8192, R, C); const int Rb = Epi::PERM ? ((R & ~31) + perm32(R & 31)) : R;
        voffA[i] = (unsigned)(R * K + C) * 2u; voffB[i] = (unsigned)(Rb * K + C) * 2u; }
    const size_t kstep = (size_t)(BK * 2);
    const size_t hstep = (size_t)HALF * K * 2;
    const size_t tstep = 2 * hstep;
    const unsigned ldsw = (unsigned)wid * 1024u;
    const int aoff = lds_byte(wr * 64 + fr, fq * 8), boff = lds_byte(wc * 32 + fr, fq * 8);
#define PG8_SA(b, h) (((b) * 2 + (h)) * HTB)
#define PG8_SB(b, h) ((4 + (b) * 2 + (h)) * HTB)
#define PG8_STAGE(bufoff, gbase, voff) do { _Pragma("unroll") for (int _i = 0; _i < 2; ++_i) \
        __builtin_amdgcn_global_load_lds((const unsigned*)((const char*)(gbase) + (voff)[_i]), (PG8_LAS unsigned*)(lds + (bufoff) + ldsw + _i * 8192), 16, 0, 0); } while (0)
#define PG8_LDA(dst, b, h) do { _Pragma("unroll") for (int m = 0; m < 4; ++m) _Pragma("unroll") for (int k = 0; k < 2; ++k) dst[m][k] = *(const PG8_LAS bf16x8*)(lds + PG8_SA(b, h) + aoff + m * 2048 + k * 1024); } while (0)
#define PG8_LDB(dst, b, h) do { _Pragma("unroll") for (int n = 0; n < 2; ++n) _Pragma("unroll") for (int k = 0; k < 2; ++k) dst[n][k] = *(const PG8_LAS bf16x8*)(lds + PG8_SB(b, h) + boff + n * 2048 + k * 1024); } while (0)
#define PG8_MMA(ai, bj, At, Bt) do { __builtin_amdgcn_s_setprio(1); _Pragma("unroll") for (int m = 0; m < 4; ++m) _Pragma("unroll") for (int n = 0; n < 2; ++n) _Pragma("unroll") for (int k = 0; k < 2; ++k) \
        acc[ai][bj][m][n] = __builtin_amdgcn_mfma_f32_16x16x32_bf16(Bt[n][k], At[m][k], acc[ai][bj][m][n], 0, 0, 0); __builtin_amdgcn_s_setprio(0); } while (0)
#define PG8_WAIT_V(n) asm volatile("s_waitcnt vmcnt(" #n ")" ::: "memory")
#define PG8_WAIT_L(n) asm volatile("s_waitcnt lgkmcnt(" #n ")" ::: "memory")
#define PG8_BAR __builtin_amdgcn_s_barrier()
#define PG8_SCHED __builtin_amdgcn_sched_barrier(0)
    Unit cur, nxt; int ui = 0;
    if (!S.next(0, cur)) return;
    f32x4 acc[2][2][4][2];
#pragma unroll
    for (int a = 0; a < 2; ++a)
#pragma unroll
        for (int b = 0; b < 2; ++b)
#pragma unroll
            for (int m = 0; m < 4; ++m)
#pragma unroll
                for (int n = 0; n < 2; ++n) acc[a][b][m][n] = (f32x4){0.f, 0.f, 0.f, 0.f};
    bf16x8 At[4][2], B0[2][2], B1[2][2];
    const char* cA = (const char*)g.A + (size_t)cur.pm * tstep; const char* cB = (const char*)g.Bt + (size_t)cur.pn * tstep;
    S.a_ready(cur);
    if constexpr (SP2) {
        PG8_STAGE(PG8_SB(0, 0), cB, voffB); PG8_STAGE(PG8_SB(0, 1), cB + hstep, voffB); PG8_STAGE(PG8_SA(0, 0), cA, voffA); PG8_STAGE(PG8_SA(0, 1), cA + hstep, voffA);
        if (wr == 1) PG8_BAR;
        PG8_WAIT_V(2); PG8_BAR;
        PG8_STAGE(PG8_SB(1, 0), cB + kstep, voffB); PG8_STAGE(PG8_SA(1, 0), cA + kstep, voffA); PG8_STAGE(PG8_SB(1, 1), cB + hstep + kstep, voffB);
        PG8_WAIT_V(6); PG8_BAR;
    } else {
        PG8_STAGE(PG8_SB(0, 0), cB, voffB); PG8_STAGE(PG8_SA(0, 0), cA, voffA); PG8_STAGE(PG8_SB(0, 1), cB + hstep, voffB); PG8_STAGE(PG8_SA(0, 1), cA + hstep, voffA);
        if (wr == 1) PG8_BAR;
        PG8_WAIT_V(4); PG8_BAR;
        PG8_STAGE(PG8_SB(1, 0), cB + kstep, voffB); PG8_STAGE(PG8_SA(1, 0), cA + kstep, voffA); PG8_STAGE(PG8_SB(1, 1), cB + hstep + kstep, voffB);
        PG8_WAIT_V(6); PG8_BAR;
    }
    for (;;) {
        const bool has_next = S.next(ui + 1, nxt);
        const char* nA = has_next ? (const char*)g.A + (size_t)nxt.pm * tstep : cA; const char* nB = has_next ? (const char*)g.Bt + (size_t)nxt.pn * tstep : cB;
        for (int t = 0; t < nt; t += 2) {
            const bool last = (t == nt - 2);
            const char* a1 = cA + (size_t)(t + 1) * kstep;
            const char* a2 = last ? nA : cA + (size_t)(t + 2) * kstep; const char* b2 = last ? nB : cB + (size_t)(t + 2) * kstep;
            const char* a3 = a2 + kstep; const char* b3 = b2 + kstep;
            if (last && has_next) S.a_ready(nxt);
            if constexpr (SP2) {
            PG8_LDB(B0, 0, 0); PG8_LDB(B1, 0, 1); PG8_SCHED; PG8_LDA(At, 0, 0); PG8_STAGE(PG8_SA(1, 1), a1 + hstep, voffA);
            PG8_WAIT_V(8); PG8_WAIT_L(0); PG8_BAR; PG8_MMA(0, 0, At, B0); PG8_MMA(0, 1, At, B1); PG8_BAR; PG8_SCHED;
            PG8_LDA(At, 0, 1); PG8_STAGE(PG8_SB(0, 0), b2, voffB); PG8_STAGE(PG8_SB(0, 1), b2 + hstep, voffB); PG8_STAGE(PG8_SA(0, 0), a2, voffA);
            PG8_WAIT_V(8); PG8_WAIT_L(0); PG8_BAR; PG8_MMA(1, 0, At, B0); PG8_MMA(1, 1, At, B1); PG8_BAR; PG8_SCHED;
            PG8_LDB(B0, 1, 0); PG8_LDB(B1, 1, 1); PG8_SCHED; PG8_LDA(At, 1, 0); PG8_STAGE(PG8_SA(0, 1), a2 + hstep, voffA);
            PG8_WAIT_V(8); PG8_WAIT_L(0); PG8_BAR; PG8_MMA(0, 0, At, B0); PG8_MMA(0, 1, At, B1); PG8_BAR; PG8_SCHED;
            PG8_LDA(At, 1, 1); PG8_STAGE(PG8_SB(1, 0), b3, voffB); PG8_STAGE(PG8_SB(1, 1), b3 + hstep, voffB); PG8_STAGE(PG8_SA(1, 0), a3, voffA);
            PG8_WAIT_V(8); PG8_WAIT_L(0); PG8_BAR; PG8_MMA(1, 0, At, B0); PG8_MMA(1, 1, At, B1); PG8_BAR; PG8_SCHED;
            } else {
            PG8_LDB(B0, 0, 0); PG8_SCHED; PG8_LDA(At, 0, 0); PG8_STAGE(PG8_SA(1, 1), a1 + hstep, voffA);
            PG8_WAIT_L(8); PG8_BAR; PG8_WAIT_L(0); PG8_MMA(0, 0, At, B0); PG8_BAR; PG8_SCHED;
            PG8_LDB(B1, 0, 1); PG8_STAGE(PG8_SB(0, 0), b2, voffB);
            PG8_BAR; PG8_WAIT_L(0); PG8_MMA(0, 1, At, B1); PG8_BAR;
            PG8_LDA(At, 0, 1); PG8_STAGE(PG8_SA(0, 0), a2, voffA);
            PG8_BAR; PG8_WAIT_L(0); PG8_MMA(1, 0, At, B0); PG8_BAR; PG8_SCHED;
            PG8_STAGE(PG8_SB(0, 1), b2 + hstep, voffB);
            PG8_WAIT_V(6); PG8_BAR; PG8_MMA(1, 1, At, B1); PG8_BAR;
            PG8_LDB(B0, 1, 0); PG8_SCHED; PG8_LDA(At, 1, 0); PG8_STAGE(PG8_SA(0, 1), a2 + hstep, voffA);
            PG8_WAIT_L(8); PG8_BAR; PG8_WAIT_L(0); PG8_MMA(0, 0, At, B0); PG8_BAR; PG8_SCHED;
            PG8_LDB(B1, 1, 1); PG8_STAGE(PG8_SB(1, 0), b3, voffB);
            PG8_BAR; PG8_WAIT_L(0); PG8_MMA(0, 1, At, B1); PG8_BAR;
            PG8_LDA(At, 1, 1); PG8_STAGE(PG8_SA(1, 0), a3, voffA);
            PG8_BAR; PG8_WAIT_L(0); PG8_MMA(1, 0, At, B0); PG8_BAR; PG8_SCHED;
            PG8_STAGE(PG8_SB(1, 1), b3 + hstep, voffB);
            PG8_WAIT_V(6); PG8_BAR; PG8_MMA(1, 1, At, B1); PG8_BAR;
            }
        }
        if constexpr (ALIGN_EPI) { if (wr == 0) PG8_BAR; }
        if constexpr (!Epi::AFTER_DRAIN) { E(acc, cur, wr, wc, fr, fq); S.done(cur); }
        if (!has_next) break;
#pragma unroll
        for (int a = 0; a < 2; ++a)
#pragma unroll
            for (int b = 0; b < 2; ++b)
#pragma unroll
                for (int m = 0; m < 4; ++m)
#pragma unroll
                    for (int n = 0; n < 2; ++n) acc[a][b][m][n] = (f32x4){0.f, 0.f, 0.f, 0.f};
        cur = nxt; cA = nA; cB = nB; ++ui;
        if constexpr (ALIGN_EPI) { if (wr == 1) PG8_BAR; }
    }
    PG8_WAIT_V(0);
    if constexpr (!ALIGN_EPI) { if (wr == 0) PG8_BAR; }
    PG8_BAR;
    if constexpr (Epi::AFTER_DRAIN) { E.fused(acc, cur, wr, wc, fr, fq, lds, wid, lane); S.done(cur); }
#undef PG8_SA
#undef PG8_SB
#undef PG8_STAGE
#undef PG8_LDA
#undef PG8_LDB
#undef PG8_MMA
#undef PG8_WAIT_V
#undef PG8_WAIT_L
#undef PG8_BAR
#undef PG8_SCHED
}
}
namespace att {
typedef unsigned short bf16;
using bf16x8 = __attribute__((ext_vector_type(8))) short;
using s16x4  = __attribute__((ext_vector_type(4))) short;
using f32x16 = __attribute__((ext_vector_type(16))) float;
using u32x4  = __attribute__((ext_vector_type(4))) unsigned;
constexpr int   D = 128, NW = 8, QBLK = 32, KVBLK = 64;
constexpr float SCALE = 0.088388347648318440f;
constexpr float THR = 8.f;
constexpr int SHM_V = KVBLK * D * 2, SHM_K = KVBLK * D * 2, SHM_ATTN = 2 * SHM_V + 2 * SHM_K + NW * 64 * 4;
constexpr float MASKED = -1e30f, M_INIT = -1e28f;
#define KSWZ(row, colB) ((row) * 256 + ((colB) ^ (((row) & 7) << 4)))
#define SBAR() __builtin_amdgcn_sched_barrier(0)
__device__ __forceinline__ int crow(int r, int hi) { return (r & 3) + 8 * (r >> 2) + 4 * hi; }
__device__ __forceinline__ unsigned cvtpk(float lo, float hi) {
  unsigned r; asm volatile("v_cvt_pk_bf16_f32 %0, %1, %2" : "=v"(r) : "v"(lo), "v"(hi)); return r;
}
__device__ __forceinline__ void partialSM(f32x16& p0, f32x16& p1, float& m_reg, float& mn, float& alpha) {
  constexpr float C = SCALE * 1.4426950408889634f;
  float pmax = p0[0];
#pragma unroll
  for (int r = 1; r < 16; ++r) pmax = fmaxf(pmax, p0[r]);
#pragma unroll
  for (int r = 0; r < 16; ++r) pmax = fmaxf(pmax, p1[r]);
  { auto rr = __builtin_amdgcn_permlane32_swap(__float_as_uint(pmax), __float_as_uint(pmax), false, false);
    pmax = fmaxf(__uint_as_float(rr[0]), __uint_as_float(rr[1])); }
  if (__builtin_expect(__all(pmax - m_reg <= THR / SCALE), 1)) { mn = m_reg; alpha = 1.f; }
  else { mn = fmaxf(m_reg, pmax); alpha = __builtin_amdgcn_exp2f((m_reg - mn) * C); m_reg = mn; }
  float mnC = -mn * C;
#pragma unroll
  for (int r = 0; r < 16; ++r) p0[r] = fmaf(p0[r], C, mnC);
#pragma unroll
  for (int r = 0; r < 16; ++r) p1[r] = fmaf(p1[r], C, mnC);
#pragma unroll
  for (int r = 0; r < 16; ++r) p0[r] = __builtin_amdgcn_exp2f(p0[r]);
}
__device__ __forceinline__ void finishSM(f32x16& p0, f32x16& p1, float alpha, float& l_reg, bf16x8& pa0, bf16x8& pa1, bf16x8& pa2, bf16x8& pa3) {
#pragma unroll
  for (int r = 0; r < 16; ++r) p1[r] = __builtin_amdgcn_exp2f(p1[r]);
  float ps = 0;
#pragma unroll
  for (int r = 0; r < 16; ++r) ps += p0[r];
#pragma unroll
  for (int r = 0; r < 16; ++r) ps += p1[r];
  { auto rr = __builtin_amdgcn_permlane32_swap(__float_as_uint(ps), __float_as_uint(ps), false, false);
    ps = __uint_as_float(rr[0]) + __uint_as_float(rr[1]); }
  l_reg = l_reg * alpha + ps;
#define PK4(P, BASE, OUT) do { unsigned a0 = cvtpk(P[BASE + 0], P[BASE + 1]), a1 = cvtpk(P[BASE + 2], P[BASE + 3]);   \
    unsigned b0 = cvtpk(P[BASE + 4], P[BASE + 5]), b1 = cvtpk(P[BASE + 6], P[BASE + 7]);                              \
    auto r0 = __builtin_amdgcn_permlane32_swap(a0, b0, false, false); auto r1 = __builtin_amdgcn_permlane32_swap(a1, b1, false, false); \
    u32x4 w = {r0[0], r1[0], r0[1], r1[1]}; OUT = *reinterpret_cast<bf16x8*>(&w); } while (0)
  PK4(p0, 0, pa0); PK4(p0, 8, pa1); PK4(p1, 0, pa2); PK4(p1, 8, pa3);
#undef PK4
}
template <bool BAND>
__device__ __forceinline__ void qkt(f32x16& p0, f32x16& p1, const bf16* Ks, const bf16x8* qr, int r32, int hi, float dq, float kf0, float nsl, float radius, float Lf) {
#pragma unroll
  for (int r = 0; r < 16; ++r) {
    const float c0 = (float)((r & 3) + 8 * (r >> 2));
    const float d0 = dq - c0, d1 = dq - (c0 + 32.f);
    float b0 = nsl * fabsf(d0), b1 = nsl * fabsf(d1);
    if (BAND) {
      const float ka = kf0 + c0, kb = kf0 + (c0 + 32.f);
      const bool v0 = (fabsf(d0) <= radius) && (ka >= 0.f) && (ka < Lf);
      const bool v1 = (fabsf(d1) <= radius) && (kb >= 0.f) && (kb < Lf);
      b0 = v0 ? b0 : MASKED; b1 = v1 ? b1 : MASKED;
    }
    p0[r] = b0; p1[r] = b1;
  }
#pragma unroll
  for (int d0 = 0; d0 < 8; ++d0) { int cb = (d0 * 16 + hi * 8) * 2;
    bf16x8 b0 = *reinterpret_cast<const bf16x8*>((const char*)Ks + KSWZ(r32, cb));
    bf16x8 b1 = *reinterpret_cast<const bf16x8*>((const char*)Ks + KSWZ(32 + r32, cb));
    p0 = __builtin_amdgcn_mfma_f32_32x32x16_bf16(b0, qr[d0], p0, 0, 0, 0);
    p1 = __builtin_amdgcn_mfma_f32_32x32x16_bf16(b1, qr[d0], p1, 0, 0, 0); }
}
__device__ __forceinline__ int v_st(int k, int c) { const int kk = (k & ~0xC) | ((k & 4) << 1) | ((k & 8) >> 1); return ((kk >> 3) * 4 + (c >> 5)) * 512 + ((kk & 7) * 32 + (c & 31)) * 2; }
__device__ __forceinline__ int v_rd_base(int lane) { return ((lane & 3) << 3) | (((lane >> 2) & 3) << 6) | (((lane >> 4) & 1) << 5) | (((lane >> 5) & 1) << 8); }
constexpr int v_rd_off(int d0, int ks, int half) { return d0 * 512 + ks * 4096 + half * 2048; }
template <int OFF> __device__ __forceinline__ s16x4 tr_read(int vb) {
  s16x4 r; asm volatile("ds_read_b64_tr_b16 %0, %1 offset:%2" : "=&v"(r) : "v"(vb), "i"(OFF) : "memory"); return r;
}
template <int D0> __device__ __forceinline__ void pv_one(f32x16& od, int vb, bf16x8 pa0, bf16x8 pa1, bf16x8 pa2, bf16x8 pa3) {
  const s16x4 l0 = tr_read<v_rd_off(D0, 0, 0)>(vb), h0 = tr_read<v_rd_off(D0, 0, 1)>(vb), l1 = tr_read<v_rd_off(D0, 1, 0)>(vb), h1 = tr_read<v_rd_off(D0, 1, 1)>(vb);
  const s16x4 l2 = tr_read<v_rd_off(D0, 2, 0)>(vb), h2 = tr_read<v_rd_off(D0, 2, 1)>(vb), l3 = tr_read<v_rd_off(D0, 3, 0)>(vb), h3 = tr_read<v_rd_off(D0, 3, 1)>(vb);
  asm volatile("s_waitcnt lgkmcnt(0)" ::: "memory"); SBAR();
#define PK(L, H) (bf16x8){L[0], L[1], L[2], L[3], H[0], H[1], H[2], H[3]}
  od = __builtin_amdgcn_mfma_f32_32x32x16_bf16(pa0, PK(l0, h0), od, 0, 0, 0);
  od = __builtin_amdgcn_mfma_f32_32x32x16_bf16(pa1, PK(l1, h1), od, 0, 0, 0);
  od = __builtin_amdgcn_mfma_f32_32x32x16_bf16(pa2, PK(l2, h2), od, 0, 0, 0);
  od = __builtin_amdgcn_mfma_f32_32x32x16_bf16(pa3, PK(l3, h3), od, 0, 0, 0);
#undef PK
}
__device__ __forceinline__ void pv_d0(f32x16* o, int vb, bf16x8 pa0, bf16x8 pa1, bf16x8 pa2, bf16x8 pa3) {
  pv_one<0>(o[0], vb, pa0, pa1, pa2, pa3); pv_one<1>(o[1], vb, pa0, pa1, pa2, pa3); pv_one<2>(o[2], vb, pa0, pa1, pa2, pa3); pv_one<3>(o[3], vb, pa0, pa1, pa2, pa3);
}

struct UnitArgs {
  const bf16* Q; long ldq;
  const bf16* K; const bf16* V; long ldk;
  int q0, L, kt0, nt;
  float nsl, radius, m_init, l_init;
  float* Of; bf16* Ob; long ldo;
  float* lse; long ldl;
};

template <bool BAND, int SDEPTH>
__device__ __forceinline__ void attn_unit(const UnitArgs& a_in, char* lds) {
  UnitArgs a = a_in;
  asm volatile("" : "+s"(a.Q), "+s"(a.ldq), "+s"(a.K), "+s"(a.V), "+s"(a.ldk));
  asm volatile("" : "+s"(a.q0), "+s"(a.L), "+s"(a.kt0), "+s"(a.nt));
  asm volatile("" : "+s"(a.Of), "+s"(a.Ob), "+s"(a.ldo), "+s"(a.lse), "+s"(a.ldl));
  int tid_ = threadIdx.x; asm volatile("" : "+v"(tid_));
  const int tid = tid_, wid = tid >> 6, lane = tid & 63, r32 = lane & 31, hi = lane >> 5;
  bf16* V_lds = (bf16*)lds; bf16* K_lds = (bf16*)(lds + 2 * SHM_V);
  float* ws = (float*)(lds + 2 * SHM_V + 2 * SHM_K) + wid * 64; float* li_l = ws; float* al_l = ws + 32;
  float m_reg = a.m_init, l_reg = a.l_init; f32x16 o[4] = {}; bf16x8 qr[8];
  const bf16* Qw = a.Q + (long)(wid * QBLK + r32) * a.ldq + hi * 8;
#pragma unroll
  for (int d0 = 0; d0 < 8; ++d0) qr[d0] = *reinterpret_cast<const bf16x8*>(Qw + d0 * 16);
  const int sr = tid >> 4, sc = (tid & 15) * 8, vst0 = v_st(sr, sc), vst1 = v_st(32 + sr, sc);
  const int vb0 = (int)(uintptr_t)V_lds + v_rd_base(lane);
  const float qf = (float)(a.q0 + wid * QBLK + r32), Lf = (float)a.L, nsl = a.nsl, radius = a.radius;
  const int Lm1 = a.L - 1, kt0 = a.kt0;
  const bf16* Kp = a.K; const bf16* Vp = a.V; const long ldk = a.ldk;
  struct { bf16x8 vs0, vs1, ks0, ks1; } sr_[SDEPTH];
  const unsigned lofs = (unsigned)((sr * ldk + sc) * 2);
  const char* Kc = (const char*)Kp; const char* Vc = (const char*)Vp; const long ldk32 = 32 * ldk * 2, ldk64 = 64 * ldk * 2;
#define SLOAD(i, t) do { if constexpr (BAND) { const int k0_ = (kt0 + (t)) * KVBLK; int ra_ = k0_ + sr, rb_ = k0_ + 32 + sr;                   \
    ra_ = ra_ < 0 ? 0 : (ra_ > Lm1 ? Lm1 : ra_); rb_ = rb_ < 0 ? 0 : (rb_ > Lm1 ? Lm1 : rb_);                                          \
    sr_[i].vs0 = *reinterpret_cast<const bf16x8*>(&Vp[(long)ra_ * ldk + sc]); sr_[i].vs1 = *reinterpret_cast<const bf16x8*>(&Vp[(long)rb_ * ldk + sc]); \
    sr_[i].ks0 = *reinterpret_cast<const bf16x8*>(&Kp[(long)ra_ * ldk + sc]); sr_[i].ks1 = *reinterpret_cast<const bf16x8*>(&Kp[(long)rb_ * ldk + sc]); } \
  else { const long tb_ = (long)(kt0 + (t)) * ldk64;                                                                                       \
    sr_[i].vs0 = *reinterpret_cast<const bf16x8*>(Vc + tb_ + lofs); sr_[i].vs1 = *reinterpret_cast<const bf16x8*>(Vc + tb_ + ldk32 + lofs); \
    sr_[i].ks0 = *reinterpret_cast<const bf16x8*>(Kc + tb_ + lofs); sr_[i].ks1 = *reinterpret_cast<const bf16x8*>(Kc + tb_ + ldk32 + lofs); } } while (0)
#define SWRITE(b, i) do { *(bf16x8*)((char*)V_lds + (b) * SHM_V + vst0) = sr_[i].vs0;          \
    *(bf16x8*)((char*)V_lds + (b) * SHM_V + vst1) = sr_[i].vs1; int kc = sc * 2;               \
    *(bf16x8*)((char*)K_lds + (b) * SHM_K + KSWZ(sr, kc)) = sr_[i].ks0;                       \
    *(bf16x8*)((char*)K_lds + (b) * SHM_K + KSWZ(32 + sr, kc)) = sr_[i].ks1; } while (0)
#define SWAIT() do { if constexpr (SDEPTH == 2) asm volatile("s_waitcnt vmcnt(4)" ::: "memory"); else asm volatile("s_waitcnt vmcnt(0)" ::: "memory"); } while (0)
#define RESC(al) do { if (__any((al) < 1.f)) { if (hi == 0) al_l[r32] = (al); asm volatile("s_waitcnt lgkmcnt(0)" ::: "memory"); \
    _Pragma("unroll") for (int d = 0; d < 4; ++d) _Pragma("unroll") for (int r = 0; r < 16; ++r) o[d][r] *= al_l[crow(r, hi)]; } } while (0)
#define QKT(PA, PB, buf, t) do { const float kf0_ = (float)((kt0 + (t)) * KVBLK + 4 * hi); \
    qkt<BAND>(PA, PB, (bf16*)((char*)K_lds + (buf) * SHM_K), qr, r32, hi, qf - kf0_, kf0_, nsl, radius, Lf); } while (0)
  f32x16 pA0, pA1, pB0, pB1; float mnA, mnB, alA, alB; bf16x8 pa0, pa1, pa2, pa3; const int NT = a.nt;
  constexpr int SE = 0, SO = SDEPTH - 1;
  SLOAD(SE, 0); asm volatile("s_waitcnt vmcnt(0)" ::: "memory"); SWRITE(0, SE); __syncthreads();
  QKT(pA0, pA1, 0, 0); partialSM(pA0, pA1, m_reg, mnA, alA);
  SLOAD(SO, 1); if constexpr (SDEPTH == 2) { if (2 < NT) SLOAD(SE, 2); }
  SWAIT(); SWRITE(1, SO); __syncthreads();
  for (int j = 1; j + 1 < NT; j += 2) {
    SBAR(); QKT(pB0, pB1, 1, j);
    finishSM(pA0, pA1, alA, l_reg, pa0, pa1, pa2, pa3); SBAR();
    SLOAD(SO, j + SDEPTH); SBAR();
    pv_d0(o, vb0, pa0, pa1, pa2, pa3); partialSM(pB0, pB1, m_reg, mnB, alB);
    __syncthreads(); SWAIT(); SWRITE(0, SE);
    RESC(alB); __syncthreads();
    SBAR(); QKT(pA0, pA1, 0, j + 1);
    finishSM(pB0, pB1, alB, l_reg, pa0, pa1, pa2, pa3); SBAR();
    if (SDEPTH == 1 || j + 3 < NT) SLOAD(SE, j + 1 + SDEPTH); SBAR();
    pv_d0(o, vb0 + (int)SHM_V, pa0, pa1, pa2, pa3); partialSM(pA0, pA1, m_reg, mnA, alA);
    __syncthreads(); SWAIT(); SWRITE(1, SO);
    RESC(alA); __syncthreads();
  }
  SBAR(); QKT(pB0, pB1, 1, NT - 1);
  finishSM(pA0, pA1, alA, l_reg, pa0, pa1, pa2, pa3); SBAR();
  pv_d0(o, vb0, pa0, pa1, pa2, pa3); partialSM(pB0, pB1, m_reg, mnB, alB);
  __syncthreads(); RESC(alB);
  finishSM(pB0, pB1, alB, l_reg, pa0, pa1, pa2, pa3); SBAR();
  pv_d0(o, vb0 + (int)SHM_V, pa0, pa1, pa2, pa3);
  if (hi == 0) li_l[r32] = l_reg; asm volatile("s_waitcnt lgkmcnt(0)" ::: "memory");
  float rli[16];
#pragma unroll
  for (int r = 0; r < 16; ++r) rli[r] = __builtin_amdgcn_rcpf(li_l[crow(r, hi)]);
  if (a.Of) {
    float* Ow = a.Of + (long)(wid * QBLK) * a.ldo;
#pragma unroll
    for (int r = 0; r < 16; ++r) { const int orow = crow(r, hi);
#pragma unroll
      for (int d0 = 0; d0 < 4; ++d0) Ow[(long)orow * a.ldo + d0 * 32 + r32] = o[d0][r] * rli[r]; }
  } else {
    bf16* Ow = a.Ob + (long)(wid * QBLK) * a.ldo;
#pragma unroll
    for (int r = 0; r < 16; ++r) { const int orow = crow(r, hi);
#pragma unroll
      for (int d0 = 0; d0 < 4; ++d0) { const float v = o[d0][r] * rli[r]; Ow[(long)orow * a.ldo + d0 * 32 + r32] = (bf16)(cvtpk(v, v) & 0xffffu); } }
  }
  if (a.lse && hi == 0) a.lse[(long)(wid * QBLK + r32) * a.ldl] = m_reg * SCALE + __logf(l_reg);
  __syncthreads();
#undef SLOAD
#undef SWRITE
#undef SWAIT
#undef RESC
#undef QKT
}
#undef KSWZ
#undef SBAR
}
constexpr int DM = 2048, BATCH = 2, SEQ = 4096, DEPTH = 4, M = BATCH * SEQ;
constexpr int AB_IN = 3584, AB_OUT = 1024, C_IN = 6144, DFF = 5504, UPW = 2 * DFF, MODW = 6 * DM;
constexpr float EPS = 1e-6f;
constexpr int NWAVES = 8;
constexpr size_t MiB = 1u << 20;
constexpr size_t WS_CTL = 0, CTL_ZERO_BYTES = 2 * MiB;
constexpr size_t WS_MOD = 2 * MiB;
constexpr size_t WS_PART = 3 * MiB;
constexpr size_t WS_WABIN = 16 * MiB;
constexpr size_t WS_WABOUT = 44 * MiB;
constexpr size_t WS_WCIN = 52 * MiB;
constexpr size_t WS_WCOUT = 100 * MiB;
constexpr size_t WS_WUP = 116 * MiB;
constexpr size_t WS_WDOWN = 288 * MiB;
constexpr size_t WS_H = 376 * MiB;
constexpr size_t WS_PROJ = 408 * MiB;
constexpr size_t WS_ATT = 504 * MiB;
constexpr size_t WS_LSE = WS_ATT + 64 * MiB;
constexpr size_t WS_O = 632 * MiB;
constexpr size_t WS_Y = 664 * MiB;
constexpr size_t WS_GU = 728 * MiB;
constexpr size_t WS_ACT = 900 * MiB;
constexpr size_t WS_END = 986 * MiB;
static_assert(WS_PART + (size_t)DEPTH * 16 * BATCH * MODW * 4 <= WS_WABIN, "ws map");
static_assert(WS_WABIN + (size_t)2 * AB_IN * DM * 2 <= WS_WABOUT && WS_WABOUT + (size_t)2 * DM * AB_OUT * 2 <= WS_WCIN, "ws map");
static_assert(WS_WCIN + (size_t)2 * C_IN * DM * 2 <= WS_WCOUT && WS_WCOUT + (size_t)2 * DM * DM * 2 <= WS_WUP, "ws map");
static_assert(WS_WUP + (size_t)4 * UPW * DM * 2 <= WS_WDOWN && WS_WDOWN + (size_t)4 * DM * DFF * 2 <= WS_H, "ws map");
static_assert(WS_H + (size_t)M * DM * 2 <= WS_PROJ && WS_PROJ + (size_t)M * C_IN * 2 <= WS_ATT && WS_ATT + (size_t)2 * M * DM * 4 <= WS_O, "ws map");
static_assert(WS_ATT + (size_t)3 * M * 512 * 4 <= WS_LSE && WS_LSE + (size_t)3 * M * 4 * 4 <= WS_O, "ws map");
static_assert(WS_O + (size_t)M * DM * 2 <= WS_Y && WS_Y + (size_t)M * DM * 4 <= WS_GU && WS_GU + (size_t)M * UPW * 2 <= WS_ACT && WS_ACT + (size_t)M * DFF * 2 <= WS_END, "ws map");
constexpr int CW_BAR = 4096;
constexpr int RING_OFF = 0, RING_BYTES = 131072;
constexpr int LDSCTL_OFF = RING_BYTES, MISC_OFF = LDSCTL_OFF + 320;
constexpr int LDS_BYTES = 147456;
static_assert(att::SHM_ATTN <= RING_BYTES, "attention LDS fits the ring region");

#define GAS __attribute__((address_space(1)))
#define LAS __attribute__((address_space(3)))
typedef unsigned short bf16;
typedef unsigned v4u __attribute__((ext_vector_type(4)));
typedef unsigned v2u __attribute__((ext_vector_type(2)));
typedef float f32x4 __attribute__((ext_vector_type(4)));
typedef GAS unsigned gu32;
#define LDS_WAIT() asm volatile("s_waitcnt lgkmcnt(0)" ::: "memory")
__device__ __forceinline__ unsigned pk2(float lo, float hi) { unsigned r; asm volatile("v_cvt_pk_bf16_f32 %0, %1, %2" : "=v"(r) : "v"(lo), "v"(hi)); return r; }
__device__ __forceinline__ float bf_lo(unsigned w) { return __uint_as_float(w << 16); }
__device__ __forceinline__ float bf_hi(unsigned w) { return __uint_as_float(w & 0xffff0000u); }
#define XB_TMO      128
#define XB_XCNT(j)  (256  + 64 * (j))
#define XB_XSUB(j)  (1280 + 64 * (j))
#define XB_XGEN(j)  (2304 + 64 * (j))
#define XB_TOP      3328
#define XB_TOPGEN   3392
#define XCD_BAR_WORDS 3456
#define XB_SPIN_CAP (1u << 18)

__device__ __forceinline__ unsigned xb_ld(unsigned* p)              { return __hip_atomic_load(p, __ATOMIC_RELAXED, __HIP_MEMORY_SCOPE_AGENT); }
__device__ __forceinline__ unsigned xb_add(unsigned* p, unsigned v) { return __hip_atomic_fetch_add(p, v, __ATOMIC_RELAXED, __HIP_MEMORY_SCOPE_AGENT); }
__device__ __forceinline__ unsigned xb_xcc_id() { return (unsigned)__builtin_amdgcn_s_getreg((3 << 11) | 20) & 0xFu; }
#define XB_SPIN(cond, bar) do { unsigned _sp = 0; while (cond) { __builtin_amdgcn_s_sleep(1); \
    if ((++_sp & 255u) == 0u) { if (xb_ld(&(bar)[XB_TMO])) break; if (_sp > XB_SPIN_CAP) { atomicAdd(&(bar)[XB_TMO], 1u); break; } } } } while (0)

struct XcdBarrier {
    unsigned* bar; unsigned x;
    volatile LAS unsigned* st;
};

__device__ __forceinline__ XcdBarrier xcd_barrier_post(unsigned* bar, volatile LAS unsigned* st) {
    XcdBarrier b; b.bar = bar; b.x = xb_xcc_id(); b.st = st;
    if (threadIdx.x == 0) (void)xb_add(&bar[XB_XCNT(b.x)], 1u);
    return b;
}
__device__ __forceinline__ void xcd_barrier_complete(unsigned* bar, unsigned x, unsigned& nloc, unsigned& nx) {
    const unsigned G = gridDim.x * gridDim.y * gridDim.z;
    unsigned sum, cnt, mine, sp = 0u;
    for (;;) {
        sum = 0u; cnt = 0u; mine = 0u;
#pragma unroll
        for (unsigned j = 0; j < 16; ++j) { const unsigned c = xb_ld(&bar[XB_XCNT(j)]); sum += c; cnt += (c > 0u) ? 1u : 0u; mine = (j == x) ? c : mine; }
        if (sum == G) break;
        __builtin_amdgcn_s_sleep(1);
        if ((++sp & 255u) == 0u) { if (xb_ld(&bar[XB_TMO])) break; if (sp > XB_SPIN_CAP) { atomicAdd(&bar[XB_TMO], 1u); break; } }
    }
    nloc = mine > 0u ? mine : 1u; nx = cnt > 0u ? cnt : 1u;
}

__device__ __forceinline__ void xcd_barrier(const XcdBarrier& b) {
    asm volatile("s_waitcnt vmcnt(0)" ::: "memory");
    __syncthreads();
    if (threadIdx.x == 0) {
        unsigned* bar = b.bar;
        __builtin_amdgcn_s_waitcnt(0);
        unsigned nloc = b.st[0], nx = b.st[1];
        if (nloc == 0u) { xcd_barrier_complete(bar, b.x, nloc, nx); b.st[0] = nloc; b.st[1] = nx; }
        const unsigned old = xb_add(&bar[XB_XSUB(b.x)], 1u);
        const unsigned gen = old / nloc;
        if (old + 1u == (gen + 1u) * nloc) {
            __builtin_amdgcn_fence(__ATOMIC_RELEASE, "agent");
            asm volatile("s_waitcnt vmcnt(0)" ::: "memory");
            const unsigned og = xb_add(&bar[XB_TOP], 1u);
            const unsigned tg = og / nx;
            if (og + 1u == (tg + 1u) * nx) xb_add(&bar[XB_TOPGEN], 1u);
            else XB_SPIN(xb_ld(&bar[XB_TOPGEN]) == tg, bar);
            __builtin_amdgcn_fence(__ATOMIC_ACQUIRE, "agent");
            xb_add(&bar[XB_XGEN(b.x)], 1u);
            asm volatile("s_waitcnt vmcnt(0)" ::: "memory");
        } else {
            XB_SPIN(xb_ld(&bar[XB_XGEN(b.x)]) == gen, bar);
            __builtin_amdgcn_fence(__ATOMIC_ACQUIRE, "agent");
            asm volatile("s_waitcnt vmcnt(0)" ::: "memory");
        }
    }
    __syncthreads();
}
struct Frame {
    LAS unsigned char* lds; char* ldsg;
    int tid, lane, wave, G, gw, NGW;
    const float *x, *c, *ada_w, *ada_b, *norm_g, *ab_w_in, *ab_w_out, *a_sink, *c_w_in, *c_w_out, *c_lambda, *c_subln_g, *w_up, *conv_w, *conv_b, *w_down;
    float* out; unsigned char* ws;
};
#define PHASE_IDS() int tid = threadIdx.x; asm volatile("" : "+v"(tid)); const int lane = tid & 63, wave = __builtin_amdgcn_readfirstlane(tid >> 6), gw = (int)blockIdx.x * NWAVES + wave; (void)lane; (void)gw
__device__ __forceinline__ float wave_sum(float v) {
#pragma unroll
    for (int o = 1; o < 64; o <<= 1) v += __shfl_xor(v, o);
    return v;
}
__device__ __forceinline__ void transpose_item(const float* W, int K, int N, bf16* WT, LAS float* scr, int item, int lane) {
    const int nblk = N / 32, kb = item / nblk, nb = item % nblk, k0 = 64 * kb, n0 = 32 * nb;
#pragma unroll 8
    for (int i = 0; i < 32; ++i) { const int kk = 2 * i + (lane >> 5); scr[kk * 33 + (lane & 31)] = W[(size_t)(k0 + kk) * N + n0 + (lane & 31)]; }
    LDS_WAIT(); asm volatile("" ::: "memory");
    const int c = lane & 7;
#pragma unroll
    for (int j = 0; j < 4; ++j) { const int n = (lane >> 3) + 8 * j; const LAS float* s = scr + (8 * c) * 33 + n;
        v4u o; o.x = pk2(s[0 * 33], s[1 * 33]); o.y = pk2(s[2 * 33], s[3 * 33]); o.z = pk2(s[4 * 33], s[5 * 33]); o.w = pk2(s[6 * 33], s[7 * 33]);
        *(GAS v4u*)(WT + (size_t)(n0 + n) * K + k0 + 8 * c) = o; }
    LDS_WAIT(); asm volatile("" ::: "memory");
}
__device__ __forceinline__ float silu_f(float v) { return v / (1.f + __expf(-v)); }

__device__ __forceinline__ void p0a_prologue(Frame& F) {
    PHASE_IDS();
    LAS float* scr = (LAS float*)(F.lds + RING_OFF + wave * 16384);
    constexpr int I_ABIN = (DM / 64) * (AB_IN / 32), I_ABOUT = (AB_OUT / 64) * (DM / 32), I_CIN = (DM / 64) * (C_IN / 32), I_COUT = (DM / 64) * (DM / 32),
                  I_UP = (DM / 64) * (UPW / 32), I_DOWN = (DFF / 64) * (DM / 32);
    constexpr int NT_ITEMS = 2 * I_ABIN + 2 * I_ABOUT + 2 * I_CIN + 2 * I_COUT + 4 * I_UP + 4 * I_DOWN;
    bf16* wabin = (bf16*)(F.ws + WS_WABIN); bf16* wabout = (bf16*)(F.ws + WS_WABOUT); bf16* wcin = (bf16*)(F.ws + WS_WCIN); bf16* wcout = (bf16*)(F.ws + WS_WCOUT);
    bf16* wup = (bf16*)(F.ws + WS_WUP); bf16* wdown = (bf16*)(F.ws + WS_WDOWN);
    for (int it = gw; it < NT_ITEMS; it += F.NGW) {
        int r = it;
        if (r < 2 * I_ABIN) { const int j = r / I_ABIN; transpose_item(F.ab_w_in + (size_t)j * DM * AB_IN, DM, AB_IN, wabin + (size_t)j * AB_IN * DM, scr, r % I_ABIN, lane); continue; } r -= 2 * I_ABIN;
        if (r < 2 * I_ABOUT) { const int j = r / I_ABOUT; transpose_item(F.ab_w_out + (size_t)j * AB_OUT * DM, AB_OUT, DM, wabout + (size_t)j * DM * AB_OUT, scr, r % I_ABOUT, lane); continue; } r -= 2 * I_ABOUT;
        if (r < 2 * I_CIN) { const int j = r / I_CIN; transpose_item(F.c_w_in + (size_t)j * DM * C_IN, DM, C_IN, wcin + (size_t)j * C_IN * DM, scr, r % I_CIN, lane); continue; } r -= 2 * I_CIN;
        if (r < 2 * I_COUT) { const int j = r / I_COUT; transpose_item(F.c_w_out + (size_t)j * DM * DM, DM, DM, wcout + (size_t)j * DM * DM, scr, r % I_COUT, lane); continue; } r -= 2 * I_COUT;
        if (r < 4 * I_UP) { const int j = r / I_UP; transpose_item(F.w_up + (size_t)j * DM * UPW, DM, UPW, wup + (size_t)j * UPW * DM, scr, r % I_UP, lane); continue; } r -= 4 * I_UP;
        { const int j = r / I_DOWN; transpose_item(F.w_down + (size_t)j * DFF * DM, DFF, DM, wdown + (size_t)j * DM * DFF, scr, r % I_DOWN, lane); }
    }
    float* part = (float*)(F.ws + WS_PART);
    constexpr int NCH = MODW / 256, NKC = 16, KCH = DM / NKC;
    for (int it = gw; it < DEPTH * NCH * NKC; it += F.NGW) {
        const int kc = it % NKC, nch = (it / NKC) % NCH, l = it / (NKC * NCH), k0 = kc * KCH;
        const float c0a = silu_f(F.c[k0 + lane]), c0b = silu_f(F.c[k0 + 64 + lane]), c1a = silu_f(F.c[DM + k0 + lane]), c1b = silu_f(F.c[DM + k0 + 64 + lane]);
        const float* wp = F.ada_w + ((size_t)l * DM + k0) * MODW + nch * 256 + 4 * lane;
        f32x4 a0 = {0.f, 0.f, 0.f, 0.f}, a1 = {0.f, 0.f, 0.f, 0.f};
#pragma unroll 8
        for (int k = 0; k < 64; ++k) { const f32x4 w = *(const f32x4*)(wp + (size_t)k * MODW); const float s0 = __shfl(c0a, k), s1 = __shfl(c1a, k); a0 += w * s0; a1 += w * s1; }
#pragma unroll 8
        for (int k = 0; k < 64; ++k) { const f32x4 w = *(const f32x4*)(wp + (size_t)(64 + k) * MODW); const float s0 = __shfl(c0b, k), s1 = __shfl(c1b, k); a0 += w * s0; a1 += w * s1; }
        float* pp = part + (((size_t)l * NKC + kc) * BATCH) * MODW + nch * 256 + 4 * lane;
        *(f32x4*)pp = a0; *(f32x4*)(pp + MODW) = a1;
    }
}
__device__ __forceinline__ void p0b_modreduce(Frame& F) {
    PHASE_IDS();
    const float* part = (const float*)(F.ws + WS_PART); float* mod = (float*)(F.ws + WS_MOD);
    for (int i = blockIdx.x * (NWAVES * 64) + tid; i < DEPTH * BATCH * MODW; i += F.G * NWAVES * 64) {
        const int n = i % MODW, b = (i / MODW) % BATCH, l = i / (MODW * BATCH);
        float s = F.ada_b[l * MODW + n];
#pragma unroll
        for (int kc = 0; kc < 16; ++kc) s += part[(((size_t)l * 16 + kc) * BATCH + b) * MODW + n];
        mod[i] = s;
    }
}
__device__ __forceinline__ void rows_pre(Frame& F, const float* x, const float* ng, const float* scale, const float* shift, bf16* H) {
    PHASE_IDS();
    for (int m = gw; m < M; m += F.NGW) {
        const int b = m / SEQ; f32x4 v[8]; float ss = 0.f;
#pragma unroll
        for (int j = 0; j < 8; ++j) { v[j] = *(const f32x4*)(x + (size_t)m * DM + 4 * lane + 256 * j); ss += (v[j].x * v[j].x + v[j].y * v[j].y) + (v[j].z * v[j].z + v[j].w * v[j].w); }
        const float r = 1.f / sqrtf(wave_sum(ss) * (1.f / DM) + EPS);
#pragma unroll
        for (int j = 0; j < 8; ++j) { const int c = 4 * lane + 256 * j;
            const f32x4 g = *(const f32x4*)(ng + c), sc = *(const f32x4*)(scale + (size_t)b * MODW + c), sh = *(const f32x4*)(shift + (size_t)b * MODW + c);
            const f32x4 h = (v[j] * r) * g * (sc + 1.f) + sh;
            v2u o; o.x = pk2(h.x, h.y); o.y = pk2(h.z, h.w); *(v2u*)(H + (size_t)m * DM + c) = o; }
    }
}
__device__ __forceinline__ void rows_post(Frame& F, const float* Y, const float* xs, float* xd, const float* gate, const float* nga,
                                          const float* ngb, const float* scale, const float* shift, bf16* H, bool doH) {
    PHASE_IDS();
    for (int m = gw; m < M; m += F.NGW) {
        const int b = m / SEQ; f32x4 v[8]; float ss = 0.f;
#pragma unroll
        for (int j = 0; j < 8; ++j) { v[j] = *(const f32x4*)(Y + (size_t)m * DM + 4 * lane + 256 * j); ss += (v[j].x * v[j].x + v[j].y * v[j].y) + (v[j].z * v[j].z + v[j].w * v[j].w); }
        const float r = 1.f / sqrtf(wave_sum(ss) * (1.f / DM) + EPS); float ss2 = 0.f;
#pragma unroll
        for (int j = 0; j < 8; ++j) { const int c = 4 * lane + 256 * j;
            const f32x4 xv = *(const f32x4*)(xs + (size_t)m * DM + c), g = *(const f32x4*)(gate + (size_t)b * MODW + c), na = *(const f32x4*)(nga + c);
            v[j] = xv + g * ((v[j] * r) * na);
            ss2 += (v[j].x * v[j].x + v[j].y * v[j].y) + (v[j].z * v[j].z + v[j].w * v[j].w);
            *(f32x4*)(xd + (size_t)m * DM + c) = v[j]; }
        if (doH) {
            const float r2 = 1.f / sqrtf(wave_sum(ss2) * (1.f / DM) + EPS);
#pragma unroll
            for (int j = 0; j < 8; ++j) { const int c = 4 * lane + 256 * j;
                const f32x4 g = *(const f32x4*)(ngb + c), sc = *(const f32x4*)(scale + (size_t)b * MODW + c), sh = *(const f32x4*)(shift + (size_t)b * MODW + c);
                const f32x4 h = (v[j] * r2) * g * (sc + 1.f) + sh;
                v2u o; o.x = pk2(h.x, h.y); o.y = pk2(h.z, h.w); *(v2u*)(H + (size_t)m * DM + c) = o; }
        }
    }
}
__device__ __forceinline__ void rows_subln(Frame& F, const float* A0, const float* A1, const float* lamp, const float* sg, float lambda_init, bf16* O) {
    PHASE_IDS();
    const float l0 = lamp[lane] * lamp[128 + lane] + lamp[64 + lane] * lamp[128 + 64 + lane];
    const float l1 = lamp[256 + lane] * lamp[384 + lane] + lamp[256 + 64 + lane] * lamp[384 + 64 + lane];
    const float lam = __expf(wave_sum(l0)) - __expf(wave_sum(l1)) + lambda_init;
    const f32x4 g = *(const f32x4*)(sg + 4 * lane) * (1.f - lambda_init);
    for (int m = gw; m < M; m += F.NGW) {
#pragma unroll
        for (int j = 0; j < 8; ++j) { const size_t off = (size_t)m * DM + 4 * lane + 256 * j;
            const f32x4 d = *(const f32x4*)(A0 + off) - *(const f32x4*)(A1 + off) * lam;
            const float ss = wave_sum((d.x * d.x + d.y * d.y) + (d.z * d.z + d.w * d.w));
            const float r = 1.f / sqrtf(ss * (1.f / 256.f) + EPS);
            const f32x4 h = (d * r) * g;
            v2u o; o.x = pk2(h.x, h.y); o.y = pk2(h.z, h.w); *(v2u*)(O + off) = o; }
    }
}
__device__ __forceinline__ void rows_bmerge(Frame& F, const float* OB, const float* LSE, bf16* O) {
    PHASE_IDS();
    for (int m = gw; m < M; m += F.NGW) {
        const int hb = lane >> 4;
        const float e0 = LSE[(size_t)m * 4 + hb], e1 = LSE[((size_t)M + m) * 4 + hb], e2 = LSE[((size_t)2 * M + m) * 4 + hb];
        const float mx = fmaxf(e0, fmaxf(e1, e2));
        float w0 = __expf(e0 - mx), w1 = __expf(e1 - mx), w2 = __expf(e2 - mx); const float inv = 1.f / (w0 + w1 + w2); w0 *= inv; w1 *= inv; w2 *= inv;
        const float* p = OB + (size_t)m * 512 + 8 * lane;
        const f32x4 a0 = *(const f32x4*)p, a1 = *(const f32x4*)(p + 4);
        const f32x4 b0 = *(const f32x4*)(p + (size_t)M * 512), b1 = *(const f32x4*)(p + (size_t)M * 512 + 4);
        const f32x4 c0 = *(const f32x4*)(p + (size_t)2 * M * 512), c1 = *(const f32x4*)(p + (size_t)2 * M * 512 + 4);
        const f32x4 r0 = a0 * w0 + b0 * w1 + c0 * w2, r1 = a1 * w0 + b1 * w1 + c1 * w2;
        v4u o; o.x = pk2(r0.x, r0.y); o.y = pk2(r0.z, r0.w); o.z = pk2(r1.x, r1.y); o.w = pk2(r1.z, r1.w);
        *(v4u*)(O + (size_t)m * AB_OUT + 512 + 8 * lane) = o;
    }
}
__device__ __forceinline__ float gelu_tanh(float v) {
    const float u = 0.7978845608028654f * (v + 0.044715f * v * v * v);
    const float e = __expf(2.f * u);
    const float t = 1.f - 2.f / (e + 1.f);
    return 0.5f * v * (1.f + t);
}
__device__ __forceinline__ void phase_act(Frame& F, const bf16* GU, const float* cw, const float* cb, bf16* ACT) {
    PHASE_IDS();
    constexpr int NC8 = DFF / 8, RB = 8, NRB = M / RB;
    for (int it = blockIdx.x * (NWAVES * 64) + tid; it < NRB * NC8; it += F.G * NWAVES * 64) {
        const int c8 = it % NC8, rb = it / NC8, c = c8 * 8, m0 = rb * RB;
        float w0[8], w1[8], w2[8], bb[8];
#pragma unroll
        for (int i = 0; i < 8; ++i) { w0[i] = cw[c + i]; w1[i] = cw[DFF + c + i]; w2[i] = cw[2 * DFF + c + i]; bb[i] = cb[c + i]; }
        v4u gp, gc, gn;
        if ((m0 % SEQ) == 0) gp = (v4u){0u, 0u, 0u, 0u}; else gp = *(const v4u*)(GU + (size_t)(m0 - 1) * UPW + c);
        gc = *(const v4u*)(GU + (size_t)m0 * UPW + c);
#pragma unroll
        for (int rr = 0; rr < RB; ++rr) {
            const int m = m0 + rr;
            if ((m % SEQ) == SEQ - 1) gn = (v4u){0u, 0u, 0u, 0u}; else gn = *(const v4u*)(GU + (size_t)(m + 1) * UPW + c);
            const v4u up = *(const v4u*)(GU + (size_t)m * UPW + DFF + c);
            float r[8];
#pragma unroll
            for (int q = 0; q < 4; ++q) {
                const float a_lo = w0[2 * q] * bf_lo(gp[q]) + w1[2 * q] * bf_lo(gc[q]) + w2[2 * q] * bf_lo(gn[q]) + bb[2 * q];
                const float a_hi = w0[2 * q + 1] * bf_hi(gp[q]) + w1[2 * q + 1] * bf_hi(gc[q]) + w2[2 * q + 1] * bf_hi(gn[q]) + bb[2 * q + 1];
                r[2 * q] = gelu_tanh(a_lo) * bf_lo(up[q]); r[2 * q + 1] = gelu_tanh(a_hi) * bf_hi(up[q]);
            }
            v4u o; o.x = pk2(r[0], r[1]); o.y = pk2(r[2], r[3]); o.z = pk2(r[4], r[5]); o.w = pk2(r[6], r[7]);
            *(v4u*)(ACT + (size_t)m * DFF + c) = o;
            gp = gc; gc = gn;
        }
    }
}
__device__ __forceinline__ float alibi16(int i) { return exp2f(-0.5f * (float)(i + 1)); }
__device__ __forceinline__ void phase_attn_ab(Frame& F, int jl) {
    const bf16* P = (const bf16*)(F.ws + WS_PROJ); bf16* O = (bf16*)(F.ws + WS_O); float* OB = (float*)(F.ws + WS_ATT); float* LSE = (float*)(F.ws + WS_LSE);
    for (int u = blockIdx.x; u < 512; u += F.G) {
        att::UnitArgs a;
        if (u < 128) {
            const int qb = u % 16, qh = (u / 16) % 4, b = u / 64, q0 = qb * 256; const size_t row0 = (size_t)b * SEQ;
            a.Q = P + (row0 + q0) * AB_IN + qh * 128; a.ldq = AB_IN;
            a.K = P + row0 * AB_IN + 512 + (qh >> 1) * 128; a.V = P + row0 * AB_IN + 768 + (qh >> 1) * 128; a.ldk = AB_IN;
            a.q0 = q0; a.L = SEQ; a.kt0 = q0 / 64 - 2; a.nt = 8;
            a.nsl = -alibi16(qh) / att::SCALE; a.radius = 128.f; a.m_init = F.a_sink[jl * 4 + qh] / att::SCALE; a.l_init = 1.f;
            a.Of = nullptr; a.Ob = O + (row0 + q0) * AB_OUT + qh * 128; a.ldo = AB_OUT; a.lse = nullptr; a.ldl = 0;
        } else {
            const int v = (u - 128) % 128, gi = (u - 128) / 128, dil = gi == 0 ? 1 : (gi == 1 ? 4 : 16), L = SEQ / dil;
            int qb, r, hb, b;
            if (gi == 0) { qb = v % 16; r = 0; hb = (v / 16) % 4; b = v / 64; }
            else if (gi == 1) { qb = v % 4; r = (v / 4) % 4; hb = (v / 16) % 4; b = v / 64; }
            else { qb = 0; r = v % 16; hb = (v / 16) % 4; b = v / 64; }
            const int q0 = qb * 256; const size_t seq0 = (size_t)b * SEQ + r, rowq = seq0 + (size_t)dil * q0;
            a.Q = P + rowq * AB_IN + 1024 + gi * 512 + hb * 128; a.ldq = (long)dil * AB_IN;
            a.K = P + seq0 * AB_IN + 2560 + hb * 128; a.V = P + seq0 * AB_IN + 3072 + hb * 128; a.ldk = (long)dil * AB_IN;
            a.q0 = q0; a.L = L; a.kt0 = q0 / 64 - 1; a.nt = 6;
            a.nsl = -alibi16(4 + gi * 4 + hb) * (float)dil / att::SCALE; a.radius = 64.f; a.m_init = att::M_INIT; a.l_init = 0.f;
            a.Of = OB + ((size_t)gi * M + rowq) * 512 + hb * 128; a.Ob = nullptr; a.ldo = (long)dil * 512;
            a.lse = LSE + ((size_t)gi * M + rowq) * 4 + hb; a.ldl = (long)dil * 4;
        }
        att::attn_unit<true, 1>(a, F.ldsg + RING_OFF);
    }
}
__device__ __forceinline__ void phase_attn_c(Frame& F) {
    const bf16* P = (const bf16*)(F.ws + WS_PROJ); float* AT = (float*)(F.ws + WS_ATT);
    for (int u = blockIdx.x; u < 1024; u += F.G) {
        const int qb = u % 16, vh = (u / 16) % 2, j = (u / 32) % 2, h = (u / 64) % 8, b = u / 512, q0 = qb * 256; const size_t row0 = (size_t)b * SEQ;
        att::UnitArgs a;
        a.Q = P + (row0 + q0) * C_IN + h * 256 + j * 128; a.ldq = C_IN;
        a.K = P + row0 * C_IN + 2048 + h * 256 + j * 128; a.V = P + row0 * C_IN + 4096 + h * 256 + vh * 128; a.ldk = C_IN;
        a.q0 = q0; a.L = SEQ; a.kt0 = 0; a.nt = SEQ / 64;
        a.nsl = -exp2f(-(float)(h + 1)) / att::SCALE; a.radius = 0.f; a.m_init = att::M_INIT; a.l_init = 0.f;
        a.Of = AT + ((size_t)j * M + row0 + q0) * DM + h * 256 + vh * 128; a.Ob = nullptr; a.ldo = DM; a.lse = nullptr; a.ldl = 0;
        att::attn_unit<false, 2>(a, F.ldsg + RING_OFF);
    }
}

constexpr int N_PHASES = 3 + 5 * 8;
struct Args { const float* in[16]; float* out; unsigned char* ws; int lo, hi; };
template <int MASK> __global__ void __launch_bounds__(NWAVES * 64, 2) enc_fwd(Args args) {
    extern __shared__ __attribute__((aligned(16))) unsigned char lds[];
    Frame F;
    F.lds = (LAS unsigned char*)lds; F.ldsg = (char*)lds;
    F.tid = threadIdx.x; F.lane = F.tid & 63; F.wave = __builtin_amdgcn_readfirstlane(F.tid >> 6);
    F.G = gridDim.x; F.gw = blockIdx.x * NWAVES + F.wave; F.NGW = F.G * NWAVES;
    F.x = args.in[0]; F.c = args.in[1]; F.ada_w = args.in[2]; F.ada_b = args.in[3]; F.norm_g = args.in[4]; F.ab_w_in = args.in[5]; F.ab_w_out = args.in[6]; F.a_sink = args.in[7];
    F.c_w_in = args.in[8]; F.c_w_out = args.in[9]; F.c_lambda = args.in[10]; F.c_subln_g = args.in[11]; F.w_up = args.in[12]; F.conv_w = args.in[13]; F.conv_b = args.in[14]; F.w_down = args.in[15];
    F.out = args.out; F.ws = args.ws;
    gu32* ctl = (gu32*)(F.ws + WS_CTL);
    for (int u = F.tid; u < (LDS_BYTES - LDSCTL_OFF) / 4; u += NWAVES * 64) ((LAS unsigned*)(F.lds + LDSCTL_OFF))[u] = 0u;
    __syncthreads();
    const int lo = args.lo, hi = args.hi;
    const bool multi = (hi - lo) > 1;
    XcdBarrier bar; bar.bar = (unsigned*)(ctl + CW_BAR); bar.x = 0; bar.st = nullptr;
    if (multi) bar = xcd_barrier_post((unsigned*)(ctl + CW_BAR), (volatile LAS unsigned*)(F.lds + MISC_OFF) + 8);
#define IN(k) (lo <= (k) && (k) < hi)
#define SEAM(k) do { if (IN(k) && IN((k) + 1)) xcd_barrier(bar); } while (0)
    float* mod = (float*)(F.ws + WS_MOD);
    bf16* H = (bf16*)(F.ws + WS_H); bf16* PROJ = (bf16*)(F.ws + WS_PROJ); bf16* O = (bf16*)(F.ws + WS_O); float* Y = (float*)(F.ws + WS_Y);
    bf16* GU = (bf16*)(F.ws + WS_GU); bf16* ACT = (bf16*)(F.ws + WS_ACT); float* AT = (float*)(F.ws + WS_ATT);

    if constexpr (MASK & 1) { if (IN(0)) { p0a_prologue(F); } } SEAM(0);
    if constexpr (MASK & 2) { if (IN(1)) { p0b_modreduce(F); } } SEAM(1);
    if constexpr (MASK & 2) { if (IN(2)) { rows_pre(F, F.x, F.norm_g, mod + 1 * DM, mod + 0 * DM, H); } } SEAM(2);

    for (int s = 0; s < 8; ++s) {
        const int l = s >> 1, sub = s & 1, jl = l >> 1, even = !(l & 1), base = 3 + 5 * s;
        if (base + 5 <= lo || base >= hi) continue;
        const float* modl = mod + (size_t)l * BATCH * MODW;
        if constexpr (MASK & 4) if (IN(base)) {
            pg8::Gemm g; bf16* dst; int N;
            if (sub == 0) { if (even) { N = AB_IN; g.Bt = (const bf16*)(F.ws + WS_WABIN) + (size_t)jl * AB_IN * DM; } else { N = C_IN; g.Bt = (const bf16*)(F.ws + WS_WCIN) + (size_t)jl * C_IN * DM; } dst = PROJ; }
            else { N = UPW; g.Bt = (const bf16*)(F.ws + WS_WUP) + (size_t)l * UPW * DM; dst = GU; }
            g.A = H; g.M = M; g.N = N; g.K = DM;
            pg8::StaticOrder S; S.init(M, N, F.G, (int)blockIdx.x);
            pg8::EpiBf16<0> E{dst, N, nullptr, 0, 0, 1.f};
            pg8::gemm_phase<pg8::EpiBf16<0>, pg8::StaticOrder, true, true>(F.lds + RING_OFF, g, S, E);
        }
        SEAM(base);
        if (IN(base + 1)) {
            if (sub == 0) { if (even) { if constexpr (MASK & 16) phase_attn_ab(F, jl); } else { if constexpr (MASK & 32) phase_attn_c(F); } }
            else { if constexpr (MASK & 2) phase_act(F, GU, F.conv_w + (size_t)l * 3 * DFF, F.conv_b + (size_t)l * DFF, ACT); }
        }
        SEAM(base + 1);
        if constexpr (MASK & 2) if (IN(base + 2) && sub == 0) {
            if (even) rows_bmerge(F, AT, (const float*)(F.ws + WS_LSE), O);
            else rows_subln(F, AT, AT + (size_t)M * DM, F.c_lambda + (size_t)jl * 4 * 128, F.c_subln_g + (size_t)jl * 256, 0.8f - 0.6f * __expf(-0.3f * (float)l), O);
        }
        if (sub == 0) SEAM(base + 2);
        if constexpr (MASK & 8) if (IN(base + 3)) {
            pg8::Gemm g; int K;
            if (sub == 0) { if (even) { K = AB_OUT; g.Bt = (const bf16*)(F.ws + WS_WABOUT) + (size_t)jl * DM * AB_OUT; } else { K = DM; g.Bt = (const bf16*)(F.ws + WS_WCOUT) + (size_t)jl * DM * DM; } g.A = O; }
            else { K = DFF; g.Bt = (const bf16*)(F.ws + WS_WDOWN) + (size_t)l * DM * DFF; g.A = ACT; }
            g.M = M; g.N = DM; g.K = K;
            pg8::StaticOrder S; S.init(M, DM, F.G, (int)blockIdx.x);
            pg8::EpiF32 E{Y, DM, nullptr};
            pg8::gemm_phase<pg8::EpiF32, pg8::StaticOrder, false, true>(F.lds + RING_OFF, g, S, E);
        }
        SEAM(base + 3);
        if constexpr (MASK & 2) if (IN(base + 4)) {
            const float* xs = (s == 0) ? F.x : F.out;
            if (sub == 0) rows_post(F, Y, xs, F.out, modl + 2 * DM, F.norm_g + ((size_t)l * 4 + 1) * DM, F.norm_g + ((size_t)l * 4 + 2) * DM, modl + 4 * DM, modl + 3 * DM, H, true);
            else { const int ln = l + 1 < DEPTH ? l + 1 : l; const float* modn = mod + (size_t)ln * BATCH * MODW;
                rows_post(F, Y, xs, F.out, modl + 5 * DM, F.norm_g + ((size_t)l * 4 + 3) * DM, F.norm_g + ((size_t)ln * 4 + 0) * DM, modn + 1 * DM, modn + 0 * DM, H, l + 1 < DEPTH); }
        }
        SEAM(base + 4);
    }
#undef IN
#undef SEAM
}

#ifndef ENC_LAUNCH_PER_PHASE
#define ENC_LAUNCH_PER_PHASE 0
#endif
extern "C" void kernel_launch(void* const* d_in, const int* in_sizes, int n_in, void* d_out, int out_size, void* d_ws, size_t ws_size, hipStream_t stream) {
    static int grid = 0;
    if (grid == 0) {
        if (n_in != 16 || in_sizes[0] != M * DM || out_size != M * DM || ws_size < WS_END) { fprintf(stderr, "kernel_launch: unexpected shapes (n_in %d, in0 %d, out %d, ws %zu < %zu)\n", n_in, n_in > 0 ? in_sizes[0] : -1, out_size, ws_size, (size_t)WS_END); grid = -1; return; }
        int dev = 0, cus = 0, per_cu = 0;
        if (hipGetDevice(&dev) != hipSuccess || hipDeviceGetAttribute(&cus, hipDeviceAttributeMultiprocessorCount, dev) != hipSuccess) { grid = -1; return; }
#if ENC_LAUNCH_PER_PHASE
        const void* fns[6] = {(const void*)enc_fwd<1>, (const void*)enc_fwd<2>, (const void*)enc_fwd<4>, (const void*)enc_fwd<8>, (const void*)enc_fwd<16>, (const void*)enc_fwd<32>};
        for (int i = 0; i < 6; ++i) if (hipFuncSetAttribute(fns[i], hipFuncAttributeMaxDynamicSharedMemorySize, LDS_BYTES) != hipSuccess) { fprintf(stderr, "kernel_launch: hipFuncSetAttribute failed\n"); grid = -1; return; }
#else
        if (hipFuncSetAttribute((const void*)enc_fwd<63>, hipFuncAttributeMaxDynamicSharedMemorySize, LDS_BYTES) != hipSuccess) { fprintf(stderr, "kernel_launch: hipFuncSetAttribute failed\n"); grid = -1; return; }
#endif
#if !ENC_LAUNCH_PER_PHASE
        if (hipOccupancyMaxActiveBlocksPerMultiprocessor(&per_cu, (const void*)enc_fwd<63>, NWAVES * 64, LDS_BYTES) != hipSuccess || per_cu < 1) { fprintf(stderr, "kernel_launch: occupancy query says %d\n", per_cu); }
#endif
        (void)hipGetLastError();
        grid = cus;
    }
    if (grid < 0) return;
    (void)hipMemsetAsync((char*)d_ws + WS_CTL, 0, CTL_ZERO_BYTES, stream);
    Args a{};
    for (int i = 0; i < 16; ++i) a.in[i] = (const float*)d_in[i];
    a.out = (float*)d_out; a.ws = (unsigned char*)d_ws;
#if ENC_LAUNCH_PER_PHASE
    for (int p = 0; p < N_PHASES; ++p) {
        a.lo = p; a.hi = p + 1;
        int kind;
        if (p == 0) kind = 1; else if (p < 3) kind = 2;
        else { const int s = (p - 3) / 5, q = (p - 3) % 5, sub = s & 1, even = !((s >> 1) & 1);
            if (q == 0) kind = 4; else if (q == 3) kind = 8; else if (q == 1 && sub == 0) kind = even ? 16 : 32; else if (q == 2 && sub == 1) continue; else kind = 2; }
        switch (kind) {
            case 1:  hipLaunchKernelGGL(enc_fwd<1>,  dim3(grid), dim3(NWAVES * 64), LDS_BYTES, stream, a); break;
            case 2:  hipLaunchKernelGGL(enc_fwd<2>,  dim3(grid), dim3(NWAVES * 64), LDS_BYTES, stream, a); break;
            case 4:  hipLaunchKernelGGL(enc_fwd<4>,  dim3(grid), dim3(NWAVES * 64), LDS_BYTES, stream, a); break;
            case 8:  hipLaunchKernelGGL(enc_fwd<8>,  dim3(grid), dim3(NWAVES * 64), LDS_BYTES, stream, a); break;
            case 16: hipLaunchKernelGGL(enc_fwd<16>, dim3(grid), dim3(NWAVES * 64), LDS_BYTES, stream, a); break;
            default: hipLaunchKernelGGL(enc_fwd<32>, dim3(grid), dim3(NWAVES * 64), LDS_BYTES, stream, a); break;
        }
    }
#else
    a.lo = 0; a.hi = N_PHASES;
    hipLaunchKernelGGL(enc_fwd<63>, dim3(grid), dim3(NWAVES * 64), LDS_BYTES, stream, a);
#endif
}
```

```cpp
#include <hip/hip_runtime.h>
#include <cstdio>
#include <cstdint>
namespace pg8 {
#define PG8_LAS __attribute__((address_space(3)))
typedef unsigned short bf16_t;
typedef short bf16x8 __attribute__((ext_vector_type(8)));
typedef float f32x4 __attribute__((ext_vector_type(4)));
typedef unsigned u32x4 __attribute__((ext_vector_type(4)));
constexpr int BM = 256, BK = 64, HALF = 128, HTB = HALF * BK * 2  , STAGE_BYTES = 8 * HTB, NXCD = 8, WGM = 8;

__host__ __device__ __forceinline__ int lds_byte(int r, int c) { const int st = (r >> 4) * 2 + (c >> 5), rr = r & 15, cc = c & 31, ob = rr * 64 + cc * 2; return st * 1024 + (ob ^ (((ob >> 9) & 1) << 5)); }
__host__ __device__ __forceinline__ void stage_rc(int b, int& R, int& C) { const int st = b / 1024, sb = b % 1024, swz = sb ^ (((sb >> 9) & 1) << 5); R = (st >> 1) * 16 + swz / 64; C = (st & 1) * 32 + (swz % 64) / 2; }
__host__ __device__ __forceinline__ int perm32(int rho) { const int n = rho >> 4, i = rho & 15; return 8 * (i >> 2) + 4 * n + (i & 3); }

struct Unit { int pm, pn; };
struct Gemm { const bf16_t* A; const bf16_t* Bt; int M, N, K; };

struct StaticOrder {
    int nM, nN, nwg, G, c;
    __host__ __device__ void init(int M, int N, int G_, int c_) { nM = M / BM; nN = N / BM; nwg = nM * nN; G = G_; c = c_; }
    __host__ __device__ bool next(int i, Unit& u) const {
        const long L = (long)i * G + c; if (L >= nwg) return false;
        int wgid = (int)L; { const int q = nwg / NXCD, r = nwg % NXCD, xcd = wgid % NXCD, off = wgid / NXCD; wgid = (xcd < r ? xcd * (q + 1) : r * (q + 1) + (xcd - r) * q) + off; }
        const int nig = WGM * nN, gid = wgid / nig, fm = gid * WGM, gsz = (nM - fm) < WGM ? (nM - fm) : WGM;
        u.pm = fm + ((wgid % nig) % gsz); u.pn = (wgid % nig) / gsz; return true;
    }
    __device__ __forceinline__ void a_ready(const Unit&) const {}
    __device__ __forceinline__ void done(const Unit&) const {}
};

__device__ __forceinline__ unsigned cvt_pk_bf16(float lo, float hi) { unsigned r; asm volatile("v_cvt_pk_bf16_f32 %0, %1, %2" : "=v"(r) : "v"(lo), "v"(hi)); return r; }
typedef float f32x2 __attribute__((ext_vector_type(2)));
__device__ __forceinline__ f32x2 gelu_pk(f32x2 v) {
    const f32x2 av = __builtin_elementwise_abs(v), d = av * 0.2316418882f + 1.0f;
    f32x2 t; t.x = __builtin_amdgcn_rcpf(d.x); t.y = __builtin_amdgcn_rcpf(d.y);
    f32x2 q = t * 0.5307027145f + (-0.7265760135f); q = q * t + 0.7107068705f; q = q * t + (-0.142248368f); q = q * t + 0.127414796f; q = q * t;
    const f32x2 s = (v * v) * (-0.72134752044f);
    f32x2 e; e.x = __builtin_amdgcn_exp2f(s.x); e.y = __builtin_amdgcn_exp2f(s.y);
    const f32x2 m = v * (q * e), r = v - m;
    f32x2 o; o.x = v.x < 0.f ? m.x : r.x; o.y = v.y < 0.f ? m.y : r.y; return o;
}

template <int ACT  > struct EpiBf16 {
    static constexpr bool PERM = true, AFTER_DRAIN = false; static_assert(ACT == 0 || ACT == 1, "EpiBf16: ACT is 0 (none) or 1 (gelu_pk)");
    bf16_t* O; int ldc; const float* bias; int split_cols; size_t split_stride; float scale0;
    __device__ __forceinline__ void operator()(const f32x4 (&acc)[2][2][4][2], const Unit& u, int wr, int wc, int fr, int fq) const {
        const int row0 = u.pm * BM + wr * 64 + fr; int colt = u.pn * BM; bf16_t* base = O;
        float sc = 1.f; if (split_cols) { const int t = colt / split_cols; base += (size_t)t * split_stride; colt -= t * split_cols; if (t == 0) sc = scale0; }
        const int col0 = colt + wc * 32 + 8 * fq, bcol0 = u.pn * BM + wc * 32 + 8 * fq;
        f32x4 bv[2][2];
#pragma unroll
        for (int bj = 0; bj < 2; ++bj)
#pragma unroll
            for (int n = 0; n < 2; ++n) bv[bj][n] = bias ? *(const f32x4*)(bias + bcol0 + bj * HALF + 4 * n) : (f32x4){0.f, 0.f, 0.f, 0.f};
#pragma unroll
        for (int ai = 0; ai < 2; ++ai)
#pragma unroll
            for (int m = 0; m < 4; ++m) { bf16_t* rowp = base + (size_t)(row0 + ai * HALF + m * 16) * ldc + col0;
#pragma unroll
                for (int bj = 0; bj < 2; ++bj) { f32x4 v0 = acc[ai][bj][m][0] + bv[bj][0], v1 = acc[ai][bj][m][1] + bv[bj][1];
                    if (ACT == 1) { f32x2 a = gelu_pk((f32x2){v0[0], v0[1]}), b = gelu_pk((f32x2){v0[2], v0[3]}), c = gelu_pk((f32x2){v1[0], v1[1]}), d = gelu_pk((f32x2){v1[2], v1[3]});
                        v0 = (f32x4){a.x, a.y, b.x, b.y}; v1 = (f32x4){c.x, c.y, d.x, d.y}; }
                    v0 = v0 * sc; v1 = v1 * sc; u32x4 w; w.x = cvt_pk_bf16(v0[0], v0[1]); w.y = cvt_pk_bf16(v0[2], v0[3]); w.z = cvt_pk_bf16(v1[0], v1[1]); w.w = cvt_pk_bf16(v1[2], v1[3]);
                    *(u32x4*)(rowp + bj * HALF) = w; } }
    }
};
struct EpiF32 {
    static constexpr bool PERM = false, AFTER_DRAIN = false;
    float* C; int ldc; const float* bias;
    __device__ __forceinline__ void operator()(const f32x4 (&acc)[2][2][4][2], const Unit& u, int wr, int wc, int fr, int fq) const {
        const int row0 = u.pm * BM + wr * 64 + fr, col0 = u.pn * BM + wc * 32 + 4 * fq;
        f32x4 bv[2][2];
#pragma unroll
        for (int bj = 0; bj < 2; ++bj)
#pragma unroll
            for (int n = 0; n < 2; ++n) bv[bj][n] = bias ? *(const f32x4*)(bias + col0 + bj * HALF + n * 16) : (f32x4){0.f, 0.f, 0.f, 0.f};
#pragma unroll
        for (int ai = 0; ai < 2; ++ai)
#pragma unroll
            for (int m = 0; m < 4; ++m) { float* rowp = C + (size_t)(row0 + ai * HALF + m * 16) * ldc + col0;
#pragma unroll
                for (int bj = 0; bj < 2; ++bj)
#pragma unroll
                    for (int n = 0; n < 2; ++n) *(f32x4*)(rowp + bj * HALF + n * 16) = acc[ai][bj][m][n] + bv[bj][n]; }
    }
};
template <class Epi, class Sched, bool ALIGN_EPI = false, bool SP2 = false>
__device__ __forceinline__ void gemm_phase(PG8_LAS unsigned char* lds, const Gemm g, const Sched& S, const Epi& E) {
    int tid_ = threadIdx.x; asm volatile("" : "+v"(tid_));
    const int tid = tid_, wid = __builtin_amdgcn_readfirstlane(tid >> 6), lane = tid & 63, wr = wid >> 2, wc = wid & 3, fr = lane & 15, fq = lane >> 4;
    const int K = g.K, nt = K / BK;
    unsigned voffA[2], voffB[2];
#pragma unroll
    for (int i = 0; i < 2; ++i) { int R, C; stage_rc(tid * 16 + i * 8192, R, C); const int Rb = Epi::PERM ? ((R & ~31) + perm32(R & 31)) : R;
        voffA[i] = (unsigned)(R * K + C) * 2u; voffB[i] = (unsigned)(Rb * K + C) * 2u; }
    const size_t kstep = (size_t)(BK * 2);
    const size_t hstep = (size_t)HALF * K * 2;
    const size_t tstep = 2 * hstep;
    const unsigned ldsw = (unsigned)wid * 1024u;
    const int aoff = lds_byte(wr * 64 + fr, fq * 8), boff = lds_byte(wc * 32 + fr, fq * 8);
#define PG8_SA(b, h) (((b) * 2 + (h)) * HTB)
#define PG8_SB(b, h) ((4 + (b) * 2 + (h)) * HTB)
#define PG8_STAGE(bufoff, gbase, voff) do { _Pragma("unroll") for (int _i = 0; _i < 2; ++_i) \
        __builtin_amdgcn_global_load_lds((const unsigned*)((const char*)(gbase) + (voff)[_i]), (PG8_LAS unsigned*)(lds + (bufoff) + ldsw + _i * 8192), 16, 0, 0); } while (0)
#define PG8_LDA(dst, b, h) do { _Pragma("unroll") for (int m = 0; m < 4; ++m) _Pragma("unroll") for (int k = 0; k < 2; ++k) dst[m][k] = *(const PG8_LAS bf16x8*)(lds + PG8_SA(b, h) + aoff + m * 2048 + k * 1024); } while (0)
#define PG8_LDB(dst, b, h) do { _Pragma("unroll") for (int n = 0; n < 2; ++n) _Pragma("unroll") for (int k = 0; k < 2; ++k) dst[n][k] = *(const PG8_LAS bf16x8*)(lds + PG8_SB(b, h) + boff + n * 2048 + k * 1024); } while (0)
#define PG8_MMA(ai, bj, At, Bt) do { __builtin_amdgcn_s_setprio(1); _Pragma("unroll") for (int m = 0; m < 4; ++m) _Pragma("unroll") for (int n = 0; n < 2; ++n) _Pragma("unroll") for (int k = 0; k < 2; ++k) \
        acc[ai][bj][m][n] = __builtin_amdgcn_mfma_f32_16x16x32_bf16(Bt[n][k], At[m][k], acc[ai][bj][m][n], 0, 0, 0); __builtin_amdgcn_s_setprio(0); } while (0)
#define PG8_WAIT_V(n) asm volatile("s_waitcnt vmcnt(" #n ")" ::: "memory")
#define PG8_WAIT_L(n) asm volatile("s_waitcnt lgkmcnt(" #n ")" ::: "memory")
#define PG8_BAR __builtin_amdgcn_s_barrier()
#define PG8_SCHED __builtin_amdgcn_sched_barrier(0)
    Unit cur, nxt; int ui = 0;
    if (!S.next(0, cur)) return;
    f32x4 acc[2][2][4][2];
#pragma unroll
    for (int a = 0; a < 2; ++a)
#pragma unroll
        for (int b = 0; b < 2; ++b)
#pragma unroll
            for (int m = 0; m < 4; ++m)
#pragma unroll
                for (int n = 0; n < 2; ++n) acc[a][b][m][n] = (f32x4){0.f, 0.f, 0.f, 0.f};
    bf16x8 At[4][2], B0[2][2], B1[2][2];
    const char* cA = (const char*)g.A + (size_t)cur.pm * tstep; const char* cB = (const char*)g.Bt + (size_t)cur.pn * tstep;
    S.a_ready(cur);
    if constexpr (SP2) {
        PG8_STAGE(PG8_SB(0, 0), cB, voffB); PG8_STAGE(PG8_SB(0, 1), cB + hstep, voffB); PG8_STAGE(PG8_SA(0, 0), cA, voffA); PG8_STAGE(PG8_SA(0, 1), cA + hstep, voffA);
        if (wr == 1) PG8_BAR;
        PG8_WAIT_V(2); PG8_BAR;
        PG8_STAGE(PG8_SB(1, 0), cB + kstep, voffB); PG8_STAGE(PG8_SA(1, 0), cA + kstep, voffA); PG8_STAGE(PG8_SB(1, 1), cB + hstep + kstep, voffB);
        PG8_WAIT_V(6); PG8_BAR;
    } else {
        PG8_STAGE(PG8_SB(0, 0), cB, voffB); PG8_STAGE(PG8_SA(0, 0), cA, voffA); PG8_STAGE(PG8_SB(0, 1), cB + hstep, voffB); PG8_STAGE(PG8_SA(0, 1), cA + hstep, voffA);
        if (wr == 1) PG8_BAR;
        PG8_WAIT_V(4); PG8_BAR;
        PG8_STAGE(PG8_SB(1, 0), cB + kstep, voffB); PG8_STAGE(PG8_SA(1, 0), cA + kstep, voffA); PG8_STAGE(PG8_SB(1, 1), cB + hstep + kstep, voffB);
        PG8_WAIT_V(6); PG8_BAR;
    }
    for (;;) {
        const bool has_next = S.next(ui + 1, nxt);
        const char* nA = has_next ? (const char*)g.A + (size_t)nxt.pm * tstep : cA; const char* nB = has_next ? (const char*)g.Bt + (size_t)nxt.pn * tstep : cB;
        for (int t = 0; t < nt; t += 2) {
            const bool last = (t == nt - 2);
            const char* a1 = cA + (size_t)(t + 1) * kstep;
            const char* a2 = last ? nA : cA + (size_t)(t + 2) * kstep; const char* b2 = last ? nB : cB + (size_t)(t + 2) * kstep;
            const char* a3 = a2 + kstep; const char* b3 = b2 + kstep;
            if (last && has_next) S.a_ready(nxt);
            if constexpr (SP2) {
            PG8_LDB(B0, 0, 0); PG8_LDB(B1, 0, 1); PG8_SCHED; PG8_LDA(At, 0, 0); PG8_STAGE(PG8_SA(1, 1), a1 + hstep, voffA);
            PG8_WAIT_V(8); PG8_WAIT_L(0); PG8_BAR; PG8_MMA(0, 0, At, B0); PG8_MMA(0, 1, At, B1); PG8_BAR; PG8_SCHED;
            PG8_LDA(At, 0, 1); PG8_STAGE(PG8_SB(0, 0), b2, voffB); PG8_STAGE(PG8_SB(0, 1), b2 + hstep, voffB); PG8_STAGE(PG8_SA(0, 0), a2, voffA);
            PG8_WAIT_V(8); PG8_WAIT_L(0); PG8_BAR; PG8_MMA(1, 0, At, B0); PG8_MMA(1, 1, At, B1); PG8_BAR; PG8_SCHED;
            PG8_LDB(B0, 1, 0); PG8_LDB(B1, 1, 1); PG8_SCHED; PG8_LDA(At, 1, 0); PG8_STAGE(PG8_SA(0, 1), a2 + hstep, voffA);
            PG8_WAIT_V(8); PG8_WAIT_L(0); PG8_BAR; PG8_MMA(0, 0, At, B0); PG8_MMA(0, 1, At, B1); PG8_BAR; PG8_SCHED;
            PG8_LDA(At, 1, 1); PG8_STAGE(PG8_SB(1, 0), b3, voffB); PG8_STAGE(PG8_SB(1, 1), b3 + hstep, voffB); PG8_STAGE(PG8_SA(1, 0), a3, voffA);
            PG8_WAIT_V(8); PG8_WAIT_L(0); PG8_BAR; PG8_MMA(1, 0, At, B0); PG8_MMA(1, 1, At, B1); PG8_BAR; PG8_SCHED;
            } else {
            PG8_LDB(B0, 0, 0); PG8_SCHED; PG8_LDA(At, 0, 0); PG8_STAGE(PG8_SA(1, 1), a1 + hstep, voffA);
            PG8_WAIT_L(8); PG8_BAR; PG8_WAIT_L(0); PG8_MMA(0, 0, At, B0); PG8_BAR; PG8_SCHED;
            PG8_LDB(B1, 0, 1); PG8_STAGE(PG8_SB(0, 0), b2, voffB);
            PG8_BAR; PG8_WAIT_L(0); PG8_MMA(0, 1, At, B1); PG8_BAR;
            PG8_LDA(At, 0, 1); PG8_STAGE(PG8_SA(0, 0), a2, voffA);
            PG8_BAR; PG8_WAIT_L(0); PG8_MMA(1, 0, At, B0); PG8_BAR; PG8_SCHED;
            PG8_STAGE(PG8_SB(0, 1), b2 + hstep, voffB);
            PG8_WAIT_V(6); PG8_BAR; PG8_MMA(1, 1, At, B1); PG8_BAR;
            PG8_LDB(B0, 1, 0); PG8_SCHED; PG8_LDA(At, 1, 0); PG8_STAGE(PG8_SA(0, 1), a2 + hstep, voffA);
            PG8_WAIT_L(8); PG8_BAR; PG8_WAIT_L(0); PG8_MMA(0, 0, At, B0); PG8_BAR; PG8_SCHED;
            PG8_LDB(B1, 1, 1); PG8_STAGE(PG8_SB(1, 0), b3, voffB);
            PG8_BAR; PG8_WAIT_L(0); PG8_MMA(0, 1, At, B1); PG8_BAR;
            PG8_LDA(At, 1, 1); PG8_STAGE(PG8_SA(1, 0), a3, voffA);
            PG8_BAR; PG8_WAIT_L(0); PG8_MMA(1, 0, At, B0); PG8_BAR; PG8_SCHED;
            PG8_STAGE(PG8_SB(1, 1), b3 + hstep, voffB);
            PG8_WAIT_V(6); PG8_BAR; PG8_MMA(1, 1, At, B1); PG8_BAR;
            }
        }
        if constexpr (ALIGN_EPI) { if (wr == 0) PG8_BAR; }
        if constexpr (!Epi::AFTER_DRAIN) { E(acc, cur, wr, wc, fr, fq); S.done(cur); }
        if (!has_next) break;
#pragma unroll
        for (int a = 0; a < 2; ++a)
#pragma unroll
            for (int b = 0; b < 2; ++b)
#pragma unroll
                for (int m = 0; m < 4; ++m)
#pragma unroll
                    for (int n = 0; n < 2; ++n) acc[a][b][m][n] = (f32x4){0.f, 0.f, 0.f, 0.f};
        cur = nxt; cA = nA; cB = nB; ++ui;
        if constexpr (ALIGN_EPI) { if (wr == 1) PG8_BAR; }
    }
    PG8_WAIT_V(0);
    if constexpr (!ALIGN_EPI) { if (wr == 0) PG8_BAR; }
    PG8_BAR;
    if constexpr (Epi::AFTER_DRAIN) { E.fused(acc, cur, wr, wc, fr, fq, lds, wid, lane); S.done(cur); }
#undef PG8_SA
#undef PG8_SB
#undef PG8_STAGE
#undef PG8_LDA
#undef PG8_LDB
#undef PG8_MMA
#undef PG8_WAIT_V
#undef PG8_WAIT_L
#undef PG8_BAR
#undef PG8_SCHED
}
}
namespace att {
typedef unsigned short bf16;
using bf16x8 = __attribute__((ext_vector_type(8))) short;
using s16x4  = __attribute__((ext_vector_type(4))) short;
using f32x16 = __attribute__((ext_vector_type(16))) float;
using u32x4  = __attribute__((ext_vector_type(4))) unsigned;
constexpr int   D = 128, NW = 8, QBLK = 32, KVBLK = 64;
constexpr float SCALE = 0.088388347648318440f;
constexpr float THR = 8.f;
constexpr int SHM_V = KVBLK * D * 2, SHM_K = KVBLK * D * 2, SHM_ATTN = 2 * SHM_V + 2 * SHM_K + NW * 64 * 4;
constexpr float MASKED = -1e30f, M_INIT = -1e28f;
#define KSWZ(row, colB) ((row) * 256 + ((colB) ^ (((row) & 7) << 4)))
#define SBAR() __builtin_amdgcn_sched_barrier(0)
__device__ __forceinline__ int crow(int r, int hi) { return (r & 3) + 8 * (r >> 2) + 4 * hi; }
__device__ __forceinline__ unsigned cvtpk(float lo, float hi) {
  unsigned r; asm volatile("v_cvt_pk_bf16_f32 %0, %1, %2" : "=v"(r) : "v"(lo), "v"(hi)); return r;
}
__device__ __forceinline__ void partialSM(f32x16& p0, f32x16& p1, float& m_reg, float& mn, float& alpha) {
  constexpr float C = SCALE * 1.4426950408889634f;
  float pmax = p0[0];
#pragma unroll
  for (int r = 1; r < 16; ++r) pmax = fmaxf(pmax, p0[r]);
#pragma unroll
  for (int r = 0; r < 16; ++r) pmax = fmaxf(pmax, p1[r]);
  { auto rr = __builtin_amdgcn_permlane32_swap(__float_as_uint(pmax), __float_as_uint(pmax), false, false);
    pmax = fmaxf(__uint_as_float(rr[0]), __uint_as_float(rr[1])); }
  if (__builtin_expect(__all(pmax - m_reg <= THR / SCALE), 1)) { mn = m_reg; alpha = 1.f; }
  else { mn = fmaxf(m_reg, pmax); alpha = __builtin_amdgcn_exp2f((m_reg - mn) * C); m_reg = mn; }
  float mnC = -mn * C;
#pragma unroll
  for (int r = 0; r < 16; ++r) p0[r] = fmaf(p0[r], C, mnC);
#pragma unroll
  for (int r = 0; r < 16; ++r) p1[r] = fmaf(p1[r], C, mnC);
#pragma unroll
  for (int r = 0; r < 16; ++r) p0[r] = __builtin_amdgcn_exp2f(p0[r]);
}
__device__ __forceinline__ void finishSM(f32x16& p0, f32x16& p1, float alpha, float& l_reg, bf16x8& pa0, bf16x8& pa1, bf16x8& pa2, bf16x8& pa3) {
#pragma unroll
  for (int r = 0; r < 16; ++r) p1[r] = __builtin_amdgcn_exp2f(p1[r]);
  float ps = 0;
#pragma unroll
  for (int r = 0; r < 16; ++r) ps += p0[r];
#pragma unroll
  for (int r = 0; r < 16; ++r) ps += p1[r];
  { auto rr = __builtin_amdgcn_permlane32_swap(__float_as_uint(ps), __float_as_uint(ps), false, false);
    ps = __uint_as_float(rr[0]) + __uint_as_float(rr[1]); }
  l_reg = l_reg * alpha + ps;
#define PK4(P, BASE, OUT) do { unsigned a0 = cvtpk(P[BASE + 0], P[BASE + 1]), a1 = cvtpk(P[BASE + 2], P[BASE + 3]);   \
    unsigned b0 = cvtpk(P[BASE + 4], P[BASE + 5]), b1 = cvtpk(P[BASE + 6], P[BASE + 7]);                              \
    auto r0 = __builtin_amdgcn_permlane32_swap(a0, b0, false, false); auto r1 = __builtin_amdgcn_permlane32_swap(a1, b1, false, false); \
    u32x4 w = {r0[0], r1[0], r0[1], r1[1]}; OUT = *reinterpret_cast<bf16x8*>(&w); } while (0)
  PK4(p0, 0, pa0); PK4(p0, 8, pa1); PK4(p1, 0, pa2); PK4(p1, 8, pa3);
#undef PK4
}
template <bool BAND>
__device__ __forceinline__ void qkt(f32x16& p0, f32x16& p1, const bf16* Ks, const bf16x8* qr, int r32, int hi, float dq, float kf0, float nsl, float radius, float Lf) {
#pragma unroll
  for (int r = 0; r < 16; ++r) {
    const float c0 = (float)((r & 3) + 8 * (r >> 2));
    const float d0 = dq - c0, d1 = dq - (c0 + 32.f);
    float b0 = nsl * fabsf(d0), b1 = nsl * fabsf(d1);
    if (BAND) {
      const float ka = kf0 + c0, kb = kf0 + (c0 + 32.f);
      const bool v0 = (fabsf(d0) <= radius) && (ka >= 0.f) && (ka < Lf);
      const bool v1 = (fabsf(d1) <= radius) && (kb >= 0.f) && (kb < Lf);
      b0 = v0 ? b0 : MASKED; b1 = v1 ? b1 : MASKED;
    }
    p0[r] = b0; p1[r] = b1;
  }
#pragma unroll
  for (int d0 = 0; d0 < 8; ++d0) { int cb = (d0 * 16 + hi * 8) * 2;
    bf16x8 b0 = *reinterpret_cast<const bf16x8*>((const char*)Ks + KSWZ(r32, cb));
    bf16x8 b1 = *reinterpret_cast<const bf16x8*>((const char*)Ks + KSWZ(32 + r32, cb));
    p0 = __builtin_amdgcn_mfma_f32_32x32x16_bf16(b0, qr[d0], p0, 0, 0, 0);
    p1 = __builtin_amdgcn_mfma_f32_32x32x16_bf16(b1, qr[d0], p1, 0, 0, 0); }
}
__device__ __forceinline__ int v_st(int k, int c) { const int kk = (k & ~0xC) | ((k & 4) << 1) | ((k & 8) >> 1); return ((kk >> 3) * 4 + (c >> 5)) * 512 + ((kk & 7) * 32 + (c & 31)) * 2; }
__device__ __forceinline__ int v_rd_base(int lane) { return ((lane & 3) << 3) | (((lane >> 2) & 3) << 6) | (((lane >> 4) & 1) << 5) | (((lane >> 5) & 1) << 8); }
constexpr int v_rd_off(int d0, int ks, int half) { return d0 * 512 + ks * 4096 + half * 2048; }
template <int OFF> __device__ __forceinline__ s16x4 tr_read(int vb) {
  s16x4 r; asm volatile("ds_read_b64_tr_b16 %0, %1 offset:%2" : "=&v"(r) : "v"(vb), "i"(OFF) : "memory"); return r;
}
template <int D0> __device__ __forceinline__ void pv_one(f32x16& od, int vb, bf16x8 pa0, bf16x8 pa1, bf16x8 pa2, bf16x8 pa3) {
  const s16x4 l0 = tr_read<v_rd_off(D0, 0, 0)>(vb), h0 = tr_read<v_rd_off(D0, 0, 1)>(vb), l1 = tr_read<v_rd_off(D0, 1, 0)>(vb), h1 = tr_read<v_rd_off(D0, 1, 1)>(vb);
  const s16x4 l2 = tr_read<v_rd_off(D0, 2, 0)>(vb), h2 = tr_read<v_rd_off(D0, 2, 1)>(vb), l3 = tr_read<v_rd_off(D0, 3, 0)>(vb), h3 = tr_read<v_rd_off(D0, 3, 1)>(vb);
  asm volatile("s_waitcnt lgkmcnt(0)" ::: "memory"); SBAR();
#define PK(L, H) (bf16x8){L[0], L[1], L[2], L[3], H[0], H[1], H[2], H[3]}
  od = __builtin_amdgcn_mfma_f32_32x32x16_bf16(pa0, PK(l0, h0), od, 0, 0, 0);
  od = __builtin_amdgcn_mfma_f32_32x32x16_bf16(pa1, PK(l1, h1), od, 0, 0, 0);
  od = __builtin_amdgcn_mfma_f32_32x32x16_bf16(pa2, PK(l2, h2), od, 0, 0, 0);
  od = __builtin_amdgcn_mfma_f32_32x32x16_bf16(pa3, PK(l3, h3), od, 0, 0, 0);
#undef PK
}
__device__ __forceinline__ void pv_d0(f32x16* o, int vb, bf16x8 pa0, bf16x8 pa1, bf16x8 pa2, bf16x8 pa3) {
  pv_one<0>(o[0], vb, pa0, pa1, pa2, pa3); pv_one<1>(o[1], vb, pa0, pa1, pa2, pa3); pv_one<2>(o[2], vb, pa0, pa1, pa2, pa3); pv_one<3>(o[3], vb, pa0, pa1, pa2, pa3);
}

struct UnitArgs {
  const bf16* Q; long ldq;
  const bf16* K; const bf16* V; long ldk;
  int q0, L, kt0, nt;
  float nsl, radius, m_init, l_init;
  float* Of; bf16* Ob; long ldo;
  float* lse; long ldl;
};

template <bool BAND, int SDEPTH>
__device__ __forceinline__ void attn_unit(const UnitArgs& a_in, char* lds) {
  UnitArgs a = a_in;
  asm volatile("" : "+s"(a.Q), "+s"(a.ldq), "+s"(a.K), "+s"(a.V), "+s"(a.ldk));
  asm volatile("" : "+s"(a.q0), "+s"(a.L), "+s"(a.kt0), "+s"(a.nt));
  asm volatile("" : "+s"(a.Of), "+s"(a.Ob), "+s"(a.ldo), "+s"(a.lse), "+s"(a.ldl));
  int tid_ = threadIdx.x; asm volatile("" : "+v"(tid_));
  const int tid = tid_, wid = tid >> 6, lane = tid & 63, r32 = lane & 31, hi = lane >> 5;
  bf16* V_lds = (bf16*)lds; bf16* K_lds = (bf16*)(lds + 2 * SHM_V);
  float* ws = (float*)(lds + 2 * SHM_V + 2 * SHM_K) + wid * 64; float* li_l = ws; float* al_l = ws + 32;
  float m_reg = a.m_init, l_reg = a.l_init; f32x16 o[4] = {}; bf16x8 qr[8];
  const bf16* Qw = a.Q + (long)(wid * QBLK + r32) * a.ldq + hi * 8;
#pragma unroll
  for (int d0 = 0; d0 < 8; ++d0) qr[d0] = *reinterpret_cast<const bf16x8*>(Qw + d0 * 16);
  const int sr = tid >> 4, sc = (tid & 15) * 8, vst0 = v_st(sr, sc), vst1 = v_st(32 + sr, sc);
  const int vb0 = (int)(uintptr_t)V_lds + v_rd_base(lane);
  const float qf = (float)(a.q0 + wid * QBLK + r32), Lf = (float)a.L, nsl = a.nsl, radius = a.radius;
  const int Lm1 = a.L - 1, kt0 = a.kt0;
  const bf16* Kp = a.K; const bf16* Vp = a.V; const long ldk = a.ldk;
  struct { bf16x8 vs0, vs1, ks0, ks1; } sr_[SDEPTH];
  const unsigned lofs = (unsigned)((sr * ldk + sc) * 2);
  const char* Kc = (const char*)Kp; const char* Vc = (const char*)Vp; const long ldk32 = 32 * ldk * 2, ldk64 = 64 * ldk * 2;
#define SLOAD(i, t) do { if constexpr (BAND) { const int k0_ = (kt0 + (t)) * KVBLK; int ra_ = k0_ + sr, rb_ = k0_ + 32 + sr;                   \
    ra_ = ra_ < 0 ? 0 : (ra_ > Lm1 ? Lm1 : ra_); rb_ = rb_ < 0 ? 0 : (rb_ > Lm1 ? Lm1 : rb_);                                          \
    sr_[i].vs0 = *reinterpret_cast<const bf16x8*>(&Vp[(long)ra_ * ldk + sc]); sr_[i].vs1 = *reinterpret_cast<const bf16x8*>(&Vp[(long)rb_ * ldk + sc]); \
    sr_[i].ks0 = *reinterpret_cast<const bf16x8*>(&Kp[(long)ra_ * ldk + sc]); sr_[i].ks1 = *reinterpret_cast<const bf16x8*>(&Kp[(long)rb_ * ldk + sc]); } \
  else { const long tb_ = (long)(kt0 + (t)) * ldk64;                                                                                       \
    sr_[i].vs0 = *reinterpret_cast<const bf16x8*>(Vc + tb_ + lofs); sr_[i].vs1 = *reinterpret_cast<const bf16x8*>(Vc + tb_ + ldk32 + lofs); \
    sr_[i].ks0 = *reinterpret_cast<const bf16x8*>(Kc + tb_ + lofs); sr_[i].ks1 = *reinterpret_cast<const bf16x8*>(Kc + tb_ + ldk32 + lofs); } } while (0)
#define SWRITE(b, i) do { *(bf16x8*)((char*)V_lds + (b) * SHM_V + vst0) = sr_[i].vs0;          \
    *(bf16x8*)((char*)V_lds + (b) * SHM_V + vst1) = sr_[i].vs1; int kc = sc * 2;               \
    *(bf16x8*)((char*)K_lds + (b) * SHM_K + KSWZ(sr, kc)) = sr_[i].ks0;                       \
    *(bf16x8*)((char*)K_lds + (b) * SHM_K + KSWZ(32 + sr, kc)) = sr_[i].ks1; } while (0)
#define SWAIT() do { if constexpr (SDEPTH == 2) asm volatile("s_waitcnt vmcnt(4)" ::: "memory"); else asm volatile("s_waitcnt vmcnt(0)" ::: "memory"); } while (0)
#define RESC(al) do { if (__any((al) < 1.f)) { if (hi == 0) al_l[r32] = (al); asm volatile("s_waitcnt lgkmcnt(0)" ::: "memory"); \
    _Pragma("unroll") for (int d = 0; d < 4; ++d) _Pragma("unroll") for (int r = 0; r < 16; ++r) o[d][r] *= al_l[crow(r, hi)]; } } while (0)
#define QKT(PA, PB, buf, t) do { const float kf0_ = (float)((kt0 + (t)) * KVBLK + 4 * hi); \
    qkt<BAND>(PA, PB, (bf16*)((char*)K_lds + (buf) * SHM_K), qr, r32, hi, qf - kf0_, kf0_, nsl, radius, Lf); } while (0)
  f32x16 pA0, pA1, pB0, pB1; float mnA, mnB, alA, alB; bf16x8 pa0, pa1, pa2, pa3; const int NT = a.nt;
  constexpr int SE = 0, SO = SDEPTH - 1;
  SLOAD(SE, 0); asm volatile("s_waitcnt vmcnt(0)" ::: "memory"); SWRITE(0, SE); __syncthreads();
  QKT(pA0, pA1, 0, 0); partialSM(pA0, pA1, m_reg, mnA, alA);
  SLOAD(SO, 1); if constexpr (SDEPTH == 2) { if (2 < NT) SLOAD(SE, 2); }
  SWAIT(); SWRITE(1, SO); __syncthreads();
  for (int j = 1; j + 1 < NT; j += 2) {
    SBAR(); QKT(pB0, pB1, 1, j);
    finishSM(pA0, pA1, alA, l_reg, pa0, pa1, pa2, pa3); SBAR();
    SLOAD(SO, j + SDEPTH); SBAR();
    pv_d0(o, vb0, pa0, pa1, pa2, pa3); partialSM(pB0, pB1, m_reg, mnB, alB);
    __syncthreads(); SWAIT(); SWRITE(0, SE);
    RESC(alB); __syncthreads();
    SBAR(); QKT(pA0, pA1, 0, j + 1);
    finishSM(pB0, pB1, alB, l_reg, pa0, pa1, pa2, pa3); SBAR();
    if (SDEPTH == 1 || j + 3 < NT) SLOAD(SE, j + 1 + SDEPTH); SBAR();
    pv_d0(o, vb0 + (int)SHM_V, pa0, pa1, pa2, pa3); partialSM(pA0, pA1, m_reg, mnA, alA);
    __syncthreads(); SWAIT(); SWRITE(1, SO);
    RESC(alA); __syncthreads();
  }
  SBAR(); QKT(pB0, pB1, 1, NT - 1);
  finishSM(pA0, pA1, alA, l_reg, pa0, pa1, pa2, pa3); SBAR();
  pv_d0(o, vb0, pa0, pa1, pa2, pa3); partialSM(pB0, pB1, m_reg, mnB, alB);
  __syncthreads(); RESC(alB);
  finishSM(pB0, pB1, alB, l_reg, pa0, pa1, pa2, pa3); SBAR();
  pv_d0(o, vb0 + (int)SHM_V, pa0, pa1, pa2, pa3);
  if (hi == 0) li_l[r32] = l_reg; asm volatile("s_waitcnt lgkmcnt(0)" ::: "memory");
  float rli[16];
#pragma unroll
  for (int r = 0; r < 16; ++r) rli[r] = __builtin_amdgcn_rcpf(li_l[crow(r, hi)]);
  if (a.Of) {
    float* Ow = a.Of + (long)(wid * QBLK) * a.ldo;
#pragma unroll
    for (int r = 0; r < 16; ++r) { const int orow = crow(r, hi);
#pragma unroll
      for (int d0 = 0; d0 < 4; ++d0) Ow[(long)orow * a.ldo + d0 * 32 + r32] = o[d0][r] * rli[r]; }
  } else {
    bf16* Ow = a.Ob + (long)(wid * QBLK) * a.ldo;
#pragma unroll
    for (int r = 0; r < 16; ++r) { const int orow = crow(r, hi);
#pragma unroll
      for (int d0 = 0; d0 < 4; ++d0) { const float v = o[d0][r] * rli[r]; Ow[(long)orow * a.ldo + d0 * 32 + r32] = (bf16)(cvtpk(v, v) & 0xffffu); } }
  }
  if (a.lse && hi == 0) a.lse[(long)(wid * QBLK + r32) * a.ldl] = m_reg * SCALE + __logf(l_reg);
  __syncthreads();
#undef SLOAD
#undef SWRITE
#undef SWAIT
#undef RESC
#undef QKT
}
#undef KSWZ
#undef SBAR
}
constexpr int DM = 2048, BATCH = 2, SEQ = 4096, DEPTH = 4, M = BATCH * SEQ;
constexpr int AB_IN = 3584, AB_OUT = 1024, C_IN = 6144, DFF = 5504, UPW = 2 * DFF, MODW = 6 * DM;
constexpr float EPS = 1e-6f;
constexpr int NWAVES = 8;
constexpr size_t MiB = 1u << 20;
constexpr size_t WS_CTL = 0, CTL_ZERO_BYTES = 2 * MiB;
constexpr size_t WS_MOD = 2 * MiB;
constexpr size_t WS_PART = 3 * MiB;
constexpr size_t WS_NRM = 12 * MiB;
constexpr size_t WS_WABIN = 16 * MiB;
constexpr size_t WS_WABOUT = 44 * MiB;
constexpr size_t WS_WCIN = 52 * MiB;
constexpr size_t WS_WCOUT = 100 * MiB;
constexpr size_t WS_WUP = 116 * MiB;
constexpr size_t WS_WDOWN = 288 * MiB;
constexpr size_t WS_H = 376 * MiB;
constexpr size_t WS_PROJ = 408 * MiB;
constexpr size_t WS_ATT = 504 * MiB;
constexpr size_t WS_LSE = WS_ATT + 64 * MiB;
constexpr size_t WS_O = 632 * MiB;
constexpr size_t WS_Y = 664 * MiB;
constexpr size_t WS_GU = 728 * MiB;
constexpr size_t WS_ACT = 900 * MiB;
constexpr size_t WS_END = 986 * MiB;
static_assert(WS_PART + (size_t)DEPTH * 16 * BATCH * MODW * 4 <= WS_WABIN, "ws map");
static_assert(WS_WABIN + (size_t)2 * AB_IN * DM * 2 <= WS_WABOUT && WS_WABOUT + (size_t)2 * DM * AB_OUT * 2 <= WS_WCIN, "ws map");
static_assert(WS_WCIN + (size_t)2 * C_IN * DM * 2 <= WS_WCOUT && WS_WCOUT + (size_t)2 * DM * DM * 2 <= WS_WUP, "ws map");
static_assert(WS_WUP + (size_t)4 * UPW * DM * 2 <= WS_WDOWN && WS_WDOWN + (size_t)4 * DM * DFF * 2 <= WS_H, "ws map");
static_assert(WS_H + (size_t)M * DM * 2 <= WS_PROJ && WS_PROJ + (size_t)M * C_IN * 2 <= WS_ATT && WS_ATT + (size_t)2 * M * DM * 4 <= WS_O, "ws map");
static_assert(WS_ATT + (size_t)3 * M * 512 * 4 <= WS_LSE && WS_LSE + (size_t)3 * M * 4 * 4 <= WS_O, "ws map");
static_assert(WS_O + (size_t)M * DM * 2 <= WS_Y && WS_Y + (size_t)M * DM * 4 <= WS_GU && WS_GU + (size_t)M * UPW * 2 <= WS_ACT && WS_ACT + (size_t)M * DFF * 2 <= WS_END, "ws map");
constexpr int CW_BAR = 4096;
constexpr int RING_OFF = 0, RING_BYTES = 131072;
constexpr int LDSCTL_OFF = RING_BYTES, MISC_OFF = LDSCTL_OFF + 320;
constexpr int LDS_BYTES = 147456;
static_assert(att::SHM_ATTN <= RING_BYTES, "attention LDS fits the ring region");

#define GAS __attribute__((address_space(1)))
#define LAS __attribute__((address_space(3)))
typedef unsigned short bf16;
typedef unsigned v4u __attribute__((ext_vector_type(4)));
typedef unsigned v2u __attribute__((ext_vector_type(2)));
typedef float f32x4 __attribute__((ext_vector_type(4)));
typedef GAS unsigned gu32;
#define LDS_WAIT() asm volatile("s_waitcnt lgkmcnt(0)" ::: "memory")
__device__ __forceinline__ unsigned pk2(float lo, float hi) { unsigned r; asm volatile("v_cvt_pk_bf16_f32 %0, %1, %2" : "=v"(r) : "v"(lo), "v"(hi)); return r; }
__device__ __forceinline__ float bf_lo(unsigned w) { return __uint_as_float(w << 16); }
__device__ __forceinline__ float bf_hi(unsigned w) { return __uint_as_float(w & 0xffff0000u); }
#define XB_TMO      128
#define XB_XCNT(j)  (256  + 64 * (j))
#define XB_XSUB(j)  (1280 + 64 * (j))
#define XB_XGEN(j)  (2304 + 64 * (j))
#define XB_TOP      3328
#define XB_TOPGEN   3392
#define XCD_BAR_WORDS 3456
#define XB_SPIN_CAP (1u << 18)

__device__ __forceinline__ unsigned xb_ld(unsigned* p)              { return __hip_atomic_load(p, __ATOMIC_RELAXED, __HIP_MEMORY_SCOPE_AGENT); }
__device__ __forceinline__ unsigned xb_add(unsigned* p, unsigned v) { return __hip_atomic_fetch_add(p, v, __ATOMIC_RELAXED, __HIP_MEMORY_SCOPE_AGENT); }
__device__ __forceinline__ unsigned xb_xcc_id() { return (unsigned)__builtin_amdgcn_s_getreg((3 << 11) | 20) & 0xFu; }
#define XB_SPIN(cond, bar) do { unsigned _sp = 0; while (cond) { __builtin_amdgcn_s_sleep(1); \
    if ((++_sp & 255u) == 0u) { if (xb_ld(&(bar)[XB_TMO])) break; if (_sp > XB_SPIN_CAP) { atomicAdd(&(bar)[XB_TMO], 1u); break; } } } } while (0)

struct XcdBarrier {
    unsigned* bar; unsigned x;
    volatile LAS unsigned* st;
};

__device__ __forceinline__ XcdBarrier xcd_barrier_post(unsigned* bar, volatile LAS unsigned* st) {
    XcdBarrier b; b.bar = bar; b.x = xb_xcc_id(); b.st = st;
    if (threadIdx.x == 0) (void)xb_add(&bar[XB_XCNT(b.x)], 1u);
    return b;
}
__device__ __forceinline__ void xcd_barrier_complete(unsigned* bar, unsigned x, unsigned& nloc, unsigned& nx) {
    const unsigned G = gridDim.x * gridDim.y * gridDim.z;
    unsigned sum, cnt, mine, sp = 0u;
    for (;;) {
        sum = 0u; cnt = 0u; mine = 0u;
#pragma unroll
        for (unsigned j = 0; j < 16; ++j) { const unsigned c = xb_ld(&bar[XB_XCNT(j)]); sum += c; cnt += (c > 0u) ? 1u : 0u; mine = (j == x) ? c : mine; }
        if (sum == G) break;
        __builtin_amdgcn_s_sleep(1);
        if ((++sp & 255u) == 0u) { if (xb_ld(&bar[XB_TMO])) break; if (sp > XB_SPIN_CAP) { atomicAdd(&bar[XB_TMO], 1u); break; } }
    }
    nloc = mine > 0u ? mine : 1u; nx = cnt > 0u ? cnt : 1u;
}

__device__ __forceinline__ void xcd_barrier(const XcdBarrier& b) {
    asm volatile("s_waitcnt vmcnt(0)" ::: "memory");
    __syncthreads();
    if (threadIdx.x == 0) {
        unsigned* bar = b.bar;
        __builtin_amdgcn_s_waitcnt(0);
        unsigned nloc = b.st[0], nx = b.st[1];
        if (nloc == 0u) { xcd_barrier_complete(bar, b.x, nloc, nx); b.st[0] = nloc; b.st[1] = nx; }
        const unsigned old = xb_add(&bar[XB_XSUB(b.x)], 1u);
        const unsigned gen = old / nloc;
        if (old + 1u == (gen + 1u) * nloc) {
            __builtin_amdgcn_fence(__ATOMIC_RELEASE, "agent");
            asm volatile("s_waitcnt vmcnt(0)" ::: "memory");
            const unsigned og = xb_add(&bar[XB_TOP], 1u);
            const unsigned tg = og / nx;
            if (og + 1u == (tg + 1u) * nx) xb_add(&bar[XB_TOPGEN], 1u);
            else XB_SPIN(xb_ld(&bar[XB_TOPGEN]) == tg, bar);
            __builtin_amdgcn_fence(__ATOMIC_ACQUIRE, "agent");
            xb_add(&bar[XB_XGEN(b.x)], 1u);
            asm volatile("s_waitcnt vmcnt(0)" ::: "memory");
        } else {
            XB_SPIN(xb_ld(&bar[XB_XGEN(b.x)]) == gen, bar);
            __builtin_amdgcn_fence(__ATOMIC_ACQUIRE, "agent");
            asm volatile("s_waitcnt vmcnt(0)" ::: "memory");
        }
    }
    __syncthreads();
}
struct Frame {
    LAS unsigned char* lds; char* ldsg;
    int tid, lane, wave, G, gw, NGW;
    const float *x, *c, *ada_w, *ada_b, *norm_g, *ab_w_in, *ab_w_out, *a_sink, *c_w_in, *c_w_out, *c_lambda, *c_subln_g, *w_up, *conv_w, *conv_b, *w_down;
    float* out; unsigned char* ws;
};
#define PHASE_IDS() int tid = threadIdx.x; asm volatile("" : "+v"(tid)); const int lane = tid & 63, wave = __builtin_amdgcn_readfirstlane(tid >> 6), gw = (int)blockIdx.x * NWAVES + wave; (void)lane; (void)gw
__device__ __forceinline__ float wave_sum(float v) {
#pragma unroll
    for (int o = 1; o < 64; o <<= 1) v += __shfl_xor(v, o);
    return v;
}
__device__ __forceinline__ void transpose_item(const float* W, int K, int N, bf16* WT, LAS float* scr, int item, int lane) {
    const int nblk = N / 32, kb = item / nblk, nb = item % nblk, k0 = 64 * kb, n0 = 32 * nb;
#pragma unroll 8
    for (int i = 0; i < 32; ++i) { const int kk = 2 * i + (lane >> 5); scr[kk * 33 + (lane & 31)] = W[(size_t)(k0 + kk) * N + n0 + (lane & 31)]; }
    LDS_WAIT(); asm volatile("" ::: "memory");
    const int c = lane & 7;
#pragma unroll
    for (int j = 0; j < 4; ++j) { const int n = (lane >> 3) + 8 * j; const LAS float* s = scr + (8 * c) * 33 + n;
        v4u o; o.x = pk2(s[0 * 33], s[1 * 33]); o.y = pk2(s[2 * 33], s[3 * 33]); o.z = pk2(s[4 * 33], s[5 * 33]); o.w = pk2(s[6 * 33], s[7 * 33]);
        *(GAS v4u*)(WT + (size_t)(n0 + n) * K + k0 + 8 * c) = o; }
    LDS_WAIT(); asm volatile("" ::: "memory");
}
__device__ __forceinline__ float silu_f(float v) { return v / (1.f + __expf(-v)); }

__device__ __forceinline__ void p0a_prologue(Frame& F) {
    PHASE_IDS();
    LAS float* scr = (LAS float*)(F.lds + RING_OFF + wave * 16384);
    constexpr int I_ABIN = (DM / 64) * (AB_IN / 32), I_ABOUT = (AB_OUT / 64) * (DM / 32), I_CIN = (DM / 64) * (C_IN / 32), I_COUT = (DM / 64) * (DM / 32),
                  I_UP = (DM / 64) * (UPW / 32), I_DOWN = (DFF / 64) * (DM / 32);
    constexpr int NT_ITEMS = 2 * I_ABIN + 2 * I_ABOUT + 2 * I_CIN + 2 * I_COUT + 4 * I_UP + 4 * I_DOWN;
    bf16* wabin = (bf16*)(F.ws + WS_WABIN); bf16* wabout = (bf16*)(F.ws + WS_WABOUT); bf16* wcin = (bf16*)(F.ws + WS_WCIN); bf16* wcout = (bf16*)(F.ws + WS_WCOUT);
    bf16* wup = (bf16*)(F.ws + WS_WUP); bf16* wdown = (bf16*)(F.ws + WS_WDOWN);
    for (int it = gw; it < NT_ITEMS; it += F.NGW) {
        int r = it;
        if (r < 2 * I_ABIN) { const int j = r / I_ABIN; transpose_item(F.ab_w_in + (size_t)j * DM * AB_IN, DM, AB_IN, wabin + (size_t)j * AB_IN * DM, scr, r % I_ABIN, lane); continue; } r -= 2 * I_ABIN;
        if (r < 2 * I_ABOUT) { const int j = r / I_ABOUT; transpose_item(F.ab_w_out + (size_t)j * AB_OUT * DM, AB_OUT, DM, wabout + (size_t)j * DM * AB_OUT, scr, r % I_ABOUT, lane); continue; } r -= 2 * I_ABOUT;
        if (r < 2 * I_CIN) { const int j = r / I_CIN; transpose_item(F.c_w_in + (size_t)j * DM * C_IN, DM, C_IN, wcin + (size_t)j * C_IN * DM, scr, r % I_CIN, lane); continue; } r -= 2 * I_CIN;
        if (r < 2 * I_COUT) { const int j = r / I_COUT; transpose_item(F.c_w_out + (size_t)j * DM * DM, DM, DM, wcout + (size_t)j * DM * DM, scr, r % I_COUT, lane); continue; } r -= 2 * I_COUT;
        if (r < 4 * I_UP) { const int j = r / I_UP; transpose_item(F.w_up + (size_t)j * DM * UPW, DM, UPW, wup + (size_t)j * UPW * DM, scr, r % I_UP, lane); continue; } r -= 4 * I_UP;
        { const int j = r / I_DOWN; transpose_item(F.w_down + (size_t)j * DFF * DM, DFF, DM, wdown + (size_t)j * DM * DFF, scr, r % I_DOWN, lane); }
    }
    float* part = (float*)(F.ws + WS_PART);
    constexpr int NCH = MODW / 256, NKC = 16, KCH = DM / NKC;
    for (int it = gw; it < DEPTH * NCH * NKC; it += F.NGW) {
        const int kc = it % NKC, nch = (it / NKC) % NCH, l = it / (NKC * NCH), k0 = kc * KCH;
        const float c0a = silu_f(F.c[k0 + lane]), c0b = silu_f(F.c[k0 + 64 + lane]), c1a = silu_f(F.c[DM + k0 + lane]), c1b = silu_f(F.c[DM + k0 + 64 + lane]);
        const float* wp = F.ada_w + ((size_t)l * DM + k0) * MODW + nch * 256 + 4 * lane;
        f32x4 a0 = {0.f, 0.f, 0.f, 0.f}, a1 = {0.f, 0.f, 0.f, 0.f};
#pragma unroll 8
        for (int k = 0; k < 64; ++k) { const f32x4 w = *(const f32x4*)(wp + (size_t)k * MODW); const float s0 = __shfl(c0a, k), s1 = __shfl(c1a, k); a0 += w * s0; a1 += w * s1; }
#pragma unroll 8
        for (int k = 0; k < 64; ++k) { const f32x4 w = *(const f32x4*)(wp + (size_t)(64 + k) * MODW); const float s0 = __shfl(c0b, k), s1 = __shfl(c1b, k); a0 += w * s0; a1 += w * s1; }
        float* pp = part + (((size_t)l * NKC + kc) * BATCH) * MODW + nch * 256 + 4 * lane;
        *(f32x4*)pp = a0; *(f32x4*)(pp + MODW) = a1;
    }
}
__device__ __forceinline__ void p0b_modreduce(Frame& F) {
    PHASE_IDS();
    const float* part = (const float*)(F.ws + WS_PART); float* mod = (float*)(F.ws + WS_MOD);
    for (int i = blockIdx.x * (NWAVES * 64) + tid; i < DEPTH * BATCH * MODW; i += F.G * NWAVES * 64) {
        const int n = i % MODW, b = (i / MODW) % BATCH, l = i / (MODW * BATCH);
        float s = F.ada_b[l * MODW + n];
#pragma unroll
        for (int kc = 0; kc < 16; ++kc) s += part[(((size_t)l * 16 + kc) * BATCH + b) * MODW + n];
        mod[i] = s;
    }
}
__device__ __forceinline__ void rows_pre(Frame& F, const float* x, const float* ng, const float* scale, const float* shift, bf16* H) {
    PHASE_IDS();
    for (int m = gw; m < M; m += F.NGW) {
        const int b = m / SEQ; f32x4 v[8]; float ss = 0.f;
#pragma unroll
        for (int j = 0; j < 8; ++j) { v[j] = *(const f32x4*)(x + (size_t)m * DM + 4 * lane + 256 * j); ss += (v[j].x * v[j].x + v[j].y * v[j].y) + (v[j].z * v[j].z + v[j].w * v[j].w); }
        const float r = 1.f / sqrtf(wave_sum(ss) * (1.f / DM) + EPS);
#pragma unroll
        for (int j = 0; j < 8; ++j) { const int c = 4 * lane + 256 * j;
            const f32x4 g = *(const f32x4*)(ng + c), sc = *(const f32x4*)(scale + (size_t)b * MODW + c), sh = *(const f32x4*)(shift + (size_t)b * MODW + c);
            const f32x4 h = (v[j] * r) * g * (sc + 1.f) + sh;
            v2u o; o.x = pk2(h.x, h.y); o.y = pk2(h.z, h.w); *(v2u*)(H + (size_t)m * DM + c) = o; }
    }
}
__device__ __forceinline__ void rows_post(Frame& F, const float* Y, const float* xs, float* xd, const float* gate, const float* nga,
                                          const float* ngb, const float* scale, const float* shift, bf16* H, bool doH) {
    PHASE_IDS();
    for (int m = gw; m < M; m += F.NGW) {
        const int b = m / SEQ; f32x4 v[8]; float ss = 0.f;
#pragma unroll
        for (int j = 0; j < 8; ++j) { v[j] = *(const f32x4*)(Y + (size_t)m * DM + 4 * lane + 256 * j); ss += (v[j].x * v[j].x + v[j].y * v[j].y) + (v[j].z * v[j].z + v[j].w * v[j].w); }
        const float r = 1.f / sqrtf(wave_sum(ss) * (1.f / DM) + EPS); float ss2 = 0.f;
#pragma unroll
        for (int j = 0; j < 8; ++j) { const int c = 4 * lane + 256 * j;
            const f32x4 xv = *(const f32x4*)(xs + (size_t)m * DM + c), g = *(const f32x4*)(gate + (size_t)b * MODW + c), na = *(const f32x4*)(nga + c);
            v[j] = xv + g * ((v[j] * r) * na);
            ss2 += (v[j].x * v[j].x + v[j].y * v[j].y) + (v[j].z * v[j].z + v[j].w * v[j].w);
            *(f32x4*)(xd + (size_t)m * DM + c) = v[j]; }
        if (doH) {
            const float r2 = 1.f / sqrtf(wave_sum(ss2) * (1.f / DM) + EPS);
#pragma unroll
            for (int j = 0; j < 8; ++j) { const int c = 4 * lane + 256 * j;
                const f32x4 g = *(const f32x4*)(ngb + c), sc = *(const f32x4*)(scale + (size_t)b * MODW + c), sh = *(const f32x4*)(shift + (size_t)b * MODW + c);
                const f32x4 h = (v[j] * r2) * g * (sc + 1.f) + sh;
                v2u o; o.x = pk2(h.x, h.y); o.y = pk2(h.z, h.w); *(v2u*)(H + (size_t)m * DM + c) = o; }
        }
    }
}
__device__ __forceinline__ void rows_subln(Frame& F, const float* A0, const float* A1, const float* lamp, const float* sg, float lambda_init, bf16* O) {
    PHASE_IDS();
    const float l0 = lamp[lane] * lamp[128 + lane] + lamp[64 + lane] * lamp[128 + 64 + lane];
    const float l1 = lamp[256 + lane] * lamp[384 + lane] + lamp[256 + 64 + lane] * lamp[384 + 64 + lane];
    const float lam = __expf(wave_sum(l0)) - __expf(wave_sum(l1)) + lambda_init;
    const f32x4 g = *(const f32x4*)(sg + 4 * lane) * (1.f - lambda_init);
    for (int m = gw; m < M; m += F.NGW) {
#pragma unroll
        for (int j = 0; j < 8; ++j) { const size_t off = (size_t)m * DM + 4 * lane + 256 * j;
            const f32x4 d = *(const f32x4*)(A0 + off) - *(const f32x4*)(A1 + off) * lam;
            const float ss = wave_sum((d.x * d.x + d.y * d.y) + (d.z * d.z + d.w * d.w));
            const float r = 1.f / sqrtf(ss * (1.f / 256.f) + EPS);
            const f32x4 h = (d * r) * g;
            v2u o; o.x = pk2(h.x, h.y); o.y = pk2(h.z, h.w); *(v2u*)(O + off) = o; }
    }
}
__device__ __forceinline__ void rows_bmerge(Frame& F, const float* OB, const float* LSE, bf16* O) {
    PHASE_IDS();
    for (int m = gw; m < M; m += F.NGW) {
        const int hb = lane >> 4;
        const float e0 = LSE[(size_t)m * 4 + hb], e1 = LSE[((size_t)M + m) * 4 + hb], e2 = LSE[((size_t)2 * M + m) * 4 + hb];
        const float mx = fmaxf(e0, fmaxf(e1, e2));
        float w0 = __expf(e0 - mx), w1 = __expf(e1 - mx), w2 = __expf(e2 - mx); const float inv = 1.f / (w0 + w1 + w2); w0 *= inv; w1 *= inv; w2 *= inv;
        const float* p = OB + (size_t)m * 512 + 8 * lane;
        const f32x4 a0 = *(const f32x4*)p, a1 = *(const f32x4*)(p + 4);
        const f32x4 b0 = *(const f32x4*)(p + (size_t)M * 512), b1 = *(const f32x4*)(p + (size_t)M * 512 + 4);
        const f32x4 c0 = *(const f32x4*)(p + (size_t)2 * M * 512), c1 = *(const f32x4*)(p + (size_t)2 * M * 512 + 4);
        const f32x4 r0 = a0 * w0 + b0 * w1 + c0 * w2, r1 = a1 * w0 + b1 * w1 + c1 * w2;
        v4u o; o.x = pk2(r0.x, r0.y); o.y = pk2(r0.z, r0.w); o.z = pk2(r1.x, r1.y); o.w = pk2(r1.z, r1.w);
        *(v4u*)(O + (size_t)m * AB_OUT + 512 + 8 * lane) = o;
    }
}
__device__ __forceinline__ float gelu_tanh(float v) {
    const float u = 0.7978845608028654f * (v + 0.044715f * v * v * v);
    const float e = __expf(2.f * u);
    const float t = 1.f - 2.f / (e + 1.f);
    return 0.5f * v * (1.f + t);
}
__device__ __forceinline__ void phase_act(Frame& F, const bf16* GU, const float* cw, const float* cb, bf16* ACT) {
    PHASE_IDS();
    constexpr int NC8 = DFF / 8, RB = 8, NRB = M / RB;
    for (int it = blockIdx.x * (NWAVES * 64) + tid; it < NRB * NC8; it += F.G * NWAVES * 64) {
        const int c8 = it % NC8, rb = it / NC8, c = c8 * 8, m0 = rb * RB;
        float w0[8], w1[8], w2[8], bb[8];
#pragma unroll
        for (int i = 0; i < 8; ++i) { w0[i] = cw[c + i]; w1[i] = cw[DFF + c + i]; w2[i] = cw[2 * DFF + c + i]; bb[i] = cb[c + i]; }
        v4u gp, gc, gn;
        if ((m0 % SEQ) == 0) gp = (v4u){0u, 0u, 0u, 0u}; else gp = *(const v4u*)(GU + (size_t)(m0 - 1) * UPW + c);
        gc = *(const v4u*)(GU + (size_t)m0 * UPW + c);
#pragma unroll
        for (int rr = 0; rr < RB; ++rr) {
            const int m = m0 + rr;
            if ((m % SEQ) == SEQ - 1) gn = (v4u){0u, 0u, 0u, 0u}; else gn = *(const v4u*)(GU + (size_t)(m + 1) * UPW + c);
            const v4u up = *(const v4u*)(GU + (size_t)m * UPW + DFF + c);
            float r[8];
#pragma unroll
            for (int q = 0; q < 4; ++q) {
                const float a_lo = w0[2 * q] * bf_lo(gp[q]) + w1[2 * q] * bf_lo(gc[q]) + w2[2 * q] * bf_lo(gn[q]) + bb[2 * q];
                const float a_hi = w0[2 * q + 1] * bf_hi(gp[q]) + w1[2 * q + 1] * bf_hi(gc[q]) + w2[2 * q + 1] * bf_hi(gn[q]) + bb[2 * q + 1];
                r[2 * q] = gelu_tanh(a_lo) * bf_lo(up[q]); r[2 * q + 1] = gelu_tanh(a_hi) * bf_hi(up[q]);
            }
            v4u o; o.x = pk2(r[0], r[1]); o.y = pk2(r[2], r[3]); o.z = pk2(r[4], r[5]); o.w = pk2(r[6], r[7]);
            *(v4u*)(ACT + (size_t)m * DFF + c) = o;
            gp = gc; gc = gn;
        }
    }
}
__device__ __forceinline__ float alibi16(int i) { return exp2f(-0.5f * (float)(i + 1)); }
__device__ __forceinline__ void phase_attn_ab(Frame& F, int jl) {
    const bf16* P = (const bf16*)(F.ws + WS_PROJ); bf16* O = (bf16*)(F.ws + WS_O); float* OB = (float*)(F.ws + WS_ATT); float* LSE = (float*)(F.ws + WS_LSE);
    for (int u = blockIdx.x; u < 512; u += F.G) {
        att::UnitArgs a;
        if (u < 128) {
            const int qb = u % 16, qh = (u / 16) % 4, b = u / 64, q0 = qb * 256; const size_t row0 = (size_t)b * SEQ;
            a.Q = P + (row0 + q0) * AB_IN + qh * 128; a.ldq = AB_IN;
            a.K = P + row0 * AB_IN + 512 + (qh >> 1) * 128; a.V = P + row0 * AB_IN + 768 + (qh >> 1) * 128; a.ldk = AB_IN;
            a.q0 = q0; a.L = SEQ; a.kt0 = q0 / 64 - 2; a.nt = 8;
            a.nsl = -alibi16(qh) / att::SCALE; a.radius = 128.f; a.m_init = F.a_sink[jl * 4 + qh] / att::SCALE; a.l_init = 1.f;
            a.Of = nullptr; a.Ob = O + (row0 + q0) * AB_OUT + qh * 128; a.ldo = AB_OUT; a.lse = nullptr; a.ldl = 0;
        } else {
            const int v = (u - 128) % 128, gi = (u - 128) / 128, dil = gi == 0 ? 1 : (gi == 1 ? 4 : 16), L = SEQ / dil;
            int qb, r, hb, b;
            if (gi == 0) { qb = v % 16; r = 0; hb = (v / 16) % 4; b = v / 64; }
            else if (gi == 1) { qb = v % 4; r = (v / 4) % 4; hb = (v / 16) % 4; b = v / 64; }
            else { qb = 0; r = v % 16; hb = (v / 16) % 4; b = v / 64; }
            const int q0 = qb * 256; const size_t seq0 = (size_t)b * SEQ + r, rowq = seq0 + (size_t)dil * q0;
            a.Q = P + rowq * AB_IN + 1024 + gi * 512 + hb * 128; a.ldq = (long)dil * AB_IN;
            a.K = P + seq0 * AB_IN + 2560 + hb * 128; a.V = P + seq0 * AB_IN + 3072 + hb * 128; a.ldk = (long)dil * AB_IN;
            a.q0 = q0; a.L = L; a.kt0 = q0 / 64 - 1; a.nt = 6;
            a.nsl = -alibi16(4 + gi * 4 + hb) * (float)dil / att::SCALE; a.radius = 64.f; a.m_init = att::M_INIT; a.l_init = 0.f;
            a.Of = OB + ((size_t)gi * M + rowq) * 512 + hb * 128; a.Ob = nullptr; a.ldo = (long)dil * 512;
            a.lse = LSE + ((size_t)gi * M + rowq) * 4 + hb; a.ldl = (long)dil * 4;
        }
        att::attn_unit<true, 1>(a, F.ldsg + RING_OFF);
    }
}
__device__ __forceinline__ void phase_cnorm(Frame& F) {
    PHASE_IDS();
    const bf16* P = (const bf16*)(F.ws + WS_PROJ); float* NRM = (float*)(F.ws + WS_NRM);
    for (int it = gw; it < 4096; it += F.NGW) {
        const int tile = it & 63, j = (it >> 6) & 1, h = (it >> 7) & 7, b = (it >> 10) & 1, which = it >> 11;
        const bf16* base = P + ((size_t)b * SEQ + 64 * tile + (lane >> 4)) * C_IN + which * 2048 + h * 256 + j * 128 + (lane & 15) * 8;
        float mx = 0.f;
#pragma unroll 4
        for (int i = 0; i < 16; ++i) {
            const v4u w = *(const v4u*)(base + (size_t)(4 * i) * C_IN);
            float ss = 0.f;
#pragma unroll
            for (int q = 0; q < 4; ++q) { const float a = bf_lo(w[q]), c = bf_hi(w[q]); ss += a * a + c * c; }
            ss += __shfl_xor(ss, 1); ss += __shfl_xor(ss, 2); ss += __shfl_xor(ss, 4); ss += __shfl_xor(ss, 8);
            mx = fmaxf(mx, ss);
        }
        mx = fmaxf(mx, __shfl_xor(mx, 16)); mx = fmaxf(mx, __shfl_xor(mx, 32));
        if (lane == 0) NRM[it] = sqrtf(mx);
    }
}
__device__ __forceinline__ void phase_attn_c(Frame& F, gu32* ctr) {
    PHASE_IDS();
    const bf16* P = (const bf16*)(F.ws + WS_PROJ); float* AT = (float*)(F.ws + WS_ATT); const float* NRM = (const float*)(F.ws + WS_NRM);
    volatile LAS unsigned* slot = (volatile LAS unsigned*)(F.lds + MISC_OFF) + 16;
    for (;;) {
        if (tid == 0) *slot = __hip_atomic_fetch_add(ctr, 1u, __ATOMIC_RELAXED, __HIP_MEMORY_SCOPE_AGENT);
        __syncthreads();
        const int i = __builtin_amdgcn_readfirstlane((int)*slot);
        __syncthreads();
        if (i >= 1024) break;
        const int h = 7 - (i >> 7), qb = i & 15, vh = (i >> 4) & 1, j = (i >> 5) & 1, b = (i >> 6) & 1, q0 = qb * 256; const size_t row0 = (size_t)b * SEQ;
        const float slope = exp2f(-(float)(h + 1));
        const float* QN = NRM + ((b * 8 + h) * 2 + j) * 64; const float* KN = QN + 2048;
        const float qn = fmaxf(fmaxf(QN[4 * qb], QN[4 * qb + 1]), fmaxf(QN[4 * qb + 2], QN[4 * qb + 3]));
        const float ks = fmaxf(fmaxf(KN[4 * qb], KN[4 * qb + 1]), fmaxf(KN[4 * qb + 2], KN[4 * qb + 3]));
        const int klo = 64 * lane, d1 = klo - (q0 + 255), d2 = q0 - (klo + 63), dmin = d1 > 0 ? d1 : (d2 > 0 ? d2 : 0);
        const float bound = att::SCALE * 1.02f * qn * (KN[lane] + ks) - slope * (float)dmin;
        const unsigned long long need = __ballot(bound > -25.f);
        int t_lo = (int)__builtin_ctzll(need), t_hi = 64 - (int)__builtin_clzll(need);
        if ((t_hi - t_lo) & 1) { if (t_lo > 0) --t_lo; else ++t_hi; }
        att::UnitArgs a;
        a.Q = P + (row0 + q0) * C_IN + h * 256 + j * 128; a.ldq = C_IN;
        a.K = P + row0 * C_IN + 2048 + h * 256 + j * 128; a.V = P + row0 * C_IN + 4096 + h * 256 + vh * 128; a.ldk = C_IN;
        a.q0 = q0; a.L = SEQ; a.kt0 = t_lo; a.nt = t_hi - t_lo;
        a.nsl = -slope / att::SCALE; a.radius = 0.f; a.m_init = att::M_INIT; a.l_init = 0.f;
        a.Of = AT + ((size_t)j * M + row0 + q0) * DM + h * 256 + vh * 128; a.Ob = nullptr; a.ldo = DM; a.lse = nullptr; a.ldl = 0;
        att::attn_unit<false, 2>(a, F.ldsg + RING_OFF);
    }
}

#ifndef ENC_DUP
#define ENC_DUP 0
#endif
#define DUP(bit) for (int rep_ = 0; rep_ < (((ENC_DUP) & (bit)) ? 2 : 1); ++rep_)
constexpr int CW_QUEUE = 8192;
struct Args { const float* in[16]; float* out; unsigned char* ws; };
__global__ void __launch_bounds__(NWAVES * 64, 2) enc_fwd(Args args) {
    extern __shared__ __attribute__((aligned(16))) unsigned char lds[];
    Frame F;
    F.lds = (LAS unsigned char*)lds; F.ldsg = (char*)lds;
    F.tid = threadIdx.x; F.lane = F.tid & 63; F.wave = __builtin_amdgcn_readfirstlane(F.tid >> 6);
    F.G = gridDim.x; F.gw = blockIdx.x * NWAVES + F.wave; F.NGW = F.G * NWAVES;
    F.x = args.in[0]; F.c = args.in[1]; F.ada_w = args.in[2]; F.ada_b = args.in[3]; F.norm_g = args.in[4]; F.ab_w_in = args.in[5]; F.ab_w_out = args.in[6]; F.a_sink = args.in[7];
    F.c_w_in = args.in[8]; F.c_w_out = args.in[9]; F.c_lambda = args.in[10]; F.c_subln_g = args.in[11]; F.w_up = args.in[12]; F.conv_w = args.in[13]; F.conv_b = args.in[14]; F.w_down = args.in[15];
    F.out = args.out; F.ws = args.ws;
    gu32* ctl = (gu32*)(F.ws + WS_CTL);
    for (int u = F.tid; u < (LDS_BYTES - LDSCTL_OFF) / 4; u += NWAVES * 64) ((LAS unsigned*)(F.lds + LDSCTL_OFF))[u] = 0u;
    __syncthreads();
    (void)xcd_barrier_post((unsigned*)(ctl + CW_BAR), (volatile LAS unsigned*)(F.lds + MISC_OFF) + 8);
#define GB() do { unsigned char* wsb_ = args.ws; asm volatile("" : "+s"(wsb_)); XcdBarrier bar_; bar_.bar = (unsigned*)(wsb_ + WS_CTL) + CW_BAR; bar_.x = xb_xcc_id(); \
        bar_.st = (volatile LAS unsigned*)(F.lds + MISC_OFF) + 8; xcd_barrier(bar_); } while (0)
    float* mod = (float*)(F.ws + WS_MOD);
    bf16* H = (bf16*)(F.ws + WS_H); bf16* PROJ = (bf16*)(F.ws + WS_PROJ); bf16* O = (bf16*)(F.ws + WS_O); float* Y = (float*)(F.ws + WS_Y);
    bf16* GU = (bf16*)(F.ws + WS_GU); bf16* ACT = (bf16*)(F.ws + WS_ACT); float* AT = (float*)(F.ws + WS_ATT);

    DUP(1) p0a_prologue(F);
    GB();
    p0b_modreduce(F);
    GB();
    rows_pre(F, F.x, F.norm_g, mod + 1 * DM, mod + 0 * DM, H);
    GB();

    for (int s = 0; s < 8; ++s) {
        const int l = s >> 1, sub = s & 1, jl = l >> 1, even = !(l & 1);
        const float* modl = mod + (size_t)l * BATCH * MODW;
        {
            pg8::Gemm g; bf16* dst; int N;
            if (sub == 0) { if (even) { N = AB_IN; g.Bt = (const bf16*)(F.ws + WS_WABIN) + (size_t)jl * AB_IN * DM; } else { N = C_IN; g.Bt = (const bf16*)(F.ws + WS_WCIN) + (size_t)jl * C_IN * DM; } dst = PROJ; }
            else { N = UPW; g.Bt = (const bf16*)(F.ws + WS_WUP) + (size_t)l * UPW * DM; dst = GU; }
            g.A = H; g.M = M; g.N = N; g.K = DM;
            pg8::StaticOrder S; S.init(M, N, F.G, (int)blockIdx.x);
            pg8::EpiBf16<0> E{dst, N, nullptr, 0, 0, 1.f};
            DUP(4) pg8::gemm_phase<pg8::EpiBf16<0>, pg8::StaticOrder, true, true>(F.lds + RING_OFF, g, S, E);
        }
        GB();
        if (sub == 0) {
            if (even) { DUP(16) phase_attn_ab(F, jl); GB(); rows_bmerge(F, AT, (const float*)(F.ws + WS_LSE), O); }
            else { phase_cnorm(F); GB(); phase_attn_c(F, ctl + CW_QUEUE + 64 * jl); GB();
                rows_subln(F, AT, AT + (size_t)M * DM, F.c_lambda + (size_t)jl * 4 * 128, F.c_subln_g + (size_t)jl * 256, 0.8f - 0.6f * __expf(-0.3f * (float)l), O); }
        } else phase_act(F, GU, F.conv_w + (size_t)l * 3 * DFF, F.conv_b + (size_t)l * DFF, ACT);
        GB();
        {
            pg8::Gemm g; int K;
            if (sub == 0) { if (even) { K = AB_OUT; g.Bt = (const bf16*)(F.ws + WS_WABOUT) + (size_t)jl * DM * AB_OUT; } else { K = DM; g.Bt = (const bf16*)(F.ws + WS_WCOUT) + (size_t)jl * DM * DM; } g.A = O; }
            else { K = DFF; g.Bt = (const bf16*)(F.ws + WS_WDOWN) + (size_t)l * DM * DFF; g.A = ACT; }
            g.M = M; g.N = DM; g.K = K;
            pg8::StaticOrder S; S.init(M, DM, F.G, (int)blockIdx.x);
            pg8::EpiF32 E{Y, DM, nullptr};
            DUP(8) pg8::gemm_phase<pg8::EpiF32, pg8::StaticOrder, false, true>(F.lds + RING_OFF, g, S, E);
        }
        GB();
        {
            const float* xs = (s == 0) ? F.x : F.out;
            if (sub == 0) rows_post(F, Y, xs, F.out, modl + 2 * DM, F.norm_g + ((size_t)l * 4 + 1) * DM, F.norm_g + ((size_t)l * 4 + 2) * DM, modl + 4 * DM, modl + 3 * DM, H, true);
            else { const int ln = l + 1 < DEPTH ? l + 1 : l; const float* modn = mod + (size_t)ln * BATCH * MODW;
                rows_post(F, Y, xs, F.out, modl + 5 * DM, F.norm_g + ((size_t)l * 4 + 3) * DM, F.norm_g + ((size_t)ln * 4 + 0) * DM, modn + 1 * DM, modn + 0 * DM, H, l + 1 < DEPTH); }
        }
        if (s < 7) GB();
    }
#undef GB
}

extern "C" void kernel_launch(void* const* d_in, const int* in_sizes, int n_in, void* d_out, int out_size, void* d_ws, size_t ws_size, hipStream_t stream) {
    static int grid = 0;
    if (grid == 0) {
        if (n_in != 16 || in_sizes[0] != M * DM || out_size != M * DM || ws_size < WS_END) { fprintf(stderr, "kernel_launch: unexpected shapes (n_in %d, in0 %d, out %d, ws %zu < %zu)\n", n_in, n_in > 0 ? in_sizes[0] : -1, out_size, ws_size, (size_t)WS_END); grid = -1; return; }
        int dev = 0, cus = 0, per_cu = 0;
        if (hipGetDevice(&dev) != hipSuccess || hipDeviceGetAttribute(&cus, hipDeviceAttributeMultiprocessorCount, dev) != hipSuccess) { grid = -1; return; }
        if (hipFuncSetAttribute((const void*)enc_fwd, hipFuncAttributeMaxDynamicSharedMemorySize, LDS_BYTES) != hipSuccess) { fprintf(stderr, "kernel_launch: hipFuncSetAttribute failed\n"); grid = -1; return; }
        if (hipOccupancyMaxActiveBlocksPerMultiprocessor(&per_cu, (const void*)enc_fwd, NWAVES * 64, LDS_BYTES) != hipSuccess || per_cu < 1) { fprintf(stderr, "kernel_launch: occupancy query says %d\n", per_cu); }
        (void)hipGetLastError();
        grid = cus;
    }
    if (grid < 0) return;
    (void)hipMemsetAsync((char*)d_ws + WS_CTL, 0, CTL_ZERO_BYTES, stream);
    Args a{};
    for (int i = 0; i < 16; ++i) a.in[i] = (const float*)d_in[i];
    a.out = (float*)d_out; a.ws = (unsigned char*)d_ws;
    hipLaunchKernelGGL(enc_fwd, dim3(grid), dim3(NWAVES * 64), LDS_BYTES, stream, a);
}
```

```cpp
#include <hip/hip_runtime.h>
#include <cstdio>
#include <cstdint>
namespace pg8 {
#define PG8_LAS __attribute__((address_space(3)))
typedef unsigned short bf16_t;
typedef short bf16x8 __attribute__((ext_vector_type(8)));
typedef float f32x4 __attribute__((ext_vector_type(4)));
typedef unsigned u32x4 __attribute__((ext_vector_type(4)));
constexpr int BM = 256, BK = 64, HALF = 128, HTB = HALF * BK * 2  , STAGE_BYTES = 8 * HTB, NXCD = 8, WGM = 8;

__host__ __device__ __forceinline__ int lds_byte(int r, int c) { const int st = (r >> 4) * 2 + (c >> 5), rr = r & 15, cc = c & 31, ob = rr * 64 + cc * 2; return st * 1024 + (ob ^ (((ob >> 9) & 1) << 5)); }
__host__ __device__ __forceinline__ void stage_rc(int b, int& R, int& C) { const int st = b / 1024, sb = b % 1024, swz = sb ^ (((sb >> 9) & 1) << 5); R = (st >> 1) * 16 + swz / 64; C = (st & 1) * 32 + (swz % 64) / 2; }
__host__ __device__ __forceinline__ int perm32(int rho) { const int n = rho >> 4, i = rho & 15; return 8 * (i >> 2) + 4 * n + (i & 3); }

struct Unit { int pm, pn; };
struct Gemm { const bf16_t* A; const bf16_t* Bt; int M, N, K; };

struct StaticOrder {
    int nM, nN, nwg, G, c;
    __host__ __device__ void init(int M, int N, int G_, int c_) { nM = M / BM; nN = N / BM; nwg = nM * nN; G = G_; c = c_; }
    __host__ __device__ bool next(int i, Unit& u) const {
        const long L = (long)i * G + c; if (L >= nwg) return false;
        int wgid = (int)L; { const int q = nwg / NXCD, r = nwg % NXCD, xcd = wgid % NXCD, off = wgid / NXCD; wgid = (xcd < r ? xcd * (q + 1) : r * (q + 1) + (xcd - r) * q) + off; }
        const int nig = WGM * nN, gid = wgid / nig, fm = gid * WGM, gsz = (nM - fm) < WGM ? (nM - fm) : WGM;
        u.pm = fm + ((wgid % nig) % gsz); u.pn = (wgid % nig) / gsz; return true;
    }
    __device__ __forceinline__ void a_ready(const Unit&) const {}
    __device__ __forceinline__ void done(const Unit&) const {}
};

__device__ __forceinline__ unsigned cvt_pk_bf16(float lo, float hi) { unsigned r; asm volatile("v_cvt_pk_bf16_f32 %0, %1, %2" : "=v"(r) : "v"(lo), "v"(hi)); return r; }
typedef float f32x2 __attribute__((ext_vector_type(2)));
__device__ __forceinline__ f32x2 gelu_pk(f32x2 v) {
    const f32x2 av = __builtin_elementwise_abs(v), d = av * 0.2316418882f + 1.0f;
    f32x2 t; t.x = __builtin_amdgcn_rcpf(d.x); t.y = __builtin_amdgcn_rcpf(d.y);
    f32x2 q = t * 0.5307027145f + (-0.7265760135f); q = q * t + 0.7107068705f; q = q * t + (-0.142248368f); q = q * t + 0.127414796f; q = q * t;
    const f32x2 s = (v * v) * (-0.72134752044f);
    f32x2 e; e.x = __builtin_amdgcn_exp2f(s.x); e.y = __builtin_amdgcn_exp2f(s.y);
    const f32x2 m = v * (q * e), r = v - m;
    f32x2 o; o.x = v.x < 0.f ? m.x : r.x; o.y = v.y < 0.f ? m.y : r.y; return o;
}

template <int ACT  > struct EpiBf16 {
    static constexpr bool PERM = true, AFTER_DRAIN = false; static_assert(ACT == 0 || ACT == 1, "EpiBf16: ACT is 0 (none) or 1 (gelu_pk)");
    bf16_t* O; int ldc; const float* bias; int split_cols; size_t split_stride; float scale0;
    __device__ __forceinline__ void operator()(const f32x4 (&acc)[2][2][4][2], const Unit& u, int wr, int wc, int fr, int fq) const {
        const int row0 = u.pm * BM + wr * 64 + fr; int colt = u.pn * BM; bf16_t* base = O;
        float sc = 1.f; if (split_cols) { const int t = colt / split_cols; base += (size_t)t * split_stride; colt -= t * split_cols; if (t == 0) sc = scale0; }
        const int col0 = colt + wc * 32 + 8 * fq, bcol0 = u.pn * BM + wc * 32 + 8 * fq;
        f32x4 bv[2][2];
#pragma unroll
        for (int bj = 0; bj < 2; ++bj)
#pragma unroll
            for (int n = 0; n < 2; ++n) bv[bj][n] = bias ? *(const f32x4*)(bias + bcol0 + bj * HALF + 4 * n) : (f32x4){0.f, 0.f, 0.f, 0.f};
#pragma unroll
        for (int ai = 0; ai < 2; ++ai)
#pragma unroll
            for (int m = 0; m < 4; ++m) { bf16_t* rowp = base + (size_t)(row0 + ai * HALF + m * 16) * ldc + col0;
#pragma unroll
                for (int bj = 0; bj < 2; ++bj) { f32x4 v0 = acc[ai][bj][m][0] + bv[bj][0], v1 = acc[ai][bj][m][1] + bv[bj][1];
                    if (ACT == 1) { f32x2 a = gelu_pk((f32x2){v0[0], v0[1]}), b = gelu_pk((f32x2){v0[2], v0[3]}), c = gelu_pk((f32x2){v1[0], v1[1]}), d = gelu_pk((f32x2){v1[2], v1[3]});
                        v0 = (f32x4){a.x, a.y, b.x, b.y}; v1 = (f32x4){c.x, c.y, d.x, d.y}; }
                    v0 = v0 * sc; v1 = v1 * sc; u32x4 w; w.x = cvt_pk_bf16(v0[0], v0[1]); w.y = cvt_pk_bf16(v0[2], v0[3]); w.z = cvt_pk_bf16(v1[0], v1[1]); w.w = cvt_pk_bf16(v1[2], v1[3]);
                    *(u32x4*)(rowp + bj * HALF) = w; } }
    }
};
struct EpiF32 {
    static constexpr bool PERM = false, AFTER_DRAIN = false;
    float* C; int ldc; const float* bias;
    __device__ __forceinline__ void operator()(const f32x4 (&acc)[2][2][4][2], const Unit& u, int wr, int wc, int fr, int fq) const {
        const int row0 = u.pm * BM + wr * 64 + fr, col0 = u.pn * BM + wc * 32 + 4 * fq;
        f32x4 bv[2][2];
#pragma unroll
        for (int bj = 0; bj < 2; ++bj)
#pragma unroll
            for (int n = 0; n < 2; ++n) bv[bj][n] = bias ? *(const f32x4*)(bias + col0 + bj * HALF + n * 16) : (f32x4){0.f, 0.f, 0.f, 0.f};
#pragma unroll
        for (int ai = 0; ai < 2; ++ai)
#pragma unroll
            for (int m = 0; m < 4; ++m) { float* rowp = C + (size_t)(row0 + ai * HALF + m * 16) * ldc + col0;
#pragma unroll
                for (int bj = 0; bj < 2; ++bj)
#pragma unroll
                    for (int n = 0; n < 2; ++n) *(f32x4*)(rowp + bj * HALF + n * 16) = acc[ai][bj][m][n] + bv[bj][n]; }
    }
};
template <class Epi, class Sched, bool ALIGN_EPI = false, bool SP2 = false>
__device__ __forceinline__ void gemm_phase(PG8_LAS unsigned char* lds, const Gemm g, const Sched& S, const Epi& E) {
    int tid_ = threadIdx.x; asm volatile("" : "+v"(tid_));
    const int tid = tid_, wid = __builtin_amdgcn_readfirstlane(tid >> 6), lane = tid & 63, wr = wid >> 2, wc = wid & 3, fr = lane & 15, fq = lane >> 4;
    const int K = g.K, nt = K / BK;
    unsigned voffA[2], voffB[2];
#pragma unroll
    for (int i = 0; i < 2; ++i) { int R, C; stage_rc(tid * 16 + i * 8192, R, C); const int Rb = Epi::PERM ? ((R & ~31) + perm32(R & 31)) : R;
        voffA[i] = (unsigned)(R * K + C) * 2u; voffB[i] = (unsigned)(Rb * K + C) * 2u; }
    const size_t kstep = (size_t)(BK * 2);
    const size_t hstep = (size_t)HALF * K * 2;
    const size_t tstep = 2 * hstep;
    const unsigned ldsw = (unsigned)wid * 1024u;
    const int aoff = lds_byte(wr * 64 + fr, fq * 8), boff = lds_byte(wc * 32 + fr, fq * 8);
#define PG8_SA(b, h) (((b) * 2 + (h)) * HTB)
#define PG8_SB(b, h) ((4 + (b) * 2 + (h)) * HTB)
#define PG8_STAGE(bufoff, gbase, voff) do { _Pragma("unroll") for (int _i = 0; _i < 2; ++_i) \
        __builtin_amdgcn_global_load_lds((const unsigned*)((const char*)(gbase) + (voff)[_i]), (PG8_LAS unsigned*)(lds + (bufoff) + ldsw + _i * 8192), 16, 0, 0); } while (0)
#define PG8_LDA(dst, b, h) do { _Pragma("unroll") for (int m = 0; m < 4; ++m) _Pragma("unroll") for (int k = 0; k < 2; ++k) dst[m][k] = *(const PG8_LAS bf16x8*)(lds + PG8_SA(b, h) + aoff + m * 2048 + k * 1024); } while (0)
#define PG8_LDB(dst, b, h) do { _Pragma("unroll") for (int n = 0; n < 2; ++n) _Pragma("unroll") for (int k = 0; k < 2; ++k) dst[n][k] = *(const PG8_LAS bf16x8*)(lds + PG8_SB(b, h) + boff + n * 2048 + k * 1024); } while (0)
#define PG8_MMA(ai, bj, At, Bt) do { __builtin_amdgcn_s_setprio(1); _Pragma("unroll") for (int m = 0; m < 4; ++m) _Pragma("unroll") for (int n = 0; n < 2; ++n) _Pragma("unroll") for (int k = 0; k < 2; ++k) \
        acc[ai][bj][m][n] = __builtin_amdgcn_mfma_f32_16x16x32_bf16(Bt[n][k], At[m][k], acc[ai][bj][m][n], 0, 0, 0); __builtin_amdgcn_s_setprio(0); } while (0)
#define PG8_WAIT_V(n) asm volatile("s_waitcnt vmcnt(" #n ")" ::: "memory")
#define PG8_WAIT_L(n) asm volatile("s_waitcnt lgkmcnt(" #n ")" ::: "memory")
#define PG8_BAR __builtin_amdgcn_s_barrier()
#define PG8_SCHED __builtin_amdgcn_sched_barrier(0)
    Unit cur, nxt; int ui = 0;
    if (!S.next(0, cur)) return;
    f32x4 acc[2][2][4][2];
#pragma unroll
    for (int a = 0; a < 2; ++a)
#pragma unroll
        for (int b = 0; b < 2; ++b)
#pragma unroll
            for (int m = 0; m < 4; ++m)
#pragma unroll
                for (int n = 0; n < 2; ++n) acc[a][b][m][n] = (f32x4){0.f, 0.f, 0.f, 0.f};
    bf16x8 At[4][2], B0[2][2], B1[2][2];
    const char* cA = (const char*)g.A + (size_t)cur.pm * tstep; const char* cB = (const char*)g.Bt + (size_t)cur.pn * tstep;
    S.a_ready(cur);
    if constexpr (SP2) {
        PG8_STAGE(PG8_SB(0, 0), cB, voffB); PG8_STAGE(PG8_SB(0, 1), cB + hstep, voffB); PG8_STAGE(PG8_SA(0, 0), cA, voffA); PG8_STAGE(PG8_SA(0, 1), cA + hstep, voffA);
        if (wr == 1) PG8_BAR;
        PG8_WAIT_V(2); PG8_BAR;
        PG8_STAGE(PG8_SB(1, 0), cB + kstep, voffB); PG8_STAGE(PG8_SA(1, 0), cA + kstep, voffA); PG8_STAGE(PG8_SB(1, 1), cB + hstep + kstep, voffB);
        PG8_WAIT_V(6); PG8_BAR;
    } else {
        PG8_STAGE(PG8_SB(0, 0), cB, voffB); PG8_STAGE(PG8_SA(0, 0), cA, voffA); PG8_STAGE(PG8_SB(0, 1), cB + hstep, voffB); PG8_STAGE(PG8_SA(0, 1), cA + hstep, voffA);
        if (wr == 1) PG8_BAR;
        PG8_WAIT_V(4); PG8_BAR;
        PG8_STAGE(PG8_SB(1, 0), cB + kstep, voffB); PG8_STAGE(PG8_SA(1, 0), cA + kstep, voffA); PG8_STAGE(PG8_SB(1, 1), cB + hstep + kstep, voffB);
        PG8_WAIT_V(6); PG8_BAR;
    }
    for (;;) {
        const bool has_next = S.next(ui + 1, nxt);
        const char* nA = has_next ? (const char*)g.A + (size_t)nxt.pm * tstep : cA; const char* nB = has_next ? (const char*)g.Bt + (size_t)nxt.pn * tstep : cB;
        for (int t = 0; t < nt; t += 2) {
            const bool last = (t == nt - 2);
            const char* a1 = cA + (size_t)(t + 1) * kstep;
            const char* a2 = last ? nA : cA + (size_t)(t + 2) * kstep; const char* b2 = last ? nB : cB + (size_t)(t + 2) * kstep;
            const char* a3 = a2 + kstep; const char* b3 = b2 + kstep;
            if (last && has_next) S.a_ready(nxt);
            if constexpr (SP2) {
            PG8_LDB(B0, 0, 0); PG8_LDB(B1, 0, 1); PG8_SCHED; PG8_LDA(At, 0, 0); PG8_STAGE(PG8_SA(1, 1), a1 + hstep, voffA);
            PG8_WAIT_V(8); PG8_WAIT_L(0); PG8_BAR; PG8_MMA(0, 0, At, B0); PG8_MMA(0, 1, At, B1); PG8_BAR; PG8_SCHED;
            PG8_LDA(At, 0, 1); PG8_STAGE(PG8_SB(0, 0), b2, voffB); PG8_STAGE(PG8_SB(0, 1), b2 + hstep, voffB); PG8_STAGE(PG8_SA(0, 0), a2, voffA);
            PG8_WAIT_V(8); PG8_WAIT_L(0); PG8_BAR; PG8_MMA(1, 0, At, B0); PG8_MMA(1, 1, At, B1); PG8_BAR; PG8_SCHED;
            PG8_LDB(B0, 1, 0); PG8_LDB(B1, 1, 1); PG8_SCHED; PG8_LDA(At, 1, 0); PG8_STAGE(PG8_SA(0, 1), a2 + hstep, voffA);
            PG8_WAIT_V(8); PG8_WAIT_L(0); PG8_BAR; PG8_MMA(0, 0, At, B0); PG8_MMA(0, 1, At, B1); PG8_BAR; PG8_SCHED;
            PG8_LDA(At, 1, 1); PG8_STAGE(PG8_SB(1, 0), b3, voffB); PG8_STAGE(PG8_SB(1, 1), b3 + hstep, voffB); PG8_STAGE(PG8_SA(1, 0), a3, voffA);
            PG8_WAIT_V(8); PG8_WAIT_L(0); PG8_BAR; PG8_MMA(1, 0, At, B0); PG8_MMA(1, 1, At, B1); PG8_BAR; PG8_SCHED;
            } else {
            PG8_LDB(B0, 0, 0); PG8_SCHED; PG8_LDA(At, 0, 0); PG8_STAGE(PG8_SA(1, 1), a1 + hstep, voffA);
            PG8_WAIT_L(8); PG8_BAR; PG8_WAIT_L(0); PG8_MMA(0, 0, At, B0); PG8_BAR; PG8_SCHED;
            PG8_LDB(B1, 0, 1); PG8_STAGE(PG8_SB(0, 0), b2, voffB);
            PG8_BAR; PG8_WAIT_L(0); PG8_MMA(0, 1, At, B1); PG8_BAR;
            PG8_LDA(At, 0, 1); PG8_STAGE(PG8_SA(0, 0), a2, voffA);
            PG8_BAR; PG8_WAIT_L(0); PG8_MMA(1, 0, At, B0); PG8_BAR; PG8_SCHED;
            PG8_STAGE(PG8_SB(0, 1), b2 + hstep, voffB);
            PG8_WAIT_V(6); PG8_BAR; PG8_MMA(1, 1, At, B1); PG8_BAR;
            PG8_LDB(B0, 1, 0); PG8_SCHED; PG8_LDA(At, 1, 0); PG8_STAGE(PG8_SA(0, 1), a2 + hstep, voffA);
            PG8_WAIT_L(8); PG8_BAR; PG8_WAIT_L(0); PG8_MMA(0, 0, At, B0); PG8_BAR; PG8_SCHED;
            PG8_LDB(B1, 1, 1); PG8_STAGE(PG8_SB(1, 0), b3, voffB);
            PG8_BAR; PG8_WAIT_L(0); PG8_MMA(0, 1, At, B1); PG8_BAR;
            PG8_LDA(At, 1, 1); PG8_STAGE(PG8_SA(1, 0), a3, voffA);
            PG8_BAR; PG8_WAIT_L(0); PG8_MMA(1, 0, At, B0); PG8_BAR; PG8_SCHED;
            PG8_STAGE(PG8_SB(1, 1), b3 + hstep, voffB);
            PG8_WAIT_V(6); PG8_BAR; PG8_MMA(1, 1, At, B1); PG8_BAR;
            }
        }
        if constexpr (ALIGN_EPI) { if (wr == 0) PG8_BAR; }
        if constexpr (!Epi::AFTER_DRAIN) { E(acc, cur, wr, wc, fr, fq); S.done(cur); }
        if (!has_next) break;
#pragma unroll
        for (int a = 0; a < 2; ++a)
#pragma unroll
            for (int b = 0; b < 2; ++b)
#pragma unroll
                for (int m = 0; m < 4; ++m)
#pragma unroll
                    for (int n = 0; n < 2; ++n) acc[a][b][m][n] = (f32x4){0.f, 0.f, 0.f, 0.f};
        cur = nxt; cA = nA; cB = nB; ++ui;
        if constexpr (ALIGN_EPI) { if (wr == 1) PG8_BAR; }
    }
    PG8_WAIT_V(0);
    if constexpr (!ALIGN_EPI) { if (wr == 0) PG8_BAR; }
    PG8_BAR;
    if constexpr (Epi::AFTER_DRAIN) { E.fused(acc, cur, wr, wc, fr, fq, lds, wid, lane); S.done(cur); }
#undef PG8_SA
#undef PG8_SB
#undef PG8_STAGE
#undef PG8_LDA
#undef PG8_LDB
#undef PG8_MMA
#undef PG8_WAIT_V
#undef PG8_WAIT_L
#undef PG8_BAR
#undef PG8_SCHED
}
}
namespace att {
typedef unsigned short bf16;
using bf16x8 = __attribute__((ext_vector_type(8))) short;
using s16x4  = __attribute__((ext_vector_type(4))) short;
using f32x16 = __attribute__((ext_vector_type(16))) float;
using u32x4  = __attribute__((ext_vector_type(4))) unsigned;
constexpr int   D = 128, NW = 8, QBLK = 32, KVBLK = 64;
constexpr float SCALE = 0.088388347648318440f;
constexpr float THR = 8.f;
constexpr int SHM_V = KVBLK * D * 2, SHM_K = KVBLK * D * 2, SHM_ATTN = 2 * SHM_V + 2 * SHM_K + NW * 64 * 4;
constexpr float MASKED = -1e30f, M_INIT = -1e28f;
#define KSWZ(row, colB) ((row) * 256 + ((colB) ^ (((row) & 7) << 4)))
#define SBAR() __builtin_amdgcn_sched_barrier(0)
__device__ __forceinline__ int crow(int r, int hi) { return (r & 3) + 8 * (r >> 2) + 4 * hi; }
__device__ __forceinline__ unsigned cvtpk(float lo, float hi) {
  unsigned r; asm volatile("v_cvt_pk_bf16_f32 %0, %1, %2" : "=v"(r) : "v"(lo), "v"(hi)); return r;
}
__device__ __forceinline__ void partialSM(f32x16& p0, f32x16& p1, float& m_reg, float& mn, float& alpha) {
  constexpr float C = SCALE * 1.4426950408889634f;
  float pmax = p0[0];
#pragma unroll
  for (int r = 1; r < 16; ++r) pmax = fmaxf(pmax, p0[r]);
#pragma unroll
  for (int r = 0; r < 16; ++r) pmax = fmaxf(pmax, p1[r]);
  { auto rr = __builtin_amdgcn_permlane32_swap(__float_as_uint(pmax), __float_as_uint(pmax), false, false);
    pmax = fmaxf(__uint_as_float(rr[0]), __uint_as_float(rr[1])); }
  if (__builtin_expect(__all(pmax - m_reg <= THR / SCALE), 1)) { mn = m_reg; alpha = 1.f; }
  else { mn = fmaxf(m_reg, pmax); alpha = __builtin_amdgcn_exp2f((m_reg - mn) * C); m_reg = mn; }
  float mnC = -mn * C;
#pragma unroll
  for (int r = 0; r < 16; ++r) p0[r] = fmaf(p0[r], C, mnC);
#pragma unroll
  for (int r = 0; r < 16; ++r) p1[r] = fmaf(p1[r], C, mnC);
#pragma unroll
  for (int r = 0; r < 16; ++r) p0[r] = __builtin_amdgcn_exp2f(p0[r]);
}
__device__ __forceinline__ void finishSM(f32x16& p0, f32x16& p1, float alpha, float& l_reg, bf16x8& pa0, bf16x8& pa1, bf16x8& pa2, bf16x8& pa3) {
#pragma unroll
  for (int r = 0; r < 16; ++r) p1[r] = __builtin_amdgcn_exp2f(p1[r]);
  float ps = 0;
#pragma unroll
  for (int r = 0; r < 16; ++r) ps += p0[r];
#pragma unroll
  for (int r = 0; r < 16; ++r) ps += p1[r];
  { auto rr = __builtin_amdgcn_permlane32_swap(__float_as_uint(ps), __float_as_uint(ps), false, false);
    ps = __uint_as_float(rr[0]) + __uint_as_float(rr[1]); }
  l_reg = l_reg * alpha + ps;
#define PK4(P, BASE, OUT) do { unsigned a0 = cvtpk(P[BASE + 0], P[BASE + 1]), a1 = cvtpk(P[BASE + 2], P[BASE + 3]);   \
    unsigned b0 = cvtpk(P[BASE + 4], P[BASE + 5]), b1 = cvtpk(P[BASE + 6], P[BASE + 7]);                              \
    auto r0 = __builtin_amdgcn_permlane32_swap(a0, b0, false, false); auto r1 = __builtin_amdgcn_permlane32_swap(a1, b1, false, false); \
    u32x4 w = {r0[0], r1[0], r0[1], r1[1]}; OUT = *reinterpret_cast<bf16x8*>(&w); } while (0)
  PK4(p0, 0, pa0); PK4(p0, 8, pa1); PK4(p1, 0, pa2); PK4(p1, 8, pa3);
#undef PK4
}
template <bool BAND>
__device__ __forceinline__ void qkt(f32x16& p0, f32x16& p1, const bf16* Ks, const bf16x8* qr, int r32, int hi, float dq, float kf0, float nsl, float radius, float Lf) {
#pragma unroll
  for (int r = 0; r < 16; ++r) {
    const float c0 = (float)((r & 3) + 8 * (r >> 2));
    const float d0 = dq - c0, d1 = dq - (c0 + 32.f);
    float b0 = nsl * fabsf(d0), b1 = nsl * fabsf(d1);
    if (BAND) {
      const float ka = kf0 + c0, kb = kf0 + (c0 + 32.f);
      const bool v0 = (fabsf(d0) <= radius) && (ka >= 0.f) && (ka < Lf);
      const bool v1 = (fabsf(d1) <= radius) && (kb >= 0.f) && (kb < Lf);
      b0 = v0 ? b0 : MASKED; b1 = v1 ? b1 : MASKED;
    }
    p0[r] = b0; p1[r] = b1;
  }
#pragma unroll
  for (int d0 = 0; d0 < 8; ++d0) { int cb = (d0 * 16 + hi * 8) * 2;
    bf16x8 b0 = *reinterpret_cast<const bf16x8*>((const char*)Ks + KSWZ(r32, cb));
    bf16x8 b1 = *reinterpret_cast<const bf16x8*>((const char*)Ks + KSWZ(32 + r32, cb));
    p0 = __builtin_amdgcn_mfma_f32_32x32x16_bf16(b0, qr[d0], p0, 0, 0, 0);
    p1 = __builtin_amdgcn_mfma_f32_32x32x16_bf16(b1, qr[d0], p1, 0, 0, 0); }
}
__device__ __forceinline__ int v_st(int k, int c) { const int kk = (k & ~0xC) | ((k & 4) << 1) | ((k & 8) >> 1); return ((kk >> 3) * 4 + (c >> 5)) * 512 + ((kk & 7) * 32 + (c & 31)) * 2; }
__device__ __forceinline__ int v_rd_base(int lane) { return ((lane & 3) << 3) | (((lane >> 2) & 3) << 6) | (((lane >> 4) & 1) << 5) | (((lane >> 5) & 1) << 8); }
constexpr int v_rd_off(int d0, int ks, int half) { return d0 * 512 + ks * 4096 + half * 2048; }
template <int OFF> __device__ __forceinline__ s16x4 tr_read(int vb) {
  s16x4 r; asm volatile("ds_read_b64_tr_b16 %0, %1 offset:%2" : "=&v"(r) : "v"(vb), "i"(OFF) : "memory"); return r;
}
template <int D0> __device__ __forceinline__ void pv_one(f32x16& od, int vb, bf16x8 pa0, bf16x8 pa1, bf16x8 pa2, bf16x8 pa3) {
  const s16x4 l0 = tr_read<v_rd_off(D0, 0, 0)>(vb), h0 = tr_read<v_rd_off(D0, 0, 1)>(vb), l1 = tr_read<v_rd_off(D0, 1, 0)>(vb), h1 = tr_read<v_rd_off(D0, 1, 1)>(vb);
  const s16x4 l2 = tr_read<v_rd_off(D0, 2, 0)>(vb), h2 = tr_read<v_rd_off(D0, 2, 1)>(vb), l3 = tr_read<v_rd_off(D0, 3, 0)>(vb), h3 = tr_read<v_rd_off(D0, 3, 1)>(vb);
  asm volatile("s_waitcnt lgkmcnt(0)" ::: "memory"); SBAR();
#define PK(L, H) (bf16x8){L[0], L[1], L[2], L[3], H[0], H[1], H[2], H[3]}
  od = __builtin_amdgcn_mfma_f32_32x32x16_bf16(pa0, PK(l0, h0), od, 0, 0, 0);
  od = __builtin_amdgcn_mfma_f32_32x32x16_bf16(pa1, PK(l1, h1), od, 0, 0, 0);
  od = __builtin_amdgcn_mfma_f32_32x32x16_bf16(pa2, PK(l2, h2), od, 0, 0, 0);
  od = __builtin_amdgcn_mfma_f32_32x32x16_bf16(pa3, PK(l3, h3), od, 0, 0, 0);
#undef PK
}
__device__ __forceinline__ void pv_d0(f32x16* o, int vb, bf16x8 pa0, bf16x8 pa1, bf16x8 pa2, bf16x8 pa3) {
  pv_one<0>(o[0], vb, pa0, pa1, pa2, pa3); pv_one<1>(o[1], vb, pa0, pa1, pa2, pa3); pv_one<2>(o[2], vb, pa0, pa1, pa2, pa3); pv_one<3>(o[3], vb, pa0, pa1, pa2, pa3);
}

#define ATT_GAS __attribute__((address_space(1)))
struct UnitArgs {
  const ATT_GAS bf16* Q; long ldq;
  const ATT_GAS bf16* K; const ATT_GAS bf16* V; long ldk;
  int q0, L, kt0, nt;
  float nsl, radius, m_init, l_init;
  ATT_GAS float* Of; ATT_GAS bf16* Ob; long ldo;
  ATT_GAS float* lse; long ldl;
};

template <bool BAND, int SDEPTH>
__device__ __forceinline__ void attn_unit(const UnitArgs& a_in, char* lds) {
  UnitArgs a = a_in;
  asm volatile("" : "+s"(a.Q), "+s"(a.ldq), "+s"(a.K), "+s"(a.V), "+s"(a.ldk));
  asm volatile("" : "+s"(a.q0), "+s"(a.L), "+s"(a.kt0), "+s"(a.nt));
  asm volatile("" : "+s"(a.Of), "+s"(a.Ob), "+s"(a.ldo), "+s"(a.lse), "+s"(a.ldl));
  int tid_ = threadIdx.x; asm volatile("" : "+v"(tid_));
  const int tid = tid_, wid = tid >> 6, lane = tid & 63, r32 = lane & 31, hi = lane >> 5;
  bf16* V_lds = (bf16*)lds; bf16* K_lds = (bf16*)(lds + 2 * SHM_V);
  float* ws = (float*)(lds + 2 * SHM_V + 2 * SHM_K) + wid * 64; float* li_l = ws; float* al_l = ws + 32;
  float m_reg = a.m_init, l_reg = a.l_init; f32x16 o[4] = {}; bf16x8 qr[8];
  const ATT_GAS bf16* Qw = a.Q + (long)(wid * QBLK + r32) * a.ldq + hi * 8;
#pragma unroll
  for (int d0 = 0; d0 < 8; ++d0) qr[d0] = *reinterpret_cast<const ATT_GAS bf16x8*>(Qw + d0 * 16);
  const int sr = tid >> 4, sc = (tid & 15) * 8, vst0 = v_st(sr, sc), vst1 = v_st(32 + sr, sc);
  const int vb0 = (int)(uintptr_t)V_lds + v_rd_base(lane);
  const float qf = (float)(a.q0 + wid * QBLK + r32), Lf = (float)a.L, nsl = a.nsl, radius = a.radius;
  const int Lm1 = a.L - 1, kt0 = a.kt0;
  const ATT_GAS bf16* Kp = a.K; const ATT_GAS bf16* Vp = a.V; const long ldk = a.ldk;
  struct { bf16x8 vs0, vs1, ks0, ks1; } sr_[SDEPTH];
  const unsigned lofs = (unsigned)((sr * ldk + sc) * 2);
  const ATT_GAS char* Kc = (const ATT_GAS char*)Kp; const ATT_GAS char* Vc = (const ATT_GAS char*)Vp; const long ldk32 = 32 * ldk * 2, ldk64 = 64 * ldk * 2;
#define SLOAD(i, t) do { if constexpr (BAND) { const int k0_ = (kt0 + (t)) * KVBLK; int ra_ = k0_ + sr, rb_ = k0_ + 32 + sr;                   \
    ra_ = ra_ < 0 ? 0 : (ra_ > Lm1 ? Lm1 : ra_); rb_ = rb_ < 0 ? 0 : (rb_ > Lm1 ? Lm1 : rb_);                                          \
    sr_[i].vs0 = *reinterpret_cast<const ATT_GAS bf16x8*>(&Vp[(long)ra_ * ldk + sc]); sr_[i].vs1 = *reinterpret_cast<const ATT_GAS bf16x8*>(&Vp[(long)rb_ * ldk + sc]); \
    sr_[i].ks0 = *reinterpret_cast<const ATT_GAS bf16x8*>(&Kp[(long)ra_ * ldk + sc]); sr_[i].ks1 = *reinterpret_cast<const ATT_GAS bf16x8*>(&Kp[(long)rb_ * ldk + sc]); } \
  else { const long tb_ = (long)(kt0 + (t)) * ldk64;                                                                                       \
    sr_[i].vs0 = *reinterpret_cast<const ATT_GAS bf16x8*>(Vc + tb_ + lofs); sr_[i].vs1 = *reinterpret_cast<const ATT_GAS bf16x8*>(Vc + tb_ + ldk32 + lofs); \
    sr_[i].ks0 = *reinterpret_cast<const ATT_GAS bf16x8*>(Kc + tb_ + lofs); sr_[i].ks1 = *reinterpret_cast<const ATT_GAS bf16x8*>(Kc + tb_ + ldk32 + lofs); } } while (0)
#define SWRITE(b, i) do { *(bf16x8*)((char*)V_lds + (b) * SHM_V + vst0) = sr_[i].vs0;          \
    *(bf16x8*)((char*)V_lds + (b) * SHM_V + vst1) = sr_[i].vs1; int kc = sc * 2;               \
    *(bf16x8*)((char*)K_lds + (b) * SHM_K + KSWZ(sr, kc)) = sr_[i].ks0;                       \
    *(bf16x8*)((char*)K_lds + (b) * SHM_K + KSWZ(32 + sr, kc)) = sr_[i].ks1; } while (0)
#define SWAIT() do { if constexpr (SDEPTH == 2) asm volatile("s_waitcnt vmcnt(4)" ::: "memory"); else asm volatile("s_waitcnt vmcnt(0)" ::: "memory"); } while (0)
#define RESC(al) do { if (__any((al) < 1.f)) { if (hi == 0) al_l[r32] = (al); asm volatile("s_waitcnt lgkmcnt(0)" ::: "memory"); \
    _Pragma("unroll") for (int d = 0; d < 4; ++d) _Pragma("unroll") for (int r = 0; r < 16; ++r) o[d][r] *= al_l[crow(r, hi)]; } } while (0)
#define QKT(PA, PB, buf, t) do { const float kf0_ = (float)((kt0 + (t)) * KVBLK + 4 * hi); \
    qkt<BAND>(PA, PB, (bf16*)((char*)K_lds + (buf) * SHM_K), qr, r32, hi, qf - kf0_, kf0_, nsl, radius, Lf); } while (0)
  f32x16 pA0, pA1, pB0, pB1; float mnA, mnB, alA, alB; bf16x8 pa0, pa1, pa2, pa3; const int NT = a.nt;
  constexpr int SE = 0, SO = SDEPTH - 1;
  SLOAD(SE, 0); asm volatile("s_waitcnt vmcnt(0)" ::: "memory"); SWRITE(0, SE); __syncthreads();
  QKT(pA0, pA1, 0, 0); partialSM(pA0, pA1, m_reg, mnA, alA);
  SLOAD(SO, 1); if constexpr (SDEPTH == 2) { if (2 < NT) SLOAD(SE, 2); }
  SWAIT(); SWRITE(1, SO); __syncthreads();
  for (int j = 1; j + 1 < NT; j += 2) {
    SBAR(); QKT(pB0, pB1, 1, j);
    finishSM(pA0, pA1, alA, l_reg, pa0, pa1, pa2, pa3); SBAR();
    SLOAD(SO, j + SDEPTH); SBAR();
    pv_d0(o, vb0, pa0, pa1, pa2, pa3); partialSM(pB0, pB1, m_reg, mnB, alB);
    __syncthreads(); SWAIT(); SWRITE(0, SE);
    RESC(alB); __syncthreads();
    SBAR(); QKT(pA0, pA1, 0, j + 1);
    finishSM(pB0, pB1, alB, l_reg, pa0, pa1, pa2, pa3); SBAR();
    if (SDEPTH == 1 || j + 3 < NT) SLOAD(SE, j + 1 + SDEPTH); SBAR();
    pv_d0(o, vb0 + (int)SHM_V, pa0, pa1, pa2, pa3); partialSM(pA0, pA1, m_reg, mnA, alA);
    __syncthreads(); SWAIT(); SWRITE(1, SO);
    RESC(alA); __syncthreads();
  }
  SBAR(); QKT(pB0, pB1, 1, NT - 1);
  finishSM(pA0, pA1, alA, l_reg, pa0, pa1, pa2, pa3); SBAR();
  pv_d0(o, vb0, pa0, pa1, pa2, pa3); partialSM(pB0, pB1, m_reg, mnB, alB);
  __syncthreads(); RESC(alB);
  finishSM(pB0, pB1, alB, l_reg, pa0, pa1, pa2, pa3); SBAR();
  pv_d0(o, vb0 + (int)SHM_V, pa0, pa1, pa2, pa3);
  if (hi == 0) li_l[r32] = l_reg; asm volatile("s_waitcnt lgkmcnt(0)" ::: "memory");
  float rli[16];
#pragma unroll
  for (int r = 0; r < 16; ++r) rli[r] = __builtin_amdgcn_rcpf(li_l[crow(r, hi)]);
  if (a.Of) {
    ATT_GAS float* Ow = a.Of + (long)(wid * QBLK) * a.ldo;
#pragma unroll
    for (int r = 0; r < 16; ++r) { const int orow = crow(r, hi);
#pragma unroll
      for (int d0 = 0; d0 < 4; ++d0) Ow[(long)orow * a.ldo + d0 * 32 + r32] = o[d0][r] * rli[r]; }
  } else {
    ATT_GAS bf16* Ow = a.Ob + (long)(wid * QBLK) * a.ldo;
#pragma unroll
    for (int r = 0; r < 16; ++r) { const int orow = crow(r, hi);
#pragma unroll
      for (int d0 = 0; d0 < 4; ++d0) { const float v = o[d0][r] * rli[r]; Ow[(long)orow * a.ldo + d0 * 32 + r32] = (bf16)(cvtpk(v, v) & 0xffffu); } }
  }
  if (a.lse && hi == 0) a.lse[(long)(wid * QBLK + r32) * a.ldl] = m_reg * SCALE + __logf(l_reg);
  __syncthreads();
#undef SLOAD
#undef SWRITE
#undef SWAIT
#undef RESC
#undef QKT
}
#undef KSWZ
#undef SBAR
}
constexpr int DM = 2048, BATCH = 2, SEQ = 4096, DEPTH = 4, M = BATCH * SEQ;
constexpr int AB_IN = 3584, AB_OUT = 1024, C_IN = 6144, DFF = 5504, UPW = 2 * DFF, MODW = 6 * DM;
constexpr float EPS = 1e-6f;
constexpr int NWAVES = 8;
constexpr size_t MiB = 1u << 20;
constexpr size_t WS_CTL = 0, CTL_ZERO_BYTES = 2 * MiB;
constexpr size_t WS_MOD = 2 * MiB;
constexpr size_t WS_PART = 3 * MiB;
constexpr size_t WS_NRM = 12 * MiB;
constexpr size_t WS_WABIN = 16 * MiB;
constexpr size_t WS_WABOUT = 44 * MiB;
constexpr size_t WS_WCIN = 52 * MiB;
constexpr size_t WS_WCOUT = 100 * MiB;
constexpr size_t WS_WUP = 116 * MiB;
constexpr size_t WS_WDOWN = 288 * MiB;
constexpr size_t WS_H = 376 * MiB;
constexpr size_t WS_PROJ = 408 * MiB;
constexpr size_t WS_ATT = 504 * MiB;
constexpr size_t WS_LSE = WS_ATT + 64 * MiB;
constexpr size_t WS_O = 632 * MiB;
constexpr size_t WS_Y = 664 * MiB;
constexpr size_t WS_GU = 728 * MiB;
constexpr size_t WS_ACT = 900 * MiB;
constexpr size_t WS_END = 986 * MiB;
static_assert(WS_PART + (size_t)DEPTH * 16 * BATCH * MODW * 4 <= WS_WABIN, "ws map");
static_assert(WS_WABIN + (size_t)2 * AB_IN * DM * 2 <= WS_WABOUT && WS_WABOUT + (size_t)2 * DM * AB_OUT * 2 <= WS_WCIN, "ws map");
static_assert(WS_WCIN + (size_t)2 * C_IN * DM * 2 <= WS_WCOUT && WS_WCOUT + (size_t)2 * DM * DM * 2 <= WS_WUP, "ws map");
static_assert(WS_WUP + (size_t)4 * UPW * DM * 2 <= WS_WDOWN && WS_WDOWN + (size_t)4 * DM * DFF * 2 <= WS_H, "ws map");
static_assert(WS_H + (size_t)M * DM * 2 <= WS_PROJ && WS_PROJ + (size_t)M * C_IN * 2 <= WS_ATT && WS_ATT + (size_t)2 * M * DM * 4 <= WS_O, "ws map");
static_assert(WS_ATT + (size_t)3 * M * 512 * 4 <= WS_LSE && WS_LSE + (size_t)3 * M * 4 * 4 <= WS_O, "ws map");
static_assert(WS_O + (size_t)M * DM * 2 <= WS_Y && WS_Y + (size_t)M * DM * 4 <= WS_GU && WS_GU + (size_t)M * UPW * 2 <= WS_ACT && WS_ACT + (size_t)M * DFF * 2 <= WS_END, "ws map");
constexpr int CW_BAR = 4096;
constexpr int RING_OFF = 0, RING_BYTES = 131072;
constexpr int LDSCTL_OFF = RING_BYTES, MISC_OFF = LDSCTL_OFF + 320;
constexpr int LDS_BYTES = 147456;
static_assert(att::SHM_ATTN <= RING_BYTES, "attention LDS fits the ring region");

#define GAS __attribute__((address_space(1)))
#define LAS __attribute__((address_space(3)))
typedef unsigned short bf16;
typedef unsigned v4u __attribute__((ext_vector_type(4)));
typedef unsigned v2u __attribute__((ext_vector_type(2)));
typedef float f32x4 __attribute__((ext_vector_type(4)));
typedef GAS unsigned gu32;
#define LDS_WAIT() asm volatile("s_waitcnt lgkmcnt(0)" ::: "memory")
__device__ __forceinline__ unsigned pk2(float lo, float hi) { unsigned r; asm volatile("v_cvt_pk_bf16_f32 %0, %1, %2" : "=v"(r) : "v"(lo), "v"(hi)); return r; }
__device__ __forceinline__ float bf_lo(unsigned w) { return __uint_as_float(w << 16); }
__device__ __forceinline__ float bf_hi(unsigned w) { return __uint_as_float(w & 0xffff0000u); }
#define XB_TMO      128
#define XB_XCNT(j)  (256  + 64 * (j))
#define XB_XSUB(j)  (1280 + 64 * (j))
#define XB_XGEN(j)  (2304 + 64 * (j))
#define XB_TOP      3328
#define XB_TOPGEN   3392
#define XCD_BAR_WORDS 3456
#define XB_SPIN_CAP (1u << 18)

__device__ __forceinline__ unsigned xb_ld(unsigned* p)              { return __hip_atomic_load(p, __ATOMIC_RELAXED, __HIP_MEMORY_SCOPE_AGENT); }
__device__ __forceinline__ unsigned xb_add(unsigned* p, unsigned v) { return __hip_atomic_fetch_add(p, v, __ATOMIC_RELAXED, __HIP_MEMORY_SCOPE_AGENT); }
__device__ __forceinline__ unsigned xb_xcc_id() { return (unsigned)__builtin_amdgcn_s_getreg((3 << 11) | 20) & 0xFu; }
#define XB_SPIN(cond, bar) do { unsigned _sp = 0; while (cond) { __builtin_amdgcn_s_sleep(1); \
    if ((++_sp & 255u) == 0u) { if (xb_ld(&(bar)[XB_TMO])) break; if (_sp > XB_SPIN_CAP) { atomicAdd(&(bar)[XB_TMO], 1u); break; } } } } while (0)

struct XcdBarrier {
    unsigned* bar; unsigned x;
    volatile LAS unsigned* st;
};

__device__ __forceinline__ XcdBarrier xcd_barrier_post(unsigned* bar, volatile LAS unsigned* st) {
    XcdBarrier b; b.bar = bar; b.x = xb_xcc_id(); b.st = st;
    if (threadIdx.x == 0) (void)xb_add(&bar[XB_XCNT(b.x)], 1u);
    return b;
}
__device__ __forceinline__ void xcd_barrier_complete(unsigned* bar, unsigned x, unsigned& nloc, unsigned& nx) {
    const unsigned G = gridDim.x * gridDim.y * gridDim.z;
    unsigned sum, cnt, mine, sp = 0u;
    for (;;) {
        sum = 0u; cnt = 0u; mine = 0u;
#pragma unroll
        for (unsigned j = 0; j < 16; ++j) { const unsigned c = xb_ld(&bar[XB_XCNT(j)]); sum += c; cnt += (c > 0u) ? 1u : 0u; mine = (j == x) ? c : mine; }
        if (sum == G) break;
        __builtin_amdgcn_s_sleep(1);
        if ((++sp & 255u) == 0u) { if (xb_ld(&bar[XB_TMO])) break; if (sp > XB_SPIN_CAP) { atomicAdd(&bar[XB_TMO], 1u); break; } }
    }
    nloc = mine > 0u ? mine : 1u; nx = cnt > 0u ? cnt : 1u;
}

__device__ __forceinline__ void xcd_barrier(const XcdBarrier& b) {
    asm volatile("s_waitcnt vmcnt(0)" ::: "memory");
    __syncthreads();
    if (threadIdx.x == 0) {
        unsigned* bar = b.bar;
        __builtin_amdgcn_s_waitcnt(0);
        unsigned nloc = b.st[0], nx = b.st[1];
        if (nloc == 0u) { xcd_barrier_complete(bar, b.x, nloc, nx); b.st[0] = nloc; b.st[1] = nx; }
        const unsigned old = xb_add(&bar[XB_XSUB(b.x)], 1u);
        const unsigned gen = old / nloc;
        if (old + 1u == (gen + 1u) * nloc) {
            __builtin_amdgcn_fence(__ATOMIC_RELEASE, "agent");
            asm volatile("s_waitcnt vmcnt(0)" ::: "memory");
            const unsigned og = xb_add(&bar[XB_TOP], 1u);
            const unsigned tg = og / nx;
            if (og + 1u == (tg + 1u) * nx) xb_add(&bar[XB_TOPGEN], 1u);
            else XB_SPIN(xb_ld(&bar[XB_TOPGEN]) == tg, bar);
            __builtin_amdgcn_fence(__ATOMIC_ACQUIRE, "agent");
            xb_add(&bar[XB_XGEN(b.x)], 1u);
            asm volatile("s_waitcnt vmcnt(0)" ::: "memory");
        } else {
            XB_SPIN(xb_ld(&bar[XB_XGEN(b.x)]) == gen, bar);
            __builtin_amdgcn_fence(__ATOMIC_ACQUIRE, "agent");
            asm volatile("s_waitcnt vmcnt(0)" ::: "memory");
        }
    }
    __syncthreads();
}
struct Frame {
    LAS unsigned char* lds; char* ldsg;
    int tid, lane, wave, G, gw, NGW;
    const float *x, *c, *ada_w, *ada_b, *norm_g, *ab_w_in, *ab_w_out, *a_sink, *c_w_in, *c_w_out, *c_lambda, *c_subln_g, *w_up, *conv_w, *conv_b, *w_down;
    float* out; unsigned char* ws;
};
#define PHASE_IDS() int tid = threadIdx.x; asm volatile("" : "+v"(tid)); const int lane = tid & 63, wave = __builtin_amdgcn_readfirstlane(tid >> 6), gw = (int)blockIdx.x * NWAVES + wave; (void)lane; (void)gw
__device__ __forceinline__ float wave_sum(float v) {
#pragma unroll
    for (int o = 1; o < 64; o <<= 1) v += __shfl_xor(v, o);
    return v;
}
__device__ __forceinline__ void transpose_item(const float* W, int K, int N, bf16* WT, LAS float* scr, int item, int lane) {
    const int nblk = N / 32, kb = item / nblk, nb = item % nblk, k0 = 64 * kb, n0 = 32 * nb;
#pragma unroll 8
    for (int i = 0; i < 32; ++i) { const int kk = 2 * i + (lane >> 5); scr[kk * 33 + (lane & 31)] = W[(size_t)(k0 + kk) * N + n0 + (lane & 31)]; }
    LDS_WAIT(); asm volatile("" ::: "memory");
    const int c = lane & 7;
#pragma unroll
    for (int j = 0; j < 4; ++j) { const int n = (lane >> 3) + 8 * j; const LAS float* s = scr + (8 * c) * 33 + n;
        v4u o; o.x = pk2(s[0 * 33], s[1 * 33]); o.y = pk2(s[2 * 33], s[3 * 33]); o.z = pk2(s[4 * 33], s[5 * 33]); o.w = pk2(s[6 * 33], s[7 * 33]);
        *(GAS v4u*)(WT + (size_t)(n0 + n) * K + k0 + 8 * c) = o; }
    LDS_WAIT(); asm volatile("" ::: "memory");
}
__device__ __forceinline__ float silu_f(float v) { return v / (1.f + __expf(-v)); }

__device__ __forceinline__ void p0a_prologue(Frame& F) {
    PHASE_IDS();
    LAS float* scr = (LAS float*)(F.lds + RING_OFF + wave * 16384);
    constexpr int I_ABIN = (DM / 64) * (AB_IN / 32), I_ABOUT = (AB_OUT / 64) * (DM / 32), I_CIN = (DM / 64) * (C_IN / 32), I_COUT = (DM / 64) * (DM / 32),
                  I_UP = (DM / 64) * (UPW / 32), I_DOWN = (DFF / 64) * (DM / 32);
    constexpr int NT_ITEMS = 2 * I_ABIN + 2 * I_ABOUT + 2 * I_CIN + 2 * I_COUT + 4 * I_UP + 4 * I_DOWN;
    bf16* wabin = (bf16*)(F.ws + WS_WABIN); bf16* wabout = (bf16*)(F.ws + WS_WABOUT); bf16* wcin = (bf16*)(F.ws + WS_WCIN); bf16* wcout = (bf16*)(F.ws + WS_WCOUT);
    bf16* wup = (bf16*)(F.ws + WS_WUP); bf16* wdown = (bf16*)(F.ws + WS_WDOWN);
    for (int it = gw; it < NT_ITEMS; it += F.NGW) {
        int r = it;
        if (r < 2 * I_ABIN) { const int j = r / I_ABIN; transpose_item(F.ab_w_in + (size_t)j * DM * AB_IN, DM, AB_IN, wabin + (size_t)j * AB_IN * DM, scr, r % I_ABIN, lane); continue; } r -= 2 * I_ABIN;
        if (r < 2 * I_ABOUT) { const int j = r / I_ABOUT; transpose_item(F.ab_w_out + (size_t)j * AB_OUT * DM, AB_OUT, DM, wabout + (size_t)j * DM * AB_OUT, scr, r % I_ABOUT, lane); continue; } r -= 2 * I_ABOUT;
        if (r < 2 * I_CIN) { const int j = r / I_CIN; transpose_item(F.c_w_in + (size_t)j * DM * C_IN, DM, C_IN, wcin + (size_t)j * C_IN * DM, scr, r % I_CIN, lane); continue; } r -= 2 * I_CIN;
        if (r < 2 * I_COUT) { const int j = r / I_COUT; transpose_item(F.c_w_out + (size_t)j * DM * DM, DM, DM, wcout + (size_t)j * DM * DM, scr, r % I_COUT, lane); continue; } r -= 2 * I_COUT;
        if (r < 4 * I_UP) { const int j = r / I_UP; transpose_item(F.w_up + (size_t)j * DM * UPW, DM, UPW, wup + (size_t)j * UPW * DM, scr, r % I_UP, lane); continue; } r -= 4 * I_UP;
        { const int j = r / I_DOWN; transpose_item(F.w_down + (size_t)j * DFF * DM, DFF, DM, wdown + (size_t)j * DM * DFF, scr, r % I_DOWN, lane); }
    }
    float* part = (float*)(F.ws + WS_PART);
    constexpr int NCH = MODW / 256, NKC = 16, KCH = DM / NKC;
    for (int it = gw; it < DEPTH * NCH * NKC; it += F.NGW) {
        const int kc = it % NKC, nch = (it / NKC) % NCH, l = it / (NKC * NCH), k0 = kc * KCH;
        const float c0a = silu_f(F.c[k0 + lane]), c0b = silu_f(F.c[k0 + 64 + lane]), c1a = silu_f(F.c[DM + k0 + lane]), c1b = silu_f(F.c[DM + k0 + 64 + lane]);
        const float* wp = F.ada_w + ((size_t)l * DM + k0) * MODW + nch * 256 + 4 * lane;
        f32x4 a0 = {0.f, 0.f, 0.f, 0.f}, a1 = {0.f, 0.f, 0.f, 0.f};
#pragma unroll 8
        for (int k = 0; k < 64; ++k) { const f32x4 w = *(const f32x4*)(wp + (size_t)k * MODW); const float s0 = __shfl(c0a, k), s1 = __shfl(c1a, k); a0 += w * s0; a1 += w * s1; }
#pragma unroll 8
        for (int k = 0; k < 64; ++k) { const f32x4 w = *(const f32x4*)(wp + (size_t)(64 + k) * MODW); const float s0 = __shfl(c0b, k), s1 = __shfl(c1b, k); a0 += w * s0; a1 += w * s1; }
        float* pp = part + (((size_t)l * NKC + kc) * BATCH) * MODW + nch * 256 + 4 * lane;
        *(f32x4*)pp = a0; *(f32x4*)(pp + MODW) = a1;
    }
}
__device__ __forceinline__ void p0b_modreduce(Frame& F) {
    PHASE_IDS();
    const float* part = (const float*)(F.ws + WS_PART); float* mod = (float*)(F.ws + WS_MOD);
    for (int i = blockIdx.x * (NWAVES * 64) + tid; i < DEPTH * BATCH * MODW; i += F.G * NWAVES * 64) {
        const int n = i % MODW, b = (i / MODW) % BATCH, l = i / (MODW * BATCH);
        float s = F.ada_b[l * MODW + n];
#pragma unroll
        for (int kc = 0; kc < 16; ++kc) s += part[(((size_t)l * 16 + kc) * BATCH + b) * MODW + n];
        mod[i] = s;
    }
}
__device__ __forceinline__ void rows_pre(Frame& F, const float* x, const float* ng, const float* scale, const float* shift, bf16* H) {
    PHASE_IDS();
    for (int m = gw; m < M; m += F.NGW) {
        const int b = m / SEQ; f32x4 v[8]; float ss = 0.f;
#pragma unroll
        for (int j = 0; j < 8; ++j) { v[j] = *(const f32x4*)(x + (size_t)m * DM + 4 * lane + 256 * j); ss += (v[j].x * v[j].x + v[j].y * v[j].y) + (v[j].z * v[j].z + v[j].w * v[j].w); }
        const float r = 1.f / sqrtf(wave_sum(ss) * (1.f / DM) + EPS);
#pragma unroll
        for (int j = 0; j < 8; ++j) { const int c = 4 * lane + 256 * j;
            const f32x4 g = *(const f32x4*)(ng + c), sc = *(const f32x4*)(scale + (size_t)b * MODW + c), sh = *(const f32x4*)(shift + (size_t)b * MODW + c);
            const f32x4 h = (v[j] * r) * g * (sc + 1.f) + sh;
            v2u o; o.x = pk2(h.x, h.y); o.y = pk2(h.z, h.w); *(v2u*)(H + (size_t)m * DM + c) = o; }
    }
}
__device__ __forceinline__ void rows_post(Frame& F, const float* Y, const float* xs, float* xd, const float* gate, const float* nga,
                                          const float* ngb, const float* scale, const float* shift, bf16* H, bool doH) {
    PHASE_IDS();
    for (int m = gw; m < M; m += F.NGW) {
        const int b = m / SEQ; f32x4 v[8]; float ss = 0.f;
#pragma unroll
        for (int j = 0; j < 8; ++j) { v[j] = *(const f32x4*)(Y + (size_t)m * DM + 4 * lane + 256 * j); ss += (v[j].x * v[j].x + v[j].y * v[j].y) + (v[j].z * v[j].z + v[j].w * v[j].w); }
        const float r = 1.f / sqrtf(wave_sum(ss) * (1.f / DM) + EPS); float ss2 = 0.f;
#pragma unroll
        for (int j = 0; j < 8; ++j) { const int c = 4 * lane + 256 * j;
            const f32x4 xv = *(const f32x4*)(xs + (size_t)m * DM + c), g = *(const f32x4*)(gate + (size_t)b * MODW + c), na = *(const f32x4*)(nga + c);
            v[j] = xv + g * ((v[j] * r) * na);
            ss2 += (v[j].x * v[j].x + v[j].y * v[j].y) + (v[j].z * v[j].z + v[j].w * v[j].w);
            *(f32x4*)(xd + (size_t)m * DM + c) = v[j]; }
        if (doH) {
            const float r2 = 1.f / sqrtf(wave_sum(ss2) * (1.f / DM) + EPS);
#pragma unroll
            for (int j = 0; j < 8; ++j) { const int c = 4 * lane + 256 * j;
                const f32x4 g = *(const f32x4*)(ngb + c), sc = *(const f32x4*)(scale + (size_t)b * MODW + c), sh = *(const f32x4*)(shift + (size_t)b * MODW + c);
                const f32x4 h = (v[j] * r2) * g * (sc + 1.f) + sh;
                v2u o; o.x = pk2(h.x, h.y); o.y = pk2(h.z, h.w); *(v2u*)(H + (size_t)m * DM + c) = o; }
        }
    }
}
__device__ __forceinline__ void rows_subln(Frame& F, const float* A0, const float* A1, const float* lamp, const float* sg, float lambda_init, bf16* O) {
    PHASE_IDS();
    const float l0 = lamp[lane] * lamp[128 + lane] + lamp[64 + lane] * lamp[128 + 64 + lane];
    const float l1 = lamp[256 + lane] * lamp[384 + lane] + lamp[256 + 64 + lane] * lamp[384 + 64 + lane];
    const float lam = __expf(wave_sum(l0)) - __expf(wave_sum(l1)) + lambda_init;
    const f32x4 g = *(const f32x4*)(sg + 4 * lane) * (1.f - lambda_init);
    for (int m = gw; m < M; m += F.NGW) {
#pragma unroll
        for (int j = 0; j < 8; ++j) { const size_t off = (size_t)m * DM + 4 * lane + 256 * j;
            const f32x4 d = *(const f32x4*)(A0 + off) - *(const f32x4*)(A1 + off) * lam;
            const float ss = wave_sum((d.x * d.x + d.y * d.y) + (d.z * d.z + d.w * d.w));
            const float r = 1.f / sqrtf(ss * (1.f / 256.f) + EPS);
            const f32x4 h = (d * r) * g;
            v2u o; o.x = pk2(h.x, h.y); o.y = pk2(h.z, h.w); *(v2u*)(O + off) = o; }
    }
}
__device__ __forceinline__ void rows_bmerge(Frame& F, const float* OB, const float* LSE, bf16* O) {
    PHASE_IDS();
    for (int m = gw; m < M; m += F.NGW) {
        const int hb = lane >> 4;
        const float e0 = LSE[(size_t)m * 4 + hb], e1 = LSE[((size_t)M + m) * 4 + hb], e2 = LSE[((size_t)2 * M + m) * 4 + hb];
        const float mx = fmaxf(e0, fmaxf(e1, e2));
        float w0 = __expf(e0 - mx), w1 = __expf(e1 - mx), w2 = __expf(e2 - mx); const float inv = 1.f / (w0 + w1 + w2); w0 *= inv; w1 *= inv; w2 *= inv;
        const float* p = OB + (size_t)m * 512 + 8 * lane;
        const f32x4 a0 = *(const f32x4*)p, a1 = *(const f32x4*)(p + 4);
        const f32x4 b0 = *(const f32x4*)(p + (size_t)M * 512), b1 = *(const f32x4*)(p + (size_t)M * 512 + 4);
        const f32x4 c0 = *(const f32x4*)(p + (size_t)2 * M * 512), c1 = *(const f32x4*)(p + (size_t)2 * M * 512 + 4);
        const f32x4 r0 = a0 * w0 + b0 * w1 + c0 * w2, r1 = a1 * w0 + b1 * w1 + c1 * w2;
        v4u o; o.x = pk2(r0.x, r0.y); o.y = pk2(r0.z, r0.w); o.z = pk2(r1.x, r1.y); o.w = pk2(r1.z, r1.w);
        *(v4u*)(O + (size_t)m * AB_OUT + 512 + 8 * lane) = o;
    }
}
__device__ __forceinline__ float gelu_tanh(float v) {
    const float u = 0.7978845608028654f * (v + 0.044715f * v * v * v);
    const float e = __expf(2.f * u);
    const float t = 1.f - 2.f / (e + 1.f);
    return 0.5f * v * (1.f + t);
}
__device__ __forceinline__ void phase_act(Frame& F, const bf16* GU, const float* cw, const float* cb, bf16* ACT) {
    PHASE_IDS();
    constexpr int NC8 = DFF / 8, RB = 8, NRB = M / RB;
    for (int it = blockIdx.x * (NWAVES * 64) + tid; it < NRB * NC8; it += F.G * NWAVES * 64) {
        const int c8 = it % NC8, rb = it / NC8, c = c8 * 8, m0 = rb * RB;
        float w0[8], w1[8], w2[8], bb[8];
#pragma unroll
        for (int i = 0; i < 8; ++i) { w0[i] = cw[c + i]; w1[i] = cw[DFF + c + i]; w2[i] = cw[2 * DFF + c + i]; bb[i] = cb[c + i]; }
        v4u gp, gc, gn;
        if ((m0 % SEQ) == 0) gp = (v4u){0u, 0u, 0u, 0u}; else gp = *(const v4u*)(GU + (size_t)(m0 - 1) * UPW + c);
        gc = *(const v4u*)(GU + (size_t)m0 * UPW + c);
#pragma unroll
        for (int rr = 0; rr < RB; ++rr) {
            const int m = m0 + rr;
            if ((m % SEQ) == SEQ - 1) gn = (v4u){0u, 0u, 0u, 0u}; else gn = *(const v4u*)(GU + (size_t)(m + 1) * UPW + c);
            const v4u up = *(const v4u*)(GU + (size_t)m * UPW + DFF + c);
            float r[8];
#pragma unroll
            for (int q = 0; q < 4; ++q) {
                const float a_lo = w0[2 * q] * bf_lo(gp[q]) + w1[2 * q] * bf_lo(gc[q]) + w2[2 * q] * bf_lo(gn[q]) + bb[2 * q];
                const float a_hi = w0[2 * q + 1] * bf_hi(gp[q]) + w1[2 * q + 1] * bf_hi(gc[q]) + w2[2 * q + 1] * bf_hi(gn[q]) + bb[2 * q + 1];
                r[2 * q] = gelu_tanh(a_lo) * bf_lo(up[q]); r[2 * q + 1] = gelu_tanh(a_hi) * bf_hi(up[q]);
            }
            v4u o; o.x = pk2(r[0], r[1]); o.y = pk2(r[2], r[3]); o.z = pk2(r[4], r[5]); o.w = pk2(r[6], r[7]);
            *(v4u*)(ACT + (size_t)m * DFF + c) = o;
            gp = gc; gc = gn;
        }
    }
}
__device__ __forceinline__ float alibi16(int i) { return exp2f(-0.5f * (float)(i + 1)); }
__device__ __forceinline__ void phase_attn_ab(Frame& F, int jl) {
    const bf16* P = (const bf16*)(F.ws + WS_PROJ); bf16* O = (bf16*)(F.ws + WS_O); float* OB = (float*)(F.ws + WS_ATT); float* LSE = (float*)(F.ws + WS_LSE);
    for (int u = blockIdx.x; u < 512; u += F.G) {
        att::UnitArgs a;
        if (u < 128) {
            const int qb = u % 16, qh = (u / 16) % 4, b = u / 64, q0 = qb * 256; const size_t row0 = (size_t)b * SEQ;
            a.Q = (const GAS bf16*)P + (row0 + q0) * AB_IN + qh * 128; a.ldq = AB_IN;
            a.K = (const GAS bf16*)P + row0 * AB_IN + 512 + (qh >> 1) * 128; a.V = (const GAS bf16*)P + row0 * AB_IN + 768 + (qh >> 1) * 128; a.ldk = AB_IN;
            a.q0 = q0; a.L = SEQ; a.kt0 = q0 / 64 - 2; a.nt = 8;
            a.nsl = -alibi16(qh) / att::SCALE; a.radius = 128.f; a.m_init = F.a_sink[jl * 4 + qh] / att::SCALE; a.l_init = 1.f;
            a.Of = nullptr; a.Ob = (GAS bf16*)O + (row0 + q0) * AB_OUT + qh * 128; a.ldo = AB_OUT; a.lse = nullptr; a.ldl = 0;
        } else {
            const int v = (u - 128) % 128, gi = (u - 128) / 128, dil = gi == 0 ? 1 : (gi == 1 ? 4 : 16), L = SEQ / dil;
            int qb, r, hb, b;
            if (gi == 0) { qb = v % 16; r = 0; hb = (v / 16) % 4; b = v / 64; }
            else if (gi == 1) { qb = v % 4; r = (v / 4) % 4; hb = (v / 16) % 4; b = v / 64; }
            else { qb = 0; r = v % 16; hb = (v / 16) % 4; b = v / 64; }
            const int q0 = qb * 256; const size_t seq0 = (size_t)b * SEQ + r, rowq = seq0 + (size_t)dil * q0;
            a.Q = (const GAS bf16*)P + rowq * AB_IN + 1024 + gi * 512 + hb * 128; a.ldq = (long)dil * AB_IN;
            a.K = (const GAS bf16*)P + seq0 * AB_IN + 2560 + hb * 128; a.V = (const GAS bf16*)P + seq0 * AB_IN + 3072 + hb * 128; a.ldk = (long)dil * AB_IN;
            a.q0 = q0; a.L = L; a.kt0 = q0 / 64 - 1; a.nt = 6;
            a.nsl = -alibi16(4 + gi * 4 + hb) * (float)dil / att::SCALE; a.radius = 64.f; a.m_init = att::M_INIT; a.l_init = 0.f;
            a.Of = (GAS float*)OB + ((size_t)gi * M + rowq) * 512 + hb * 128; a.Ob = nullptr; a.ldo = (long)dil * 512;
            a.lse = (GAS float*)LSE + ((size_t)gi * M + rowq) * 4 + hb; a.ldl = (long)dil * 4;
        }
        att::attn_unit<true, 1>(a, F.ldsg + RING_OFF);
    }
}
__device__ __forceinline__ void phase_cnorm(Frame& F) {
    PHASE_IDS();
    const bf16* P = (const bf16*)(F.ws + WS_PROJ); float* NRM = (float*)(F.ws + WS_NRM);
    for (int it = gw; it < 4096; it += F.NGW) {
        const int tile = it & 63, j = (it >> 6) & 1, h = (it >> 7) & 7, b = (it >> 10) & 1, which = it >> 11;
        const bf16* base = P + ((size_t)b * SEQ + 64 * tile + (lane >> 4)) * C_IN + which * 2048 + h * 256 + j * 128 + (lane & 15) * 8;
        float mx = 0.f;
#pragma unroll 4
        for (int i = 0; i < 16; ++i) {
            const v4u w = *(const v4u*)(base + (size_t)(4 * i) * C_IN);
            float ss = 0.f;
#pragma unroll
            for (int q = 0; q < 4; ++q) { const float a = bf_lo(w[q]), c = bf_hi(w[q]); ss += a * a + c * c; }
            ss += __shfl_xor(ss, 1); ss += __shfl_xor(ss, 2); ss += __shfl_xor(ss, 4); ss += __shfl_xor(ss, 8);
            mx = fmaxf(mx, ss);
        }
        mx = fmaxf(mx, __shfl_xor(mx, 16)); mx = fmaxf(mx, __shfl_xor(mx, 32));
        if (lane == 0) NRM[it] = sqrtf(mx);
    }
}
__device__ __forceinline__ void phase_attn_c(Frame& F, gu32* ctr) {
    PHASE_IDS();
    const bf16* P = (const bf16*)(F.ws + WS_PROJ); float* AT = (float*)(F.ws + WS_ATT); const float* NRM = (const float*)(F.ws + WS_NRM);
    volatile LAS unsigned* slot = (volatile LAS unsigned*)(F.lds + MISC_OFF) + 16;
    for (;;) {
        if (tid == 0) *slot = __hip_atomic_fetch_add(ctr, 1u, __ATOMIC_RELAXED, __HIP_MEMORY_SCOPE_AGENT);
        __syncthreads();
        const int i = __builtin_amdgcn_readfirstlane((int)*slot);
        __syncthreads();
        if (i >= 1024) break;
        const int h = 7 - (i >> 7), qb = i & 15, vh = (i >> 4) & 1, j = (i >> 5) & 1, b = (i >> 6) & 1, q0 = qb * 256; const size_t row0 = (size_t)b * SEQ;
        const float slope = exp2f(-(float)(h + 1));
        const float* QN = NRM + ((b * 8 + h) * 2 + j) * 64; const float* KN = QN + 2048;
        const float qn = fmaxf(fmaxf(QN[4 * qb], QN[4 * qb + 1]), fmaxf(QN[4 * qb + 2], QN[4 * qb + 3]));
        const float ks = fmaxf(fmaxf(KN[4 * qb], KN[4 * qb + 1]), fmaxf(KN[4 * qb + 2], KN[4 * qb + 3]));
        const int klo = 64 * lane, d1 = klo - (q0 + 255), d2 = q0 - (klo + 63), dmin = d1 > 0 ? d1 : (d2 > 0 ? d2 : 0);
        const float bound = att::SCALE * 1.02f * qn * (KN[lane] + ks) - slope * (float)dmin;
        const unsigned long long need = __ballot(bound > -25.f);
        int t_lo = (int)__builtin_ctzll(need), t_hi = 64 - (int)__builtin_clzll(need);
        if ((t_hi - t_lo) & 1) { if (t_lo > 0) --t_lo; else ++t_hi; }
        att::UnitArgs a;
        a.Q = (const GAS bf16*)P + (row0 + q0) * C_IN + h * 256 + j * 128; a.ldq = C_IN;
        a.K = (const GAS bf16*)P + row0 * C_IN + 2048 + h * 256 + j * 128; a.V = (const GAS bf16*)P + row0 * C_IN + 4096 + h * 256 + vh * 128; a.ldk = C_IN;
        a.q0 = q0; a.L = SEQ; a.kt0 = t_lo; a.nt = t_hi - t_lo;
        a.nsl = -slope / att::SCALE; a.radius = 0.f; a.m_init = att::M_INIT; a.l_init = 0.f;
        a.Of = (GAS float*)AT + ((size_t)j * M + row0 + q0) * DM + h * 256 + vh * 128; a.Ob = nullptr; a.ldo = DM; a.lse = nullptr; a.ldl = 0;
        att::attn_unit<false, 2>(a, F.ldsg + RING_OFF);
    }
}

#ifndef ENC_DUP
#define ENC_DUP 0
#endif
#define DUP(bit) for (int rep_ = 0; rep_ < (((ENC_DUP) & (bit)) ? 2 : 1); ++rep_)
constexpr int CW_QUEUE = 8192;
struct Args { const float* in[16]; float* out; unsigned char* ws; };
__global__ void __launch_bounds__(NWAVES * 64, 2) enc_fwd(Args args) {
    extern __shared__ __attribute__((aligned(16))) unsigned char lds[];
    Frame F;
    F.lds = (LAS unsigned char*)lds; F.ldsg = (char*)lds;
    F.tid = threadIdx.x; F.lane = F.tid & 63; F.wave = __builtin_amdgcn_readfirstlane(F.tid >> 6);
    F.G = gridDim.x; F.gw = blockIdx.x * NWAVES + F.wave; F.NGW = F.G * NWAVES;
    F.x = args.in[0]; F.c = args.in[1]; F.ada_w = args.in[2]; F.ada_b = args.in[3]; F.norm_g = args.in[4]; F.ab_w_in = args.in[5]; F.ab_w_out = args.in[6]; F.a_sink = args.in[7];
    F.c_w_in = args.in[8]; F.c_w_out = args.in[9]; F.c_lambda = args.in[10]; F.c_subln_g = args.in[11]; F.w_up = args.in[12]; F.conv_w = args.in[13]; F.conv_b = args.in[14]; F.w_down = args.in[15];
    F.out = args.out; F.ws = args.ws;
    gu32* ctl = (gu32*)(F.ws + WS_CTL);
    for (int u = F.tid; u < (LDS_BYTES - LDSCTL_OFF) / 4; u += NWAVES * 64) ((LAS unsigned*)(F.lds + LDSCTL_OFF))[u] = 0u;
    __syncthreads();
    (void)xcd_barrier_post((unsigned*)(ctl + CW_BAR), (volatile LAS unsigned*)(F.lds + MISC_OFF) + 8);
#define GB() do { unsigned char* wsb_ = args.ws; asm volatile("" : "+s"(wsb_)); XcdBarrier bar_; bar_.bar = (unsigned*)(wsb_ + WS_CTL) + CW_BAR; bar_.x = xb_xcc_id(); \
        bar_.st = (volatile LAS unsigned*)(F.lds + MISC_OFF) + 8; xcd_barrier(bar_); } while (0)
    float* mod = (float*)(F.ws + WS_MOD);
    bf16* H = (bf16*)(F.ws + WS_H); bf16* PROJ = (bf16*)(F.ws + WS_PROJ); bf16* O = (bf16*)(F.ws + WS_O); float* Y = (float*)(F.ws + WS_Y);
    bf16* GU = (bf16*)(F.ws + WS_GU); bf16* ACT = (bf16*)(F.ws + WS_ACT); float* AT = (float*)(F.ws + WS_ATT);

    DUP(1) p0a_prologue(F);
    GB();
    p0b_modreduce(F);
    GB();
    rows_pre(F, F.x, F.norm_g, mod + 1 * DM, mod + 0 * DM, H);
    GB();

    for (int s = 0; s < 8; ++s) {
        const int l = s >> 1, sub = s & 1, jl = l >> 1, even = !(l & 1);
        const float* modl = mod + (size_t)l * BATCH * MODW;
        {
            pg8::Gemm g; bf16* dst; int N;
            if (sub == 0) { if (even) { N = AB_IN; g.Bt = (const bf16*)(F.ws + WS_WABIN) + (size_t)jl * AB_IN * DM; } else { N = C_IN; g.Bt = (const bf16*)(F.ws + WS_WCIN) + (size_t)jl * C_IN * DM; } dst = PROJ; }
            else { N = UPW; g.Bt = (const bf16*)(F.ws + WS_WUP) + (size_t)l * UPW * DM; dst = GU; }
            g.A = H; g.M = M; g.N = N; g.K = DM;
            pg8::StaticOrder S; S.init(M, N, F.G, (int)blockIdx.x);
            pg8::EpiBf16<0> E{dst, N, nullptr, 0, 0, 1.f};
            DUP(4) pg8::gemm_phase<pg8::EpiBf16<0>, pg8::StaticOrder, true, true>(F.lds + RING_OFF, g, S, E);
        }
        GB();
        if (sub == 0) {
            if (even) { DUP(16) phase_attn_ab(F, jl); GB(); rows_bmerge(F, AT, (const float*)(F.ws + WS_LSE), O); }
            else { phase_cnorm(F); GB(); phase_attn_c(F, ctl + CW_QUEUE + 64 * jl); GB();
                rows_subln(F, AT, AT + (size_t)M * DM, F.c_lambda + (size_t)jl * 4 * 128, F.c_subln_g + (size_t)jl * 256, 0.8f - 0.6f * __expf(-0.3f * (float)l), O); }
        } else phase_act(F, GU, F.conv_w + (size_t)l * 3 * DFF, F.conv_b + (size_t)l * DFF, ACT);
        GB();
        {
            pg8::Gemm g; int K;
            if (sub == 0) { if (even) { K = AB_OUT; g.Bt = (const bf16*)(F.ws + WS_WABOUT) + (size_t)jl * DM * AB_OUT; } else { K = DM; g.Bt = (const bf16*)(F.ws + WS_WCOUT) + (size_t)jl * DM * DM; } g.A = O; }
            else { K = DFF; g.Bt = (const bf16*)(F.ws + WS_WDOWN) + (size_t)l * DM * DFF; g.A = ACT; }
            g.M = M; g.N = DM; g.K = K;
            pg8::StaticOrder S; S.init(M, DM, F.G, (int)blockIdx.x);
            pg8::EpiF32 E{Y, DM, nullptr};
            DUP(8) pg8::gemm_phase<pg8::EpiF32, pg8::StaticOrder, false, true>(F.lds + RING_OFF, g, S, E);
        }
        GB();
        {
            const float* xs = (s == 0) ? F.x : F.out;
            if (sub == 0) rows_post(F, Y, xs, F.out, modl + 2 * DM, F.norm_g + ((size_t)l * 4 + 1) * DM, F.norm_g + ((size_t)l * 4 + 2) * DM, modl + 4 * DM, modl + 3 * DM, H, true);
            else { const int ln = l + 1 < DEPTH ? l + 1 : l; const float* modn = mod + (size_t)ln * BATCH * MODW;
                rows_post(F, Y, xs, F.out, modl + 5 * DM, F.norm_g + ((size_t)l * 4 + 3) * DM, F.norm_g + ((size_t)ln * 4 + 0) * DM, modn + 1 * DM, modn + 0 * DM, H, l + 1 < DEPTH); }
        }
        if (s < 7) GB();
    }
#undef GB
}

extern "C" void kernel_launch(void* const* d_in, const int* in_sizes, int n_in, void* d_out, int out_size, void* d_ws, size_t ws_size, hipStream_t stream) {
    static int grid = 0;
    if (grid == 0) {
        if (n_in != 16 || in_sizes[0] != M * DM || out_size != M * DM || ws_size < WS_END) { fprintf(stderr, "kernel_launch: unexpected shapes (n_in %d, in0 %d, out %d, ws %zu < %zu)\n", n_in, n_in > 0 ? in_sizes[0] : -1, out_size, ws_size, (size_t)WS_END); grid = -1; return; }
        int dev = 0, cus = 0, per_cu = 0;
        if (hipGetDevice(&dev) != hipSuccess || hipDeviceGetAttribute(&cus, hipDeviceAttributeMultiprocessorCount, dev) != hipSuccess) { grid = -1; return; }
        if (hipFuncSetAttribute((const void*)enc_fwd, hipFuncAttributeMaxDynamicSharedMemorySize, LDS_BYTES) != hipSuccess) { fprintf(stderr, "kernel_launch: hipFuncSetAttribute failed\n"); grid = -1; return; }
        if (hipOccupancyMaxActiveBlocksPerMultiprocessor(&per_cu, (const void*)enc_fwd, NWAVES * 64, LDS_BYTES) != hipSuccess || per_cu < 1) { fprintf(stderr, "kernel_launch: occupancy query says %d\n", per_cu); }
        (void)hipGetLastError();
        grid = cus;
    }
    if (grid < 0) return;
    (void)hipMemsetAsync((char*)d_ws + WS_CTL, 0, CTL_ZERO_BYTES, stream);
    Args a{};
    for (int i = 0; i < 16; ++i) a.in[i] = (const float*)d_in[i];
    a.out = (float*)d_out; a.ws = (unsigned char*)d_ws;
    hipLaunchKernelGGL(enc_fwd, dim3(grid), dim3(NWAVES * 64), LDS_BYTES, stream, a);
}
```

```cpp
#include <hip/hip_runtime.h>
#include <cstdio>
#include <cstdint>
namespace pg8 {
#define PG8_LAS __attribute__((address_space(3)))
typedef unsigned short bf16_t;
typedef short bf16x8 __attribute__((ext_vector_type(8)));
typedef float f32x4 __attribute__((ext_vector_type(4)));
typedef unsigned u32x4 __attribute__((ext_vector_type(4)));
constexpr int BM = 256, BK = 64, HALF = 128, HTB = HALF * BK * 2  , STAGE_BYTES = 8 * HTB, NXCD = 8, WGM = 8;

__host__ __device__ __forceinline__ int lds_byte(int r, int c) { const int st = (r >> 4) * 2 + (c >> 5), rr = r & 15, cc = c & 31, ob = rr * 64 + cc * 2; return st * 1024 + (ob ^ (((ob >> 9) & 1) << 5)); }
__host__ __device__ __forceinline__ void stage_rc(int b, int& R, int& C) { const int st = b / 1024, sb = b % 1024, swz = sb ^ (((sb >> 9) & 1) << 5); R = (st >> 1) * 16 + swz / 64; C = (st & 1) * 32 + (swz % 64) / 2; }
__host__ __device__ __forceinline__ int perm32(int rho) { const int n = rho >> 4, i = rho & 15; return 8 * (i >> 2) + 4 * n + (i & 3); }

struct Unit { int pm, pn; };
struct Gemm { const bf16_t* A; const bf16_t* Bt; int M, N, K; };

struct StaticOrder {
    int nM, nN, nwg, G, c;
    __host__ __device__ void init(int M, int N, int G_, int c_) { nM = M / BM; nN = N / BM; nwg = nM * nN; G = G_; c = c_; }
    __host__ __device__ bool next(int i, Unit& u) const {
        const long L = (long)i * G + c; if (L >= nwg) return false;
        int wgid = (int)L; { const int q = nwg / NXCD, r = nwg % NXCD, xcd = wgid % NXCD, off = wgid / NXCD; wgid = (xcd < r ? xcd * (q + 1) : r * (q + 1) + (xcd - r) * q) + off; }
        const int nig = WGM * nN, gid = wgid / nig, fm = gid * WGM, gsz = (nM - fm) < WGM ? (nM - fm) : WGM;
        u.pm = fm + ((wgid % nig) % gsz); u.pn = (wgid % nig) / gsz; return true;
    }
    __device__ __forceinline__ void a_ready(const Unit&) const {}
    __device__ __forceinline__ void done(const Unit&) const {}
};

__device__ __forceinline__ unsigned cvt_pk_bf16(float lo, float hi) { unsigned r; asm volatile("v_cvt_pk_bf16_f32 %0, %1, %2" : "=v"(r) : "v"(lo), "v"(hi)); return r; }
typedef float f32x2 __attribute__((ext_vector_type(2)));
__device__ __forceinline__ f32x2 gelu_pk(f32x2 v) {
    const f32x2 av = __builtin_elementwise_abs(v), d = av * 0.2316418882f + 1.0f;
    f32x2 t; t.x = __builtin_amdgcn_rcpf(d.x); t.y = __builtin_amdgcn_rcpf(d.y);
    f32x2 q = t * 0.5307027145f + (-0.7265760135f); q = q * t + 0.7107068705f; q = q * t + (-0.142248368f); q = q * t + 0.127414796f; q = q * t;
    const f32x2 s = (v * v) * (-0.72134752044f);
    f32x2 e; e.x = __builtin_amdgcn_exp2f(s.x); e.y = __builtin_amdgcn_exp2f(s.y);
    const f32x2 m = v * (q * e), r = v - m;
    f32x2 o; o.x = v.x < 0.f ? m.x : r.x; o.y = v.y < 0.f ? m.y : r.y; return o;
}

template <int ACT  > struct EpiBf16 {
    static constexpr bool PERM = true, AFTER_DRAIN = false; static_assert(ACT == 0 || ACT == 1, "EpiBf16: ACT is 0 (none) or 1 (gelu_pk)");
    bf16_t* O; int ldc; const float* bias; int split_cols; size_t split_stride; float scale0;
    __device__ __forceinline__ void operator()(const f32x4 (&acc)[2][2][4][2], const Unit& u, int wr, int wc, int fr, int fq) const {
        const int row0 = u.pm * BM + wr * 64 + fr; int colt = u.pn * BM; bf16_t* base = O;
        float sc = 1.f; if (split_cols) { const int t = colt / split_cols; base += (size_t)t * split_stride; colt -= t * split_cols; if (t == 0) sc = scale0; }
        const int col0 = colt + wc * 32 + 8 * fq, bcol0 = u.pn * BM + wc * 32 + 8 * fq;
        f32x4 bv[2][2];
#pragma unroll
        for (int bj = 0; bj < 2; ++bj)
#pragma unroll
            for (int n = 0; n < 2; ++n) bv[bj][n] = bias ? *(const f32x4*)(bias + bcol0 + bj * HALF + 4 * n) : (f32x4){0.f, 0.f, 0.f, 0.f};
#pragma unroll
        for (int ai = 0; ai < 2; ++ai)
#pragma unroll
            for (int m = 0; m < 4; ++m) { bf16_t* rowp = base + (size_t)(row0 + ai * HALF + m * 16) * ldc + col0;
#pragma unroll
                for (int bj = 0; bj < 2; ++bj) { f32x4 v0 = acc[ai][bj][m][0] + bv[bj][0], v1 = acc[ai][bj][m][1] + bv[bj][1];
                    if (ACT == 1) { f32x2 a = gelu_pk((f32x2){v0[0], v0[1]}), b = gelu_pk((f32x2){v0[2], v0[3]}), c = gelu_pk((f32x2){v1[0], v1[1]}), d = gelu_pk((f32x2){v1[2], v1[3]});
                        v0 = (f32x4){a.x, a.y, b.x, b.y}; v1 = (f32x4){c.x, c.y, d.x, d.y}; }
                    v0 = v0 * sc; v1 = v1 * sc; u32x4 w; w.x = cvt_pk_bf16(v0[0], v0[1]); w.y = cvt_pk_bf16(v0[2], v0[3]); w.z = cvt_pk_bf16(v1[0], v1[1]); w.w = cvt_pk_bf16(v1[2], v1[3]);
                    *(u32x4*)(rowp + bj * HALF) = w; } }
    }
};
struct EpiF32 {
    static constexpr bool PERM = false, AFTER_DRAIN = false;
    float* C; int ldc; const float* bias;
    __device__ __forceinline__ void operator()(const f32x4 (&acc)[2][2][4][2], const Unit& u, int wr, int wc, int fr, int fq) const {
        const int row0 = u.pm * BM + wr * 64 + fr, col0 = u.pn * BM + wc * 32 + 4 * fq;
        f32x4 bv[2][2];
#pragma unroll
        for (int bj = 0; bj < 2; ++bj)
#pragma unroll
            for (int n = 0; n < 2; ++n) bv[bj][n] = bias ? *(const f32x4*)(bias + col0 + bj * HALF + n * 16) : (f32x4){0.f, 0.f, 0.f, 0.f};
#pragma unroll
        for (int ai = 0; ai < 2; ++ai)
#pragma unroll
            for (int m = 0; m < 4; ++m) { float* rowp = C + (size_t)(row0 + ai * HALF + m * 16) * ldc + col0;
#pragma unroll
                for (int bj = 0; bj < 2; ++bj)
#pragma unroll
                    for (int n = 0; n < 2; ++n) *(f32x4*)(rowp + bj * HALF + n * 16) = acc[ai][bj][m][n] + bv[bj][n]; }
    }
};
template <class Epi, class Sched, bool ALIGN_EPI = false, bool SP2 = false>
__device__ __forceinline__ void gemm_phase(PG8_LAS unsigned char* lds, const Gemm g, const Sched& S, const Epi& E) {
    int tid_ = threadIdx.x; asm volatile("" : "+v"(tid_));
    const int tid = tid_, wid = __builtin_amdgcn_readfirstlane(tid >> 6), lane = tid & 63, wr = wid >> 2, wc = wid & 3, fr = lane & 15, fq = lane >> 4;
    const int K = g.K, nt = K / BK;
    unsigned voffA[2], voffB[2];
#pragma unroll
    for (int i = 0; i < 2; ++i) { int R, C; stage_rc(tid * 16 + i * 8192, R, C); const int Rb = Epi::PERM ? ((R & ~31) + perm32(R & 31)) : R;
        voffA[i] = (unsigned)(R * K + C) * 2u; voffB[i] = (unsigned)(Rb * K + C) * 2u; }
    const size_t kstep = (size_t)(BK * 2);
    const size_t hstep = (size_t)HALF * K * 2;
    const size_t tstep = 2 * hstep;
    const unsigned ldsw = (unsigned)wid * 1024u;
    const int aoff = lds_byte(wr * 64 + fr, fq * 8), boff = lds_byte(wc * 32 + fr, fq * 8);
#define PG8_SA(b, h) (((b) * 2 + (h)) * HTB)
#define PG8_SB(b, h) ((4 + (b) * 2 + (h)) * HTB)
#define PG8_STAGE(bufoff, gbase, voff) do { _Pragma("unroll") for (int _i = 0; _i < 2; ++_i) \
        __builtin_amdgcn_global_load_lds((const unsigned*)((const char*)(gbase) + (voff)[_i]), (PG8_LAS unsigned*)(lds + (bufoff) + ldsw + _i * 8192), 16, 0, 0); } while (0)
#define PG8_LDA(dst, b, h) do { _Pragma("unroll") for (int m = 0; m < 4; ++m) _Pragma("unroll") for (int k = 0; k < 2; ++k) dst[m][k] = *(const PG8_LAS bf16x8*)(lds + PG8_SA(b, h) + aoff + m * 2048 + k * 1024); } while (0)
#define PG8_LDB(dst, b, h) do { _Pragma("unroll") for (int n = 0; n < 2; ++n) _Pragma("unroll") for (int k = 0; k < 2; ++k) dst[n][k] = *(const PG8_LAS bf16x8*)(lds + PG8_SB(b, h) + boff + n * 2048 + k * 1024); } while (0)
#define PG8_MMA(ai, bj, At, Bt) do { __builtin_amdgcn_s_setprio(1); _Pragma("unroll") for (int m = 0; m < 4; ++m) _Pragma("unroll") for (int n = 0; n < 2; ++n) _Pragma("unroll") for (int k = 0; k < 2; ++k) \
        acc[ai][bj][m][n] = __builtin_amdgcn_mfma_f32_16x16x32_bf16(Bt[n][k], At[m][k], acc[ai][bj][m][n], 0, 0, 0); __builtin_amdgcn_s_setprio(0); } while (0)
#define PG8_WAIT_V(n) asm volatile("s_waitcnt vmcnt(" #n ")" ::: "memory")
#define PG8_WAIT_L(n) asm volatile("s_waitcnt lgkmcnt(" #n ")" ::: "memory")
#define PG8_BAR __builtin_amdgcn_s_barrier()
#define PG8_SCHED __builtin_amdgcn_sched_barrier(0)
    Unit cur, nxt; int ui = 0;
    if (!S.next(0, cur)) return;
    f32x4 acc[2][2][4][2];
#pragma unroll
    for (int a = 0; a < 2; ++a)
#pragma unroll
        for (int b = 0; b < 2; ++b)
#pragma unroll
            for (int m = 0; m < 4; ++m)
#pragma unroll
                for (int n = 0; n < 2; ++n) acc[a][b][m][n] = (f32x4){0.f, 0.f, 0.f, 0.f};
    bf16x8 At[4][2], B0[2][2], B1[2][2];
    const char* cA = (const char*)g.A + (size_t)cur.pm * tstep; const char* cB = (const char*)g.Bt + (size_t)cur.pn * tstep;
    S.a_ready(cur);
    if constexpr (SP2) {
        PG8_STAGE(PG8_SB(0, 0), cB, voffB); PG8_STAGE(PG8_SB(0, 1), cB + hstep, voffB); PG8_STAGE(PG8_SA(0, 0), cA, voffA); PG8_STAGE(PG8_SA(0, 1), cA + hstep, voffA);
        if (wr == 1) PG8_BAR;
        PG8_WAIT_V(2); PG8_BAR;
        PG8_STAGE(PG8_SB(1, 0), cB + kstep, voffB); PG8_STAGE(PG8_SA(1, 0), cA + kstep, voffA); PG8_STAGE(PG8_SB(1, 1), cB + hstep + kstep, voffB);
        PG8_WAIT_V(6); PG8_BAR;
    } else {
        PG8_STAGE(PG8_SB(0, 0), cB, voffB); PG8_STAGE(PG8_SA(0, 0), cA, voffA); PG8_STAGE(PG8_SB(0, 1), cB + hstep, voffB); PG8_STAGE(PG8_SA(0, 1), cA + hstep, voffA);
        if (wr == 1) PG8_BAR;
        PG8_WAIT_V(4); PG8_BAR;
        PG8_STAGE(PG8_SB(1, 0), cB + kstep, voffB); PG8_STAGE(PG8_SA(1, 0), cA + kstep, voffA); PG8_STAGE(PG8_SB(1, 1), cB + hstep + kstep, voffB);
        PG8_WAIT_V(6); PG8_BAR;
    }
    for (;;) {
        const bool has_next = S.next(ui + 1, nxt);
        const char* nA = has_next ? (const char*)g.A + (size_t)nxt.pm * tstep : cA; const char* nB = has_next ? (const char*)g.Bt + (size_t)nxt.pn * tstep : cB;
        for (int t = 0; t < nt; t += 2) {
            const bool last = (t == nt - 2);
            const char* a1 = cA + (size_t)(t + 1) * kstep;
            const char* a2 = last ? nA : cA + (size_t)(t + 2) * kstep; const char* b2 = last ? nB : cB + (size_t)(t + 2) * kstep;
            const char* a3 = a2 + kstep; const char* b3 = b2 + kstep;
            if (last && has_next) S.a_ready(nxt);
            if constexpr (SP2) {
            PG8_LDB(B0, 0, 0); PG8_LDB(B1, 0, 1); PG8_SCHED; PG8_LDA(At, 0, 0); PG8_STAGE(PG8_SA(1, 1), a1 + hstep, voffA);
            PG8_WAIT_V(8); PG8_WAIT_L(0); PG8_BAR; PG8_MMA(0, 0, At, B0); PG8_MMA(0, 1, At, B1); PG8_BAR; PG8_SCHED;
            PG8_LDA(At, 0, 1); PG8_STAGE(PG8_SB(0, 0), b2, voffB); PG8_STAGE(PG8_SB(0, 1), b2 + hstep, voffB); PG8_STAGE(PG8_SA(0, 0), a2, voffA);
            PG8_WAIT_V(8); PG8_WAIT_L(0); PG8_BAR; PG8_MMA(1, 0, At, B0); PG8_MMA(1, 1, At, B1); PG8_BAR; PG8_SCHED;
            PG8_LDB(B0, 1, 0); PG8_LDB(B1, 1, 1); PG8_SCHED; PG8_LDA(At, 1, 0); PG8_STAGE(PG8_SA(0, 1), a2 + hstep, voffA);
            PG8_WAIT_V(8); PG8_WAIT_L(0); PG8_BAR; PG8_MMA(0, 0, At, B0); PG8_MMA(0, 1, At, B1); PG8_BAR; PG8_SCHED;
            PG8_LDA(At, 1, 1); PG8_STAGE(PG8_SB(1, 0), b3, voffB); PG8_STAGE(PG8_SB(1, 1), b3 + hstep, voffB); PG8_STAGE(PG8_SA(1, 0), a3, voffA);
            PG8_WAIT_V(8); PG8_WAIT_L(0); PG8_BAR; PG8_MMA(1, 0, At, B0); PG8_MMA(1, 1, At, B1); PG8_BAR; PG8_SCHED;
            } else {
            PG8_LDB(B0, 0, 0); PG8_SCHED; PG8_LDA(At, 0, 0); PG8_STAGE(PG8_SA(1, 1), a1 + hstep, voffA);
            PG8_WAIT_L(8); PG8_BAR; PG8_WAIT_L(0); PG8_MMA(0, 0, At, B0); PG8_BAR; PG8_SCHED;
            PG8_LDB(B1, 0, 1); PG8_STAGE(PG8_SB(0, 0), b2, voffB);
            PG8_BAR; PG8_WAIT_L(0); PG8_MMA(0, 1, At, B1); PG8_BAR;
            PG8_LDA(At, 0, 1); PG8_STAGE(PG8_SA(0, 0), a2, voffA);
            PG8_BAR; PG8_WAIT_L(0); PG8_MMA(1, 0, At, B0); PG8_BAR; PG8_SCHED;
            PG8_STAGE(PG8_SB(0, 1), b2 + hstep, voffB);
            PG8_WAIT_V(6); PG8_BAR; PG8_MMA(1, 1, At, B1); PG8_BAR;
            PG8_LDB(B0, 1, 0); PG8_SCHED; PG8_LDA(At, 1, 0); PG8_STAGE(PG8_SA(0, 1), a2 + hstep, voffA);
            PG8_WAIT_L(8); PG8_BAR; PG8_WAIT_L(0); PG8_MMA(0, 0, At, B0); PG8_BAR; PG8_SCHED;
            PG8_LDB(B1, 1, 1); PG8_STAGE(PG8_SB(1, 0), b3, voffB);
            PG8_BAR; PG8_WAIT_L(0); PG8_MMA(0, 1, At, B1); PG8_BAR;
            PG8_LDA(At, 1, 1); PG8_STAGE(PG8_SA(1, 0), a3, voffA);
            PG8_BAR; PG8_WAIT_L(0); PG8_MMA(1, 0, At, B0); PG8_BAR; PG8_SCHED;
            PG8_STAGE(PG8_SB(1, 1), b3 + hstep, voffB);
            PG8_WAIT_V(6); PG8_BAR; PG8_MMA(1, 1, At, B1); PG8_BAR;
            }
        }
        if constexpr (ALIGN_EPI) { if (wr == 0) PG8_BAR; }
        if constexpr (!Epi::AFTER_DRAIN) { E(acc, cur, wr, wc, fr, fq); S.done(cur); }
        if (!has_next) break;
#pragma unroll
        for (int a = 0; a < 2; ++a)
#pragma unroll
            for (int b = 0; b < 2; ++b)
#pragma unroll
                for (int m = 0; m < 4; ++m)
#pragma unroll
                    for (int n = 0; n < 2; ++n) acc[a][b][m][n] = (f32x4){0.f, 0.f, 0.f, 0.f};
        cur = nxt; cA = nA; cB = nB; ++ui;
        if constexpr (ALIGN_EPI) { if (wr == 1) PG8_BAR; }
    }
    PG8_WAIT_V(0);
    if constexpr (!ALIGN_EPI) { if (wr == 0) PG8_BAR; }
    PG8_BAR;
    if constexpr (Epi::AFTER_DRAIN) { E.fused(acc, cur, wr, wc, fr, fq, lds, wid, lane); S.done(cur); }
#undef PG8_SA
#undef PG8_SB
#undef PG8_STAGE
#undef PG8_LDA
#undef PG8_LDB
#undef PG8_MMA
#undef PG8_WAIT_V
#undef PG8_WAIT_L
#undef PG8_BAR
#undef PG8_SCHED
}
}
namespace att {
typedef unsigned short bf16;
using bf16x8 = __attribute__((ext_vector_type(8))) short;
using s16x4  = __attribute__((ext_vector_type(4))) short;
using f32x16 = __attribute__((ext_vector_type(16))) float;
using u32x4  = __attribute__((ext_vector_type(4))) unsigned;
constexpr int   D = 128, NW = 8, QBLK = 32, KVBLK = 64;
constexpr float SCALE = 0.088388347648318440f;
constexpr float THR = 8.f;
constexpr int SHM_V = KVBLK * D * 2, SHM_K = KVBLK * D * 2, SHM_ATTN = 2 * SHM_V + 2 * SHM_K + NW * 64 * 4;
constexpr float MASKED = -1e30f, M_INIT = -1e28f;
#define KSWZ(row, colB) ((row) * 256 + ((colB) ^ (((row) & 7) << 4)))
#define SBAR() __builtin_amdgcn_sched_barrier(0)
__device__ __forceinline__ int crow(int r, int hi) { return (r & 3) + 8 * (r >> 2) + 4 * hi; }
__device__ __forceinline__ unsigned cvtpk(float lo, float hi) {
  unsigned r; asm volatile("v_cvt_pk_bf16_f32 %0, %1, %2" : "=v"(r) : "v"(lo), "v"(hi)); return r;
}
__device__ __forceinline__ void partialSM(f32x16& p0, f32x16& p1, float& m_reg, float& mn, float& alpha) {
  constexpr float C = SCALE * 1.4426950408889634f;
  float pmax = p0[0];
#pragma unroll
  for (int r = 1; r < 16; ++r) pmax = fmaxf(pmax, p0[r]);
#pragma unroll
  for (int r = 0; r < 16; ++r) pmax = fmaxf(pmax, p1[r]);
  { auto rr = __builtin_amdgcn_permlane32_swap(__float_as_uint(pmax), __float_as_uint(pmax), false, false);
    pmax = fmaxf(__uint_as_float(rr[0]), __uint_as_float(rr[1])); }
  if (__builtin_expect(__all(pmax - m_reg <= THR / SCALE), 1)) { mn = m_reg; alpha = 1.f; }
  else { mn = fmaxf(m_reg, pmax); alpha = __builtin_amdgcn_exp2f((m_reg - mn) * C); m_reg = mn; }
  float mnC = -mn * C;
#pragma unroll
  for (int r = 0; r < 16; ++r) p0[r] = fmaf(p0[r], C, mnC);
#pragma unroll
  for (int r = 0; r < 16; ++r) p1[r] = fmaf(p1[r], C, mnC);
#pragma unroll
  for (int r = 0; r < 16; ++r) p0[r] = __builtin_amdgcn_exp2f(p0[r]);
}
__device__ __forceinline__ void finishSM(f32x16& p0, f32x16& p1, float alpha, float& l_reg, bf16x8& pa0, bf16x8& pa1, bf16x8& pa2, bf16x8& pa3) {
#pragma unroll
  for (int r = 0; r < 16; ++r) p1[r] = __builtin_amdgcn_exp2f(p1[r]);
  float ps = 0;
#pragma unroll
  for (int r = 0; r < 16; ++r) ps += p0[r];
#pragma unroll
  for (int r = 0; r < 16; ++r) ps += p1[r];
  { auto rr = __builtin_amdgcn_permlane32_swap(__float_as_uint(ps), __float_as_uint(ps), false, false);
    ps = __uint_as_float(rr[0]) + __uint_as_float(rr[1]); }
  l_reg = l_reg * alpha + ps;
#define PK4(P, BASE, OUT) do { unsigned a0 = cvtpk(P[BASE + 0], P[BASE + 1]), a1 = cvtpk(P[BASE + 2], P[BASE + 3]);   \
    unsigned b0 = cvtpk(P[BASE + 4], P[BASE + 5]), b1 = cvtpk(P[BASE + 6], P[BASE + 7]);                              \
    auto r0 = __builtin_amdgcn_permlane32_swap(a0, b0, false, false); auto r1 = __builtin_amdgcn_permlane32_swap(a1, b1, false, false); \
    u32x4 w = {r0[0], r1[0], r0[1], r1[1]}; OUT = *reinterpret_cast<bf16x8*>(&w); } while (0)
  PK4(p0, 0, pa0); PK4(p0, 8, pa1); PK4(p1, 0, pa2); PK4(p1, 8, pa3);
#undef PK4
}
template <bool BAND>
__device__ __forceinline__ void qkt(f32x16& p0, f32x16& p1, const bf16* Ks, const bf16x8* qr, int r32, int hi, float dq, float kf0, float nsl, float radius, float Lf) {
#pragma unroll
  for (int r = 0; r < 16; ++r) {
    const float c0 = (float)((r & 3) + 8 * (r >> 2));
    const float d0 = dq - c0, d1 = dq - (c0 + 32.f);
    float b0 = nsl * fabsf(d0), b1 = nsl * fabsf(d1);
    if (BAND) {
      const float ka = kf0 + c0, kb = kf0 + (c0 + 32.f);
      const bool v0 = (fabsf(d0) <= radius) && (ka >= 0.f) && (ka < Lf);
      const bool v1 = (fabsf(d1) <= radius) && (kb >= 0.f) && (kb < Lf);
      b0 = v0 ? b0 : MASKED; b1 = v1 ? b1 : MASKED;
    }
    p0[r] = b0; p1[r] = b1;
  }
#pragma unroll
  for (int d0 = 0; d0 < 8; ++d0) { int cb = (d0 * 16 + hi * 8) * 2;
    bf16x8 b0 = *reinterpret_cast<const bf16x8*>((const char*)Ks + KSWZ(r32, cb));
    bf16x8 b1 = *reinterpret_cast<const bf16x8*>((const char*)Ks + KSWZ(32 + r32, cb));
    p0 = __builtin_amdgcn_mfma_f32_32x32x16_bf16(b0, qr[d0], p0, 0, 0, 0);
    p1 = __builtin_amdgcn_mfma_f32_32x32x16_bf16(b1, qr[d0], p1, 0, 0, 0); }
}
__device__ __forceinline__ int v_st(int k, int c) { const int kk = (k & ~0xC) | ((k & 4) << 1) | ((k & 8) >> 1); return ((kk >> 3) * 4 + (c >> 5)) * 512 + ((kk & 7) * 32 + (c & 31)) * 2; }
__device__ __forceinline__ int v_rd_base(int lane) { return ((lane & 3) << 3) | (((lane >> 2) & 3) << 6) | (((lane >> 4) & 1) << 5) | (((lane >> 5) & 1) << 8); }
constexpr int v_rd_off(int d0, int ks, int half) { return d0 * 512 + ks * 4096 + half * 2048; }
template <int OFF> __device__ __forceinline__ s16x4 tr_read(int vb) {
  s16x4 r; asm volatile("ds_read_b64_tr_b16 %0, %1 offset:%2" : "=&v"(r) : "v"(vb), "i"(OFF) : "memory"); return r;
}
template <int D0> __device__ __forceinline__ void pv_one(f32x16& od, int vb, bf16x8 pa0, bf16x8 pa1, bf16x8 pa2, bf16x8 pa3) {
  const s16x4 l0 = tr_read<v_rd_off(D0, 0, 0)>(vb), h0 = tr_read<v_rd_off(D0, 0, 1)>(vb), l1 = tr_read<v_rd_off(D0, 1, 0)>(vb), h1 = tr_read<v_rd_off(D0, 1, 1)>(vb);
  const s16x4 l2 = tr_read<v_rd_off(D0, 2, 0)>(vb), h2 = tr_read<v_rd_off(D0, 2, 1)>(vb), l3 = tr_read<v_rd_off(D0, 3, 0)>(vb), h3 = tr_read<v_rd_off(D0, 3, 1)>(vb);
  asm volatile("s_waitcnt lgkmcnt(0)" ::: "memory"); SBAR();
#define PK(L, H) (bf16x8){L[0], L[1], L[2], L[3], H[0], H[1], H[2], H[3]}
  od = __builtin_amdgcn_mfma_f32_32x32x16_bf16(pa0, PK(l0, h0), od, 0, 0, 0);
  od = __builtin_amdgcn_mfma_f32_32x32x16_bf16(pa1, PK(l1, h1), od, 0, 0, 0);
  od = __builtin_amdgcn_mfma_f32_32x32x16_bf16(pa2, PK(l2, h2), od, 0, 0, 0);
  od = __builtin_amdgcn_mfma_f32_32x32x16_bf16(pa3, PK(l3, h3), od, 0, 0, 0);
#undef PK
}
__device__ __forceinline__ void pv_d0(f32x16* o, int vb, bf16x8 pa0, bf16x8 pa1, bf16x8 pa2, bf16x8 pa3) {
  pv_one<0>(o[0], vb, pa0, pa1, pa2, pa3); pv_one<1>(o[1], vb, pa0, pa1, pa2, pa3); pv_one<2>(o[2], vb, pa0, pa1, pa2, pa3); pv_one<3>(o[3], vb, pa0, pa1, pa2, pa3);
}

#define ATT_GAS __attribute__((address_space(1)))
struct UnitArgs {
  const ATT_GAS bf16* Q; long ldq;
  const ATT_GAS bf16* K; const ATT_GAS bf16* V; long ldk;
  int q0, L, kt0, nt;
  float nsl, radius, m_init, l_init;
  ATT_GAS float* Of; ATT_GAS bf16* Ob; long ldo;
  ATT_GAS float* lse; long ldl;
};

template <bool BAND, int SDEPTH>
__device__ __forceinline__ void attn_unit(const UnitArgs& a_in, char* lds) {
  UnitArgs a = a_in;
  asm volatile("" : "+s"(a.Q), "+s"(a.ldq), "+s"(a.K), "+s"(a.V), "+s"(a.ldk));
  asm volatile("" : "+s"(a.q0), "+s"(a.L), "+s"(a.kt0), "+s"(a.nt));
  asm volatile("" : "+s"(a.Of), "+s"(a.Ob), "+s"(a.ldo), "+s"(a.lse), "+s"(a.ldl));
  int tid_ = threadIdx.x; asm volatile("" : "+v"(tid_));
  const int tid = tid_, wid = tid >> 6, lane = tid & 63, r32 = lane & 31, hi = lane >> 5;
  bf16* V_lds = (bf16*)lds; bf16* K_lds = (bf16*)(lds + 2 * SHM_V);
  float* ws = (float*)(lds + 2 * SHM_V + 2 * SHM_K) + wid * 64; float* li_l = ws; float* al_l = ws + 32;
  float m_reg = a.m_init, l_reg = a.l_init; f32x16 o[4] = {}; bf16x8 qr[8];
  const ATT_GAS bf16* Qw = a.Q + (long)(wid * QBLK + r32) * a.ldq + hi * 8;
#pragma unroll
  for (int d0 = 0; d0 < 8; ++d0) qr[d0] = *reinterpret_cast<const ATT_GAS bf16x8*>(Qw + d0 * 16);
  const int sr = tid >> 4, sc = (tid & 15) * 8, vst0 = v_st(sr, sc), vst1 = v_st(32 + sr, sc);
  const int vb0 = (int)(uintptr_t)V_lds + v_rd_base(lane);
  const float qf = (float)(a.q0 + wid * QBLK + r32), Lf = (float)a.L, nsl = a.nsl, radius = a.radius;
  const int Lm1 = a.L - 1, kt0 = a.kt0;
  const ATT_GAS bf16* Kp = a.K; const ATT_GAS bf16* Vp = a.V; const long ldk = a.ldk;
  struct { bf16x8 vs0, vs1, ks0, ks1; } sr_[SDEPTH];
  const unsigned lofs = (unsigned)((sr * ldk + sc) * 2);
  const ATT_GAS char* Kc = (const ATT_GAS char*)Kp; const ATT_GAS char* Vc = (const ATT_GAS char*)Vp; const long ldk32 = 32 * ldk * 2, ldk64 = 64 * ldk * 2;
#define SLOAD(i, t) do { if constexpr (BAND) { const int k0_ = (kt0 + (t)) * KVBLK; int ra_ = k0_ + sr, rb_ = k0_ + 32 + sr;                   \
    ra_ = ra_ < 0 ? 0 : (ra_ > Lm1 ? Lm1 : ra_); rb_ = rb_ < 0 ? 0 : (rb_ > Lm1 ? Lm1 : rb_);                                          \
    sr_[i].vs0 = *reinterpret_cast<const ATT_GAS bf16x8*>(&Vp[(long)ra_ * ldk + sc]); sr_[i].vs1 = *reinterpret_cast<const ATT_GAS bf16x8*>(&Vp[(long)rb_ * ldk + sc]); \
    sr_[i].ks0 = *reinterpret_cast<const ATT_GAS bf16x8*>(&Kp[(long)ra_ * ldk + sc]); sr_[i].ks1 = *reinterpret_cast<const ATT_GAS bf16x8*>(&Kp[(long)rb_ * ldk + sc]); } \
  else { const long tb_ = (long)(kt0 + (t)) * ldk64;                                                                                       \
    sr_[i].vs0 = *reinterpret_cast<const ATT_GAS bf16x8*>(Vc + tb_ + lofs); sr_[i].vs1 = *reinterpret_cast<const ATT_GAS bf16x8*>(Vc + tb_ + ldk32 + lofs); \
    sr_[i].ks0 = *reinterpret_cast<const ATT_GAS bf16x8*>(Kc + tb_ + lofs); sr_[i].ks1 = *reinterpret_cast<const ATT_GAS bf16x8*>(Kc + tb_ + ldk32 + lofs); } } while (0)
#define SWRITE(b, i) do { *(bf16x8*)((char*)V_lds + (b) * SHM_V + vst0) = sr_[i].vs0;          \
    *(bf16x8*)((char*)V_lds + (b) * SHM_V + vst1) = sr_[i].vs1; int kc = sc * 2;               \
    *(bf16x8*)((char*)K_lds + (b) * SHM_K + KSWZ(sr, kc)) = sr_[i].ks0;                       \
    *(bf16x8*)((char*)K_lds + (b) * SHM_K + KSWZ(32 + sr, kc)) = sr_[i].ks1; } while (0)
#define SWAIT() do { if constexpr (SDEPTH == 2) asm volatile("s_waitcnt vmcnt(4)" ::: "memory"); else asm volatile("s_waitcnt vmcnt(0)" ::: "memory"); } while (0)
#define RESC(al) do { if (__any((al) < 1.f)) { if (hi == 0) al_l[r32] = (al); asm volatile("s_waitcnt lgkmcnt(0)" ::: "memory"); \
    _Pragma("unroll") for (int d = 0; d < 4; ++d) _Pragma("unroll") for (int r = 0; r < 16; ++r) o[d][r] *= al_l[crow(r, hi)]; } } while (0)
#define QKT(PA, PB, buf, t) do { const float kf0_ = (float)((kt0 + (t)) * KVBLK + 4 * hi); \
    qkt<BAND>(PA, PB, (bf16*)((char*)K_lds + (buf) * SHM_K), qr, r32, hi, qf - kf0_, kf0_, nsl, radius, Lf); } while (0)
  f32x16 pA0, pA1, pB0, pB1; float mnA, mnB, alA, alB; bf16x8 pa0, pa1, pa2, pa3; const int NT = a.nt;
  constexpr int SE = 0, SO = SDEPTH - 1;
  SLOAD(SE, 0); asm volatile("s_waitcnt vmcnt(0)" ::: "memory"); SWRITE(0, SE); __syncthreads();
  QKT(pA0, pA1, 0, 0); partialSM(pA0, pA1, m_reg, mnA, alA);
  SLOAD(SO, 1); if constexpr (SDEPTH == 2) { if (2 < NT) SLOAD(SE, 2); }
  SWAIT(); SWRITE(1, SO); __syncthreads();
  for (int j = 1; j + 1 < NT; j += 2) {
    SBAR(); QKT(pB0, pB1, 1, j);
    finishSM(pA0, pA1, alA, l_reg, pa0, pa1, pa2, pa3); SBAR();
    SLOAD(SO, j + SDEPTH); SBAR();
    pv_d0(o, vb0, pa0, pa1, pa2, pa3); partialSM(pB0, pB1, m_reg, mnB, alB);
    __syncthreads(); SWAIT(); SWRITE(0, SE);
    RESC(alB); __syncthreads();
    SBAR(); QKT(pA0, pA1, 0, j + 1);
    finishSM(pB0, pB1, alB, l_reg, pa0, pa1, pa2, pa3); SBAR();
    if (SDEPTH == 1 || j + 3 < NT) SLOAD(SE, j + 1 + SDEPTH); SBAR();
    pv_d0(o, vb0 + (int)SHM_V, pa0, pa1, pa2, pa3); partialSM(pA0, pA1, m_reg, mnA, alA);
    __syncthreads(); SWAIT(); SWRITE(1, SO);
    RESC(alA); __syncthreads();
  }
  SBAR(); QKT(pB0, pB1, 1, NT - 1);
  finishSM(pA0, pA1, alA, l_reg, pa0, pa1, pa2, pa3); SBAR();
  pv_d0(o, vb0, pa0, pa1, pa2, pa3); partialSM(pB0, pB1, m_reg, mnB, alB);
  __syncthreads(); RESC(alB);
  finishSM(pB0, pB1, alB, l_reg, pa0, pa1, pa2, pa3); SBAR();
  pv_d0(o, vb0 + (int)SHM_V, pa0, pa1, pa2, pa3);
  if (hi == 0) li_l[r32] = l_reg; asm volatile("s_waitcnt lgkmcnt(0)" ::: "memory");
  float rli[16];
#pragma unroll
  for (int r = 0; r < 16; ++r) rli[r] = __builtin_amdgcn_rcpf(li_l[crow(r, hi)]);
  if (a.Of) {
    ATT_GAS float* Ow = a.Of + (long)(wid * QBLK) * a.ldo;
#pragma unroll
    for (int r = 0; r < 16; ++r) { const int orow = crow(r, hi);
#pragma unroll
      for (int d0 = 0; d0 < 4; ++d0) Ow[(long)orow * a.ldo + d0 * 32 + r32] = o[d0][r] * rli[r]; }
  } else {
    ATT_GAS bf16* Ow = a.Ob + (long)(wid * QBLK) * a.ldo;
#pragma unroll
    for (int r = 0; r < 16; ++r) { const int orow = crow(r, hi);
#pragma unroll
      for (int d0 = 0; d0 < 4; ++d0) { const float v = o[d0][r] * rli[r]; Ow[(long)orow * a.ldo + d0 * 32 + r32] = (bf16)(cvtpk(v, v) & 0xffffu); } }
  }
  if (a.lse && hi == 0) a.lse[(long)(wid * QBLK + r32) * a.ldl] = m_reg * SCALE + __logf(l_reg);
  __syncthreads();
#undef SLOAD
#undef SWRITE
#undef SWAIT
#undef RESC
#undef QKT
}
#undef KSWZ
#undef SBAR
}
constexpr int DM = 2048, BATCH = 2, SEQ = 4096, DEPTH = 4, M = BATCH * SEQ;
constexpr int AB_IN = 3584, AB_OUT = 1024, C_IN = 6144, DFF = 5504, UPW = 2 * DFF, MODW = 6 * DM;
constexpr float EPS = 1e-6f;
constexpr int NWAVES = 8;
constexpr size_t MiB = 1u << 20;
constexpr size_t WS_CTL = 0, CTL_ZERO_BYTES = 2 * MiB;
constexpr size_t WS_MOD = 2 * MiB;
constexpr size_t WS_PART = 3 * MiB;
constexpr size_t WS_NRM = 12 * MiB;
constexpr size_t WS_WABIN = 16 * MiB;
constexpr size_t WS_WABOUT = 44 * MiB;
constexpr size_t WS_WCIN = 52 * MiB;
constexpr size_t WS_WCOUT = 100 * MiB;
constexpr size_t WS_WUP = 116 * MiB;
constexpr size_t WS_WDOWN = 288 * MiB;
constexpr size_t WS_H = 376 * MiB;
constexpr size_t WS_PROJ = 408 * MiB;
constexpr size_t WS_ATT = 504 * MiB;
constexpr size_t WS_LSE = WS_ATT + 64 * MiB;
constexpr size_t WS_O = 632 * MiB;
constexpr size_t WS_Y = 664 * MiB;
constexpr size_t WS_GU = 728 * MiB;
constexpr size_t WS_ACT = 900 * MiB;
constexpr size_t WS_END = 986 * MiB;
static_assert(WS_PART + (size_t)DEPTH * 16 * BATCH * MODW * 4 <= WS_WABIN, "ws map");
static_assert(WS_WABIN + (size_t)2 * AB_IN * DM * 2 <= WS_WABOUT && WS_WABOUT + (size_t)2 * DM * AB_OUT * 2 <= WS_WCIN, "ws map");
static_assert(WS_WCIN + (size_t)2 * C_IN * DM * 2 <= WS_WCOUT && WS_WCOUT + (size_t)2 * DM * DM * 2 <= WS_WUP, "ws map");
static_assert(WS_WUP + (size_t)4 * UPW * DM * 2 <= WS_WDOWN && WS_WDOWN + (size_t)4 * DM * DFF * 2 <= WS_H, "ws map");
static_assert(WS_H + (size_t)M * DM * 2 <= WS_PROJ && WS_PROJ + (size_t)M * C_IN * 2 <= WS_ATT && WS_ATT + (size_t)2 * M * DM * 4 <= WS_O, "ws map");
static_assert(WS_ATT + (size_t)3 * M * 512 * 4 <= WS_LSE && WS_LSE + (size_t)3 * M * 4 * 4 <= WS_O, "ws map");
static_assert(WS_O + (size_t)M * DM * 2 <= WS_Y && WS_Y + (size_t)M * DM * 4 <= WS_GU && WS_GU + (size_t)M * UPW * 2 <= WS_ACT && WS_ACT + (size_t)M * DFF * 2 <= WS_END, "ws map");
constexpr int CW_BAR = 4096;
constexpr int RING_OFF = 0, RING_BYTES = 131072;
constexpr int LDSCTL_OFF = RING_BYTES, MISC_OFF = LDSCTL_OFF + 320;
constexpr int LDS_BYTES = 147456;
static_assert(att::SHM_ATTN <= RING_BYTES, "attention LDS fits the ring region");

#define GAS __attribute__((address_space(1)))
#define LAS __attribute__((address_space(3)))
typedef unsigned short bf16;
typedef unsigned v4u __attribute__((ext_vector_type(4)));
typedef unsigned v2u __attribute__((ext_vector_type(2)));
typedef float f32x4 __attribute__((ext_vector_type(4)));
typedef GAS unsigned gu32;
#define LDS_WAIT() asm volatile("s_waitcnt lgkmcnt(0)" ::: "memory")
__device__ __forceinline__ unsigned pk2(float lo, float hi) { unsigned r; asm volatile("v_cvt_pk_bf16_f32 %0, %1, %2" : "=v"(r) : "v"(lo), "v"(hi)); return r; }
__device__ __forceinline__ float bf_lo(unsigned w) { return __uint_as_float(w << 16); }
__device__ __forceinline__ float bf_hi(unsigned w) { return __uint_as_float(w & 0xffff0000u); }
#define XB_TMO      128
#define XB_XCNT(j)  (256  + 64 * (j))
#define XB_XSUB(j)  (1280 + 64 * (j))
#define XB_XGEN(j)  (2304 + 64 * (j))
#define XB_TOP      3328
#define XB_TOPGEN   3392
#define XCD_BAR_WORDS 3456
#define XB_SPIN_CAP (1u << 18)

__device__ __forceinline__ unsigned xb_ld(unsigned* p)              { return __hip_atomic_load(p, __ATOMIC_RELAXED, __HIP_MEMORY_SCOPE_AGENT); }
__device__ __forceinline__ unsigned xb_add(unsigned* p, unsigned v) { return __hip_atomic_fetch_add(p, v, __ATOMIC_RELAXED, __HIP_MEMORY_SCOPE_AGENT); }
__device__ __forceinline__ unsigned xb_xcc_id() { return (unsigned)__builtin_amdgcn_s_getreg((3 << 11) | 20) & 0xFu; }
#define XB_SPIN(cond, bar) do { unsigned _sp = 0; while (cond) { __builtin_amdgcn_s_sleep(1); \
    if ((++_sp & 255u) == 0u) { if (xb_ld(&(bar)[XB_TMO])) break; if (_sp > XB_SPIN_CAP) { atomicAdd(&(bar)[XB_TMO], 1u); break; } } } } while (0)

struct XcdBarrier {
    unsigned* bar; unsigned x;
    volatile LAS unsigned* st;
};

__device__ __forceinline__ XcdBarrier xcd_barrier_post(unsigned* bar, volatile LAS unsigned* st) {
    XcdBarrier b; b.bar = bar; b.x = xb_xcc_id(); b.st = st;
    if (threadIdx.x == 0) (void)xb_add(&bar[XB_XCNT(b.x)], 1u);
    return b;
}
__device__ __forceinline__ void xcd_barrier_complete(unsigned* bar, unsigned x, unsigned& nloc, unsigned& nx) {
    const unsigned G = gridDim.x * gridDim.y * gridDim.z;
    unsigned sum, cnt, mine, sp = 0u;
    for (;;) {
        sum = 0u; cnt = 0u; mine = 0u;
#pragma unroll
        for (unsigned j = 0; j < 16; ++j) { const unsigned c = xb_ld(&bar[XB_XCNT(j)]); sum += c; cnt += (c > 0u) ? 1u : 0u; mine = (j == x) ? c : mine; }
        if (sum == G) break;
        __builtin_amdgcn_s_sleep(1);
        if ((++sp & 255u) == 0u) { if (xb_ld(&bar[XB_TMO])) break; if (sp > XB_SPIN_CAP) { atomicAdd(&bar[XB_TMO], 1u); break; } }
    }
    nloc = mine > 0u ? mine : 1u; nx = cnt > 0u ? cnt : 1u;
}

__device__ __forceinline__ void xcd_barrier(const XcdBarrier& b) {
    asm volatile("s_waitcnt vmcnt(0)" ::: "memory");
    __syncthreads();
    if (threadIdx.x == 0) {
        unsigned* bar = b.bar;
        __builtin_amdgcn_s_waitcnt(0);
        unsigned nloc = b.st[0], nx = b.st[1];
        if (nloc == 0u) { xcd_barrier_complete(bar, b.x, nloc, nx); b.st[0] = nloc; b.st[1] = nx; }
        const unsigned old = xb_add(&bar[XB_XSUB(b.x)], 1u);
        const unsigned gen = old / nloc;
        if (old + 1u == (gen + 1u) * nloc) {
            __builtin_amdgcn_fence(__ATOMIC_RELEASE, "agent");
            asm volatile("s_waitcnt vmcnt(0)" ::: "memory");
            const unsigned og = xb_add(&bar[XB_TOP], 1u);
            const unsigned tg = og / nx;
            if (og + 1u == (tg + 1u) * nx) xb_add(&bar[XB_TOPGEN], 1u);
            else XB_SPIN(xb_ld(&bar[XB_TOPGEN]) == tg, bar);
            __builtin_amdgcn_fence(__ATOMIC_ACQUIRE, "agent");
            xb_add(&bar[XB_XGEN(b.x)], 1u);
            asm volatile("s_waitcnt vmcnt(0)" ::: "memory");
        } else {
            XB_SPIN(xb_ld(&bar[XB_XGEN(b.x)]) == gen, bar);
            __builtin_amdgcn_fence(__ATOMIC_ACQUIRE, "agent");
            asm volatile("s_waitcnt vmcnt(0)" ::: "memory");
        }
    }
    __syncthreads();
}
struct Frame {
    LAS unsigned char* lds; char* ldsg;
    int tid, lane, wave, G, gw, NGW;
    const float *x, *c, *ada_w, *ada_b, *norm_g, *ab_w_in, *ab_w_out, *a_sink, *c_w_in, *c_w_out, *c_lambda, *c_subln_g, *w_up, *conv_w, *conv_b, *w_down;
    float* out; unsigned char* ws;
};
#define PHASE_IDS() int tid = threadIdx.x; asm volatile("" : "+v"(tid)); const int lane = tid & 63, wave = __builtin_amdgcn_readfirstlane(tid >> 6), gw = (int)blockIdx.x * NWAVES + wave; (void)lane; (void)gw
__device__ __forceinline__ float wave_sum(float v) {
#pragma unroll
    for (int o = 1; o < 64; o <<= 1) v += __shfl_xor(v, o);
    return v;
}
__device__ __forceinline__ void transpose_item(const float* W, int K, int N, bf16* WT, LAS float* scr, int item, int lane) {
    const int nblk = N / 32, kb = item / nblk, nb = item % nblk, k0 = 64 * kb, n0 = 32 * nb;
#pragma unroll 8
    for (int i = 0; i < 32; ++i) { const int kk = 2 * i + (lane >> 5); scr[kk * 33 + (lane & 31)] = W[(size_t)(k0 + kk) * N + n0 + (lane & 31)]; }
    LDS_WAIT(); asm volatile("" ::: "memory");
    const int c = lane & 7;
#pragma unroll
    for (int j = 0; j < 4; ++j) { const int n = (lane >> 3) + 8 * j; const LAS float* s = scr + (8 * c) * 33 + n;
        v4u o; o.x = pk2(s[0 * 33], s[1 * 33]); o.y = pk2(s[2 * 33], s[3 * 33]); o.z = pk2(s[4 * 33], s[5 * 33]); o.w = pk2(s[6 * 33], s[7 * 33]);
        *(GAS v4u*)(WT + (size_t)(n0 + n) * K + k0 + 8 * c) = o; }
    LDS_WAIT(); asm volatile("" ::: "memory");
}
__device__ __forceinline__ float silu_f(float v) { return v / (1.f + __expf(-v)); }

__device__ __forceinline__ void p0a_prologue(Frame& F) {
    PHASE_IDS();
    LAS float* scr = (LAS float*)(F.lds + RING_OFF + wave * 16384);
    constexpr int I_ABIN = (DM / 64) * (AB_IN / 32), I_ABOUT = (AB_OUT / 64) * (DM / 32), I_CIN = (DM / 64) * (C_IN / 32), I_COUT = (DM / 64) * (DM / 32),
                  I_UP = (DM / 64) * (UPW / 32), I_DOWN = (DFF / 64) * (DM / 32);
    constexpr int NT_ITEMS = 2 * I_ABIN + 2 * I_ABOUT + 2 * I_CIN + 2 * I_COUT + 4 * I_UP + 4 * I_DOWN;
    bf16* wabin = (bf16*)(F.ws + WS_WABIN); bf16* wabout = (bf16*)(F.ws + WS_WABOUT); bf16* wcin = (bf16*)(F.ws + WS_WCIN); bf16* wcout = (bf16*)(F.ws + WS_WCOUT);
    bf16* wup = (bf16*)(F.ws + WS_WUP); bf16* wdown = (bf16*)(F.ws + WS_WDOWN);
    for (int it = gw; it < NT_ITEMS; it += F.NGW) {
        int r = it;
        if (r < 2 * I_ABIN) { const int j = r / I_ABIN; transpose_item(F.ab_w_in + (size_t)j * DM * AB_IN, DM, AB_IN, wabin + (size_t)j * AB_IN * DM, scr, r % I_ABIN, lane); continue; } r -= 2 * I_ABIN;
        if (r < 2 * I_ABOUT) { const int j = r / I_ABOUT; transpose_item(F.ab_w_out + (size_t)j * AB_OUT * DM, AB_OUT, DM, wabout + (size_t)j * DM * AB_OUT, scr, r % I_ABOUT, lane); continue; } r -= 2 * I_ABOUT;
        if (r < 2 * I_CIN) { const int j = r / I_CIN; transpose_item(F.c_w_in + (size_t)j * DM * C_IN, DM, C_IN, wcin + (size_t)j * C_IN * DM, scr, r % I_CIN, lane); continue; } r -= 2 * I_CIN;
        if (r < 2 * I_COUT) { const int j = r / I_COUT; transpose_item(F.c_w_out + (size_t)j * DM * DM, DM, DM, wcout + (size_t)j * DM * DM, scr, r % I_COUT, lane); continue; } r -= 2 * I_COUT;
        if (r < 4 * I_UP) { const int j = r / I_UP; transpose_item(F.w_up + (size_t)j * DM * UPW, DM, UPW, wup + (size_t)j * UPW * DM, scr, r % I_UP, lane); continue; } r -= 4 * I_UP;
        { const int j = r / I_DOWN; transpose_item(F.w_down + (size_t)j * DFF * DM, DFF, DM, wdown + (size_t)j * DM * DFF, scr, r % I_DOWN, lane); }
    }
    float* part = (float*)(F.ws + WS_PART);
    constexpr int NCH = MODW / 256, NKC = 16, KCH = DM / NKC;
    for (int it = gw; it < DEPTH * NCH * NKC; it += F.NGW) {
        const int kc = it % NKC, nch = (it / NKC) % NCH, l = it / (NKC * NCH), k0 = kc * KCH;
        const float c0a = silu_f(F.c[k0 + lane]), c0b = silu_f(F.c[k0 + 64 + lane]), c1a = silu_f(F.c[DM + k0 + lane]), c1b = silu_f(F.c[DM + k0 + 64 + lane]);
        const float* wp = F.ada_w + ((size_t)l * DM + k0) * MODW + nch * 256 + 4 * lane;
        f32x4 a0 = {0.f, 0.f, 0.f, 0.f}, a1 = {0.f, 0.f, 0.f, 0.f};
#pragma unroll 8
        for (int k = 0; k < 64; ++k) { const f32x4 w = *(const f32x4*)(wp + (size_t)k * MODW); const float s0 = __shfl(c0a, k), s1 = __shfl(c1a, k); a0 += w * s0; a1 += w * s1; }
#pragma unroll 8
        for (int k = 0; k < 64; ++k) { const f32x4 w = *(const f32x4*)(wp + (size_t)(64 + k) * MODW); const float s0 = __shfl(c0b, k), s1 = __shfl(c1b, k); a0 += w * s0; a1 += w * s1; }
        float* pp = part + (((size_t)l * NKC + kc) * BATCH) * MODW + nch * 256 + 4 * lane;
        *(f32x4*)pp = a0; *(f32x4*)(pp + MODW) = a1;
    }
}
__device__ __forceinline__ void p0b_modreduce(Frame& F) {
    PHASE_IDS();
    const float* part = (const float*)(F.ws + WS_PART); float* mod = (float*)(F.ws + WS_MOD);
    for (int i = blockIdx.x * (NWAVES * 64) + tid; i < DEPTH * BATCH * MODW; i += F.G * NWAVES * 64) {
        const int n = i % MODW, b = (i / MODW) % BATCH, l = i / (MODW * BATCH);
        float s = F.ada_b[l * MODW + n];
#pragma unroll
        for (int kc = 0; kc < 16; ++kc) s += part[(((size_t)l * 16 + kc) * BATCH + b) * MODW + n];
        mod[i] = s;
    }
}
__device__ __forceinline__ void rows_pre(Frame& F, const float* x, const float* ng, const float* scale, const float* shift, bf16* H) {
    PHASE_IDS();
    for (int m = gw; m < M; m += F.NGW) {
        const int b = m / SEQ; f32x4 v[8]; float ss = 0.f;
#pragma unroll
        for (int j = 0; j < 8; ++j) { v[j] = *(const f32x4*)(x + (size_t)m * DM + 4 * lane + 256 * j); ss += (v[j].x * v[j].x + v[j].y * v[j].y) + (v[j].z * v[j].z + v[j].w * v[j].w); }
        const float r = 1.f / sqrtf(wave_sum(ss) * (1.f / DM) + EPS);
#pragma unroll
        for (int j = 0; j < 8; ++j) { const int c = 4 * lane + 256 * j;
            const f32x4 g = *(const f32x4*)(ng + c), sc = *(const f32x4*)(scale + (size_t)b * MODW + c), sh = *(const f32x4*)(shift + (size_t)b * MODW + c);
            const f32x4 h = (v[j] * r) * g * (sc + 1.f) + sh;
            v2u o; o.x = pk2(h.x, h.y); o.y = pk2(h.z, h.w); *(v2u*)(H + (size_t)m * DM + c) = o; }
    }
}
__device__ __forceinline__ void rows_post(Frame& F, const bf16* Y, const float* xs, float* xd, const float* gate, const float* nga,
                                          const float* ngb, const float* scale, const float* shift, bf16* H, bool doH) {
    PHASE_IDS();
    for (int m = gw; m < M; m += F.NGW) {
        const int b = m / SEQ; f32x4 v[8]; float ss = 0.f;
#pragma unroll
        for (int j = 0; j < 8; ++j) { const v2u w = *(const v2u*)(Y + (size_t)m * DM + 4 * lane + 256 * j); v[j] = (f32x4){bf_lo(w.x), bf_hi(w.x), bf_lo(w.y), bf_hi(w.y)};
            ss += (v[j].x * v[j].x + v[j].y * v[j].y) + (v[j].z * v[j].z + v[j].w * v[j].w); }
        const float r = 1.f / sqrtf(wave_sum(ss) * (1.f / DM) + EPS); float ss2 = 0.f;
#pragma unroll
        for (int j = 0; j < 8; ++j) { const int c = 4 * lane + 256 * j;
            const f32x4 xv = *(const f32x4*)(xs + (size_t)m * DM + c), g = *(const f32x4*)(gate + (size_t)b * MODW + c), na = *(const f32x4*)(nga + c);
            v[j] = xv + g * ((v[j] * r) * na);
            ss2 += (v[j].x * v[j].x + v[j].y * v[j].y) + (v[j].z * v[j].z + v[j].w * v[j].w);
            *(f32x4*)(xd + (size_t)m * DM + c) = v[j]; }
        if (doH) {
            const float r2 = 1.f / sqrtf(wave_sum(ss2) * (1.f / DM) + EPS);
#pragma unroll
            for (int j = 0; j < 8; ++j) { const int c = 4 * lane + 256 * j;
                const f32x4 g = *(const f32x4*)(ngb + c), sc = *(const f32x4*)(scale + (size_t)b * MODW + c), sh = *(const f32x4*)(shift + (size_t)b * MODW + c);
                const f32x4 h = (v[j] * r2) * g * (sc + 1.f) + sh;
                v2u o; o.x = pk2(h.x, h.y); o.y = pk2(h.z, h.w); *(v2u*)(H + (size_t)m * DM + c) = o; }
        }
    }
}
__device__ __forceinline__ void rows_subln(Frame& F, const float* A0, const float* A1, const float* lamp, const float* sg, float lambda_init, bf16* O) {
    PHASE_IDS();
    const float l0 = lamp[lane] * lamp[128 + lane] + lamp[64 + lane] * lamp[128 + 64 + lane];
    const float l1 = lamp[256 + lane] * lamp[384 + lane] + lamp[256 + 64 + lane] * lamp[384 + 64 + lane];
    const float lam = __expf(wave_sum(l0)) - __expf(wave_sum(l1)) + lambda_init;
    const f32x4 g = *(const f32x4*)(sg + 4 * lane) * (1.f - lambda_init);
    for (int m = gw; m < M; m += F.NGW) {
#pragma unroll
        for (int j = 0; j < 8; ++j) { const size_t off = (size_t)m * DM + 4 * lane + 256 * j;
            const f32x4 d = *(const f32x4*)(A0 + off) - *(const f32x4*)(A1 + off) * lam;
            const float ss = wave_sum((d.x * d.x + d.y * d.y) + (d.z * d.z + d.w * d.w));
            const float r = 1.f / sqrtf(ss * (1.f / 256.f) + EPS);
            const f32x4 h = (d * r) * g;
            v2u o; o.x = pk2(h.x, h.y); o.y = pk2(h.z, h.w); *(v2u*)(O + off) = o; }
    }
}
__device__ __forceinline__ void rows_bmerge(Frame& F, const float* OB, const float* LSE, bf16* O) {
    PHASE_IDS();
    for (int m = gw; m < M; m += F.NGW) {
        const int hb = lane >> 4;
        const float e0 = LSE[(size_t)m * 4 + hb], e1 = LSE[((size_t)M + m) * 4 + hb], e2 = LSE[((size_t)2 * M + m) * 4 + hb];
        const float mx = fmaxf(e0, fmaxf(e1, e2));
        float w0 = __expf(e0 - mx), w1 = __expf(e1 - mx), w2 = __expf(e2 - mx); const float inv = 1.f / (w0 + w1 + w2); w0 *= inv; w1 *= inv; w2 *= inv;
        const float* p = OB + (size_t)m * 512 + 8 * lane;
        const f32x4 a0 = *(const f32x4*)p, a1 = *(const f32x4*)(p + 4);
        const f32x4 b0 = *(const f32x4*)(p + (size_t)M * 512), b1 = *(const f32x4*)(p + (size_t)M * 512 + 4);
        const f32x4 c0 = *(const f32x4*)(p + (size_t)2 * M * 512), c1 = *(const f32x4*)(p + (size_t)2 * M * 512 + 4);
        const f32x4 r0 = a0 * w0 + b0 * w1 + c0 * w2, r1 = a1 * w0 + b1 * w1 + c1 * w2;
        v4u o; o.x = pk2(r0.x, r0.y); o.y = pk2(r0.z, r0.w); o.z = pk2(r1.x, r1.y); o.w = pk2(r1.z, r1.w);
        *(v4u*)(O + (size_t)m * AB_OUT + 512 + 8 * lane) = o;
    }
}
__device__ __forceinline__ float gelu_tanh(float v) {
    const float u = 0.7978845608028654f * (v + 0.044715f * v * v * v);
    const float e = __expf(2.f * u);
    const float t = 1.f - 2.f / (e + 1.f);
    return 0.5f * v * (1.f + t);
}
__device__ __forceinline__ void phase_act(Frame& F, const bf16* GU, const float* cw, const float* cb, bf16* ACT) {
    PHASE_IDS();
    constexpr int NC8 = DFF / 8, RB = 8, NRB = M / RB;
    for (int it = blockIdx.x * (NWAVES * 64) + tid; it < NRB * NC8; it += F.G * NWAVES * 64) {
        const int c8 = it % NC8, rb = it / NC8, c = c8 * 8, m0 = rb * RB;
        float w0[8], w1[8], w2[8], bb[8];
#pragma unroll
        for (int i = 0; i < 8; ++i) { w0[i] = cw[c + i]; w1[i] = cw[DFF + c + i]; w2[i] = cw[2 * DFF + c + i]; bb[i] = cb[c + i]; }
        v4u gp, gc, gn;
        if ((m0 % SEQ) == 0) gp = (v4u){0u, 0u, 0u, 0u}; else gp = *(const v4u*)(GU + (size_t)(m0 - 1) * UPW + c);
        gc = *(const v4u*)(GU + (size_t)m0 * UPW + c);
#pragma unroll
        for (int rr = 0; rr < RB; ++rr) {
            const int m = m0 + rr;
            if ((m % SEQ) == SEQ - 1) gn = (v4u){0u, 0u, 0u, 0u}; else gn = *(const v4u*)(GU + (size_t)(m + 1) * UPW + c);
            const v4u up = *(const v4u*)(GU + (size_t)m * UPW + DFF + c);
            float r[8];
#pragma unroll
            for (int q = 0; q < 4; ++q) {
                const float a_lo = w0[2 * q] * bf_lo(gp[q]) + w1[2 * q] * bf_lo(gc[q]) + w2[2 * q] * bf_lo(gn[q]) + bb[2 * q];
                const float a_hi = w0[2 * q + 1] * bf_hi(gp[q]) + w1[2 * q + 1] * bf_hi(gc[q]) + w2[2 * q + 1] * bf_hi(gn[q]) + bb[2 * q + 1];
                r[2 * q] = gelu_tanh(a_lo) * bf_lo(up[q]); r[2 * q + 1] = gelu_tanh(a_hi) * bf_hi(up[q]);
            }
            v4u o; o.x = pk2(r[0], r[1]); o.y = pk2(r[2], r[3]); o.z = pk2(r[4], r[5]); o.w = pk2(r[6], r[7]);
            *(v4u*)(ACT + (size_t)m * DFF + c) = o;
            gp = gc; gc = gn;
        }
    }
}
__device__ __forceinline__ float alibi16(int i) { return exp2f(-0.5f * (float)(i + 1)); }
__device__ __forceinline__ void phase_attn_ab(Frame& F, int jl) {
    const bf16* P = (const bf16*)(F.ws + WS_PROJ); bf16* O = (bf16*)(F.ws + WS_O); float* OB = (float*)(F.ws + WS_ATT); float* LSE = (float*)(F.ws + WS_LSE);
    for (int u = blockIdx.x; u < 512; u += F.G) {
        att::UnitArgs a;
        if (u < 128) {
            const int qb = u % 16, qh = (u / 16) % 4, b = u / 64, q0 = qb * 256; const size_t row0 = (size_t)b * SEQ;
            a.Q = (const GAS bf16*)P + (row0 + q0) * AB_IN + qh * 128; a.ldq = AB_IN;
            a.K = (const GAS bf16*)P + row0 * AB_IN + 512 + (qh >> 1) * 128; a.V = (const GAS bf16*)P + row0 * AB_IN + 768 + (qh >> 1) * 128; a.ldk = AB_IN;
            a.q0 = q0; a.L = SEQ; a.kt0 = q0 / 64 - 2; a.nt = 8;
            a.nsl = -alibi16(qh) / att::SCALE; a.radius = 128.f; a.m_init = F.a_sink[jl * 4 + qh] / att::SCALE; a.l_init = 1.f;
            a.Of = nullptr; a.Ob = (GAS bf16*)O + (row0 + q0) * AB_OUT + qh * 128; a.ldo = AB_OUT; a.lse = nullptr; a.ldl = 0;
        } else {
            const int v = (u - 128) % 128, gi = (u - 128) / 128, dil = gi == 0 ? 1 : (gi == 1 ? 4 : 16), L = SEQ / dil;
            int qb, r, hb, b;
            if (gi == 0) { qb = v % 16; r = 0; hb = (v / 16) % 4; b = v / 64; }
            else if (gi == 1) { qb = v % 4; r = (v / 4) % 4; hb = (v / 16) % 4; b = v / 64; }
            else { qb = 0; r = v % 16; hb = (v / 16) % 4; b = v / 64; }
            const int q0 = qb * 256; const size_t seq0 = (size_t)b * SEQ + r, rowq = seq0 + (size_t)dil * q0;
            a.Q = (const GAS bf16*)P + rowq * AB_IN + 1024 + gi * 512 + hb * 128; a.ldq = (long)dil * AB_IN;
            a.K = (const GAS bf16*)P + seq0 * AB_IN + 2560 + hb * 128; a.V = (const GAS bf16*)P + seq0 * AB_IN + 3072 + hb * 128; a.ldk = (long)dil * AB_IN;
            a.q0 = q0; a.L = L; a.kt0 = q0 / 64 - 1; a.nt = 6;
            a.nsl = -alibi16(4 + gi * 4 + hb) * (float)dil / att::SCALE; a.radius = 64.f; a.m_init = att::M_INIT; a.l_init = 0.f;
            a.Of = (GAS float*)OB + ((size_t)gi * M + rowq) * 512 + hb * 128; a.Ob = nullptr; a.ldo = (long)dil * 512;
            a.lse = (GAS float*)LSE + ((size_t)gi * M + rowq) * 4 + hb; a.ldl = (long)dil * 4;
        }
        att::attn_unit<true, 1>(a, F.ldsg + RING_OFF);
    }
}
__device__ __forceinline__ void phase_cnorm(Frame& F) {
    PHASE_IDS();
    const bf16* P = (const bf16*)(F.ws + WS_PROJ); float* NRM = (float*)(F.ws + WS_NRM);
    for (int it = gw; it < 4096; it += F.NGW) {
        const int tile = it & 63, j = (it >> 6) & 1, h = (it >> 7) & 7, b = (it >> 10) & 1, which = it >> 11;
        const bf16* base = P + ((size_t)b * SEQ + 64 * tile + (lane >> 4)) * C_IN + which * 2048 + h * 256 + j * 128 + (lane & 15) * 8;
        float mx = 0.f;
#pragma unroll 4
        for (int i = 0; i < 16; ++i) {
            const v4u w = *(const v4u*)(base + (size_t)(4 * i) * C_IN);
            float ss = 0.f;
#pragma unroll
            for (int q = 0; q < 4; ++q) { const float a = bf_lo(w[q]), c = bf_hi(w[q]); ss += a * a + c * c; }
            ss += __shfl_xor(ss, 1); ss += __shfl_xor(ss, 2); ss += __shfl_xor(ss, 4); ss += __shfl_xor(ss, 8);
            mx = fmaxf(mx, ss);
        }
        mx = fmaxf(mx, __shfl_xor(mx, 16)); mx = fmaxf(mx, __shfl_xor(mx, 32));
        if (lane == 0) NRM[it] = sqrtf(mx);
    }
}
__device__ __forceinline__ void phase_attn_c(Frame& F, gu32* ctr) {
    PHASE_IDS();
    const bf16* P = (const bf16*)(F.ws + WS_PROJ); float* AT = (float*)(F.ws + WS_ATT); const float* NRM = (const float*)(F.ws + WS_NRM);
    volatile LAS unsigned* slot = (volatile LAS unsigned*)(F.lds + MISC_OFF) + 16;
    for (;;) {
        if (tid == 0) *slot = __hip_atomic_fetch_add(ctr, 1u, __ATOMIC_RELAXED, __HIP_MEMORY_SCOPE_AGENT);
        __syncthreads();
        const int i = __builtin_amdgcn_readfirstlane((int)*slot);
        __syncthreads();
        if (i >= 1024) break;
        const int h = 7 - (i >> 7), qb = i & 15, vh = (i >> 4) & 1, j = (i >> 5) & 1, b = (i >> 6) & 1, q0 = qb * 256; const size_t row0 = (size_t)b * SEQ;
        const float slope = exp2f(-(float)(h + 1));
        const float* QN = NRM + ((b * 8 + h) * 2 + j) * 64; const float* KN = QN + 2048;
        const float qn = fmaxf(fmaxf(QN[4 * qb], QN[4 * qb + 1]), fmaxf(QN[4 * qb + 2], QN[4 * qb + 3]));
        const float ks = fmaxf(fmaxf(KN[4 * qb], KN[4 * qb + 1]), fmaxf(KN[4 * qb + 2], KN[4 * qb + 3]));
        const int klo = 64 * lane, d1 = klo - (q0 + 255), d2 = q0 - (klo + 63), dmin = d1 > 0 ? d1 : (d2 > 0 ? d2 : 0);
        const float bound = att::SCALE * 1.02f * qn * (KN[lane] + ks) - slope * (float)dmin;
        const unsigned long long need = __ballot(bound > -25.f);
        int t_lo = (int)__builtin_ctzll(need), t_hi = 64 - (int)__builtin_clzll(need);
        if ((t_hi - t_lo) & 1) { if (t_lo > 0) --t_lo; else ++t_hi; }
        att::UnitArgs a;
        a.Q = (const GAS bf16*)P + (row0 + q0) * C_IN + h * 256 + j * 128; a.ldq = C_IN;
        a.K = (const GAS bf16*)P + row0 * C_IN + 2048 + h * 256 + j * 128; a.V = (const GAS bf16*)P + row0 * C_IN + 4096 + h * 256 + vh * 128; a.ldk = C_IN;
        a.q0 = q0; a.L = SEQ; a.kt0 = t_lo; a.nt = t_hi - t_lo;
        a.nsl = -slope / att::SCALE; a.radius = 0.f; a.m_init = att::M_INIT; a.l_init = 0.f;
        a.Of = (GAS float*)AT + ((size_t)j * M + row0 + q0) * DM + h * 256 + vh * 128; a.Ob = nullptr; a.ldo = DM; a.lse = nullptr; a.ldl = 0;
        att::attn_unit<false, 2>(a, F.ldsg + RING_OFF);
    }
}

#ifndef ENC_DUP
#define ENC_DUP 0
#endif
#define DUP(bit) for (int rep_ = 0; rep_ < (((ENC_DUP) & (bit)) ? 2 : 1); ++rep_)
constexpr int CW_QUEUE = 8192;
struct Args { const float* in[16]; float* out; unsigned char* ws; };
__global__ void __launch_bounds__(NWAVES * 64, 2) enc_fwd(Args args) {
    extern __shared__ __attribute__((aligned(16))) unsigned char lds[];
    Frame F;
    F.lds = (LAS unsigned char*)lds; F.ldsg = (char*)lds;
    F.tid = threadIdx.x; F.lane = F.tid & 63; F.wave = __builtin_amdgcn_readfirstlane(F.tid >> 6);
    F.G = gridDim.x; F.gw = blockIdx.x * NWAVES + F.wave; F.NGW = F.G * NWAVES;
    F.x = args.in[0]; F.c = args.in[1]; F.ada_w = args.in[2]; F.ada_b = args.in[3]; F.norm_g = args.in[4]; F.ab_w_in = args.in[5]; F.ab_w_out = args.in[6]; F.a_sink = args.in[7];
    F.c_w_in = args.in[8]; F.c_w_out = args.in[9]; F.c_lambda = args.in[10]; F.c_subln_g = args.in[11]; F.w_up = args.in[12]; F.conv_w = args.in[13]; F.conv_b = args.in[14]; F.w_down = args.in[15];
    F.out = args.out; F.ws = args.ws;
    gu32* ctl = (gu32*)(F.ws + WS_CTL);
    for (int u = F.tid; u < (LDS_BYTES - LDSCTL_OFF) / 4; u += NWAVES * 64) ((LAS unsigned*)(F.lds + LDSCTL_OFF))[u] = 0u;
    __syncthreads();
    (void)xcd_barrier_post((unsigned*)(ctl + CW_BAR), (volatile LAS unsigned*)(F.lds + MISC_OFF) + 8);
#define GB() do { unsigned char* wsb_ = args.ws; asm volatile("" : "+s"(wsb_)); XcdBarrier bar_; bar_.bar = (unsigned*)(wsb_ + WS_CTL) + CW_BAR; bar_.x = xb_xcc_id(); \
        bar_.st = (volatile LAS unsigned*)(F.lds + MISC_OFF) + 8; xcd_barrier(bar_); } while (0)
    float* mod = (float*)(F.ws + WS_MOD);
    bf16* H = (bf16*)(F.ws + WS_H); bf16* PROJ = (bf16*)(F.ws + WS_PROJ); bf16* O = (bf16*)(F.ws + WS_O); bf16* Y = (bf16*)(F.ws + WS_Y);
    bf16* GU = (bf16*)(F.ws + WS_GU); bf16* ACT = (bf16*)(F.ws + WS_ACT); float* AT = (float*)(F.ws + WS_ATT);

    DUP(1) p0a_prologue(F);
    GB();
    p0b_modreduce(F);
    GB();
    rows_pre(F, F.x, F.norm_g, mod + 1 * DM, mod + 0 * DM, H);
    GB();

    for (int s = 0; s < 8; ++s) {
        const int l = s >> 1, sub = s & 1, jl = l >> 1, even = !(l & 1);
        const float* modl = mod + (size_t)l * BATCH * MODW;
        {
            pg8::Gemm g; bf16* dst; int N;
            if (sub == 0) { if (even) { N = AB_IN; g.Bt = (const bf16*)(F.ws + WS_WABIN) + (size_t)jl * AB_IN * DM; } else { N = C_IN; g.Bt = (const bf16*)(F.ws + WS_WCIN) + (size_t)jl * C_IN * DM; } dst = PROJ; }
            else { N = UPW; g.Bt = (const bf16*)(F.ws + WS_WUP) + (size_t)l * UPW * DM; dst = GU; }
            g.A = H; g.M = M; g.N = N; g.K = DM;
            pg8::StaticOrder S; S.init(M, N, F.G, (int)blockIdx.x);
            pg8::EpiBf16<0> E{dst, N, nullptr, 0, 0, 1.f};
            DUP(4) pg8::gemm_phase<pg8::EpiBf16<0>, pg8::StaticOrder, true, true>(F.lds + RING_OFF, g, S, E);
        }
        GB();
        if (sub == 0) {
            if (even) { DUP(16) phase_attn_ab(F, jl); GB(); rows_bmerge(F, AT, (const float*)(F.ws + WS_LSE), O); }
            else { phase_cnorm(F); GB(); phase_attn_c(F, ctl + CW_QUEUE + 64 * jl); GB();
                rows_subln(F, AT, AT + (size_t)M * DM, F.c_lambda + (size_t)jl * 4 * 128, F.c_subln_g + (size_t)jl * 256, 0.8f - 0.6f * __expf(-0.3f * (float)l), O); }
        } else phase_act(F, GU, F.conv_w + (size_t)l * 3 * DFF, F.conv_b + (size_t)l * DFF, ACT);
        GB();
        {
            pg8::Gemm g; int K;
            if (sub == 0) { if (even) { K = AB_OUT; g.Bt = (const bf16*)(F.ws + WS_WABOUT) + (size_t)jl * DM * AB_OUT; } else { K = DM; g.Bt = (const bf16*)(F.ws + WS_WCOUT) + (size_t)jl * DM * DM; } g.A = O; }
            else { K = DFF; g.Bt = (const bf16*)(F.ws + WS_WDOWN) + (size_t)l * DM * DFF; g.A = ACT; }
            g.M = M; g.N = DM; g.K = K;
            pg8::StaticOrder S; S.init(M, DM, F.G, (int)blockIdx.x);
            pg8::EpiBf16<0> E{Y, DM, nullptr, 0, 0, 1.f};
            DUP(8) pg8::gemm_phase<pg8::EpiBf16<0>, pg8::StaticOrder, false, true>(F.lds + RING_OFF, g, S, E);
        }
        GB();
        {
            const float* xs = (s == 0) ? F.x : F.out;
            if (sub == 0) rows_post(F, Y, xs, F.out, modl + 2 * DM, F.norm_g + ((size_t)l * 4 + 1) * DM, F.norm_g + ((size_t)l * 4 + 2) * DM, modl + 4 * DM, modl + 3 * DM, H, true);
            else { const int ln = l + 1 < DEPTH ? l + 1 : l; const float* modn = mod + (size_t)ln * BATCH * MODW;
                rows_post(F, Y, xs, F.out, modl + 5 * DM, F.norm_g + ((size_t)l * 4 + 3) * DM, F.norm_g + ((size_t)ln * 4 + 0) * DM, modn + 1 * DM, modn + 0 * DM, H, l + 1 < DEPTH); }
        }
        if (s < 7) GB();
    }
#undef GB
}

extern "C" void kernel_launch(void* const* d_in, const int* in_sizes, int n_in, void* d_out, int out_size, void* d_ws, size_t ws_size, hipStream_t stream) {
    static int grid = 0;
    if (grid == 0) {
        if (n_in != 16 || in_sizes[0] != M * DM || out_size != M * DM || ws_size < WS_END) { fprintf(stderr, "kernel_launch: unexpected shapes (n_in %d, in0 %d, out %d, ws %zu < %zu)\n", n_in, n_in > 0 ? in_sizes[0] : -1, out_size, ws_size, (size_t)WS_END); grid = -1; return; }
        int dev = 0, cus = 0, per_cu = 0;
        if (hipGetDevice(&dev) != hipSuccess || hipDeviceGetAttribute(&cus, hipDeviceAttributeMultiprocessorCount, dev) != hipSuccess) { grid = -1; return; }
        if (hipFuncSetAttribute((const void*)enc_fwd, hipFuncAttributeMaxDynamicSharedMemorySize, LDS_BYTES) != hipSuccess) { fprintf(stderr, "kernel_launch: hipFuncSetAttribute failed\n"); grid = -1; return; }
        if (hipOccupancyMaxActiveBlocksPerMultiprocessor(&per_cu, (const void*)enc_fwd, NWAVES * 64, LDS_BYTES) != hipSuccess || per_cu < 1) { fprintf(stderr, "kernel_launch: occupancy query says %d\n", per_cu); }
        (void)hipGetLastError();
        grid = cus;
    }
    if (grid < 0) return;
    (void)hipMemsetAsync((char*)d_ws + WS_CTL, 0, CTL_ZERO_BYTES, stream);
    Args a{};
    for (int i = 0; i < 16; ++i) a.in[i] = (const float*)d_in[i];
    a.out = (float*)d_out; a.ws = (unsigned char*)d_ws;
    hipLaunchKernelGGL(enc_fwd, dim3(grid), dim3(NWAVES * 64), LDS_BYTES, stream, a);
}
```

```cpp
#include <hip/hip_runtime.h>
#include <cstdio>
#include <cstdint>
namespace pg8 {
#define PG8_LAS __attribute__((address_space(3)))
typedef unsigned short bf16_t;
typedef short bf16x8 __attribute__((ext_vector_type(8)));
typedef float f32x4 __attribute__((ext_vector_type(4)));
typedef unsigned u32x4 __attribute__((ext_vector_type(4)));
constexpr int BM = 256, BK = 64, HALF = 128, HTB = HALF * BK * 2  , STAGE_BYTES = 8 * HTB, NXCD = 8, WGM = 8;

__host__ __device__ __forceinline__ int lds_byte(int r, int c) { const int st = (r >> 4) * 2 + (c >> 5), rr = r & 15, cc = c & 31, ob = rr * 64 + cc * 2; return st * 1024 + (ob ^ (((ob >> 9) & 1) << 5)); }
__host__ __device__ __forceinline__ void stage_rc(int b, int& R, int& C) { const int st = b / 1024, sb = b % 1024, swz = sb ^ (((sb >> 9) & 1) << 5); R = (st >> 1) * 16 + swz / 64; C = (st & 1) * 32 + (swz % 64) / 2; }
__host__ __device__ __forceinline__ int perm32(int rho) { const int n = rho >> 4, i = rho & 15; return 8 * (i >> 2) + 4 * n + (i & 3); }

struct Unit { int pm, pn; };
struct Gemm { const bf16_t* A; const bf16_t* Bt; int M, N, K; };

struct StaticOrder {
    int nM, nN, nwg, G, c;
    __host__ __device__ void init(int M, int N, int G_, int c_) { nM = M / BM; nN = N / BM; nwg = nM * nN; G = G_; c = c_; }
    __host__ __device__ bool next(int i, Unit& u) const {
        const long L = (long)i * G + c; if (L >= nwg) return false;
        int wgid = (int)L; { const int q = nwg / NXCD, r = nwg % NXCD, xcd = wgid % NXCD, off = wgid / NXCD; wgid = (xcd < r ? xcd * (q + 1) : r * (q + 1) + (xcd - r) * q) + off; }
        const int nig = WGM * nN, gid = wgid / nig, fm = gid * WGM, gsz = (nM - fm) < WGM ? (nM - fm) : WGM;
        u.pm = fm + ((wgid % nig) % gsz); u.pn = (wgid % nig) / gsz; return true;
    }
    __device__ __forceinline__ void a_ready(const Unit&) const {}
    __device__ __forceinline__ void done(const Unit&) const {}
};

__device__ __forceinline__ unsigned cvt_pk_bf16(float lo, float hi) { unsigned r; asm volatile("v_cvt_pk_bf16_f32 %0, %1, %2" : "=v"(r) : "v"(lo), "v"(hi)); return r; }
typedef float f32x2 __attribute__((ext_vector_type(2)));
__device__ __forceinline__ f32x2 gelu_pk(f32x2 v) {
    const f32x2 av = __builtin_elementwise_abs(v), d = av * 0.2316418882f + 1.0f;
    f32x2 t; t.x = __builtin_amdgcn_rcpf(d.x); t.y = __builtin_amdgcn_rcpf(d.y);
    f32x2 q = t * 0.5307027145f + (-0.7265760135f); q = q * t + 0.7107068705f; q = q * t + (-0.142248368f); q = q * t + 0.127414796f; q = q * t;
    const f32x2 s = (v * v) * (-0.72134752044f);
    f32x2 e; e.x = __builtin_amdgcn_exp2f(s.x); e.y = __builtin_amdgcn_exp2f(s.y);
    const f32x2 m = v * (q * e), r = v - m;
    f32x2 o; o.x = v.x < 0.f ? m.x : r.x; o.y = v.y < 0.f ? m.y : r.y; return o;
}

template <int ACT  > struct EpiBf16 {
    static constexpr bool PERM = true, AFTER_DRAIN = false; static_assert(ACT == 0 || ACT == 1, "EpiBf16: ACT is 0 (none) or 1 (gelu_pk)");
    bf16_t* O; int ldc; const float* bias; int split_cols; size_t split_stride; float scale0;
    __device__ __forceinline__ void operator()(const f32x4 (&acc)[2][2][4][2], const Unit& u, int wr, int wc, int fr, int fq) const {
        const int row0 = u.pm * BM + wr * 64 + fr; int colt = u.pn * BM; bf16_t* base = O;
        float sc = 1.f; if (split_cols) { const int t = colt / split_cols; base += (size_t)t * split_stride; colt -= t * split_cols; if (t == 0) sc = scale0; }
        const int col0 = colt + wc * 32 + 8 * fq, bcol0 = u.pn * BM + wc * 32 + 8 * fq;
        f32x4 bv[2][2];
#pragma unroll
        for (int bj = 0; bj < 2; ++bj)
#pragma unroll
            for (int n = 0; n < 2; ++n) bv[bj][n] = bias ? *(const f32x4*)(bias + bcol0 + bj * HALF + 4 * n) : (f32x4){0.f, 0.f, 0.f, 0.f};
#pragma unroll
        for (int ai = 0; ai < 2; ++ai)
#pragma unroll
            for (int m = 0; m < 4; ++m) { bf16_t* rowp = base + (size_t)(row0 + ai * HALF + m * 16) * ldc + col0;
#pragma unroll
                for (int bj = 0; bj < 2; ++bj) { f32x4 v0 = acc[ai][bj][m][0] + bv[bj][0], v1 = acc[ai][bj][m][1] + bv[bj][1];
                    if (ACT == 1) { f32x2 a = gelu_pk((f32x2){v0[0], v0[1]}), b = gelu_pk((f32x2){v0[2], v0[3]}), c = gelu_pk((f32x2){v1[0], v1[1]}), d = gelu_pk((f32x2){v1[2], v1[3]});
                        v0 = (f32x4){a.x, a.y, b.x, b.y}; v1 = (f32x4){c.x, c.y, d.x, d.y}; }
                    v0 = v0 * sc; v1 = v1 * sc; u32x4 w; w.x = cvt_pk_bf16(v0[0], v0[1]); w.y = cvt_pk_bf16(v0[2], v0[3]); w.z = cvt_pk_bf16(v1[0], v1[1]); w.w = cvt_pk_bf16(v1[2], v1[3]);
                    *(u32x4*)(rowp + bj * HALF) = w; } }
    }
};
struct EpiF32 {
    static constexpr bool PERM = false, AFTER_DRAIN = false;
    float* C; int ldc; const float* bias;
    __device__ __forceinline__ void operator()(const f32x4 (&acc)[2][2][4][2], const Unit& u, int wr, int wc, int fr, int fq) const {
        const int row0 = u.pm * BM + wr * 64 + fr, col0 = u.pn * BM + wc * 32 + 4 * fq;
        f32x4 bv[2][2];
#pragma unroll
        for (int bj = 0; bj < 2; ++bj)
#pragma unroll
            for (int n = 0; n < 2; ++n) bv[bj][n] = bias ? *(const f32x4*)(bias + col0 + bj * HALF + n * 16) : (f32x4){0.f, 0.f, 0.f, 0.f};
#pragma unroll
        for (int ai = 0; ai < 2; ++ai)
#pragma unroll
            for (int m = 0; m < 4; ++m) { float* rowp = C + (size_t)(row0 + ai * HALF + m * 16) * ldc + col0;
#pragma unroll
                for (int bj = 0; bj < 2; ++bj)
#pragma unroll
                    for (int n = 0; n < 2; ++n) *(f32x4*)(rowp + bj * HALF + n * 16) = acc[ai][bj][m][n] + bv[bj][n]; }
    }
};
template <class Epi, class Sched, bool ALIGN_EPI = false, bool SP2 = false>
__device__ __forceinline__ void gemm_phase(PG8_LAS unsigned char* lds, const Gemm g, const Sched& S, const Epi& E) {
    int tid_ = threadIdx.x; asm volatile("" : "+v"(tid_));
    const int tid = tid_, wid = __builtin_amdgcn_readfirstlane(tid >> 6), lane = tid & 63, wr = wid >> 2, wc = wid & 3, fr = lane & 15, fq = lane >> 4;
    const int K = g.K, nt = K / BK;
    unsigned voffA[2], voffB[2];
#pragma unroll
    for (int i = 0; i < 2; ++i) { int R, C; stage_rc(tid * 16 + i * 8192, R, C); const int Rb = Epi::PERM ? ((R & ~31) + perm32(R & 31)) : R;
        voffA[i] = (unsigned)(R * K + C) * 2u; voffB[i] = (unsigned)(Rb * K + C) * 2u; }
    const size_t kstep = (size_t)(BK * 2);
    const size_t hstep = (size_t)HALF * K * 2;
    const size_t tstep = 2 * hstep;
    const unsigned ldsw = (unsigned)wid * 1024u;
    const int aoff = lds_byte(wr * 64 + fr, fq * 8), boff = lds_byte(wc * 32 + fr, fq * 8);
#define PG8_SA(b, h) (((b) * 2 + (h)) * HTB)
#define PG8_SB(b, h) ((4 + (b) * 2 + (h)) * HTB)
#define PG8_STAGE(bufoff, gbase, voff) do { _Pragma("unroll") for (int _i = 0; _i < 2; ++_i) \
        __builtin_amdgcn_global_load_lds((const unsigned*)((const char*)(gbase) + (voff)[_i]), (PG8_LAS unsigned*)(lds + (bufoff) + ldsw + _i * 8192), 16, 0, 0); } while (0)
#define PG8_LDA(dst, b, h) do { _Pragma("unroll") for (int m = 0; m < 4; ++m) _Pragma("unroll") for (int k = 0; k < 2; ++k) dst[m][k] = *(const PG8_LAS bf16x8*)(lds + PG8_SA(b, h) + aoff + m * 2048 + k * 1024); } while (0)
#define PG8_LDB(dst, b, h) do { _Pragma("unroll") for (int n = 0; n < 2; ++n) _Pragma("unroll") for (int k = 0; k < 2; ++k) dst[n][k] = *(const PG8_LAS bf16x8*)(lds + PG8_SB(b, h) + boff + n * 2048 + k * 1024); } while (0)
#define PG8_MMA(ai, bj, At, Bt) do { __builtin_amdgcn_s_setprio(1); _Pragma("unroll") for (int m = 0; m < 4; ++m) _Pragma("unroll") for (int n = 0; n < 2; ++n) _Pragma("unroll") for (int k = 0; k < 2; ++k) \
        acc[ai][bj][m][n] = __builtin_amdgcn_mfma_f32_16x16x32_bf16(Bt[n][k], At[m][k], acc[ai][bj][m][n], 0, 0, 0); __builtin_amdgcn_s_setprio(0); } while (0)
#define PG8_WAIT_V(n) asm volatile("s_waitcnt vmcnt(" #n ")" ::: "memory")
#define PG8_WAIT_L(n) asm volatile("s_waitcnt lgkmcnt(" #n ")" ::: "memory")
#define PG8_BAR __builtin_amdgcn_s_barrier()
#define PG8_SCHED __builtin_amdgcn_sched_barrier(0)
    Unit cur, nxt; int ui = 0;
    if (!S.next(0, cur)) return;
    f32x4 acc[2][2][4][2];
#pragma unroll
    for (int a = 0; a < 2; ++a)
#pragma unroll
        for (int b = 0; b < 2; ++b)
#pragma unroll
            for (int m = 0; m < 4; ++m)
#pragma unroll
                for (int n = 0; n < 2; ++n) acc[a][b][m][n] = (f32x4){0.f, 0.f, 0.f, 0.f};
    bf16x8 At[4][2], B0[2][2], B1[2][2];
    const char* cA = (const char*)g.A + (size_t)cur.pm * tstep; const char* cB = (const char*)g.Bt + (size_t)cur.pn * tstep;
    S.a_ready(cur);
    if constexpr (SP2) {
        PG8_STAGE(PG8_SB(0, 0), cB, voffB); PG8_STAGE(PG8_SB(0, 1), cB + hstep, voffB); PG8_STAGE(PG8_SA(0, 0), cA, voffA); PG8_STAGE(PG8_SA(0, 1), cA + hstep, voffA);
        if (wr == 1) PG8_BAR;
        PG8_WAIT_V(2); PG8_BAR;
        PG8_STAGE(PG8_SB(1, 0), cB + kstep, voffB); PG8_STAGE(PG8_SA(1, 0), cA + kstep, voffA); PG8_STAGE(PG8_SB(1, 1), cB + hstep + kstep, voffB);
        PG8_WAIT_V(6); PG8_BAR;
    } else {
        PG8_STAGE(PG8_SB(0, 0), cB, voffB); PG8_STAGE(PG8_SA(0, 0), cA, voffA); PG8_STAGE(PG8_SB(0, 1), cB + hstep, voffB); PG8_STAGE(PG8_SA(0, 1), cA + hstep, voffA);
        if (wr == 1) PG8_BAR;
        PG8_WAIT_V(4); PG8_BAR;
        PG8_STAGE(PG8_SB(1, 0), cB + kstep, voffB); PG8_STAGE(PG8_SA(1, 0), cA + kstep, voffA); PG8_STAGE(PG8_SB(1, 1), cB + hstep + kstep, voffB);
        PG8_WAIT_V(6); PG8_BAR;
    }
    for (;;) {
        const bool has_next = S.next(ui + 1, nxt);
        const char* nA = has_next ? (const char*)g.A + (size_t)nxt.pm * tstep : cA; const char* nB = has_next ? (const char*)g.Bt + (size_t)nxt.pn * tstep : cB;
        for (int t = 0; t < nt; t += 2) {
            const bool last = (t == nt - 2);
            const char* a1 = cA + (size_t)(t + 1) * kstep;
            const char* a2 = last ? nA : cA + (size_t)(t + 2) * kstep; const char* b2 = last ? nB : cB + (size_t)(t + 2) * kstep;
            const char* a3 = a2 + kstep; const char* b3 = b2 + kstep;
            if (last && has_next) S.a_ready(nxt);
            if constexpr (SP2) {
            PG8_LDB(B0, 0, 0); PG8_LDB(B1, 0, 1); PG8_SCHED; PG8_LDA(At, 0, 0); PG8_STAGE(PG8_SA(1, 1), a1 + hstep, voffA);
            PG8_WAIT_V(8); PG8_WAIT_L(0); PG8_BAR; PG8_MMA(0, 0, At, B0); PG8_MMA(0, 1, At, B1); PG8_BAR; PG8_SCHED;
            PG8_LDA(At, 0, 1); PG8_STAGE(PG8_SB(0, 0), b2, voffB); PG8_STAGE(PG8_SB(0, 1), b2 + hstep, voffB); PG8_STAGE(PG8_SA(0, 0), a2, voffA);
            PG8_WAIT_V(8); PG8_WAIT_L(0); PG8_BAR; PG8_MMA(1, 0, At, B0); PG8_MMA(1, 1, At, B1); PG8_BAR; PG8_SCHED;
            PG8_LDB(B0, 1, 0); PG8_LDB(B1, 1, 1); PG8_SCHED; PG8_LDA(At, 1, 0); PG8_STAGE(PG8_SA(0, 1), a2 + hstep, voffA);
            PG8_WAIT_V(8); PG8_WAIT_L(0); PG8_BAR; PG8_MMA(0, 0, At, B0); PG8_MMA(0, 1, At, B1); PG8_BAR; PG8_SCHED;
            PG8_LDA(At, 1, 1); PG8_STAGE(PG8_SB(1, 0), b3, voffB); PG8_STAGE(PG8_SB(1, 1), b3 + hstep, voffB); PG8_STAGE(PG8_SA(1, 0), a3, voffA);
            PG8_WAIT_V(8); PG8_WAIT_L(0); PG8_BAR; PG8_MMA(1, 0, At, B0); PG8_MMA(1, 1, At, B1); PG8_BAR; PG8_SCHED;
            } else {
            PG8_LDB(B0, 0, 0); PG8_SCHED; PG8_LDA(At, 0, 0); PG8_STAGE(PG8_SA(1, 1), a1 + hstep, voffA);
            PG8_WAIT_L(8); PG8_BAR; PG8_WAIT_L(0); PG8_MMA(0, 0, At, B0); PG8_BAR; PG8_SCHED;
            PG8_LDB(B1, 0, 1); PG8_STAGE(PG8_SB(0, 0), b2, voffB);
            PG8_BAR; PG8_WAIT_L(0); PG8_MMA(0, 1, At, B1); PG8_BAR;
            PG8_LDA(At, 0, 1); PG8_STAGE(PG8_SA(0, 0), a2, voffA);
            PG8_BAR; PG8_WAIT_L(0); PG8_MMA(1, 0, At, B0); PG8_BAR; PG8_SCHED;
            PG8_STAGE(PG8_SB(0, 1), b2 + hstep, voffB);
            PG8_WAIT_V(6); PG8_BAR; PG8_MMA(1, 1, At, B1); PG8_BAR;
            PG8_LDB(B0, 1, 0); PG8_SCHED; PG8_LDA(At, 1, 0); PG8_STAGE(PG8_SA(0, 1), a2 + hstep, voffA);
            PG8_WAIT_L(8); PG8_BAR; PG8_WAIT_L(0); PG8_MMA(0, 0, At, B0); PG8_BAR; PG8_SCHED;
            PG8_LDB(B1, 1, 1); PG8_STAGE(PG8_SB(1, 0), b3, voffB);
            PG8_BAR; PG8_WAIT_L(0); PG8_MMA(0, 1, At, B1); PG8_BAR;
            PG8_LDA(At, 1, 1); PG8_STAGE(PG8_SA(1, 0), a3, voffA);
            PG8_BAR; PG8_WAIT_L(0); PG8_MMA(1, 0, At, B0); PG8_BAR; PG8_SCHED;
            PG8_STAGE(PG8_SB(1, 1), b3 + hstep, voffB);
            PG8_WAIT_V(6); PG8_BAR; PG8_MMA(1, 1, At, B1); PG8_BAR;
            }
        }
        if constexpr (ALIGN_EPI) { if (wr == 0) PG8_BAR; }
        if constexpr (!Epi::AFTER_DRAIN) { E(acc, cur, wr, wc, fr, fq); S.done(cur); }
        if (!has_next) break;
#pragma unroll
        for (int a = 0; a < 2; ++a)
#pragma unroll
            for (int b = 0; b < 2; ++b)
#pragma unroll
                for (int m = 0; m < 4; ++m)
#pragma unroll
                    for (int n = 0; n < 2; ++n) acc[a][b][m][n] = (f32x4){0.f, 0.f, 0.f, 0.f};
        cur = nxt; cA = nA; cB = nB; ++ui;
        if constexpr (ALIGN_EPI) { if (wr == 1) PG8_BAR; }
    }
    PG8_WAIT_V(0);
    if constexpr (!ALIGN_EPI) { if (wr == 0) PG8_BAR; }
    PG8_BAR;
    if constexpr (Epi::AFTER_DRAIN) { E.fused(acc, cur, wr, wc, fr, fq, lds, wid, lane); S.done(cur); }
#undef PG8_SA
#undef PG8_SB
#undef PG8_STAGE
#undef PG8_LDA
#undef PG8_LDB
#undef PG8_MMA
#undef PG8_WAIT_V
#undef PG8_WAIT_L
#undef PG8_BAR
#undef PG8_SCHED
}
}
namespace att {
typedef unsigned short bf16;
using bf16x8 = __attribute__((ext_vector_type(8))) short;
using s16x4  = __attribute__((ext_vector_type(4))) short;
using f32x16 = __attribute__((ext_vector_type(16))) float;
using u32x4  = __attribute__((ext_vector_type(4))) unsigned;
constexpr int   D = 128, NW = 8, QBLK = 32, KVBLK = 64;
constexpr float SCALE = 0.088388347648318440f;
constexpr float THR = 8.f;
constexpr int SHM_V = KVBLK * D * 2, SHM_K = KVBLK * D * 2, SHM_ATTN = 2 * SHM_V + 2 * SHM_K + NW * 64 * 4;
constexpr float MASKED = -1e30f, M_INIT = -1e28f;
#define KSWZ(row, colB) ((row) * 256 + ((colB) ^ (((row) & 7) << 4)))
#define SBAR() __builtin_amdgcn_sched_barrier(0)
__device__ __forceinline__ int crow(int r, int hi) { return (r & 3) + 8 * (r >> 2) + 4 * hi; }
__device__ __forceinline__ unsigned cvtpk(float lo, float hi) {
  unsigned r; asm volatile("v_cvt_pk_bf16_f32 %0, %1, %2" : "=v"(r) : "v"(lo), "v"(hi)); return r;
}
__device__ __forceinline__ void partialSM(f32x16& p0, f32x16& p1, float& m_reg, float& mn, float& alpha) {
  constexpr float C = SCALE * 1.4426950408889634f;
  float pmax = p0[0];
#pragma unroll
  for (int r = 1; r < 16; ++r) pmax = fmaxf(pmax, p0[r]);
#pragma unroll
  for (int r = 0; r < 16; ++r) pmax = fmaxf(pmax, p1[r]);
  { auto rr = __builtin_amdgcn_permlane32_swap(__float_as_uint(pmax), __float_as_uint(pmax), false, false);
    pmax = fmaxf(__uint_as_float(rr[0]), __uint_as_float(rr[1])); }
  if (__builtin_expect(__all(pmax - m_reg <= THR / SCALE), 1)) { mn = m_reg; alpha = 1.f; }
  else { mn = fmaxf(m_reg, pmax); alpha = __builtin_amdgcn_exp2f((m_reg - mn) * C); m_reg = mn; }
  float mnC = -mn * C;
#pragma unroll
  for (int r = 0; r < 16; ++r) p0[r] = fmaf(p0[r], C, mnC);
#pragma unroll
  for (int r = 0; r < 16; ++r) p1[r] = fmaf(p1[r], C, mnC);
#pragma unroll
  for (int r = 0; r < 16; ++r) p0[r] = __builtin_amdgcn_exp2f(p0[r]);
}
__device__ __forceinline__ void finishSM(f32x16& p0, f32x16& p1, float alpha, float& l_reg, bf16x8& pa0, bf16x8& pa1, bf16x8& pa2, bf16x8& pa3) {
#pragma unroll
  for (int r = 0; r < 16; ++r) p1[r] = __builtin_amdgcn_exp2f(p1[r]);
  float ps = 0;
#pragma unroll
  for (int r = 0; r < 16; ++r) ps += p0[r];
#pragma unroll
  for (int r = 0; r < 16; ++r) ps += p1[r];
  { auto rr = __builtin_amdgcn_permlane32_swap(__float_as_uint(ps), __float_as_uint(ps), false, false);
    ps = __uint_as_float(rr[0]) + __uint_as_float(rr[1]); }
  l_reg = l_reg * alpha + ps;
#define PK4(P, BASE, OUT) do { unsigned a0 = cvtpk(P[BASE + 0], P[BASE + 1]), a1 = cvtpk(P[BASE + 2], P[BASE + 3]);   \
    unsigned b0 = cvtpk(P[BASE + 4], P[BASE + 5]), b1 = cvtpk(P[BASE + 6], P[BASE + 7]);                              \
    auto r0 = __builtin_amdgcn_permlane32_swap(a0, b0, false, false); auto r1 = __builtin_amdgcn_permlane32_swap(a1, b1, false, false); \
    u32x4 w = {r0[0], r1[0], r0[1], r1[1]}; OUT = *reinterpret_cast<bf16x8*>(&w); } while (0)
  PK4(p0, 0, pa0); PK4(p0, 8, pa1); PK4(p1, 0, pa2); PK4(p1, 8, pa3);
#undef PK4
}
template <bool BAND>
__device__ __forceinline__ void qkt(f32x16& p0, f32x16& p1, const bf16* Ks, const bf16x8* qr, int r32, int hi, float dq, float kf0, float nsl, float radius, float Lf, int side) {
  if (!BAND && side != 0) {
    const float ns = side > 0 ? nsl : -nsl, t = ns * dq;
#pragma unroll
    for (int r = 0; r < 16; ++r) { const float c0 = (float)((r & 3) + 8 * (r >> 2)); p0[r] = fmaf(ns, -c0, t); p1[r] = fmaf(ns, -(c0 + 32.f), t); }
  } else
#pragma unroll
  for (int r = 0; r < 16; ++r) {
    const float c0 = (float)((r & 3) + 8 * (r >> 2));
    const float d0 = dq - c0, d1 = dq - (c0 + 32.f);
    float b0 = nsl * fabsf(d0), b1 = nsl * fabsf(d1);
    if (BAND) {
      const float ka = kf0 + c0, kb = kf0 + (c0 + 32.f);
      const bool v0 = (fabsf(d0) <= radius) && (ka >= 0.f) && (ka < Lf);
      const bool v1 = (fabsf(d1) <= radius) && (kb >= 0.f) && (kb < Lf);
      b0 = v0 ? b0 : MASKED; b1 = v1 ? b1 : MASKED;
    }
    p0[r] = b0; p1[r] = b1;
  }
#pragma unroll
  for (int d0 = 0; d0 < 8; ++d0) { int cb = (d0 * 16 + hi * 8) * 2;
    bf16x8 b0 = *reinterpret_cast<const bf16x8*>((const char*)Ks + KSWZ(r32, cb));
    bf16x8 b1 = *reinterpret_cast<const bf16x8*>((const char*)Ks + KSWZ(32 + r32, cb));
    p0 = __builtin_amdgcn_mfma_f32_32x32x16_bf16(b0, qr[d0], p0, 0, 0, 0);
    p1 = __builtin_amdgcn_mfma_f32_32x32x16_bf16(b1, qr[d0], p1, 0, 0, 0); }
}
__device__ __forceinline__ int v_st(int k, int c) { const int kk = (k & ~0xC) | ((k & 4) << 1) | ((k & 8) >> 1); return ((kk >> 3) * 4 + (c >> 5)) * 512 + ((kk & 7) * 32 + (c & 31)) * 2; }
__device__ __forceinline__ int v_rd_base(int lane) { return ((lane & 3) << 3) | (((lane >> 2) & 3) << 6) | (((lane >> 4) & 1) << 5) | (((lane >> 5) & 1) << 8); }
constexpr int v_rd_off(int d0, int ks, int half) { return d0 * 512 + ks * 4096 + half * 2048; }
template <int OFF> __device__ __forceinline__ s16x4 tr_read(int vb) {
  s16x4 r; asm volatile("ds_read_b64_tr_b16 %0, %1 offset:%2" : "=&v"(r) : "v"(vb), "i"(OFF) : "memory"); return r;
}
template <int D0> __device__ __forceinline__ void pv_one(f32x16& od, int vb, bf16x8 pa0, bf16x8 pa1, bf16x8 pa2, bf16x8 pa3) {
  const s16x4 l0 = tr_read<v_rd_off(D0, 0, 0)>(vb), h0 = tr_read<v_rd_off(D0, 0, 1)>(vb), l1 = tr_read<v_rd_off(D0, 1, 0)>(vb), h1 = tr_read<v_rd_off(D0, 1, 1)>(vb);
  const s16x4 l2 = tr_read<v_rd_off(D0, 2, 0)>(vb), h2 = tr_read<v_rd_off(D0, 2, 1)>(vb), l3 = tr_read<v_rd_off(D0, 3, 0)>(vb), h3 = tr_read<v_rd_off(D0, 3, 1)>(vb);
  asm volatile("s_waitcnt lgkmcnt(0)" ::: "memory"); SBAR();
#define PK(L, H) (bf16x8){L[0], L[1], L[2], L[3], H[0], H[1], H[2], H[3]}
  od = __builtin_amdgcn_mfma_f32_32x32x16_bf16(pa0, PK(l0, h0), od, 0, 0, 0);
  od = __builtin_amdgcn_mfma_f32_32x32x16_bf16(pa1, PK(l1, h1), od, 0, 0, 0);
  od = __builtin_amdgcn_mfma_f32_32x32x16_bf16(pa2, PK(l2, h2), od, 0, 0, 0);
  od = __builtin_amdgcn_mfma_f32_32x32x16_bf16(pa3, PK(l3, h3), od, 0, 0, 0);
#undef PK
}
__device__ __forceinline__ void pv_d0(f32x16* o, int vb, bf16x8 pa0, bf16x8 pa1, bf16x8 pa2, bf16x8 pa3) {
  pv_one<0>(o[0], vb, pa0, pa1, pa2, pa3); pv_one<1>(o[1], vb, pa0, pa1, pa2, pa3); pv_one<2>(o[2], vb, pa0, pa1, pa2, pa3); pv_one<3>(o[3], vb, pa0, pa1, pa2, pa3);
}

#define ATT_GAS __attribute__((address_space(1)))
struct UnitArgs {
  const ATT_GAS bf16* Q; long ldq;
  const ATT_GAS bf16* K; const ATT_GAS bf16* V; long ldk;
  int q0, L, kt0, nt;
  float nsl, radius, m_init, l_init;
  ATT_GAS float* Of; ATT_GAS bf16* Ob; long ldo;
  ATT_GAS float* lse; long ldl;
};

template <bool BAND, int SDEPTH>
__device__ __forceinline__ void attn_unit(const UnitArgs& a_in, char* lds) {
  UnitArgs a = a_in;
  asm volatile("" : "+s"(a.Q), "+s"(a.ldq), "+s"(a.K), "+s"(a.V), "+s"(a.ldk));
  asm volatile("" : "+s"(a.q0), "+s"(a.L), "+s"(a.kt0), "+s"(a.nt));
  asm volatile("" : "+s"(a.Of), "+s"(a.Ob), "+s"(a.ldo), "+s"(a.lse), "+s"(a.ldl));
  int tid_ = threadIdx.x; asm volatile("" : "+v"(tid_));
  const int tid = tid_, wid = tid >> 6, lane = tid & 63, r32 = lane & 31, hi = lane >> 5;
  bf16* V_lds = (bf16*)lds; bf16* K_lds = (bf16*)(lds + 2 * SHM_V);
  float* ws = (float*)(lds + 2 * SHM_V + 2 * SHM_K) + wid * 64; float* li_l = ws; float* al_l = ws + 32;
  float m_reg = a.m_init, l_reg = a.l_init; f32x16 o[4] = {}; bf16x8 qr[8];
  const ATT_GAS bf16* Qw = a.Q + (long)(wid * QBLK + r32) * a.ldq + hi * 8;
#pragma unroll
  for (int d0 = 0; d0 < 8; ++d0) qr[d0] = *reinterpret_cast<const ATT_GAS bf16x8*>(Qw + d0 * 16);
  const int sr = tid >> 4, sc = (tid & 15) * 8, vst0 = v_st(sr, sc), vst1 = v_st(32 + sr, sc);
  const int vb0 = (int)(uintptr_t)V_lds + v_rd_base(lane);
  const float qf = (float)(a.q0 + wid * QBLK + r32), Lf = (float)a.L, nsl = a.nsl, radius = a.radius;
  const int Lm1 = a.L - 1, kt0 = a.kt0, qw0 = a.q0 + __builtin_amdgcn_readfirstlane(wid) * QBLK;
  const ATT_GAS bf16* Kp = a.K; const ATT_GAS bf16* Vp = a.V; const long ldk = a.ldk;
  struct { bf16x8 vs0, vs1, ks0, ks1; } sr_[SDEPTH];
  const unsigned lofs = (unsigned)((sr * ldk + sc) * 2);
  const ATT_GAS char* Kc = (const ATT_GAS char*)Kp; const ATT_GAS char* Vc = (const ATT_GAS char*)Vp; const long ldk32 = 32 * ldk * 2, ldk64 = 64 * ldk * 2;
#define SLOAD(i, t) do { if constexpr (BAND) { const int k0_ = (kt0 + (t)) * KVBLK; int ra_ = k0_ + sr, rb_ = k0_ + 32 + sr;                   \
    ra_ = ra_ < 0 ? 0 : (ra_ > Lm1 ? Lm1 : ra_); rb_ = rb_ < 0 ? 0 : (rb_ > Lm1 ? Lm1 : rb_);                                          \
    sr_[i].vs0 = *reinterpret_cast<const ATT_GAS bf16x8*>(&Vp[(long)ra_ * ldk + sc]); sr_[i].vs1 = *reinterpret_cast<const ATT_GAS bf16x8*>(&Vp[(long)rb_ * ldk + sc]); \
    sr_[i].ks0 = *reinterpret_cast<const ATT_GAS bf16x8*>(&Kp[(long)ra_ * ldk + sc]); sr_[i].ks1 = *reinterpret_cast<const ATT_GAS bf16x8*>(&Kp[(long)rb_ * ldk + sc]); } \
  else { const long tb_ = (long)(kt0 + (t)) * ldk64;                                                                                       \
    sr_[i].vs0 = *reinterpret_cast<const ATT_GAS bf16x8*>(Vc + tb_ + lofs); sr_[i].vs1 = *reinterpret_cast<const ATT_GAS bf16x8*>(Vc + tb_ + ldk32 + lofs); \
    sr_[i].ks0 = *reinterpret_cast<const ATT_GAS bf16x8*>(Kc + tb_ + lofs); sr_[i].ks1 = *reinterpret_cast<const ATT_GAS bf16x8*>(Kc + tb_ + ldk32 + lofs); } } while (0)
#define SWRITE(b, i) do { *(bf16x8*)((char*)V_lds + (b) * SHM_V + vst0) = sr_[i].vs0;          \
    *(bf16x8*)((char*)V_lds + (b) * SHM_V + vst1) = sr_[i].vs1; int kc = sc * 2;               \
    *(bf16x8*)((char*)K_lds + (b) * SHM_K + KSWZ(sr, kc)) = sr_[i].ks0;                       \
    *(bf16x8*)((char*)K_lds + (b) * SHM_K + KSWZ(32 + sr, kc)) = sr_[i].ks1; } while (0)
#define SWAIT() do { if constexpr (SDEPTH == 2) asm volatile("s_waitcnt vmcnt(4)" ::: "memory"); else asm volatile("s_waitcnt vmcnt(0)" ::: "memory"); } while (0)
#define RESC(al) do { if (__any((al) < 1.f)) { if (hi == 0) al_l[r32] = (al); asm volatile("s_waitcnt lgkmcnt(0)" ::: "memory"); \
    _Pragma("unroll") for (int d = 0; d < 4; ++d) _Pragma("unroll") for (int r = 0; r < 16; ++r) o[d][r] *= al_l[crow(r, hi)]; } } while (0)
#define QKT(PA, PB, buf, t) do { const int k0_ = (kt0 + (t)) * KVBLK; const float kf0_ = (float)(k0_ + 4 * hi); \
    const int side_ = (k0_ + KVBLK - 1 < qw0) ? 1 : ((k0_ > qw0 + QBLK - 1) ? -1 : 0); \
    qkt<BAND>(PA, PB, (bf16*)((char*)K_lds + (buf) * SHM_K), qr, r32, hi, qf - kf0_, kf0_, nsl, radius, Lf, side_); } while (0)
  f32x16 pA0, pA1, pB0, pB1; float mnA, mnB, alA, alB; bf16x8 pa0, pa1, pa2, pa3; const int NT = a.nt;
  constexpr int SE = 0, SO = SDEPTH - 1;
  SLOAD(SE, 0); asm volatile("s_waitcnt vmcnt(0)" ::: "memory"); SWRITE(0, SE); __syncthreads();
  QKT(pA0, pA1, 0, 0); partialSM(pA0, pA1, m_reg, mnA, alA);
  SLOAD(SO, 1); if constexpr (SDEPTH == 2) { if (2 < NT) SLOAD(SE, 2); }
  SWAIT(); SWRITE(1, SO); __syncthreads();
  for (int j = 1; j + 1 < NT; j += 2) {
    SBAR(); QKT(pB0, pB1, 1, j);
    finishSM(pA0, pA1, alA, l_reg, pa0, pa1, pa2, pa3); SBAR();
    SLOAD(SO, j + SDEPTH); SBAR();
    pv_d0(o, vb0, pa0, pa1, pa2, pa3); partialSM(pB0, pB1, m_reg, mnB, alB);
    __syncthreads(); SWAIT(); SWRITE(0, SE);
    RESC(alB); __syncthreads();
    SBAR(); QKT(pA0, pA1, 0, j + 1);
    finishSM(pB0, pB1, alB, l_reg, pa0, pa1, pa2, pa3); SBAR();
    if (SDEPTH == 1 || j + 3 < NT) SLOAD(SE, j + 1 + SDEPTH); SBAR();
    pv_d0(o, vb0 + (int)SHM_V, pa0, pa1, pa2, pa3); partialSM(pA0, pA1, m_reg, mnA, alA);
    __syncthreads(); SWAIT(); SWRITE(1, SO);
    RESC(alA); __syncthreads();
  }
  SBAR(); QKT(pB0, pB1, 1, NT - 1);
  finishSM(pA0, pA1, alA, l_reg, pa0, pa1, pa2, pa3); SBAR();
  pv_d0(o, vb0, pa0, pa1, pa2, pa3); partialSM(pB0, pB1, m_reg, mnB, alB);
  __syncthreads(); RESC(alB);
  finishSM(pB0, pB1, alB, l_reg, pa0, pa1, pa2, pa3); SBAR();
  pv_d0(o, vb0 + (int)SHM_V, pa0, pa1, pa2, pa3);
  if (hi == 0) li_l[r32] = l_reg; asm volatile("s_waitcnt lgkmcnt(0)" ::: "memory");
  float rli[16];
#pragma unroll
  for (int r = 0; r < 16; ++r) rli[r] = __builtin_amdgcn_rcpf(li_l[crow(r, hi)]);
  if (a.Of) {
    ATT_GAS float* Ow = a.Of + (long)(wid * QBLK) * a.ldo;
#pragma unroll
    for (int r = 0; r < 16; ++r) { const int orow = crow(r, hi);
#pragma unroll
      for (int d0 = 0; d0 < 4; ++d0) Ow[(long)orow * a.ldo + d0 * 32 + r32] = o[d0][r] * rli[r]; }
  } else {
    ATT_GAS bf16* Ow = a.Ob + (long)(wid * QBLK) * a.ldo;
#pragma unroll
    for (int r = 0; r < 16; ++r) { const int orow = crow(r, hi);
#pragma unroll
      for (int d0 = 0; d0 < 4; ++d0) { const float v = o[d0][r] * rli[r]; Ow[(long)orow * a.ldo + d0 * 32 + r32] = (bf16)(cvtpk(v, v) & 0xffffu); } }
  }
  if (a.lse && hi == 0) a.lse[(long)(wid * QBLK + r32) * a.ldl] = m_reg * SCALE + __logf(l_reg);
  __syncthreads();
#undef SLOAD
#undef SWRITE
#undef SWAIT
#undef RESC
#undef QKT
}
#undef KSWZ
#undef SBAR
}
constexpr int DM = 2048, BATCH = 2, SEQ = 4096, DEPTH = 4, M = BATCH * SEQ;
constexpr int AB_IN = 3584, AB_OUT = 1024, C_IN = 6144, DFF = 5504, UPW = 2 * DFF, MODW = 6 * DM;
constexpr float EPS = 1e-6f;
constexpr int NWAVES = 8;
constexpr size_t MiB = 1u << 20;
constexpr size_t WS_CTL = 0, CTL_ZERO_BYTES = 2 * MiB;
constexpr size_t WS_MOD = 2 * MiB;
constexpr size_t WS_PART = 3 * MiB;
constexpr size_t WS_NRM = 12 * MiB;
constexpr size_t WS_WABIN = 16 * MiB;
constexpr size_t WS_WABOUT = 44 * MiB;
constexpr size_t WS_WCIN = 52 * MiB;
constexpr size_t WS_WCOUT = 100 * MiB;
constexpr size_t WS_WUP = 116 * MiB;
constexpr size_t WS_WDOWN = 288 * MiB;
constexpr size_t WS_H = 376 * MiB;
constexpr size_t WS_PROJ = 408 * MiB;
constexpr size_t WS_ATT = 504 * MiB;
constexpr size_t WS_LSE = WS_ATT + 64 * MiB;
constexpr size_t WS_O = 632 * MiB;
constexpr size_t WS_Y = 664 * MiB;
constexpr size_t WS_GU = 728 * MiB;
constexpr size_t WS_ACT = 900 * MiB;
constexpr size_t WS_END = 986 * MiB;
static_assert(WS_PART + (size_t)DEPTH * 16 * BATCH * MODW * 4 <= WS_WABIN, "ws map");
static_assert(WS_WABIN + (size_t)2 * AB_IN * DM * 2 <= WS_WABOUT && WS_WABOUT + (size_t)2 * DM * AB_OUT * 2 <= WS_WCIN, "ws map");
static_assert(WS_WCIN + (size_t)2 * C_IN * DM * 2 <= WS_WCOUT && WS_WCOUT + (size_t)2 * DM * DM * 2 <= WS_WUP, "ws map");
static_assert(WS_WUP + (size_t)4 * UPW * DM * 2 <= WS_WDOWN && WS_WDOWN + (size_t)4 * DM * DFF * 2 <= WS_H, "ws map");
static_assert(WS_H + (size_t)M * DM * 2 <= WS_PROJ && WS_PROJ + (size_t)M * C_IN * 2 <= WS_ATT && WS_ATT + (size_t)2 * M * DM * 4 <= WS_O, "ws map");
static_assert(WS_ATT + (size_t)3 * M * 512 * 4 <= WS_LSE && WS_LSE + (size_t)3 * M * 4 * 4 <= WS_O, "ws map");
static_assert(WS_O + (size_t)M * DM * 2 <= WS_Y && WS_Y + (size_t)M * DM * 4 <= WS_GU && WS_GU + (size_t)M * UPW * 2 <= WS_ACT && WS_ACT + (size_t)M * DFF * 2 <= WS_END, "ws map");
constexpr int CW_BAR = 4096;
constexpr int RING_OFF = 0, RING_BYTES = 131072;
constexpr int LDSCTL_OFF = RING_BYTES, MISC_OFF = LDSCTL_OFF + 320;
constexpr int LDS_BYTES = 147456;
static_assert(att::SHM_ATTN <= RING_BYTES, "attention LDS fits the ring region");

#define GAS __attribute__((address_space(1)))
#define LAS __attribute__((address_space(3)))
typedef unsigned short bf16;
typedef unsigned v4u __attribute__((ext_vector_type(4)));
typedef unsigned v2u __attribute__((ext_vector_type(2)));
typedef float f32x4 __attribute__((ext_vector_type(4)));
typedef GAS unsigned gu32;
#define LDS_WAIT() asm volatile("s_waitcnt lgkmcnt(0)" ::: "memory")
__device__ __forceinline__ unsigned pk2(float lo, float hi) { unsigned r; asm volatile("v_cvt_pk_bf16_f32 %0, %1, %2" : "=v"(r) : "v"(lo), "v"(hi)); return r; }
__device__ __forceinline__ float bf_lo(unsigned w) { return __uint_as_float(w << 16); }
__device__ __forceinline__ float bf_hi(unsigned w) { return __uint_as_float(w & 0xffff0000u); }
#define XB_TMO      128
#define XB_XCNT(j)  (256  + 64 * (j))
#define XB_XSUB(j)  (1280 + 64 * (j))
#define XB_XGEN(j)  (2304 + 64 * (j))
#define XB_TOP      3328
#define XB_TOPGEN   3392
#define XCD_BAR_WORDS 3456
#define XB_SPIN_CAP (1u << 18)

__device__ __forceinline__ unsigned xb_ld(unsigned* p)              { return __hip_atomic_load(p, __ATOMIC_RELAXED, __HIP_MEMORY_SCOPE_AGENT); }
__device__ __forceinline__ unsigned xb_add(unsigned* p, unsigned v) { return __hip_atomic_fetch_add(p, v, __ATOMIC_RELAXED, __HIP_MEMORY_SCOPE_AGENT); }
__device__ __forceinline__ unsigned xb_xcc_id() { return (unsigned)__builtin_amdgcn_s_getreg((3 << 11) | 20) & 0xFu; }
#define XB_SPIN(cond, bar) do { unsigned _sp = 0; while (cond) { __builtin_amdgcn_s_sleep(1); \
    if ((++_sp & 255u) == 0u) { if (xb_ld(&(bar)[XB_TMO])) break; if (_sp > XB_SPIN_CAP) { atomicAdd(&(bar)[XB_TMO], 1u); break; } } } } while (0)

struct XcdBarrier {
    unsigned* bar; unsigned x;
    volatile LAS unsigned* st;
};

__device__ __forceinline__ XcdBarrier xcd_barrier_post(unsigned* bar, volatile LAS unsigned* st) {
    XcdBarrier b; b.bar = bar; b.x = xb_xcc_id(); b.st = st;
    if (threadIdx.x == 0) (void)xb_add(&bar[XB_XCNT(b.x)], 1u);
    return b;
}
__device__ __forceinline__ void xcd_barrier_complete(unsigned* bar, unsigned x, unsigned& nloc, unsigned& nx) {
    const unsigned G = gridDim.x * gridDim.y * gridDim.z;
    unsigned sum, cnt, mine, sp = 0u;
    for (;;) {
        sum = 0u; cnt = 0u; mine = 0u;
#pragma unroll
        for (unsigned j = 0; j < 16; ++j) { const unsigned c = xb_ld(&bar[XB_XCNT(j)]); sum += c; cnt += (c > 0u) ? 1u : 0u; mine = (j == x) ? c : mine; }
        if (sum == G) break;
        __builtin_amdgcn_s_sleep(1);
        if ((++sp & 255u) == 0u) { if (xb_ld(&bar[XB_TMO])) break; if (sp > XB_SPIN_CAP) { atomicAdd(&bar[XB_TMO], 1u); break; } }
    }
    nloc = mine > 0u ? mine : 1u; nx = cnt > 0u ? cnt : 1u;
}

__device__ __forceinline__ void xcd_barrier(const XcdBarrier& b) {
    asm volatile("s_waitcnt vmcnt(0)" ::: "memory");
    __syncthreads();
    if (threadIdx.x == 0) {
        unsigned* bar = b.bar;
        __builtin_amdgcn_s_waitcnt(0);
        unsigned nloc = b.st[0], nx = b.st[1];
        if (nloc == 0u) { xcd_barrier_complete(bar, b.x, nloc, nx); b.st[0] = nloc; b.st[1] = nx; }
        const unsigned old = xb_add(&bar[XB_XSUB(b.x)], 1u);
        const unsigned gen = old / nloc;
        if (old + 1u == (gen + 1u) * nloc) {
            __builtin_amdgcn_fence(__ATOMIC_RELEASE, "agent");
            asm volatile("s_waitcnt vmcnt(0)" ::: "memory");
            const unsigned og = xb_add(&bar[XB_TOP], 1u);
            const unsigned tg = og / nx;
            if (og + 1u == (tg + 1u) * nx) xb_add(&bar[XB_TOPGEN], 1u);
            else XB_SPIN(xb_ld(&bar[XB_TOPGEN]) == tg, bar);
            __builtin_amdgcn_fence(__ATOMIC_ACQUIRE, "agent");
            xb_add(&bar[XB_XGEN(b.x)], 1u);
            asm volatile("s_waitcnt vmcnt(0)" ::: "memory");
        } else {
            XB_SPIN(xb_ld(&bar[XB_XGEN(b.x)]) == gen, bar);
            __builtin_amdgcn_fence(__ATOMIC_ACQUIRE, "agent");
            asm volatile("s_waitcnt vmcnt(0)" ::: "memory");
        }
    }
    __syncthreads();
}
struct Frame {
    LAS unsigned char* lds; char* ldsg;
    int tid, lane, wave, G, gw, NGW;
    const float *x, *c, *ada_w, *ada_b, *norm_g, *ab_w_in, *ab_w_out, *a_sink, *c_w_in, *c_w_out, *c_lambda, *c_subln_g, *w_up, *conv_w, *conv_b, *w_down;
    float* out; unsigned char* ws;
};
#define PHASE_IDS() int tid = threadIdx.x; asm volatile("" : "+v"(tid)); const int lane = tid & 63, wave = __builtin_amdgcn_readfirstlane(tid >> 6), gw = (int)blockIdx.x * NWAVES + wave; (void)lane; (void)gw
__device__ __forceinline__ float wave_sum(float v) {
#pragma unroll
    for (int o = 1; o < 64; o <<= 1) v += __shfl_xor(v, o);
    return v;
}
__device__ __forceinline__ void transpose_item(const float* W, int K, int N, bf16* WT, LAS float* scr, int item, int lane) {
    const int nblk = N / 32, kb = item / nblk, nb = item % nblk, k0 = 64 * kb, n0 = 32 * nb;
#pragma unroll 8
    for (int i = 0; i < 32; ++i) { const int kk = 2 * i + (lane >> 5); scr[kk * 33 + (lane & 31)] = W[(size_t)(k0 + kk) * N + n0 + (lane & 31)]; }
    LDS_WAIT(); asm volatile("" ::: "memory");
    const int c = lane & 7;
#pragma unroll
    for (int j = 0; j < 4; ++j) { const int n = (lane >> 3) + 8 * j; const LAS float* s = scr + (8 * c) * 33 + n;
        v4u o; o.x = pk2(s[0 * 33], s[1 * 33]); o.y = pk2(s[2 * 33], s[3 * 33]); o.z = pk2(s[4 * 33], s[5 * 33]); o.w = pk2(s[6 * 33], s[7 * 33]);
        *(GAS v4u*)(WT + (size_t)(n0 + n) * K + k0 + 8 * c) = o; }
    LDS_WAIT(); asm volatile("" ::: "memory");
}
__device__ __forceinline__ float silu_f(float v) { return v / (1.f + __expf(-v)); }

__device__ __forceinline__ void p0a_prologue(Frame& F) {
    PHASE_IDS();
    LAS float* scr = (LAS float*)(F.lds + RING_OFF + wave * 16384);
    constexpr int I_ABIN = (DM / 64) * (AB_IN / 32), I_ABOUT = (AB_OUT / 64) * (DM / 32), I_CIN = (DM / 64) * (C_IN / 32), I_COUT = (DM / 64) * (DM / 32),
                  I_UP = (DM / 64) * (UPW / 32), I_DOWN = (DFF / 64) * (DM / 32);
    constexpr int NT_ITEMS = 2 * I_ABIN + 2 * I_ABOUT + 2 * I_CIN + 2 * I_COUT + 4 * I_UP + 4 * I_DOWN;
    bf16* wabin = (bf16*)(F.ws + WS_WABIN); bf16* wabout = (bf16*)(F.ws + WS_WABOUT); bf16* wcin = (bf16*)(F.ws + WS_WCIN); bf16* wcout = (bf16*)(F.ws + WS_WCOUT);
    bf16* wup = (bf16*)(F.ws + WS_WUP); bf16* wdown = (bf16*)(F.ws + WS_WDOWN);
    for (int it = gw; it < NT_ITEMS; it += F.NGW) {
        int r = it;
        if (r < 2 * I_ABIN) { const int j = r / I_ABIN; transpose_item(F.ab_w_in + (size_t)j * DM * AB_IN, DM, AB_IN, wabin + (size_t)j * AB_IN * DM, scr, r % I_ABIN, lane); continue; } r -= 2 * I_ABIN;
        if (r < 2 * I_ABOUT) { const int j = r / I_ABOUT; transpose_item(F.ab_w_out + (size_t)j * AB_OUT * DM, AB_OUT, DM, wabout + (size_t)j * DM * AB_OUT, scr, r % I_ABOUT, lane); continue; } r -= 2 * I_ABOUT;
        if (r < 2 * I_CIN) { const int j = r / I_CIN; transpose_item(F.c_w_in + (size_t)j * DM * C_IN, DM, C_IN, wcin + (size_t)j * C_IN * DM, scr, r % I_CIN, lane); continue; } r -= 2 * I_CIN;
        if (r < 2 * I_COUT) { const int j = r / I_COUT; transpose_item(F.c_w_out + (size_t)j * DM * DM, DM, DM, wcout + (size_t)j * DM * DM, scr, r % I_COUT, lane); continue; } r -= 2 * I_COUT;
        if (r < 4 * I_UP) { const int j = r / I_UP; transpose_item(F.w_up + (size_t)j * DM * UPW, DM, UPW, wup + (size_t)j * UPW * DM, scr, r % I_UP, lane); continue; } r -= 4 * I_UP;
        { const int j = r / I_DOWN; transpose_item(F.w_down + (size_t)j * DFF * DM, DFF, DM, wdown + (size_t)j * DM * DFF, scr, r % I_DOWN, lane); }
    }
    float* part = (float*)(F.ws + WS_PART);
    constexpr int NCH = MODW / 256, NKC = 16, KCH = DM / NKC;
    for (int it = gw; it < DEPTH * NCH * NKC; it += F.NGW) {
        const int kc = it % NKC, nch = (it / NKC) % NCH, l = it / (NKC * NCH), k0 = kc * KCH;
        const float c0a = silu_f(F.c[k0 + lane]), c0b = silu_f(F.c[k0 + 64 + lane]), c1a = silu_f(F.c[DM + k0 + lane]), c1b = silu_f(F.c[DM + k0 + 64 + lane]);
        const float* wp = F.ada_w + ((size_t)l * DM + k0) * MODW + nch * 256 + 4 * lane;
        f32x4 a0 = {0.f, 0.f, 0.f, 0.f}, a1 = {0.f, 0.f, 0.f, 0.f};
#pragma unroll 8
        for (int k = 0; k < 64; ++k) { const f32x4 w = *(const f32x4*)(wp + (size_t)k * MODW); const float s0 = __shfl(c0a, k), s1 = __shfl(c1a, k); a0 += w * s0; a1 += w * s1; }
#pragma unroll 8
        for (int k = 0; k < 64; ++k) { const f32x4 w = *(const f32x4*)(wp + (size_t)(64 + k) * MODW); const float s0 = __shfl(c0b, k), s1 = __shfl(c1b, k); a0 += w * s0; a1 += w * s1; }
        float* pp = part + (((size_t)l * NKC + kc) * BATCH) * MODW + nch * 256 + 4 * lane;
        *(f32x4*)pp = a0; *(f32x4*)(pp + MODW) = a1;
    }
}
__device__ __forceinline__ void p0b_modreduce(Frame& F) {
    PHASE_IDS();
    const float* part = (const float*)(F.ws + WS_PART); float* mod = (float*)(F.ws + WS_MOD);
    for (int i = blockIdx.x * (NWAVES * 64) + tid; i < DEPTH * BATCH * MODW; i += F.G * NWAVES * 64) {
        const int n = i % MODW, b = (i / MODW) % BATCH, l = i / (MODW * BATCH);
        float s = F.ada_b[l * MODW + n];
#pragma unroll
        for (int kc = 0; kc < 16; ++kc) s += part[(((size_t)l * 16 + kc) * BATCH + b) * MODW + n];
        mod[i] = s;
    }
}
__device__ __forceinline__ void rows_pre(Frame& F, const float* x, const float* ng, const float* scale, const float* shift, bf16* H) {
    PHASE_IDS();
    for (int m = gw; m < M; m += F.NGW) {
        const int b = m / SEQ; f32x4 v[8]; float ss = 0.f;
#pragma unroll
        for (int j = 0; j < 8; ++j) { v[j] = *(const f32x4*)(x + (size_t)m * DM + 4 * lane + 256 * j); ss += (v[j].x * v[j].x + v[j].y * v[j].y) + (v[j].z * v[j].z + v[j].w * v[j].w); }
        const float r = 1.f / sqrtf(wave_sum(ss) * (1.f / DM) + EPS);
#pragma unroll
        for (int j = 0; j < 8; ++j) { const int c = 4 * lane + 256 * j;
            const f32x4 g = *(const f32x4*)(ng + c), sc = *(const f32x4*)(scale + (size_t)b * MODW + c), sh = *(const f32x4*)(shift + (size_t)b * MODW + c);
            const f32x4 h = (v[j] * r) * g * (sc + 1.f) + sh;
            v2u o; o.x = pk2(h.x, h.y); o.y = pk2(h.z, h.w); *(v2u*)(H + (size_t)m * DM + c) = o; }
    }
}
__device__ __forceinline__ void rows_post(Frame& F, const bf16* Y, const float* xs, float* xd, const float* gate, const float* nga,
                                          const float* ngb, const float* scale, const float* shift, bf16* H, bool doH) {
    PHASE_IDS();
    for (int m = gw; m < M; m += F.NGW) {
        const int b = m / SEQ; f32x4 v[8]; float ss = 0.f;
#pragma unroll
        for (int j = 0; j < 8; ++j) { const v2u w = *(const v2u*)(Y + (size_t)m * DM + 4 * lane + 256 * j); v[j] = (f32x4){bf_lo(w.x), bf_hi(w.x), bf_lo(w.y), bf_hi(w.y)};
            ss += (v[j].x * v[j].x + v[j].y * v[j].y) + (v[j].z * v[j].z + v[j].w * v[j].w); }
        const float r = 1.f / sqrtf(wave_sum(ss) * (1.f / DM) + EPS); float ss2 = 0.f;
#pragma unroll
        for (int j = 0; j < 8; ++j) { const int c = 4 * lane + 256 * j;
            const f32x4 xv = *(const f32x4*)(xs + (size_t)m * DM + c), g = *(const f32x4*)(gate + (size_t)b * MODW + c), na = *(const f32x4*)(nga + c);
            v[j] = xv + g * ((v[j] * r) * na);
            ss2 += (v[j].x * v[j].x + v[j].y * v[j].y) + (v[j].z * v[j].z + v[j].w * v[j].w);
            *(f32x4*)(xd + (size_t)m * DM + c) = v[j]; }
        if (doH) {
            const float r2 = 1.f / sqrtf(wave_sum(ss2) * (1.f / DM) + EPS);
#pragma unroll
            for (int j = 0; j < 8; ++j) { const int c = 4 * lane + 256 * j;
                const f32x4 g = *(const f32x4*)(ngb + c), sc = *(const f32x4*)(scale + (size_t)b * MODW + c), sh = *(const f32x4*)(shift + (size_t)b * MODW + c);
                const f32x4 h = (v[j] * r2) * g * (sc + 1.f) + sh;
                v2u o; o.x = pk2(h.x, h.y); o.y = pk2(h.z, h.w); *(v2u*)(H + (size_t)m * DM + c) = o; }
        }
    }
}
__device__ __forceinline__ void rows_subln(Frame& F, const float* A0, const float* A1, const float* lamp, const float* sg, float lambda_init, bf16* O) {
    PHASE_IDS();
    const float l0 = lamp[lane] * lamp[128 + lane] + lamp[64 + lane] * lamp[128 + 64 + lane];
    const float l1 = lamp[256 + lane] * lamp[384 + lane] + lamp[256 + 64 + lane] * lamp[384 + 64 + lane];
    const float lam = __expf(wave_sum(l0)) - __expf(wave_sum(l1)) + lambda_init;
    const f32x4 g = *(const f32x4*)(sg + 4 * lane) * (1.f - lambda_init);
    for (int m = gw; m < M; m += F.NGW) {
#pragma unroll
        for (int j = 0; j < 8; ++j) { const size_t off = (size_t)m * DM + 4 * lane + 256 * j;
            const f32x4 d = *(const f32x4*)(A0 + off) - *(const f32x4*)(A1 + off) * lam;
            const float ss = wave_sum((d.x * d.x + d.y * d.y) + (d.z * d.z + d.w * d.w));
            const float r = 1.f / sqrtf(ss * (1.f / 256.f) + EPS);
            const f32x4 h = (d * r) * g;
            v2u o; o.x = pk2(h.x, h.y); o.y = pk2(h.z, h.w); *(v2u*)(O + off) = o; }
    }
}
__device__ __forceinline__ void rows_bmerge(Frame& F, const float* OB, const float* LSE, bf16* O) {
    PHASE_IDS();
    for (int m = gw; m < M; m += F.NGW) {
        const int hb = lane >> 4;
        const float e0 = LSE[(size_t)m * 4 + hb], e1 = LSE[((size_t)M + m) * 4 + hb], e2 = LSE[((size_t)2 * M + m) * 4 + hb];
        const float mx = fmaxf(e0, fmaxf(e1, e2));
        float w0 = __expf(e0 - mx), w1 = __expf(e1 - mx), w2 = __expf(e2 - mx); const float inv = 1.f / (w0 + w1 + w2); w0 *= inv; w1 *= inv; w2 *= inv;
        const float* p = OB + (size_t)m * 512 + 8 * lane;
        const f32x4 a0 = *(const f32x4*)p, a1 = *(const f32x4*)(p + 4);
        const f32x4 b0 = *(const f32x4*)(p + (size_t)M * 512), b1 = *(const f32x4*)(p + (size_t)M * 512 + 4);
        const f32x4 c0 = *(const f32x4*)(p + (size_t)2 * M * 512), c1 = *(const f32x4*)(p + (size_t)2 * M * 512 + 4);
        const f32x4 r0 = a0 * w0 + b0 * w1 + c0 * w2, r1 = a1 * w0 + b1 * w1 + c1 * w2;
        v4u o; o.x = pk2(r0.x, r0.y); o.y = pk2(r0.z, r0.w); o.z = pk2(r1.x, r1.y); o.w = pk2(r1.z, r1.w);
        *(v4u*)(O + (size_t)m * AB_OUT + 512 + 8 * lane) = o;
    }
}
__device__ __forceinline__ float gelu_tanh(float v) {
    const float u = 0.7978845608028654f * (v + 0.044715f * v * v * v);
    const float e = __expf(2.f * u);
    const float t = 1.f - 2.f / (e + 1.f);
    return 0.5f * v * (1.f + t);
}
__device__ __forceinline__ void phase_act(Frame& F, const bf16* GU, const float* cw, const float* cb, bf16* ACT) {
    PHASE_IDS();
    constexpr int NC8 = DFF / 8, RB = 8, NRB = M / RB;
    for (int it = blockIdx.x * (NWAVES * 64) + tid; it < NRB * NC8; it += F.G * NWAVES * 64) {
        const int c8 = it % NC8, rb = it / NC8, c = c8 * 8, m0 = rb * RB;
        float w0[8], w1[8], w2[8], bb[8];
#pragma unroll
        for (int i = 0; i < 8; ++i) { w0[i] = cw[c + i]; w1[i] = cw[DFF + c + i]; w2[i] = cw[2 * DFF + c + i]; bb[i] = cb[c + i]; }
        v4u gp, gc, gn;
        if ((m0 % SEQ) == 0) gp = (v4u){0u, 0u, 0u, 0u}; else gp = *(const v4u*)(GU + (size_t)(m0 - 1) * UPW + c);
        gc = *(const v4u*)(GU + (size_t)m0 * UPW + c);
#pragma unroll
        for (int rr = 0; rr < RB; ++rr) {
            const int m = m0 + rr;
            if ((m % SEQ) == SEQ - 1) gn = (v4u){0u, 0u, 0u, 0u}; else gn = *(const v4u*)(GU + (size_t)(m + 1) * UPW + c);
            const v4u up = *(const v4u*)(GU + (size_t)m * UPW + DFF + c);
            float r[8];
#pragma unroll
            for (int q = 0; q < 4; ++q) {
                const float a_lo = w0[2 * q] * bf_lo(gp[q]) + w1[2 * q] * bf_lo(gc[q]) + w2[2 * q] * bf_lo(gn[q]) + bb[2 * q];
                const float a_hi = w0[2 * q + 1] * bf_hi(gp[q]) + w1[2 * q + 1] * bf_hi(gc[q]) + w2[2 * q + 1] * bf_hi(gn[q]) + bb[2 * q + 1];
                r[2 * q] = gelu_tanh(a_lo) * bf_lo(up[q]); r[2 * q + 1] = gelu_tanh(a_hi) * bf_hi(up[q]);
            }
            v4u o; o.x = pk2(r[0], r[1]); o.y = pk2(r[2], r[3]); o.z = pk2(r[4], r[5]); o.w = pk2(r[6], r[7]);
            *(v4u*)(ACT + (size_t)m * DFF + c) = o;
            gp = gc; gc = gn;
        }
    }
}
__device__ __forceinline__ float alibi16(int i) { return exp2f(-0.5f * (float)(i + 1)); }
__device__ __forceinline__ void phase_attn_ab(Frame& F, int jl) {
    const bf16* P = (const bf16*)(F.ws + WS_PROJ); bf16* O = (bf16*)(F.ws + WS_O); float* OB = (float*)(F.ws + WS_ATT); float* LSE = (float*)(F.ws + WS_LSE);
    for (int u = blockIdx.x; u < 512; u += F.G) {
        att::UnitArgs a;
        if (u < 128) {
            const int qb = u % 16, qh = (u / 16) % 4, b = u / 64, q0 = qb * 256; const size_t row0 = (size_t)b * SEQ;
            a.Q = (const GAS bf16*)P + (row0 + q0) * AB_IN + qh * 128; a.ldq = AB_IN;
            a.K = (const GAS bf16*)P + row0 * AB_IN + 512 + (qh >> 1) * 128; a.V = (const GAS bf16*)P + row0 * AB_IN + 768 + (qh >> 1) * 128; a.ldk = AB_IN;
            a.q0 = q0; a.L = SEQ; a.kt0 = q0 / 64 - 2; a.nt = 8;
            a.nsl = -alibi16(qh) / att::SCALE; a.radius = 128.f; a.m_init = F.a_sink[jl * 4 + qh] / att::SCALE; a.l_init = 1.f;
            a.Of = nullptr; a.Ob = (GAS bf16*)O + (row0 + q0) * AB_OUT + qh * 128; a.ldo = AB_OUT; a.lse = nullptr; a.ldl = 0;
        } else {
            const int v = (u - 128) % 128, gi = (u - 128) / 128, dil = gi == 0 ? 1 : (gi == 1 ? 4 : 16), L = SEQ / dil;
            int qb, r, hb, b;
            if (gi == 0) { qb = v % 16; r = 0; hb = (v / 16) % 4; b = v / 64; }
            else if (gi == 1) { qb = v % 4; r = (v / 4) % 4; hb = (v / 16) % 4; b = v / 64; }
            else { qb = 0; r = v % 16; hb = (v / 16) % 4; b = v / 64; }
            const int q0 = qb * 256; const size_t seq0 = (size_t)b * SEQ + r, rowq = seq0 + (size_t)dil * q0;
            a.Q = (const GAS bf16*)P + rowq * AB_IN + 1024 + gi * 512 + hb * 128; a.ldq = (long)dil * AB_IN;
            a.K = (const GAS bf16*)P + seq0 * AB_IN + 2560 + hb * 128; a.V = (const GAS bf16*)P + seq0 * AB_IN + 3072 + hb * 128; a.ldk = (long)dil * AB_IN;
            a.q0 = q0; a.L = L; a.kt0 = q0 / 64 - 1; a.nt = 6;
            a.nsl = -alibi16(4 + gi * 4 + hb) * (float)dil / att::SCALE; a.radius = 64.f; a.m_init = att::M_INIT; a.l_init = 0.f;
            a.Of = (GAS float*)OB + ((size_t)gi * M + rowq) * 512 + hb * 128; a.Ob = nullptr; a.ldo = (long)dil * 512;
            a.lse = (GAS float*)LSE + ((size_t)gi * M + rowq) * 4 + hb; a.ldl = (long)dil * 4;
        }
        att::attn_unit<true, 1>(a, F.ldsg + RING_OFF);
    }
}
__device__ __forceinline__ void phase_cnorm(Frame& F) {
    PHASE_IDS();
    const bf16* P = (const bf16*)(F.ws + WS_PROJ); float* NRM = (float*)(F.ws + WS_NRM);
    for (int it = gw; it < 2048; it += F.NGW) {
        const int tile = it & 63, j = (it >> 6) & 1, h = (it >> 7) & 7, b = (it >> 10) & 1;
        const bf16* base = P + ((size_t)b * SEQ + 64 * tile + (lane >> 4)) * C_IN + h * 256 + j * 128 + (lane & 15) * 8;
        float mq = 0.f, mk = 0.f, ms = 3.0e38f;
#pragma unroll 4
        for (int i = 0; i < 16; ++i) {
            const v4u wq = *(const v4u*)(base + (size_t)(4 * i) * C_IN), wk = *(const v4u*)(base + (size_t)(4 * i) * C_IN + 2048);
            float sq = 0.f, sk = 0.f, dt = 0.f;
#pragma unroll
            for (int q = 0; q < 4; ++q) { const float a = bf_lo(wq[q]), c = bf_hi(wq[q]), e = bf_lo(wk[q]), g = bf_hi(wk[q]); sq += a * a + c * c; sk += e * e + g * g; dt += a * e + c * g; }
#pragma unroll
            for (int o = 1; o < 16; o <<= 1) { sq += __shfl_xor(sq, o); sk += __shfl_xor(sk, o); dt += __shfl_xor(dt, o); }
            mq = fmaxf(mq, sq); mk = fmaxf(mk, sk); ms = fminf(ms, dt);
        }
        mq = fmaxf(mq, __shfl_xor(mq, 16)); mq = fmaxf(mq, __shfl_xor(mq, 32)); mk = fmaxf(mk, __shfl_xor(mk, 16)); mk = fmaxf(mk, __shfl_xor(mk, 32));
        ms = fminf(ms, __shfl_xor(ms, 16)); ms = fminf(ms, __shfl_xor(ms, 32));
        if (lane == 0) { NRM[it] = sqrtf(mq); NRM[2048 + it] = sqrtf(mk); NRM[4096 + it] = att::SCALE * ms; }
    }
}
__device__ __forceinline__ void phase_attn_c(Frame& F, gu32* ctr) {
    PHASE_IDS();
    const bf16* P = (const bf16*)(F.ws + WS_PROJ); float* AT = (float*)(F.ws + WS_ATT); const float* NRM = (const float*)(F.ws + WS_NRM);
    volatile LAS unsigned* slot = (volatile LAS unsigned*)(F.lds + MISC_OFF) + 16;
    for (;;) {
        if (tid == 0) *slot = __hip_atomic_fetch_add(ctr, 1u, __ATOMIC_RELAXED, __HIP_MEMORY_SCOPE_AGENT);
        __syncthreads();
        const int i = __builtin_amdgcn_readfirstlane((int)*slot);
        __syncthreads();
        if (i >= 1024) break;
        const int h = 7 - (i >> 7), qb = i & 15, vh = (i >> 4) & 1, j = (i >> 5) & 1, b = (i >> 6) & 1, q0 = qb * 256; const size_t row0 = (size_t)b * SEQ;
        const float slope = exp2f(-(float)(h + 1));
        const float* QN = NRM + ((b * 8 + h) * 2 + j) * 64; const float* KN = QN + 2048;
        const float* SS = QN + 4096;
        const float qn = fmaxf(fmaxf(QN[4 * qb], QN[4 * qb + 1]), fmaxf(QN[4 * qb + 2], QN[4 * qb + 3]));
        const float smin = fminf(fminf(SS[4 * qb], SS[4 * qb + 1]), fminf(SS[4 * qb + 2], SS[4 * qb + 3])) - 0.05f;
        const int klo = 64 * lane, d1 = klo - (q0 + 255), d2 = q0 - (klo + 63), dmin = d1 > 0 ? d1 : (d2 > 0 ? d2 : 0);
        const float bound = att::SCALE * 1.02f * qn * KN[lane] - slope * (float)dmin;
        const unsigned long long need = __ballot((bound - smin > -25.f) || (dmin == 0));
        int t_lo = (int)__builtin_ctzll(need), t_hi = 64 - (int)__builtin_clzll(need);
        if ((t_hi - t_lo) & 1) { if (t_lo > 0) --t_lo; else ++t_hi; }
        att::UnitArgs a;
        a.Q = (const GAS bf16*)P + (row0 + q0) * C_IN + h * 256 + j * 128; a.ldq = C_IN;
        a.K = (const GAS bf16*)P + row0 * C_IN + 2048 + h * 256 + j * 128; a.V = (const GAS bf16*)P + row0 * C_IN + 4096 + h * 256 + vh * 128; a.ldk = C_IN;
        a.q0 = q0; a.L = SEQ; a.kt0 = t_lo; a.nt = t_hi - t_lo;
        a.nsl = -slope / att::SCALE; a.radius = 0.f; a.m_init = att::M_INIT; a.l_init = 0.f;
        a.Of = (GAS float*)AT + ((size_t)j * M + row0 + q0) * DM + h * 256 + vh * 128; a.Ob = nullptr; a.ldo = DM; a.lse = nullptr; a.ldl = 0;
        att::attn_unit<false, 2>(a, F.ldsg + RING_OFF);
    }
}

#ifndef ENC_DUP
#define ENC_DUP 0
#endif
#define DUP(bit) for (int rep_ = 0; rep_ < (((ENC_DUP) & (bit)) ? 2 : 1); ++rep_)
constexpr int CW_QUEUE = 8192;
struct Args { const float* in[16]; float* out; unsigned char* ws; };
__global__ void __launch_bounds__(NWAVES * 64, 2) enc_fwd(Args args) {
    extern __shared__ __attribute__((aligned(16))) unsigned char lds[];
    Frame F;
    F.lds = (LAS unsigned char*)lds; F.ldsg = (char*)lds;
    F.tid = threadIdx.x; F.lane = F.tid & 63; F.wave = __builtin_amdgcn_readfirstlane(F.tid >> 6);
    F.G = gridDim.x; F.gw = blockIdx.x * NWAVES + F.wave; F.NGW = F.G * NWAVES;
    F.x = args.in[0]; F.c = args.in[1]; F.ada_w = args.in[2]; F.ada_b = args.in[3]; F.norm_g = args.in[4]; F.ab_w_in = args.in[5]; F.ab_w_out = args.in[6]; F.a_sink = args.in[7];
    F.c_w_in = args.in[8]; F.c_w_out = args.in[9]; F.c_lambda = args.in[10]; F.c_subln_g = args.in[11]; F.w_up = args.in[12]; F.conv_w = args.in[13]; F.conv_b = args.in[14]; F.w_down = args.in[15];
    F.out = args.out; F.ws = args.ws;
    gu32* ctl = (gu32*)(F.ws + WS_CTL);
    for (int u = F.tid; u < (LDS_BYTES - LDSCTL_OFF) / 4; u += NWAVES * 64) ((LAS unsigned*)(F.lds + LDSCTL_OFF))[u] = 0u;
    __syncthreads();
    (void)xcd_barrier_post((unsigned*)(ctl + CW_BAR), (volatile LAS unsigned*)(F.lds + MISC_OFF) + 8);
#define GB() do { unsigned char* wsb_ = args.ws; asm volatile("" : "+s"(wsb_)); XcdBarrier bar_; bar_.bar = (unsigned*)(wsb_ + WS_CTL) + CW_BAR; bar_.x = xb_xcc_id(); \
        bar_.st = (volatile LAS unsigned*)(F.lds + MISC_OFF) + 8; xcd_barrier(bar_); } while (0)
    float* mod = (float*)(F.ws + WS_MOD);
    bf16* H = (bf16*)(F.ws + WS_H); bf16* PROJ = (bf16*)(F.ws + WS_PROJ); bf16* O = (bf16*)(F.ws + WS_O); bf16* Y = (bf16*)(F.ws + WS_Y);
    bf16* GU = (bf16*)(F.ws + WS_GU); bf16* ACT = (bf16*)(F.ws + WS_ACT); float* AT = (float*)(F.ws + WS_ATT);

    DUP(1) p0a_prologue(F);
    GB();
    p0b_modreduce(F);
    GB();
    rows_pre(F, F.x, F.norm_g, mod + 1 * DM, mod + 0 * DM, H);
    GB();

    for (int s = 0; s < 8; ++s) {
        const int l = s >> 1, sub = s & 1, jl = l >> 1, even = !(l & 1);
        const float* modl = mod + (size_t)l * BATCH * MODW;
        {
            pg8::Gemm g; bf16* dst; int N;
            if (sub == 0) { if (even) { N = AB_IN; g.Bt = (const bf16*)(F.ws + WS_WABIN) + (size_t)jl * AB_IN * DM; } else { N = C_IN; g.Bt = (const bf16*)(F.ws + WS_WCIN) + (size_t)jl * C_IN * DM; } dst = PROJ; }
            else { N = UPW; g.Bt = (const bf16*)(F.ws + WS_WUP) + (size_t)l * UPW * DM; dst = GU; }
            g.A = H; g.M = M; g.N = N; g.K = DM;
            pg8::StaticOrder S; S.init(M, N, F.G, (int)blockIdx.x);
            pg8::EpiBf16<0> E{dst, N, nullptr, 0, 0, 1.f};
            DUP(4) pg8::gemm_phase<pg8::EpiBf16<0>, pg8::StaticOrder, true, true>(F.lds + RING_OFF, g, S, E);
        }
        GB();
        if (sub == 0) {
            if (even) { DUP(16) phase_attn_ab(F, jl); GB(); rows_bmerge(F, AT, (const float*)(F.ws + WS_LSE), O); }
            else { phase_cnorm(F); GB(); phase_attn_c(F, ctl + CW_QUEUE + 64 * jl); GB();
                rows_subln(F, AT, AT + (size_t)M * DM, F.c_lambda + (size_t)jl * 4 * 128, F.c_subln_g + (size_t)jl * 256, 0.8f - 0.6f * __expf(-0.3f * (float)l), O); }
        } else phase_act(F, GU, F.conv_w + (size_t)l * 3 * DFF, F.conv_b + (size_t)l * DFF, ACT);
        GB();
        {
            pg8::Gemm g; int K;
            if (sub == 0) { if (even) { K = AB_OUT; g.Bt = (const bf16*)(F.ws + WS_WABOUT) + (size_t)jl * DM * AB_OUT; } else { K = DM; g.Bt = (const bf16*)(F.ws + WS_WCOUT) + (size_t)jl * DM * DM; } g.A = O; }
            else { K = DFF; g.Bt = (const bf16*)(F.ws + WS_WDOWN) + (size_t)l * DM * DFF; g.A = ACT; }
            g.M = M; g.N = DM; g.K = K;
            pg8::StaticOrder S; S.init(M, DM, F.G, (int)blockIdx.x);
            pg8::EpiBf16<0> E{Y, DM, nullptr, 0, 0, 1.f};
            DUP(8) pg8::gemm_phase<pg8::EpiBf16<0>, pg8::StaticOrder, false, true>(F.lds + RING_OFF, g, S, E);
        }
        GB();
        {
            const float* xs = (s == 0) ? F.x : F.out;
            if (sub == 0) rows_post(F, Y, xs, F.out, modl + 2 * DM, F.norm_g + ((size_t)l * 4 + 1) * DM, F.norm_g + ((size_t)l * 4 + 2) * DM, modl + 4 * DM, modl + 3 * DM, H, true);
            else { const int ln = l + 1 < DEPTH ? l + 1 : l; const float* modn = mod + (size_t)ln * BATCH * MODW;
                rows_post(F, Y, xs, F.out, modl + 5 * DM, F.norm_g + ((size_t)l * 4 + 3) * DM, F.norm_g + ((size_t)ln * 4 + 0) * DM, modn + 1 * DM, modn + 0 * DM, H, l + 1 < DEPTH); }
        }
        if (s < 7) GB();
    }
#undef GB
}

extern "C" void kernel_launch(void* const* d_in, const int* in_sizes, int n_in, void* d_out, int out_size, void* d_ws, size_t ws_size, hipStream_t stream) {
    static int grid = 0;
    if (grid == 0) {
        if (n_in != 16 || in_sizes[0] != M * DM || out_size != M * DM || ws_size < WS_END) { fprintf(stderr, "kernel_launch: unexpected shapes (n_in %d, in0 %d, out %d, ws %zu < %zu)\n", n_in, n_in > 0 ? in_sizes[0] : -1, out_size, ws_size, (size_t)WS_END); grid = -1; return; }
        int dev = 0, cus = 0, per_cu = 0;
        if (hipGetDevice(&dev) != hipSuccess || hipDeviceGetAttribute(&cus, hipDeviceAttributeMultiprocessorCount, dev) != hipSuccess) { grid = -1; return; }
        if (hipFuncSetAttribute((const void*)enc_fwd, hipFuncAttributeMaxDynamicSharedMemorySize, LDS_BYTES) != hipSuccess) { fprintf(stderr, "kernel_launch: hipFuncSetAttribute failed\n"); grid = -1; return; }
        if (hipOccupancyMaxActiveBlocksPerMultiprocessor(&per_cu, (const void*)enc_fwd, NWAVES * 64, LDS_BYTES) != hipSuccess || per_cu < 1) { fprintf(stderr, "kernel_launch: occupancy query says %d\n", per_cu); }
        (void)hipGetLastError();
        grid = cus;
    }
    if (grid < 0) return;
    (void)hipMemsetAsync((char*)d_ws + WS_CTL, 0, CTL_ZERO_BYTES, stream);
    Args a{};
    for (int i = 0; i < 16; ++i) a.in[i] = (const float*)d_in[i];
    a.out = (float*)d_out; a.ws = (unsigned char*)d_ws;
    hipLaunchKernelGGL(enc_fwd, dim3(grid), dim3(NWAVES * 64), LDS_BYTES, stream, a);
}
```

```cpp
#include <hip/hip_runtime.h>
#include <cstdio>
#include <cstdint>
namespace pg8 {
#define PG8_LAS __attribute__((address_space(3)))
typedef unsigned short bf16_t;
typedef short bf16x8 __attribute__((ext_vector_type(8)));
typedef float f32x4 __attribute__((ext_vector_type(4)));
typedef unsigned u32x4 __attribute__((ext_vector_type(4)));
constexpr int BM = 256, BK = 64, HALF = 128, HTB = HALF * BK * 2  , STAGE_BYTES = 8 * HTB, NXCD = 8, WGM = 8;

__host__ __device__ __forceinline__ int lds_byte(int r, int c) { const int st = (r >> 4) * 2 + (c >> 5), rr = r & 15, cc = c & 31, ob = rr * 64 + cc * 2; return st * 1024 + (ob ^ (((ob >> 9) & 1) << 5)); }
__host__ __device__ __forceinline__ void stage_rc(int b, int& R, int& C) { const int st = b / 1024, sb = b % 1024, swz = sb ^ (((sb >> 9) & 1) << 5); R = (st >> 1) * 16 + swz / 64; C = (st & 1) * 32 + (swz % 64) / 2; }
__host__ __device__ __forceinline__ int perm32(int rho) { const int n = rho >> 4, i = rho & 15; return 8 * (i >> 2) + 4 * n + (i & 3); }

struct Unit { int pm, pn; };
struct Gemm { const bf16_t* A; const bf16_t* Bt; int M, N, K; };

struct StaticOrder {
    int nM, nN, nwg, G, c;
    __host__ __device__ void init(int M, int N, int G_, int c_) { nM = M / BM; nN = N / BM; nwg = nM * nN; G = G_; c = c_; }
    __host__ __device__ bool next(int i, Unit& u) const {
        const long L = (long)i * G + c; if (L >= nwg) return false;
        int wgid = (int)L; { const int q = nwg / NXCD, r = nwg % NXCD, xcd = wgid % NXCD, off = wgid / NXCD; wgid = (xcd < r ? xcd * (q + 1) : r * (q + 1) + (xcd - r) * q) + off; }
        const int nig = WGM * nN, gid = wgid / nig, fm = gid * WGM, gsz = (nM - fm) < WGM ? (nM - fm) : WGM;
        u.pm = fm + ((wgid % nig) % gsz); u.pn = (wgid % nig) / gsz; return true;
    }
    __device__ __forceinline__ void a_ready(const Unit&) const {}
    __device__ __forceinline__ void done(const Unit&) const {}
};

__device__ __forceinline__ unsigned cvt_pk_bf16(float lo, float hi) { unsigned r; asm volatile("v_cvt_pk_bf16_f32 %0, %1, %2" : "=v"(r) : "v"(lo), "v"(hi)); return r; }
typedef float f32x2 __attribute__((ext_vector_type(2)));
__device__ __forceinline__ f32x2 gelu_pk(f32x2 v) {
    const f32x2 av = __builtin_elementwise_abs(v), d = av * 0.2316418882f + 1.0f;
    f32x2 t; t.x = __builtin_amdgcn_rcpf(d.x); t.y = __builtin_amdgcn_rcpf(d.y);
    f32x2 q = t * 0.5307027145f + (-0.7265760135f); q = q * t + 0.7107068705f; q = q * t + (-0.142248368f); q = q * t + 0.127414796f; q = q * t;
    const f32x2 s = (v * v) * (-0.72134752044f);
    f32x2 e; e.x = __builtin_amdgcn_exp2f(s.x); e.y = __builtin_amdgcn_exp2f(s.y);
    const f32x2 m = v * (q * e), r = v - m;
    f32x2 o; o.x = v.x < 0.f ? m.x : r.x; o.y = v.y < 0.f ? m.y : r.y; return o;
}

template <int ACT  > struct EpiBf16 {
    static constexpr bool PERM = true, AFTER_DRAIN = false; static_assert(ACT == 0 || ACT == 1, "EpiBf16: ACT is 0 (none) or 1 (gelu_pk)");
    bf16_t* O; int ldc; const float* bias; int split_cols; size_t split_stride; float scale0;
    __device__ __forceinline__ void operator()(const f32x4 (&acc)[2][2][4][2], const Unit& u, int wr, int wc, int fr, int fq) const {
        const int row0 = u.pm * BM + wr * 64 + fr; int colt = u.pn * BM; bf16_t* base = O;
        float sc = 1.f; if (split_cols) { const int t = colt / split_cols; base += (size_t)t * split_stride; colt -= t * split_cols; if (t == 0) sc = scale0; }
        const int col0 = colt + wc * 32 + 8 * fq, bcol0 = u.pn * BM + wc * 32 + 8 * fq;
        f32x4 bv[2][2];
#pragma unroll
        for (int bj = 0; bj < 2; ++bj)
#pragma unroll
            for (int n = 0; n < 2; ++n) bv[bj][n] = bias ? *(const f32x4*)(bias + bcol0 + bj * HALF + 4 * n) : (f32x4){0.f, 0.f, 0.f, 0.f};
#pragma unroll
        for (int ai = 0; ai < 2; ++ai)
#pragma unroll
            for (int m = 0; m < 4; ++m) { bf16_t* rowp = base + (size_t)(row0 + ai * HALF + m * 16) * ldc + col0;
#pragma unroll
                for (int bj = 0; bj < 2; ++bj) { f32x4 v0 = acc[ai][bj][m][0] + bv[bj][0], v1 = acc[ai][bj][m][1] + bv[bj][1];
                    if (ACT == 1) { f32x2 a = gelu_pk((f32x2){v0[0], v0[1]}), b = gelu_pk((f32x2){v0[2], v0[3]}), c = gelu_pk((f32x2){v1[0], v1[1]}), d = gelu_pk((f32x2){v1[2], v1[3]});
                        v0 = (f32x4){a.x, a.y, b.x, b.y}; v1 = (f32x4){c.x, c.y, d.x, d.y}; }
                    v0 = v0 * sc; v1 = v1 * sc; u32x4 w; w.x = cvt_pk_bf16(v0[0], v0[1]); w.y = cvt_pk_bf16(v0[2], v0[3]); w.z = cvt_pk_bf16(v1[0], v1[1]); w.w = cvt_pk_bf16(v1[2], v1[3]);
                    *(u32x4*)(rowp + bj * HALF) = w; } }
    }
};
struct EpiF32 {
    static constexpr bool PERM = false, AFTER_DRAIN = false;
    float* C; int ldc; const float* bias;
    __device__ __forceinline__ void operator()(const f32x4 (&acc)[2][2][4][2], const Unit& u, int wr, int wc, int fr, int fq) const {
        const int row0 = u.pm * BM + wr * 64 + fr, col0 = u.pn * BM + wc * 32 + 4 * fq;
        f32x4 bv[2][2];
#pragma unroll
        for (int bj = 0; bj < 2; ++bj)
#pragma unroll
            for (int n = 0; n < 2; ++n) bv[bj][n] = bias ? *(const f32x4*)(bias + col0 + bj * HALF + n * 16) : (f32x4){0.f, 0.f, 0.f, 0.f};
#pragma unroll
        for (int ai = 0; ai < 2; ++ai)
#pragma unroll
            for (int m = 0; m < 4; ++m) { float* rowp = C + (size_t)(row0 + ai * HALF + m * 16) * ldc + col0;
#pragma unroll
                for (int bj = 0; bj < 2; ++bj)
#pragma unroll
                    for (int n = 0; n < 2; ++n) *(f32x4*)(rowp + bj * HALF + n * 16) = acc[ai][bj][m][n] + bv[bj][n]; }
    }
};

template <int CTRL> __device__ __forceinline__ float dpp_mov(float x) { return __builtin_bit_cast(float, __builtin_amdgcn_mov_dpp(__builtin_bit_cast(int, x), CTRL, 0xf, 0xf, true)); }
template <int CTRL> __device__ __forceinline__ float dpp_upd(float old, float x) { return __builtin_bit_cast(float, __builtin_amdgcn_update_dpp(__builtin_bit_cast(int, old), __builtin_bit_cast(int, x), CTRL, 0xf, 0xf, false)); }
__device__ __forceinline__ float gelu_tanh_mul(float v, float up) {
    const float e = __builtin_amdgcn_exp2f(v * fmaf(v * v, -0.10294324f, -2.3022082f));
    return v * up * __builtin_amdgcn_rcpf(1.f + e);
}
struct EpiAct {
    static constexpr bool PERM = true, AFTER_DRAIN = false;
    bf16_t* ACT; int dff; const float* cw; const float* cb; float* HG; float* HU; PG8_LAS float* bnd;
    __device__ __forceinline__ void operator()(const f32x4 (&acc)[2][2][4][2], const Unit& u, int wr, int wc, int fr, int fq) const {
        const int chl = wc * 32 + 8 * fq, ch = u.pn * 128 + chl;
        if (fr == 0) {
#pragma unroll
            for (int ai = 0; ai < 2; ++ai) { PG8_LAS float* p = bnd + ((2 * ai + wr) * 2 + 0) * 128 + chl; *(PG8_LAS f32x4*)p = acc[ai][0][0][0]; *(PG8_LAS f32x4*)(p + 4) = acc[ai][0][0][1]; } }
        if (fr == 15) {
#pragma unroll
            for (int ai = 0; ai < 2; ++ai) { PG8_LAS float* p = bnd + ((2 * ai + wr) * 2 + 1) * 128 + chl; *(PG8_LAS f32x4*)p = acc[ai][0][3][0]; *(PG8_LAS f32x4*)(p + 4) = acc[ai][0][3][1]; } }
        if (wr == 0 && fr <= 1) { float* p = HG + ((size_t)u.pm * 4 + fr) * dff + ch; *(f32x4*)p = acc[0][0][0][0]; *(f32x4*)(p + 4) = acc[0][0][0][1];
            if (fr == 0) { float* q = HU + ((size_t)u.pm * 2 + 0) * dff + ch; *(f32x4*)q = acc[0][1][0][0]; *(f32x4*)(q + 4) = acc[0][1][0][1]; } }
        if (wr == 1 && fr >= 14) { float* p = HG + ((size_t)u.pm * 4 + 2 + (fr - 14)) * dff + ch; *(f32x4*)p = acc[1][0][3][0]; *(f32x4*)(p + 4) = acc[1][0][3][1];
            if (fr == 15) { float* q = HU + ((size_t)u.pm * 2 + 1) * dff + ch; *(f32x4*)q = acc[1][1][3][0]; *(f32x4*)(q + 4) = acc[1][1][3][1]; } }
        f32x4 w0[2], w1[2], w2[2], bb[2];
#pragma unroll
        for (int n = 0; n < 2; ++n) { w0[n] = *(const f32x4*)(cw + ch + 4 * n); w1[n] = *(const f32x4*)(cw + dff + ch + 4 * n); w2[n] = *(const f32x4*)(cw + 2 * dff + ch + 4 * n); bb[n] = *(const f32x4*)(cb + ch + 4 * n); }
        asm volatile("s_waitcnt lgkmcnt(0)" ::: "memory"); __builtin_amdgcn_s_barrier(); asm volatile("" ::: "memory");
        f32x4 bp[2][2], bn[2][2];
#pragma unroll
        for (int ai = 0; ai < 2; ++ai) { const int c = 2 * ai + wr;
#pragma unroll
            for (int n = 0; n < 2; ++n) {
                bp[ai][n] = c > 0 ? *(const PG8_LAS f32x4*)(bnd + ((c - 1) * 2 + 1) * 128 + chl + 4 * n) : (f32x4){0.f, 0.f, 0.f, 0.f};
                bn[ai][n] = c < 3 ? *(const PG8_LAS f32x4*)(bnd + ((c + 1) * 2 + 0) * 128 + chl + 4 * n) : (f32x4){0.f, 0.f, 0.f, 0.f}; } }
        const int row0 = u.pm * BM + wr * 64 + fr;
#pragma unroll
        for (int ai = 0; ai < 2; ++ai)
#pragma unroll
            for (int m = 0; m < 4; ++m) {
                unsigned pk[4];
#pragma unroll
                for (int n = 0; n < 2; ++n) { float r[4];
#pragma unroll
                    for (int i = 0; i < 4; ++i) {
                        const float g = acc[ai][0][m][n][i];
                        const float oldp = (m == 0) ? bp[ai][n][i] : dpp_mov<0x121>(acc[ai][0][m == 0 ? 0 : m - 1][n][i]);
                        const float gp = dpp_upd<0x111>(oldp, g);
                        const float oldn = (m == 3) ? bn[ai][n][i] : dpp_mov<0x12F>(acc[ai][0][m == 3 ? 3 : m + 1][n][i]);
                        const float gn = dpp_upd<0x101>(oldn, g);
                        const float a = fmaf(w0[n][i], gp, fmaf(w1[n][i], g, fmaf(w2[n][i], gn, bb[n][i])));
                        r[i] = gelu_tanh_mul(a, acc[ai][1][m][n][i]);
                    }
                    pk[2 * n] = cvt_pk_bf16(r[0], r[1]); pk[2 * n + 1] = cvt_pk_bf16(r[2], r[3]); }
                u32x4 w; w.x = pk[0]; w.y = pk[1]; w.z = pk[2]; w.w = pk[3];
                *(u32x4*)(ACT + (size_t)(row0 + ai * HALF + m * 16) * dff + ch) = w;
            }
    }
};
template <class Epi, class Sched, bool ALIGN_EPI = false, bool SP2 = false>
__device__ __forceinline__ void gemm_phase(PG8_LAS unsigned char* lds, const Gemm g, const Sched& S, const Epi& E) {
    int tid_ = threadIdx.x; asm volatile("" : "+v"(tid_));
    const int tid = tid_, wid = __builtin_amdgcn_readfirstlane(tid >> 6), lane = tid & 63, wr = wid >> 2, wc = wid & 3, fr = lane & 15, fq = lane >> 4;
    const int K = g.K, nt = K / BK;
    unsigned voffA[2], voffB[2];
#pragma unroll
    for (int i = 0; i < 2; ++i) { int R, C; stage_rc(tid * 16 + i * 8192, R, C); const int Rb = Epi::PERM ? ((R & ~31) + perm32(R & 31)) : R;
        voffA[i] = (unsigned)(R * K + C) * 2u; voffB[i] = (unsigned)(Rb * K + C) * 2u; }
    const size_t kstep = (size_t)(BK * 2);
    const size_t hstep = (size_t)HALF * K * 2;
    const size_t tstep = 2 * hstep;
    const unsigned ldsw = (unsigned)wid * 1024u;
    const int aoff = lds_byte(wr * 64 + fr, fq * 8), boff = lds_byte(wc * 32 + fr, fq * 8);
#define PG8_SA(b, h) (((b) * 2 + (h)) * HTB)
#define PG8_SB(b, h) ((4 + (b) * 2 + (h)) * HTB)
#define PG8_STAGE(bufoff, gbase, voff) do { _Pragma("unroll") for (int _i = 0; _i < 2; ++_i) \
        __builtin_amdgcn_global_load_lds((const unsigned*)((const char*)(gbase) + (voff)[_i]), (PG8_LAS unsigned*)(lds + (bufoff) + ldsw + _i * 8192), 16, 0, 0); } while (0)
#define PG8_LDA(dst, b, h) do { _Pragma("unroll") for (int m = 0; m < 4; ++m) _Pragma("unroll") for (int k = 0; k < 2; ++k) dst[m][k] = *(const PG8_LAS bf16x8*)(lds + PG8_SA(b, h) + aoff + m * 2048 + k * 1024); } while (0)
#define PG8_LDB(dst, b, h) do { _Pragma("unroll") for (int n = 0; n < 2; ++n) _Pragma("unroll") for (int k = 0; k < 2; ++k) dst[n][k] = *(const PG8_LAS bf16x8*)(lds + PG8_SB(b, h) + boff + n * 2048 + k * 1024); } while (0)
#define PG8_MMA(ai, bj, At, Bt) do { __builtin_amdgcn_s_setprio(1); _Pragma("unroll") for (int m = 0; m < 4; ++m) _Pragma("unroll") for (int n = 0; n < 2; ++n) _Pragma("unroll") for (int k = 0; k < 2; ++k) \
        acc[ai][bj][m][n] = __builtin_amdgcn_mfma_f32_16x16x32_bf16(Bt[n][k], At[m][k], acc[ai][bj][m][n], 0, 0, 0); __builtin_amdgcn_s_setprio(0); } while (0)
#define PG8_WAIT_V(n) asm volatile("s_waitcnt vmcnt(" #n ")" ::: "memory")
#define PG8_WAIT_L(n) asm volatile("s_waitcnt lgkmcnt(" #n ")" ::: "memory")
#define PG8_BAR __builtin_amdgcn_s_barrier()
#define PG8_SCHED __builtin_amdgcn_sched_barrier(0)
    Unit cur, nxt; int ui = 0;
    if (!S.next(0, cur)) return;
    f32x4 acc[2][2][4][2];
#pragma unroll
    for (int a = 0; a < 2; ++a)
#pragma unroll
        for (int b = 0; b < 2; ++b)
#pragma unroll
            for (int m = 0; m < 4; ++m)
#pragma unroll
                for (int n = 0; n < 2; ++n) acc[a][b][m][n] = (f32x4){0.f, 0.f, 0.f, 0.f};
    bf16x8 At[4][2], B0[2][2], B1[2][2];
    const char* cA = (const char*)g.A + (size_t)cur.pm * tstep; const char* cB = (const char*)g.Bt + (size_t)cur.pn * tstep;
    S.a_ready(cur);
    if constexpr (SP2) {
        PG8_STAGE(PG8_SB(0, 0), cB, voffB); PG8_STAGE(PG8_SB(0, 1), cB + hstep, voffB); PG8_STAGE(PG8_SA(0, 0), cA, voffA); PG8_STAGE(PG8_SA(0, 1), cA + hstep, voffA);
        if (wr == 1) PG8_BAR;
        PG8_WAIT_V(2); PG8_BAR;
        PG8_STAGE(PG8_SB(1, 0), cB + kstep, voffB); PG8_STAGE(PG8_SA(1, 0), cA + kstep, voffA); PG8_STAGE(PG8_SB(1, 1), cB + hstep + kstep, voffB);
        PG8_WAIT_V(6); PG8_BAR;
    } else {
        PG8_STAGE(PG8_SB(0, 0), cB, voffB); PG8_STAGE(PG8_SA(0, 0), cA, voffA); PG8_STAGE(PG8_SB(0, 1), cB + hstep, voffB); PG8_STAGE(PG8_SA(0, 1), cA + hstep, voffA);
        if (wr == 1) PG8_BAR;
        PG8_WAIT_V(4); PG8_BAR;
        PG8_STAGE(PG8_SB(1, 0), cB + kstep, voffB); PG8_STAGE(PG8_SA(1, 0), cA + kstep, voffA); PG8_STAGE(PG8_SB(1, 1), cB + hstep + kstep, voffB);
        PG8_WAIT_V(6); PG8_BAR;
    }
    for (;;) {
        const bool has_next = S.next(ui + 1, nxt);
        const char* nA = has_next ? (const char*)g.A + (size_t)nxt.pm * tstep : cA; const char* nB = has_next ? (const char*)g.Bt + (size_t)nxt.pn * tstep : cB;
        for (int t = 0; t < nt; t += 2) {
            const bool last = (t == nt - 2);
            const char* a1 = cA + (size_t)(t + 1) * kstep;
            const char* a2 = last ? nA : cA + (size_t)(t + 2) * kstep; const char* b2 = last ? nB : cB + (size_t)(t + 2) * kstep;
            const char* a3 = a2 + kstep; const char* b3 = b2 + kstep;
            if (last && has_next) S.a_ready(nxt);
            if constexpr (SP2) {
            PG8_LDB(B0, 0, 0); PG8_LDB(B1, 0, 1); PG8_SCHED; PG8_LDA(At, 0, 0); PG8_STAGE(PG8_SA(1, 1), a1 + hstep, voffA);
            PG8_WAIT_V(8); PG8_WAIT_L(0); PG8_BAR; PG8_MMA(0, 0, At, B0); PG8_MMA(0, 1, At, B1); PG8_BAR; PG8_SCHED;
            PG8_LDA(At, 0, 1); PG8_STAGE(PG8_SB(0, 0), b2, voffB); PG8_STAGE(PG8_SB(0, 1), b2 + hstep, voffB); PG8_STAGE(PG8_SA(0, 0), a2, voffA);
            PG8_WAIT_V(8); PG8_WAIT_L(0); PG8_BAR; PG8_MMA(1, 0, At, B0); PG8_MMA(1, 1, At, B1); PG8_BAR; PG8_SCHED;
            PG8_LDB(B0, 1, 0); PG8_LDB(B1, 1, 1); PG8_SCHED; PG8_LDA(At, 1, 0); PG8_STAGE(PG8_SA(0, 1), a2 + hstep, voffA);
            PG8_WAIT_V(8); PG8_WAIT_L(0); PG8_BAR; PG8_MMA(0, 0, At, B0); PG8_MMA(0, 1, At, B1); PG8_BAR; PG8_SCHED;
            PG8_LDA(At, 1, 1); PG8_STAGE(PG8_SB(1, 0), b3, voffB); PG8_STAGE(PG8_SB(1, 1), b3 + hstep, voffB); PG8_STAGE(PG8_SA(1, 0), a3, voffA);
            PG8_WAIT_V(8); PG8_WAIT_L(0); PG8_BAR; PG8_MMA(1, 0, At, B0); PG8_MMA(1, 1, At, B1); PG8_BAR; PG8_SCHED;
            } else {
            PG8_LDB(B0, 0, 0); PG8_SCHED; PG8_LDA(At, 0, 0); PG8_STAGE(PG8_SA(1, 1), a1 + hstep, voffA);
            PG8_WAIT_L(8); PG8_BAR; PG8_WAIT_L(0); PG8_MMA(0, 0, At, B0); PG8_BAR; PG8_SCHED;
            PG8_LDB(B1, 0, 1); PG8_STAGE(PG8_SB(0, 0), b2, voffB);
            PG8_BAR; PG8_WAIT_L(0); PG8_MMA(0, 1, At, B1); PG8_BAR;
            PG8_LDA(At, 0, 1); PG8_STAGE(PG8_SA(0, 0), a2, voffA);
            PG8_BAR; PG8_WAIT_L(0); PG8_MMA(1, 0, At, B0); PG8_BAR; PG8_SCHED;
            PG8_STAGE(PG8_SB(0, 1), b2 + hstep, voffB);
            PG8_WAIT_V(6); PG8_BAR; PG8_MMA(1, 1, At, B1); PG8_BAR;
            PG8_LDB(B0, 1, 0); PG8_SCHED; PG8_LDA(At, 1, 0); PG8_STAGE(PG8_SA(0, 1), a2 + hstep, voffA);
            PG8_WAIT_L(8); PG8_BAR; PG8_WAIT_L(0); PG8_MMA(0, 0, At, B0); PG8_BAR; PG8_SCHED;
            PG8_LDB(B1, 1, 1); PG8_STAGE(PG8_SB(1, 0), b3, voffB);
            PG8_BAR; PG8_WAIT_L(0); PG8_MMA(0, 1, At, B1); PG8_BAR;
            PG8_LDA(At, 1, 1); PG8_STAGE(PG8_SA(1, 0), a3, voffA);
            PG8_BAR; PG8_WAIT_L(0); PG8_MMA(1, 0, At, B0); PG8_BAR; PG8_SCHED;
            PG8_STAGE(PG8_SB(1, 1), b3 + hstep, voffB);
            PG8_WAIT_V(6); PG8_BAR; PG8_MMA(1, 1, At, B1); PG8_BAR;
            }
        }
        if constexpr (ALIGN_EPI) { if (wr == 0) PG8_BAR; }
        if constexpr (!Epi::AFTER_DRAIN) { E(acc, cur, wr, wc, fr, fq); S.done(cur); }
        if (!has_next) break;
#pragma unroll
        for (int a = 0; a < 2; ++a)
#pragma unroll
            for (int b = 0; b < 2; ++b)
#pragma unroll
                for (int m = 0; m < 4; ++m)
#pragma unroll
                    for (int n = 0; n < 2; ++n) acc[a][b][m][n] = (f32x4){0.f, 0.f, 0.f, 0.f};
        cur = nxt; cA = nA; cB = nB; ++ui;
        if constexpr (ALIGN_EPI) { if (wr == 1) PG8_BAR; }
    }
    PG8_WAIT_V(0);
    if constexpr (!ALIGN_EPI) { if (wr == 0) PG8_BAR; }
    PG8_BAR;
    if constexpr (Epi::AFTER_DRAIN) { E.fused(acc, cur, wr, wc, fr, fq, lds, wid, lane); S.done(cur); }
#undef PG8_SA
#undef PG8_SB
#undef PG8_STAGE
#undef PG8_LDA
#undef PG8_LDB
#undef PG8_MMA
#undef PG8_WAIT_V
#undef PG8_WAIT_L
#undef PG8_BAR
#undef PG8_SCHED
}
}
namespace att {
typedef unsigned short bf16;
using bf16x8 = __attribute__((ext_vector_type(8))) short;
using s16x4  = __attribute__((ext_vector_type(4))) short;
using f32x16 = __attribute__((ext_vector_type(16))) float;
using u32x4  = __attribute__((ext_vector_type(4))) unsigned;
constexpr int   D = 128, NW = 8, QBLK = 32, KVBLK = 64;
constexpr float SCALE = 0.088388347648318440f;
constexpr float THR = 8.f;
constexpr int SHM_V = KVBLK * D * 2, SHM_K = KVBLK * D * 2, SHM_ATTN = 2 * SHM_V + 2 * SHM_K + NW * 64 * 4;
constexpr float MASKED = -1e30f, M_INIT = -1e28f;
#define KSWZ(row, colB) ((row) * 256 + ((colB) ^ (((row) & 7) << 4)))
#define SBAR() __builtin_amdgcn_sched_barrier(0)
__device__ __forceinline__ int crow(int r, int hi) { return (r & 3) + 8 * (r >> 2) + 4 * hi; }
__device__ __forceinline__ unsigned cvtpk(float lo, float hi) {
  unsigned r; asm volatile("v_cvt_pk_bf16_f32 %0, %1, %2" : "=v"(r) : "v"(lo), "v"(hi)); return r;
}
__device__ __forceinline__ void partialSM(f32x16& p0, f32x16& p1, float& m_reg, float& mn, float& alpha) {
  constexpr float C = SCALE * 1.4426950408889634f;
  float pmax = p0[0];
#pragma unroll
  for (int r = 1; r < 16; ++r) pmax = fmaxf(pmax, p0[r]);
#pragma unroll
  for (int r = 0; r < 16; ++r) pmax = fmaxf(pmax, p1[r]);
  { auto rr = __builtin_amdgcn_permlane32_swap(__float_as_uint(pmax), __float_as_uint(pmax), false, false);
    pmax = fmaxf(__uint_as_float(rr[0]), __uint_as_float(rr[1])); }
  if (__builtin_expect(__all(pmax - m_reg <= THR / SCALE), 1)) { mn = m_reg; alpha = 1.f; }
  else { mn = fmaxf(m_reg, pmax); alpha = __builtin_amdgcn_exp2f((m_reg - mn) * C); m_reg = mn; }
  float mnC = -mn * C;
#pragma unroll
  for (int r = 0; r < 16; ++r) p0[r] = fmaf(p0[r], C, mnC);
#pragma unroll
  for (int r = 0; r < 16; ++r) p1[r] = fmaf(p1[r], C, mnC);
#pragma unroll
  for (int r = 0; r < 16; ++r) p0[r] = __builtin_amdgcn_exp2f(p0[r]);
}
__device__ __forceinline__ void finishSM(f32x16& p0, f32x16& p1, float alpha, float& l_reg, bf16x8& pa0, bf16x8& pa1, bf16x8& pa2, bf16x8& pa3) {
#pragma unroll
  for (int r = 0; r < 16; ++r) p1[r] = __builtin_amdgcn_exp2f(p1[r]);
  float ps = 0;
#pragma unroll
  for (int r = 0; r < 16; ++r) ps += p0[r];
#pragma unroll
  for (int r = 0; r < 16; ++r) ps += p1[r];
  { auto rr = __builtin_amdgcn_permlane32_swap(__float_as_uint(ps), __float_as_uint(ps), false, false);
    ps = __uint_as_float(rr[0]) + __uint_as_float(rr[1]); }
  l_reg = l_reg * alpha + ps;
#define PK4(P, BASE, OUT) do { unsigned a0 = cvtpk(P[BASE + 0], P[BASE + 1]), a1 = cvtpk(P[BASE + 2], P[BASE + 3]);   \
    unsigned b0 = cvtpk(P[BASE + 4], P[BASE + 5]), b1 = cvtpk(P[BASE + 6], P[BASE + 7]);                              \
    auto r0 = __builtin_amdgcn_permlane32_swap(a0, b0, false, false); auto r1 = __builtin_amdgcn_permlane32_swap(a1, b1, false, false); \
    u32x4 w = {r0[0], r1[0], r0[1], r1[1]}; OUT = *reinterpret_cast<bf16x8*>(&w); } while (0)
  PK4(p0, 0, pa0); PK4(p0, 8, pa1); PK4(p1, 0, pa2); PK4(p1, 8, pa3);
#undef PK4
}
template <bool BAND>
__device__ __forceinline__ void qkt(f32x16& p0, f32x16& p1, const bf16* Ks, const bf16x8* qr, int r32, int hi, float dq, float kf0, float nsl, float radius, float Lf, int side) {
  if (!BAND && side != 0) {
    const float ns = side > 0 ? nsl : -nsl, t = ns * dq;
#pragma unroll
    for (int r = 0; r < 16; ++r) { const float c0 = (float)((r & 3) + 8 * (r >> 2)); p0[r] = fmaf(ns, -c0, t); p1[r] = fmaf(ns, -(c0 + 32.f), t); }
  } else
#pragma unroll
  for (int r = 0; r < 16; ++r) {
    const float c0 = (float)((r & 3) + 8 * (r >> 2));
    const float d0 = dq - c0, d1 = dq - (c0 + 32.f);
    float b0 = nsl * fabsf(d0), b1 = nsl * fabsf(d1);
    if (BAND) {
      const float ka = kf0 + c0, kb = kf0 + (c0 + 32.f);
      const bool v0 = (fabsf(d0) <= radius) && (ka >= 0.f) && (ka < Lf);
      const bool v1 = (fabsf(d1) <= radius) && (kb >= 0.f) && (kb < Lf);
      b0 = v0 ? b0 : MASKED; b1 = v1 ? b1 : MASKED;
    }
    p0[r] = b0; p1[r] = b1;
  }
#pragma unroll
  for (int d0 = 0; d0 < 8; ++d0) { int cb = (d0 * 16 + hi * 8) * 2;
    bf16x8 b0 = *reinterpret_cast<const bf16x8*>((const char*)Ks + KSWZ(r32, cb));
    bf16x8 b1 = *reinterpret_cast<const bf16x8*>((const char*)Ks + KSWZ(32 + r32, cb));
    p0 = __builtin_amdgcn_mfma_f32_32x32x16_bf16(b0, qr[d0], p0, 0, 0, 0);
    p1 = __builtin_amdgcn_mfma_f32_32x32x16_bf16(b1, qr[d0], p1, 0, 0, 0); }
}
__device__ __forceinline__ int v_st(int k, int c) { const int kk = (k & ~0xC) | ((k & 4) << 1) | ((k & 8) >> 1); return ((kk >> 3) * 4 + (c >> 5)) * 512 + ((kk & 7) * 32 + (c & 31)) * 2; }
__device__ __forceinline__ int v_rd_base(int lane) { return ((lane & 3) << 3) | (((lane >> 2) & 3) << 6) | (((lane >> 4) & 1) << 5) | (((lane >> 5) & 1) << 8); }
constexpr int v_rd_off(int d0, int ks, int half) { return d0 * 512 + ks * 4096 + half * 2048; }
template <int OFF> __device__ __forceinline__ s16x4 tr_read(int vb) {
  s16x4 r; asm volatile("ds_read_b64_tr_b16 %0, %1 offset:%2" : "=&v"(r) : "v"(vb), "i"(OFF) : "memory"); return r;
}
template <int D0> __device__ __forceinline__ void pv_one(f32x16& od, int vb, bf16x8 pa0, bf16x8 pa1, bf16x8 pa2, bf16x8 pa3) {
  const s16x4 l0 = tr_read<v_rd_off(D0, 0, 0)>(vb), h0 = tr_read<v_rd_off(D0, 0, 1)>(vb), l1 = tr_read<v_rd_off(D0, 1, 0)>(vb), h1 = tr_read<v_rd_off(D0, 1, 1)>(vb);
  const s16x4 l2 = tr_read<v_rd_off(D0, 2, 0)>(vb), h2 = tr_read<v_rd_off(D0, 2, 1)>(vb), l3 = tr_read<v_rd_off(D0, 3, 0)>(vb), h3 = tr_read<v_rd_off(D0, 3, 1)>(vb);
  asm volatile("s_waitcnt lgkmcnt(0)" ::: "memory"); SBAR();
#define PK(L, H) (bf16x8){L[0], L[1], L[2], L[3], H[0], H[1], H[2], H[3]}
  od = __builtin_amdgcn_mfma_f32_32x32x16_bf16(pa0, PK(l0, h0), od, 0, 0, 0);
  od = __builtin_amdgcn_mfma_f32_32x32x16_bf16(pa1, PK(l1, h1), od, 0, 0, 0);
  od = __builtin_amdgcn_mfma_f32_32x32x16_bf16(pa2, PK(l2, h2), od, 0, 0, 0);
  od = __builtin_amdgcn_mfma_f32_32x32x16_bf16(pa3, PK(l3, h3), od, 0, 0, 0);
#undef PK
}
__device__ __forceinline__ void pv_d0(f32x16* o, int vb, bf16x8 pa0, bf16x8 pa1, bf16x8 pa2, bf16x8 pa3) {
  pv_one<0>(o[0], vb, pa0, pa1, pa2, pa3); pv_one<1>(o[1], vb, pa0, pa1, pa2, pa3); pv_one<2>(o[2], vb, pa0, pa1, pa2, pa3); pv_one<3>(o[3], vb, pa0, pa1, pa2, pa3);
}

#define ATT_GAS __attribute__((address_space(1)))
struct UnitArgs {
  const ATT_GAS bf16* Q; long ldq;
  const ATT_GAS bf16* K; const ATT_GAS bf16* V; long ldk;
  int q0, L, kt0, nt;
  float nsl, radius, m_init, l_init;
  ATT_GAS float* Of; ATT_GAS bf16* Ob; long ldo;
  ATT_GAS float* lse; long ldl;
};

template <bool BAND, int SDEPTH>
__device__ __forceinline__ void attn_unit(const UnitArgs& a_in, char* lds) {
  UnitArgs a = a_in;
  asm volatile("" : "+s"(a.Q), "+s"(a.ldq), "+s"(a.K), "+s"(a.V), "+s"(a.ldk));
  asm volatile("" : "+s"(a.q0), "+s"(a.L), "+s"(a.kt0), "+s"(a.nt));
  asm volatile("" : "+s"(a.Of), "+s"(a.Ob), "+s"(a.ldo), "+s"(a.lse), "+s"(a.ldl));
  int tid_ = threadIdx.x; asm volatile("" : "+v"(tid_));
  const int tid = tid_, wid = tid >> 6, lane = tid & 63, r32 = lane & 31, hi = lane >> 5;
  bf16* V_lds = (bf16*)lds; bf16* K_lds = (bf16*)(lds + 2 * SHM_V);
  float* ws = (float*)(lds + 2 * SHM_V + 2 * SHM_K) + wid * 64; float* li_l = ws; float* al_l = ws + 32;
  float m_reg = a.m_init, l_reg = a.l_init; f32x16 o[4] = {}; bf16x8 qr[8];
  const ATT_GAS bf16* Qw = a.Q + (long)(wid * QBLK + r32) * a.ldq + hi * 8;
#pragma unroll
  for (int d0 = 0; d0 < 8; ++d0) qr[d0] = *reinterpret_cast<const ATT_GAS bf16x8*>(Qw + d0 * 16);
  const int sr = tid >> 4, sc = (tid & 15) * 8, vst0 = v_st(sr, sc), vst1 = v_st(32 + sr, sc);
  const int vb0 = (int)(uintptr_t)V_lds + v_rd_base(lane);
  const float qf = (float)(a.q0 + wid * QBLK + r32), Lf = (float)a.L, nsl = a.nsl, radius = a.radius;
  const int Lm1 = a.L - 1, kt0 = a.kt0, qw0 = a.q0 + __builtin_amdgcn_readfirstlane(wid) * QBLK;
  const ATT_GAS bf16* Kp = a.K; const ATT_GAS bf16* Vp = a.V; const long ldk = a.ldk;
  struct { bf16x8 vs0, vs1, ks0, ks1; } sr_[SDEPTH];
  const unsigned lofs = (unsigned)((sr * ldk + sc) * 2);
  const ATT_GAS char* Kc = (const ATT_GAS char*)Kp; const ATT_GAS char* Vc = (const ATT_GAS char*)Vp; const long ldk32 = 32 * ldk * 2, ldk64 = 64 * ldk * 2;
#define SLOAD(i, t) do { if constexpr (BAND) { const int k0_ = (kt0 + (t)) * KVBLK; int ra_ = k0_ + sr, rb_ = k0_ + 32 + sr;                   \
    ra_ = ra_ < 0 ? 0 : (ra_ > Lm1 ? Lm1 : ra_); rb_ = rb_ < 0 ? 0 : (rb_ > Lm1 ? Lm1 : rb_);                                          \
    sr_[i].vs0 = *reinterpret_cast<const ATT_GAS bf16x8*>(&Vp[(long)ra_ * ldk + sc]); sr_[i].vs1 = *reinterpret_cast<const ATT_GAS bf16x8*>(&Vp[(long)rb_ * ldk + sc]); \
    sr_[i].ks0 = *reinterpret_cast<const ATT_GAS bf16x8*>(&Kp[(long)ra_ * ldk + sc]); sr_[i].ks1 = *reinterpret_cast<const ATT_GAS bf16x8*>(&Kp[(long)rb_ * ldk + sc]); } \
  else { const long tb_ = (long)(kt0 + (t)) * ldk64;                                                                                       \
    sr_[i].vs0 = *reinterpret_cast<const ATT_GAS bf16x8*>(Vc + tb_ + lofs); sr_[i].vs1 = *reinterpret_cast<const ATT_GAS bf16x8*>(Vc + tb_ + ldk32 + lofs); \
    sr_[i].ks0 = *reinterpret_cast<const ATT_GAS bf16x8*>(Kc + tb_ + lofs); sr_[i].ks1 = *reinterpret_cast<const ATT_GAS bf16x8*>(Kc + tb_ + ldk32 + lofs); } } while (0)
#define SWRITE(b, i) do { *(bf16x8*)((char*)V_lds + (b) * SHM_V + vst0) = sr_[i].vs0;          \
    *(bf16x8*)((char*)V_lds + (b) * SHM_V + vst1) = sr_[i].vs1; int kc = sc * 2;               \
    *(bf16x8*)((char*)K_lds + (b) * SHM_K + KSWZ(sr, kc)) = sr_[i].ks0;                       \
    *(bf16x8*)((char*)K_lds + (b) * SHM_K + KSWZ(32 + sr, kc)) = sr_[i].ks1; } while (0)
#define SWAIT() do { if constexpr (SDEPTH == 2) asm volatile("s_waitcnt vmcnt(4)" ::: "memory"); else asm volatile("s_waitcnt vmcnt(0)" ::: "memory"); } while (0)
#define RESC(al) do { if (__any((al) < 1.f)) { if (hi == 0) al_l[r32] = (al); asm volatile("s_waitcnt lgkmcnt(0)" ::: "memory"); \
    _Pragma("unroll") for (int d = 0; d < 4; ++d) _Pragma("unroll") for (int r = 0; r < 16; ++r) o[d][r] *= al_l[crow(r, hi)]; } } while (0)
#define QKT(PA, PB, buf, t) do { const int k0_ = (kt0 + (t)) * KVBLK; const float kf0_ = (float)(k0_ + 4 * hi); \
    const int side_ = (k0_ + KVBLK - 1 < qw0) ? 1 : ((k0_ > qw0 + QBLK - 1) ? -1 : 0); \
    qkt<BAND>(PA, PB, (bf16*)((char*)K_lds + (buf) * SHM_K), qr, r32, hi, qf - kf0_, kf0_, nsl, radius, Lf, side_); } while (0)
  f32x16 pA0, pA1, pB0, pB1; float mnA, mnB, alA, alB; bf16x8 pa0, pa1, pa2, pa3; const int NT = a.nt;
  constexpr int SE = 0, SO = SDEPTH - 1;
  SLOAD(SE, 0); asm volatile("s_waitcnt vmcnt(0)" ::: "memory"); SWRITE(0, SE); __syncthreads();
  QKT(pA0, pA1, 0, 0); partialSM(pA0, pA1, m_reg, mnA, alA);
  SLOAD(SO, 1); if constexpr (SDEPTH == 2) { if (2 < NT) SLOAD(SE, 2); }
  SWAIT(); SWRITE(1, SO); __syncthreads();
  for (int j = 1; j + 1 < NT; j += 2) {
    SBAR(); QKT(pB0, pB1, 1, j);
    finishSM(pA0, pA1, alA, l_reg, pa0, pa1, pa2, pa3); SBAR();
    SLOAD(SO, j + SDEPTH); SBAR();
    pv_d0(o, vb0, pa0, pa1, pa2, pa3); partialSM(pB0, pB1, m_reg, mnB, alB);
    __syncthreads(); SWAIT(); SWRITE(0, SE);
    RESC(alB); __syncthreads();
    SBAR(); QKT(pA0, pA1, 0, j + 1);
    finishSM(pB0, pB1, alB, l_reg, pa0, pa1, pa2, pa3); SBAR();
    if (SDEPTH == 1 || j + 3 < NT) SLOAD(SE, j + 1 + SDEPTH); SBAR();
    pv_d0(o, vb0 + (int)SHM_V, pa0, pa1, pa2, pa3); partialSM(pA0, pA1, m_reg, mnA, alA);
    __syncthreads(); SWAIT(); SWRITE(1, SO);
    RESC(alA); __syncthreads();
  }
  SBAR(); QKT(pB0, pB1, 1, NT - 1);
  finishSM(pA0, pA1, alA, l_reg, pa0, pa1, pa2, pa3); SBAR();
  pv_d0(o, vb0, pa0, pa1, pa2, pa3); partialSM(pB0, pB1, m_reg, mnB, alB);
  __syncthreads(); RESC(alB);
  finishSM(pB0, pB1, alB, l_reg, pa0, pa1, pa2, pa3); SBAR();
  pv_d0(o, vb0 + (int)SHM_V, pa0, pa1, pa2, pa3);
  if (hi == 0) li_l[r32] = l_reg; asm volatile("s_waitcnt lgkmcnt(0)" ::: "memory");
  float rli[16];
#pragma unroll
  for (int r = 0; r < 16; ++r) rli[r] = __builtin_amdgcn_rcpf(li_l[crow(r, hi)]);
  if (a.Of) {
    ATT_GAS float* Ow = a.Of + (long)(wid * QBLK) * a.ldo;
#pragma unroll
    for (int r = 0; r < 16; ++r) { const int orow = crow(r, hi);
#pragma unroll
      for (int d0 = 0; d0 < 4; ++d0) Ow[(long)orow * a.ldo + d0 * 32 + r32] = o[d0][r] * rli[r]; }
  } else {
    ATT_GAS bf16* Ow = a.Ob + (long)(wid * QBLK) * a.ldo;
#pragma unroll
    for (int r = 0; r < 16; ++r) { const int orow = crow(r, hi);
#pragma unroll
      for (int d0 = 0; d0 < 4; ++d0) { const float v = o[d0][r] * rli[r]; Ow[(long)orow * a.ldo + d0 * 32 + r32] = (bf16)(cvtpk(v, v) & 0xffffu); } }
  }
  if (a.lse && hi == 0) a.lse[(long)(wid * QBLK + r32) * a.ldl] = m_reg * SCALE + __logf(l_reg);
  __syncthreads();
#undef SLOAD
#undef SWRITE
#undef SWAIT
#undef RESC
#undef QKT
}
#undef KSWZ
#undef SBAR
}
constexpr int DM = 2048, BATCH = 2, SEQ = 4096, DEPTH = 4, M = BATCH * SEQ;
constexpr int AB_IN = 3584, AB_OUT = 1024, C_IN = 6144, DFF = 5504, UPW = 2 * DFF, MODW = 6 * DM;
constexpr float EPS = 1e-6f;
constexpr int NWAVES = 8;
constexpr size_t MiB = 1u << 20;
constexpr size_t WS_CTL = 0, CTL_ZERO_BYTES = 2 * MiB;
constexpr size_t WS_MOD = 2 * MiB;
constexpr size_t WS_PART = 3 * MiB;
constexpr size_t WS_NRM = 12 * MiB;
constexpr size_t WS_WABIN = 16 * MiB;
constexpr size_t WS_WABOUT = 44 * MiB;
constexpr size_t WS_WCIN = 52 * MiB;
constexpr size_t WS_WCOUT = 100 * MiB;
constexpr size_t WS_WUP = 116 * MiB;
constexpr size_t WS_WDOWN = 288 * MiB;
constexpr size_t WS_H = 376 * MiB;
constexpr size_t WS_PROJ = 408 * MiB;
constexpr size_t WS_ATT = 504 * MiB;
constexpr size_t WS_LSE = WS_ATT + 64 * MiB;
constexpr size_t WS_O = 632 * MiB;
constexpr size_t WS_Y = 664 * MiB;
constexpr size_t WS_HG = 728 * MiB;
constexpr size_t WS_HU = 732 * MiB;
constexpr size_t WS_ACT = 900 * MiB;
constexpr size_t WS_END = 986 * MiB;
static_assert(WS_PART + (size_t)DEPTH * 16 * BATCH * MODW * 4 <= WS_WABIN, "ws map");
static_assert(WS_WABIN + (size_t)2 * AB_IN * DM * 2 <= WS_WABOUT && WS_WABOUT + (size_t)2 * DM * AB_OUT * 2 <= WS_WCIN, "ws map");
static_assert(WS_WCIN + (size_t)2 * C_IN * DM * 2 <= WS_WCOUT && WS_WCOUT + (size_t)2 * DM * DM * 2 <= WS_WUP, "ws map");
static_assert(WS_WUP + (size_t)4 * UPW * DM * 2 <= WS_WDOWN && WS_WDOWN + (size_t)4 * DM * DFF * 2 <= WS_H, "ws map");
static_assert(WS_H + (size_t)M * DM * 2 <= WS_PROJ && WS_PROJ + (size_t)M * C_IN * 2 <= WS_ATT && WS_ATT + (size_t)2 * M * DM * 4 <= WS_O, "ws map");
static_assert(WS_ATT + (size_t)3 * M * 512 * 4 <= WS_LSE && WS_LSE + (size_t)3 * M * 4 * 4 <= WS_O, "ws map");
static_assert(WS_O + (size_t)M * DM * 2 <= WS_Y && WS_Y + (size_t)M * DM * 4 <= WS_HG && WS_HG + (size_t)(M / 256) * 4 * DFF * 4 <= WS_HU && WS_HU + (size_t)(M / 256) * 2 * DFF * 4 <= WS_ACT && WS_ACT + (size_t)M * DFF * 2 <= WS_END, "ws map");
constexpr int CW_BAR = 4096;
constexpr int RING_OFF = 0, RING_BYTES = 131072;
constexpr int LDSCTL_OFF = RING_BYTES, MISC_OFF = LDSCTL_OFF + 320, BND_OFF = LDSCTL_OFF + 1024;
constexpr int LDS_BYTES = 147456;
static_assert(att::SHM_ATTN <= RING_BYTES, "attention LDS fits the ring region");

#define GAS __attribute__((address_space(1)))
#define LAS __attribute__((address_space(3)))
typedef unsigned short bf16;
typedef unsigned v4u __attribute__((ext_vector_type(4)));
typedef unsigned v2u __attribute__((ext_vector_type(2)));
typedef float f32x4 __attribute__((ext_vector_type(4)));
typedef GAS unsigned gu32;
#define LDS_WAIT() asm volatile("s_waitcnt lgkmcnt(0)" ::: "memory")
__device__ __forceinline__ unsigned pk2(float lo, float hi) { unsigned r; asm volatile("v_cvt_pk_bf16_f32 %0, %1, %2" : "=v"(r) : "v"(lo), "v"(hi)); return r; }
__device__ __forceinline__ float bf_lo(unsigned w) { return __uint_as_float(w << 16); }
__device__ __forceinline__ float bf_hi(unsigned w) { return __uint_as_float(w & 0xffff0000u); }
#define XB_TMO      128
#define XB_XCNT(j)  (256  + 64 * (j))
#define XB_XSUB(j)  (1280 + 64 * (j))
#define XB_XGEN(j)  (2304 + 64 * (j))
#define XB_TOP      3328
#define XB_TOPGEN   3392
#define XCD_BAR_WORDS 3456
#define XB_SPIN_CAP (1u << 18)

__device__ __forceinline__ unsigned xb_ld(unsigned* p)              { return __hip_atomic_load(p, __ATOMIC_RELAXED, __HIP_MEMORY_SCOPE_AGENT); }
__device__ __forceinline__ unsigned xb_add(unsigned* p, unsigned v) { return __hip_atomic_fetch_add(p, v, __ATOMIC_RELAXED, __HIP_MEMORY_SCOPE_AGENT); }
__device__ __forceinline__ unsigned xb_xcc_id() { return (unsigned)__builtin_amdgcn_s_getreg((3 << 11) | 20) & 0xFu; }
#define XB_SPIN(cond, bar) do { unsigned _sp = 0; while (cond) { __builtin_amdgcn_s_sleep(1); \
    if ((++_sp & 255u) == 0u) { if (xb_ld(&(bar)[XB_TMO])) break; if (_sp > XB_SPIN_CAP) { atomicAdd(&(bar)[XB_TMO], 1u); break; } } } } while (0)

struct XcdBarrier {
    unsigned* bar; unsigned x;
    volatile LAS unsigned* st;
};

__device__ __forceinline__ XcdBarrier xcd_barrier_post(unsigned* bar, volatile LAS unsigned* st) {
    XcdBarrier b; b.bar = bar; b.x = xb_xcc_id(); b.st = st;
    if (threadIdx.x == 0) (void)xb_add(&bar[XB_XCNT(b.x)], 1u);
    return b;
}
__device__ __forceinline__ void xcd_barrier_complete(unsigned* bar, unsigned x, unsigned& nloc, unsigned& nx) {
    const unsigned G = gridDim.x * gridDim.y * gridDim.z;
    unsigned sum, cnt, mine, sp = 0u;
    for (;;) {
        sum = 0u; cnt = 0u; mine = 0u;
#pragma unroll
        for (unsigned j = 0; j < 16; ++j) { const unsigned c = xb_ld(&bar[XB_XCNT(j)]); sum += c; cnt += (c > 0u) ? 1u : 0u; mine = (j == x) ? c : mine; }
        if (sum == G) break;
        __builtin_amdgcn_s_sleep(1);
        if ((++sp & 255u) == 0u) { if (xb_ld(&bar[XB_TMO])) break; if (sp > XB_SPIN_CAP) { atomicAdd(&bar[XB_TMO], 1u); break; } }
    }
    nloc = mine > 0u ? mine : 1u; nx = cnt > 0u ? cnt : 1u;
}

__device__ __forceinline__ void xcd_barrier(const XcdBarrier& b) {
    asm volatile("s_waitcnt vmcnt(0)" ::: "memory");
    __syncthreads();
    if (threadIdx.x == 0) {
        unsigned* bar = b.bar;
        __builtin_amdgcn_s_waitcnt(0);
        unsigned nloc = b.st[0], nx = b.st[1];
        if (nloc == 0u) { xcd_barrier_complete(bar, b.x, nloc, nx); b.st[0] = nloc; b.st[1] = nx; }
        const unsigned old = xb_add(&bar[XB_XSUB(b.x)], 1u);
        const unsigned gen = old / nloc;
        if (old + 1u == (gen + 1u) * nloc) {
            __builtin_amdgcn_fence(__ATOMIC_RELEASE, "agent");
            asm volatile("s_waitcnt vmcnt(0)" ::: "memory");
            const unsigned og = xb_add(&bar[XB_TOP], 1u);
            const unsigned tg = og / nx;
            if (og + 1u == (tg + 1u) * nx) xb_add(&bar[XB_TOPGEN], 1u);
            else XB_SPIN(xb_ld(&bar[XB_TOPGEN]) == tg, bar);
            __builtin_amdgcn_fence(__ATOMIC_ACQUIRE, "agent");
            xb_add(&bar[XB_XGEN(b.x)], 1u);
            asm volatile("s_waitcnt vmcnt(0)" ::: "memory");
        } else {
            XB_SPIN(xb_ld(&bar[XB_XGEN(b.x)]) == gen, bar);
            __builtin_amdgcn_fence(__ATOMIC_ACQUIRE, "agent");
            asm volatile("s_waitcnt vmcnt(0)" ::: "memory");
        }
    }
    __syncthreads();
}
struct Frame {
    LAS unsigned char* lds; char* ldsg;
    int tid, lane, wave, G, gw, NGW;
    const float *x, *c, *ada_w, *ada_b, *norm_g, *ab_w_in, *ab_w_out, *a_sink, *c_w_in, *c_w_out, *c_lambda, *c_subln_g, *w_up, *conv_w, *conv_b, *w_down;
    float* out; unsigned char* ws;
};
#define PHASE_IDS() int tid = threadIdx.x; asm volatile("" : "+v"(tid)); const int lane = tid & 63, wave = __builtin_amdgcn_readfirstlane(tid >> 6), gw = (int)blockIdx.x * NWAVES + wave; (void)lane; (void)gw
__device__ __forceinline__ float wave_sum(float v) {
#pragma unroll
    for (int o = 1; o < 64; o <<= 1) v += __shfl_xor(v, o);
    return v;
}
__device__ __forceinline__ void transpose_item(const float* W, int K, int N, bf16* WT, LAS float* scr, int item, int lane, int remap = 0) {
    const int nblk = N / 32, kb = item / nblk, nb = item % nblk, k0 = 64 * kb, n0 = 32 * nb;
    int d0 = n0; if (remap) { const int isup = n0 >= DFF, c0 = n0 - isup * DFF; d0 = (c0 >> 7) * 256 + isup * 128 + (c0 & 127); }
#pragma unroll 8
    for (int i = 0; i < 32; ++i) { const int kk = 2 * i + (lane >> 5); scr[kk * 33 + (lane & 31)] = W[(size_t)(k0 + kk) * N + n0 + (lane & 31)]; }
    LDS_WAIT(); asm volatile("" ::: "memory");
    const int c = lane & 7;
#pragma unroll
    for (int j = 0; j < 4; ++j) { const int n = (lane >> 3) + 8 * j; const LAS float* s = scr + (8 * c) * 33 + n;
        v4u o; o.x = pk2(s[0 * 33], s[1 * 33]); o.y = pk2(s[2 * 33], s[3 * 33]); o.z = pk2(s[4 * 33], s[5 * 33]); o.w = pk2(s[6 * 33], s[7 * 33]);
        *(GAS v4u*)(WT + (size_t)(d0 + n) * K + k0 + 8 * c) = o; }
    LDS_WAIT(); asm volatile("" ::: "memory");
}
__device__ __forceinline__ float silu_f(float v) { return v / (1.f + __expf(-v)); }

__device__ __forceinline__ void p0a_prologue(Frame& F) {
    PHASE_IDS();
    LAS float* scr = (LAS float*)(F.lds + RING_OFF + wave * 16384);
    constexpr int I_ABIN = (DM / 64) * (AB_IN / 32), I_ABOUT = (AB_OUT / 64) * (DM / 32), I_CIN = (DM / 64) * (C_IN / 32), I_COUT = (DM / 64) * (DM / 32),
                  I_UP = (DM / 64) * (UPW / 32), I_DOWN = (DFF / 64) * (DM / 32);
    constexpr int NT_ITEMS = 2 * I_ABIN + 2 * I_ABOUT + 2 * I_CIN + 2 * I_COUT + 4 * I_UP + 4 * I_DOWN;
    bf16* wabin = (bf16*)(F.ws + WS_WABIN); bf16* wabout = (bf16*)(F.ws + WS_WABOUT); bf16* wcin = (bf16*)(F.ws + WS_WCIN); bf16* wcout = (bf16*)(F.ws + WS_WCOUT);
    bf16* wup = (bf16*)(F.ws + WS_WUP); bf16* wdown = (bf16*)(F.ws + WS_WDOWN);
    for (int it = gw; it < NT_ITEMS; it += F.NGW) {
        int r = it;
        if (r < 2 * I_ABIN) { const int j = r / I_ABIN; transpose_item(F.ab_w_in + (size_t)j * DM * AB_IN, DM, AB_IN, wabin + (size_t)j * AB_IN * DM, scr, r % I_ABIN, lane); continue; } r -= 2 * I_ABIN;
        if (r < 2 * I_ABOUT) { const int j = r / I_ABOUT; transpose_item(F.ab_w_out + (size_t)j * AB_OUT * DM, AB_OUT, DM, wabout + (size_t)j * DM * AB_OUT, scr, r % I_ABOUT, lane); continue; } r -= 2 * I_ABOUT;
        if (r < 2 * I_CIN) { const int j = r / I_CIN; transpose_item(F.c_w_in + (size_t)j * DM * C_IN, DM, C_IN, wcin + (size_t)j * C_IN * DM, scr, r % I_CIN, lane); continue; } r -= 2 * I_CIN;
        if (r < 2 * I_COUT) { const int j = r / I_COUT; transpose_item(F.c_w_out + (size_t)j * DM * DM, DM, DM, wcout + (size_t)j * DM * DM, scr, r % I_COUT, lane); continue; } r -= 2 * I_COUT;
        if (r < 4 * I_UP) { const int j = r / I_UP; transpose_item(F.w_up + (size_t)j * DM * UPW, DM, UPW, wup + (size_t)j * UPW * DM, scr, r % I_UP, lane, 1); continue; } r -= 4 * I_UP;
        { const int j = r / I_DOWN; transpose_item(F.w_down + (size_t)j * DFF * DM, DFF, DM, wdown + (size_t)j * DM * DFF, scr, r % I_DOWN, lane); }
    }
    float* part = (float*)(F.ws + WS_PART);
    constexpr int NCH = MODW / 256, NKC = 16, KCH = DM / NKC;
    for (int it = gw; it < DEPTH * NCH * NKC; it += F.NGW) {
        const int kc = it % NKC, nch = (it / NKC) % NCH, l = it / (NKC * NCH), k0 = kc * KCH;
        const float c0a = silu_f(F.c[k0 + lane]), c0b = silu_f(F.c[k0 + 64 + lane]), c1a = silu_f(F.c[DM + k0 + lane]), c1b = silu_f(F.c[DM + k0 + 64 + lane]);
        const float* wp = F.ada_w + ((size_t)l * DM + k0) * MODW + nch * 256 + 4 * lane;
        f32x4 a0 = {0.f, 0.f, 0.f, 0.f}, a1 = {0.f, 0.f, 0.f, 0.f};
#pragma unroll 8
        for (int k = 0; k < 64; ++k) { const f32x4 w = *(const f32x4*)(wp + (size_t)k * MODW); const float s0 = __shfl(c0a, k), s1 = __shfl(c1a, k); a0 += w * s0; a1 += w * s1; }
#pragma unroll 8
        for (int k = 0; k < 64; ++k) { const f32x4 w = *(const f32x4*)(wp + (size_t)(64 + k) * MODW); const float s0 = __shfl(c0b, k), s1 = __shfl(c1b, k); a0 += w * s0; a1 += w * s1; }
        float* pp = part + (((size_t)l * NKC + kc) * BATCH) * MODW + nch * 256 + 4 * lane;
        *(f32x4*)pp = a0; *(f32x4*)(pp + MODW) = a1;
    }
}
__device__ __forceinline__ void p0b_modreduce(Frame& F) {
    PHASE_IDS();
    const float* part = (const float*)(F.ws + WS_PART); float* mod = (float*)(F.ws + WS_MOD);
    for (int i = blockIdx.x * (NWAVES * 64) + tid; i < DEPTH * BATCH * MODW; i += F.G * NWAVES * 64) {
        const int n = i % MODW, b = (i / MODW) % BATCH, l = i / (MODW * BATCH);
        float s = F.ada_b[l * MODW + n];
#pragma unroll
        for (int kc = 0; kc < 16; ++kc) s += part[(((size_t)l * 16 + kc) * BATCH + b) * MODW + n];
        mod[i] = s;
    }
}
__device__ __forceinline__ void rows_pre(Frame& F, const float* x, const float* ng, const float* scale, const float* shift, bf16* H) {
    PHASE_IDS();
    for (int m = gw; m < M; m += F.NGW) {
        const int b = m / SEQ; f32x4 v[8]; float ss = 0.f;
#pragma unroll
        for (int j = 0; j < 8; ++j) { v[j] = *(const f32x4*)(x + (size_t)m * DM + 4 * lane + 256 * j); ss += (v[j].x * v[j].x + v[j].y * v[j].y) + (v[j].z * v[j].z + v[j].w * v[j].w); }
        const float r = 1.f / sqrtf(wave_sum(ss) * (1.f / DM) + EPS);
#pragma unroll
        for (int j = 0; j < 8; ++j) { const int c = 4 * lane + 256 * j;
            const f32x4 g = *(const f32x4*)(ng + c), sc = *(const f32x4*)(scale + (size_t)b * MODW + c), sh = *(const f32x4*)(shift + (size_t)b * MODW + c);
            const f32x4 h = (v[j] * r) * g * (sc + 1.f) + sh;
            v2u o; o.x = pk2(h.x, h.y); o.y = pk2(h.z, h.w); *(v2u*)(H + (size_t)m * DM + c) = o; }
    }
}
__device__ __forceinline__ void rows_post(Frame& F, const bf16* Y, const float* xs, float* xd, const float* gate, const float* nga,
                                          const float* ngb, const float* scale, const float* shift, bf16* H, bool doH) {
    PHASE_IDS();
    for (int m = gw; m < M; m += F.NGW) {
        const int b = m / SEQ; f32x4 v[8]; float ss = 0.f;
#pragma unroll
        for (int j = 0; j < 8; ++j) { const v2u w = *(const v2u*)(Y + (size_t)m * DM + 4 * lane + 256 * j); v[j] = (f32x4){bf_lo(w.x), bf_hi(w.x), bf_lo(w.y), bf_hi(w.y)};
            ss += (v[j].x * v[j].x + v[j].y * v[j].y) + (v[j].z * v[j].z + v[j].w * v[j].w); }
        const float r = 1.f / sqrtf(wave_sum(ss) * (1.f / DM) + EPS); float ss2 = 0.f;
#pragma unroll
        for (int j = 0; j < 8; ++j) { const int c = 4 * lane + 256 * j;
            const f32x4 xv = *(const f32x4*)(xs + (size_t)m * DM + c), g = *(const f32x4*)(gate + (size_t)b * MODW + c), na = *(const f32x4*)(nga + c);
            v[j] = xv + g * ((v[j] * r) * na);
            ss2 += (v[j].x * v[j].x + v[j].y * v[j].y) + (v[j].z * v[j].z + v[j].w * v[j].w);
            *(f32x4*)(xd + (size_t)m * DM + c) = v[j]; }
        if (doH) {
            const float r2 = 1.f / sqrtf(wave_sum(ss2) * (1.f / DM) + EPS);
#pragma unroll
            for (int j = 0; j < 8; ++j) { const int c = 4 * lane + 256 * j;
                const f32x4 g = *(const f32x4*)(ngb + c), sc = *(const f32x4*)(scale + (size_t)b * MODW + c), sh = *(const f32x4*)(shift + (size_t)b * MODW + c);
                const f32x4 h = (v[j] * r2) * g * (sc + 1.f) + sh;
                v2u o; o.x = pk2(h.x, h.y); o.y = pk2(h.z, h.w); *(v2u*)(H + (size_t)m * DM + c) = o; }
        }
    }
}
__device__ __forceinline__ void rows_subln(Frame& F, const float* A0, const float* A1, const float* lamp, const float* sg, float lambda_init, bf16* O) {
    PHASE_IDS();
    const float l0 = lamp[lane] * lamp[128 + lane] + lamp[64 + lane] * lamp[128 + 64 + lane];
    const float l1 = lamp[256 + lane] * lamp[384 + lane] + lamp[256 + 64 + lane] * lamp[384 + 64 + lane];
    const float lam = __expf(wave_sum(l0)) - __expf(wave_sum(l1)) + lambda_init;
    const f32x4 g = *(const f32x4*)(sg + 4 * lane) * (1.f - lambda_init);
    for (int m = gw; m < M; m += F.NGW) {
#pragma unroll
        for (int j = 0; j < 8; ++j) { const size_t off = (size_t)m * DM + 4 * lane + 256 * j;
            const f32x4 d = *(const f32x4*)(A0 + off) - *(const f32x4*)(A1 + off) * lam;
            const float ss = wave_sum((d.x * d.x + d.y * d.y) + (d.z * d.z + d.w * d.w));
            const float r = 1.f / sqrtf(ss * (1.f / 256.f) + EPS);
            const f32x4 h = (d * r) * g;
            v2u o; o.x = pk2(h.x, h.y); o.y = pk2(h.z, h.w); *(v2u*)(O + off) = o; }
    }
}
__device__ __forceinline__ void rows_bmerge(Frame& F, const float* OB, const float* LSE, bf16* O) {
    PHASE_IDS();
    for (int m = gw; m < M; m += F.NGW) {
        const int hb = lane >> 4;
        const float e0 = LSE[(size_t)m * 4 + hb], e1 = LSE[((size_t)M + m) * 4 + hb], e2 = LSE[((size_t)2 * M + m) * 4 + hb];
        const float mx = fmaxf(e0, fmaxf(e1, e2));
        float w0 = __expf(e0 - mx), w1 = __expf(e1 - mx), w2 = __expf(e2 - mx); const float inv = 1.f / (w0 + w1 + w2); w0 *= inv; w1 *= inv; w2 *= inv;
        const float* p = OB + (size_t)m * 512 + 8 * lane;
        const f32x4 a0 = *(const f32x4*)p, a1 = *(const f32x4*)(p + 4);
        const f32x4 b0 = *(const f32x4*)(p + (size_t)M * 512), b1 = *(const f32x4*)(p + (size_t)M * 512 + 4);
        const f32x4 c0 = *(const f32x4*)(p + (size_t)2 * M * 512), c1 = *(const f32x4*)(p + (size_t)2 * M * 512 + 4);
        const f32x4 r0 = a0 * w0 + b0 * w1 + c0 * w2, r1 = a1 * w0 + b1 * w1 + c1 * w2;
        v4u o; o.x = pk2(r0.x, r0.y); o.y = pk2(r0.z, r0.w); o.z = pk2(r1.x, r1.y); o.w = pk2(r1.z, r1.w);
        *(v4u*)(O + (size_t)m * AB_OUT + 512 + 8 * lane) = o;
    }
}
__device__ __forceinline__ float gelu_tanh(float v) {
    const float u = 0.7978845608028654f * (v + 0.044715f * v * v * v);
    const float e = __expf(2.f * u);
    const float t = 1.f - 2.f / (e + 1.f);
    return 0.5f * v * (1.f + t);
}
__device__ __forceinline__ void phase_actfix(Frame& F, const float* cw, const float* cb, bf16* ACT) {
    PHASE_IDS();
    const float* HG = (const float*)(F.ws + WS_HG); const float* HU = (const float*)(F.ws + WS_HU);
    constexpr int NC4 = DFF / 4, NT = M / 256;
    for (int it = (int)blockIdx.x * (NWAVES * 64) + tid; it < 2 * NT * NC4; it += F.G * NWAVES * 64) {
        const int c = (it % NC4) * 4, rr = it / NC4, pm = rr >> 1, side = rr & 1;
        const f32x4 z = {0.f, 0.f, 0.f, 0.f}; f32x4 gp, gc, gn, up; size_t row;
        if (side == 0) { gp = (pm % (SEQ / 256) == 0) ? z : *(const f32x4*)(HG + ((size_t)(pm - 1) * 4 + 3) * DFF + c); gc = *(const f32x4*)(HG + ((size_t)pm * 4 + 0) * DFF + c);
            gn = *(const f32x4*)(HG + ((size_t)pm * 4 + 1) * DFF + c); up = *(const f32x4*)(HU + ((size_t)pm * 2 + 0) * DFF + c); row = (size_t)pm * 256; }
        else { gp = *(const f32x4*)(HG + ((size_t)pm * 4 + 2) * DFF + c); gc = *(const f32x4*)(HG + ((size_t)pm * 4 + 3) * DFF + c);
            gn = (pm % (SEQ / 256) == SEQ / 256 - 1) ? z : *(const f32x4*)(HG + ((size_t)(pm + 1) * 4 + 0) * DFF + c); up = *(const f32x4*)(HU + ((size_t)pm * 2 + 1) * DFF + c); row = (size_t)pm * 256 + 255; }
        const f32x4 w0 = *(const f32x4*)(cw + c), w1 = *(const f32x4*)(cw + DFF + c), w2 = *(const f32x4*)(cw + 2 * DFF + c), bb = *(const f32x4*)(cb + c);
        float r[4];
#pragma unroll
        for (int i = 0; i < 4; ++i) r[i] = pg8::gelu_tanh_mul(fmaf(w0[i], gp[i], fmaf(w1[i], gc[i], fmaf(w2[i], gn[i], bb[i]))), up[i]);
        v2u o; o.x = pk2(r[0], r[1]); o.y = pk2(r[2], r[3]); *(v2u*)(ACT + row * DFF + c) = o;
    }
}
__device__ __forceinline__ float alibi16(int i) { return exp2f(-0.5f * (float)(i + 1)); }
__device__ __forceinline__ void phase_attn_ab(Frame& F, int jl) {
    const bf16* P = (const bf16*)(F.ws + WS_PROJ); bf16* O = (bf16*)(F.ws + WS_O); float* OB = (float*)(F.ws + WS_ATT); float* LSE = (float*)(F.ws + WS_LSE);
    for (int u = blockIdx.x; u < 512; u += F.G) {
        att::UnitArgs a;
        if (u < 128) {
            const int qb = u % 16, qh = (u / 16) % 4, b = u / 64, q0 = qb * 256; const size_t row0 = (size_t)b * SEQ;
            a.Q = (const GAS bf16*)P + (row0 + q0) * AB_IN + qh * 128; a.ldq = AB_IN;
            a.K = (const GAS bf16*)P + row0 * AB_IN + 512 + (qh >> 1) * 128; a.V = (const GAS bf16*)P + row0 * AB_IN + 768 + (qh >> 1) * 128; a.ldk = AB_IN;
            a.q0 = q0; a.L = SEQ; a.kt0 = q0 / 64 - 2; a.nt = 8;
            a.nsl = -alibi16(qh) / att::SCALE; a.radius = 128.f; a.m_init = F.a_sink[jl * 4 + qh] / att::SCALE; a.l_init = 1.f;
            a.Of = nullptr; a.Ob = (GAS bf16*)O + (row0 + q0) * AB_OUT + qh * 128; a.ldo = AB_OUT; a.lse = nullptr; a.ldl = 0;
        } else {
            const int v = (u - 128) % 128, gi = (u - 128) / 128, dil = gi == 0 ? 1 : (gi == 1 ? 4 : 16), L = SEQ / dil;
            int qb, r, hb, b;
            if (gi == 0) { qb = v % 16; r = 0; hb = (v / 16) % 4; b = v / 64; }
            else if (gi == 1) { qb = v % 4; r = (v / 4) % 4; hb = (v / 16) % 4; b = v / 64; }
            else { qb = 0; r = v % 16; hb = (v / 16) % 4; b = v / 64; }
            const int q0 = qb * 256; const size_t seq0 = (size_t)b * SEQ + r, rowq = seq0 + (size_t)dil * q0;
            a.Q = (const GAS bf16*)P + rowq * AB_IN + 1024 + gi * 512 + hb * 128; a.ldq = (long)dil * AB_IN;
            a.K = (const GAS bf16*)P + seq0 * AB_IN + 2560 + hb * 128; a.V = (const GAS bf16*)P + seq0 * AB_IN + 3072 + hb * 128; a.ldk = (long)dil * AB_IN;
            a.q0 = q0; a.L = L; a.kt0 = q0 / 64 - 1; a.nt = 6;
            a.nsl = -alibi16(4 + gi * 4 + hb) * (float)dil / att::SCALE; a.radius = 64.f; a.m_init = att::M_INIT; a.l_init = 0.f;
            a.Of = (GAS float*)OB + ((size_t)gi * M + rowq) * 512 + hb * 128; a.Ob = nullptr; a.ldo = (long)dil * 512;
            a.lse = (GAS float*)LSE + ((size_t)gi * M + rowq) * 4 + hb; a.ldl = (long)dil * 4;
        }
        att::attn_unit<true, 1>(a, F.ldsg + RING_OFF);
    }
}
__device__ __forceinline__ void phase_cnorm(Frame& F) {
    PHASE_IDS();
    const bf16* P = (const bf16*)(F.ws + WS_PROJ); float* NRM = (float*)(F.ws + WS_NRM);
    for (int it = gw; it < 2048; it += F.NGW) {
        const int tile = it & 63, j = (it >> 6) & 1, h = (it >> 7) & 7, b = (it >> 10) & 1;
        const bf16* base = P + ((size_t)b * SEQ + 64 * tile + (lane >> 4)) * C_IN + h * 256 + j * 128 + (lane & 15) * 8;
        float mq = 0.f, mk = 0.f, ms = 3.0e38f;
#pragma unroll 4
        for (int i = 0; i < 16; ++i) {
            const v4u wq = *(const v4u*)(base + (size_t)(4 * i) * C_IN), wk = *(const v4u*)(base + (size_t)(4 * i) * C_IN + 2048);
            float sq = 0.f, sk = 0.f, dt = 0.f;
#pragma unroll
            for (int q = 0; q < 4; ++q) { const float a = bf_lo(wq[q]), c = bf_hi(wq[q]), e = bf_lo(wk[q]), g = bf_hi(wk[q]); sq += a * a + c * c; sk += e * e + g * g; dt += a * e + c * g; }
#pragma unroll
            for (int o = 1; o < 16; o <<= 1) { sq += __shfl_xor(sq, o); sk += __shfl_xor(sk, o); dt += __shfl_xor(dt, o); }
            mq = fmaxf(mq, sq); mk = fmaxf(mk, sk); ms = fminf(ms, dt);
        }
        mq = fmaxf(mq, __shfl_xor(mq, 16)); mq = fmaxf(mq, __shfl_xor(mq, 32)); mk = fmaxf(mk, __shfl_xor(mk, 16)); mk = fmaxf(mk, __shfl_xor(mk, 32));
        ms = fminf(ms, __shfl_xor(ms, 16)); ms = fminf(ms, __shfl_xor(ms, 32));
        if (lane == 0) { NRM[it] = sqrtf(mq); NRM[2048 + it] = sqrtf(mk); NRM[4096 + it] = att::SCALE * ms; }
    }
}
__device__ __forceinline__ void phase_attn_c(Frame& F, gu32* ctr) {
    PHASE_IDS();
    const bf16* P = (const bf16*)(F.ws + WS_PROJ); float* AT = (float*)(F.ws + WS_ATT); const float* NRM = (const float*)(F.ws + WS_NRM);
    volatile LAS unsigned* slot = (volatile LAS unsigned*)(F.lds + MISC_OFF) + 16;
    for (;;) {
        if (tid == 0) *slot = __hip_atomic_fetch_add(ctr, 1u, __ATOMIC_RELAXED, __HIP_MEMORY_SCOPE_AGENT);
        __syncthreads();
        const int i = __builtin_amdgcn_readfirstlane((int)*slot);
        __syncthreads();
        if (i >= 1024) break;
        const int h = 7 - (i >> 7), qb = i & 15, vh = (i >> 4) & 1, j = (i >> 5) & 1, b = (i >> 6) & 1, q0 = qb * 256; const size_t row0 = (size_t)b * SEQ;
        const float slope = exp2f(-(float)(h + 1));
        const float* QN = NRM + ((b * 8 + h) * 2 + j) * 64; const float* KN = QN + 2048;
        const float* SS = QN + 4096;
        const float qn = fmaxf(fmaxf(QN[4 * qb], QN[4 * qb + 1]), fmaxf(QN[4 * qb + 2], QN[4 * qb + 3]));
        const float smin = fminf(fminf(SS[4 * qb], SS[4 * qb + 1]), fminf(SS[4 * qb + 2], SS[4 * qb + 3])) - 0.05f;
        const int klo = 64 * lane, d1 = klo - (q0 + 255), d2 = q0 - (klo + 63), dmin = d1 > 0 ? d1 : (d2 > 0 ? d2 : 0);
        const float bound = att::SCALE * 1.02f * qn * KN[lane] - slope * (float)dmin;
        const unsigned long long need = __ballot((bound - smin > -25.f) || (dmin == 0));
        int t_lo = (int)__builtin_ctzll(need), t_hi = 64 - (int)__builtin_clzll(need);
        if ((t_hi - t_lo) & 1) { if (t_lo > 0) --t_lo; else ++t_hi; }
        att::UnitArgs a;
        a.Q = (const GAS bf16*)P + (row0 + q0) * C_IN + h * 256 + j * 128; a.ldq = C_IN;
        a.K = (const GAS bf16*)P + row0 * C_IN + 2048 + h * 256 + j * 128; a.V = (const GAS bf16*)P + row0 * C_IN + 4096 + h * 256 + vh * 128; a.ldk = C_IN;
        a.q0 = q0; a.L = SEQ; a.kt0 = t_lo; a.nt = t_hi - t_lo;
        a.nsl = -slope / att::SCALE; a.radius = 0.f; a.m_init = att::M_INIT; a.l_init = 0.f;
        a.Of = (GAS float*)AT + ((size_t)j * M + row0 + q0) * DM + h * 256 + vh * 128; a.Ob = nullptr; a.ldo = DM; a.lse = nullptr; a.ldl = 0;
        att::attn_unit<false, 2>(a, F.ldsg + RING_OFF);
    }
}

#ifndef ENC_DUP
#define ENC_DUP 0
#endif
#define DUP(bit) for (int rep_ = 0; rep_ < (((ENC_DUP) & (bit)) ? 2 : 1); ++rep_)
constexpr int CW_QUEUE = 8192;
struct Args { const float* in[16]; float* out; unsigned char* ws; };
__global__ void __launch_bounds__(NWAVES * 64, 2) enc_fwd(Args args) {
    extern __shared__ __attribute__((aligned(16))) unsigned char lds[];
    Frame F;
    F.lds = (LAS unsigned char*)lds; F.ldsg = (char*)lds;
    F.tid = threadIdx.x; F.lane = F.tid & 63; F.wave = __builtin_amdgcn_readfirstlane(F.tid >> 6);
    F.G = gridDim.x; F.gw = blockIdx.x * NWAVES + F.wave; F.NGW = F.G * NWAVES;
    F.x = args.in[0]; F.c = args.in[1]; F.ada_w = args.in[2]; F.ada_b = args.in[3]; F.norm_g = args.in[4]; F.ab_w_in = args.in[5]; F.ab_w_out = args.in[6]; F.a_sink = args.in[7];
    F.c_w_in = args.in[8]; F.c_w_out = args.in[9]; F.c_lambda = args.in[10]; F.c_subln_g = args.in[11]; F.w_up = args.in[12]; F.conv_w = args.in[13]; F.conv_b = args.in[14]; F.w_down = args.in[15];
    F.out = args.out; F.ws = args.ws;
    gu32* ctl = (gu32*)(F.ws + WS_CTL);
    for (int u = F.tid; u < (LDS_BYTES - LDSCTL_OFF) / 4; u += NWAVES * 64) ((LAS unsigned*)(F.lds + LDSCTL_OFF))[u] = 0u;
    __syncthreads();
    (void)xcd_barrier_post((unsigned*)(ctl + CW_BAR), (volatile LAS unsigned*)(F.lds + MISC_OFF) + 8);
#define GB() do { unsigned char* wsb_ = args.ws; asm volatile("" : "+s"(wsb_)); XcdBarrier bar_; bar_.bar = (unsigned*)(wsb_ + WS_CTL) + CW_BAR; bar_.x = xb_xcc_id(); \
        bar_.st = (volatile LAS unsigned*)(F.lds + MISC_OFF) + 8; xcd_barrier(bar_); } while (0)
    float* mod = (float*)(F.ws + WS_MOD);
    bf16* H = (bf16*)(F.ws + WS_H); bf16* PROJ = (bf16*)(F.ws + WS_PROJ); bf16* O = (bf16*)(F.ws + WS_O); bf16* Y = (bf16*)(F.ws + WS_Y);
    bf16* ACT = (bf16*)(F.ws + WS_ACT); float* AT = (float*)(F.ws + WS_ATT);

    DUP(1) p0a_prologue(F);
    GB();
    p0b_modreduce(F);
    GB();
    rows_pre(F, F.x, F.norm_g, mod + 1 * DM, mod + 0 * DM, H);
    GB();

    for (int s = 0; s < 8; ++s) {
        const int l = s >> 1, sub = s & 1, jl = l >> 1, even = !(l & 1);
        const float* modl = mod + (size_t)l * BATCH * MODW;
        if (sub == 0) {
            pg8::Gemm g; int N;
            if (even) { N = AB_IN; g.Bt = (const bf16*)(F.ws + WS_WABIN) + (size_t)jl * AB_IN * DM; } else { N = C_IN; g.Bt = (const bf16*)(F.ws + WS_WCIN) + (size_t)jl * C_IN * DM; }
            g.A = H; g.M = M; g.N = N; g.K = DM;
            pg8::StaticOrder S; S.init(M, N, F.G, (int)blockIdx.x);
            pg8::EpiBf16<0> E{PROJ, N, nullptr, 0, 0, 1.f};
            DUP(4) pg8::gemm_phase<pg8::EpiBf16<0>, pg8::StaticOrder, true, true>(F.lds + RING_OFF, g, S, E);
        } else {
            pg8::Gemm g; g.A = H; g.Bt = (const bf16*)(F.ws + WS_WUP) + (size_t)l * UPW * DM; g.M = M; g.N = UPW; g.K = DM;
            pg8::StaticOrder S; S.init(M, UPW, F.G, (int)blockIdx.x);
            pg8::EpiAct E{ACT, DFF, F.conv_w + (size_t)l * 3 * DFF, F.conv_b + (size_t)l * DFF, (float*)(F.ws + WS_HG), (float*)(F.ws + WS_HU), (LAS float*)(F.lds + BND_OFF)};
            DUP(4) pg8::gemm_phase<pg8::EpiAct, pg8::StaticOrder, true, true>(F.lds + RING_OFF, g, S, E);
        }
        GB();
        if (sub == 0) {
            if (even) { DUP(16) phase_attn_ab(F, jl); GB(); rows_bmerge(F, AT, (const float*)(F.ws + WS_LSE), O); }
            else { phase_cnorm(F); GB(); phase_attn_c(F, ctl + CW_QUEUE + 64 * jl); GB();
                rows_subln(F, AT, AT + (size_t)M * DM, F.c_lambda + (size_t)jl * 4 * 128, F.c_subln_g + (size_t)jl * 256, 0.8f - 0.6f * __expf(-0.3f * (float)l), O); }
        } else phase_actfix(F, F.conv_w + (size_t)l * 3 * DFF, F.conv_b + (size_t)l * DFF, ACT);
        GB();
        {
            pg8::Gemm g; int K;
            if (sub == 0) { if (even) { K = AB_OUT; g.Bt = (const bf16*)(F.ws + WS_WABOUT) + (size_t)jl * DM * AB_OUT; } else { K = DM; g.Bt = (const bf16*)(F.ws + WS_WCOUT) + (size_t)jl * DM * DM; } g.A = O; }
            else { K = DFF; g.Bt = (const bf16*)(F.ws + WS_WDOWN) + (size_t)l * DM * DFF; g.A = ACT; }
            g.M = M; g.N = DM; g.K = K;
            pg8::StaticOrder S; S.init(M, DM, F.G, (int)blockIdx.x);
            pg8::EpiBf16<0> E{Y, DM, nullptr, 0, 0, 1.f};
            DUP(8) pg8::gemm_phase<pg8::EpiBf16<0>, pg8::StaticOrder, false, true>(F.lds + RING_OFF, g, S, E);
        }
        GB();
        {
            const float* xs = (s == 0) ? F.x : F.out;
            if (sub == 0) rows_post(F, Y, xs, F.out, modl + 2 * DM, F.norm_g + ((size_t)l * 4 + 1) * DM, F.norm_g + ((size_t)l * 4 + 2) * DM, modl + 4 * DM, modl + 3 * DM, H, true);
            else { const int ln = l + 1 < DEPTH ? l + 1 : l; const float* modn = mod + (size_t)ln * BATCH * MODW;
                rows_post(F, Y, xs, F.out, modl + 5 * DM, F.norm_g + ((size_t)l * 4 + 3) * DM, F.norm_g + ((size_t)ln * 4 + 0) * DM, modn + 1 * DM, modn + 0 * DM, H, l + 1 < DEPTH); }
        }
        if (s < 7) GB();
    }
#undef GB
}

extern "C" void kernel_launch(void* const* d_in, const int* in_sizes, int n_in, void* d_out, int out_size, void* d_ws, size_t ws_size, hipStream_t stream) {
    static int grid = 0;
    if (grid == 0) {
        if (n_in != 16 || in_sizes[0] != M * DM || out_size != M * DM || ws_size < WS_END) { fprintf(stderr, "kernel_launch: unexpected shapes (n_in %d, in0 %d, out %d, ws %zu < %zu)\n", n_in, n_in > 0 ? in_sizes[0] : -1, out_size, ws_size, (size_t)WS_END); grid = -1; return; }
        int dev = 0, cus = 0, per_cu = 0;
        if (hipGetDevice(&dev) != hipSuccess || hipDeviceGetAttribute(&cus, hipDeviceAttributeMultiprocessorCount, dev) != hipSuccess) { grid = -1; return; }
        if (hipFuncSetAttribute((const void*)enc_fwd, hipFuncAttributeMaxDynamicSharedMemorySize, LDS_BYTES) != hipSuccess) { fprintf(stderr, "kernel_launch: hipFuncSetAttribute failed\n"); grid = -1; return; }
        if (hipOccupancyMaxActiveBlocksPerMultiprocessor(&per_cu, (const void*)enc_fwd, NWAVES * 64, LDS_BYTES) != hipSuccess || per_cu < 1) { fprintf(stderr, "kernel_launch: occupancy query says %d\n", per_cu); }
        (void)hipGetLastError();
        grid = cus;
    }
    if (grid < 0) return;
    (void)hipMemsetAsync((char*)d_ws + WS_CTL, 0, CTL_ZERO_BYTES, stream);
    Args a{};
    for (int i = 0; i < 16; ++i) a.in[i] = (const float*)d_in[i];
    a.out = (float*)d_out; a.ws = (unsigned char*)d_ws;
    hipLaunchKernelGGL(enc_fwd, dim3(grid), dim3(NWAVES * 64), LDS_BYTES, stream, a);
}
```

```cpp
#include <hip/hip_runtime.h>
#include <cstdio>
#include <cstdint>
namespace pg8 {
#define PG8_LAS __attribute__((address_space(3)))
typedef unsigned short bf16_t;
typedef short bf16x8 __attribute__((ext_vector_type(8)));
typedef float f32x4 __attribute__((ext_vector_type(4)));
typedef unsigned u32x4 __attribute__((ext_vector_type(4)));
constexpr int BM = 256, BK = 64, HALF = 128, HTB = HALF * BK * 2  , STAGE_BYTES = 8 * HTB, NXCD = 8, WGM = 8;

__host__ __device__ __forceinline__ int lds_byte(int r, int c) { const int st = (r >> 4) * 2 + (c >> 5), rr = r & 15, cc = c & 31, ob = rr * 64 + cc * 2; return st * 1024 + (ob ^ (((ob >> 9) & 1) << 5)); }
__host__ __device__ __forceinline__ void stage_rc(int b, int& R, int& C) { const int st = b / 1024, sb = b % 1024, swz = sb ^ (((sb >> 9) & 1) << 5); R = (st >> 1) * 16 + swz / 64; C = (st & 1) * 32 + (swz % 64) / 2; }
__host__ __device__ __forceinline__ int perm32(int rho) { const int n = rho >> 4, i = rho & 15; return 8 * (i >> 2) + 4 * n + (i & 3); }

struct Unit { int pm, pn; };
struct Gemm { const bf16_t* A; const bf16_t* Bt; int M, N, K; };

struct StaticOrder {
    int nM, nN, nwg, G, c;
    __host__ __device__ void init(int M, int N, int G_, int c_) { nM = M / BM; nN = N / BM; nwg = nM * nN; G = G_; c = c_; }
    __host__ __device__ bool next(int i, Unit& u) const {
        const long L = (long)i * G + c; if (L >= nwg) return false;
        int wgid = (int)L; { const int q = nwg / NXCD, r = nwg % NXCD, xcd = wgid % NXCD, off = wgid / NXCD; wgid = (xcd < r ? xcd * (q + 1) : r * (q + 1) + (xcd - r) * q) + off; }
        const int nig = WGM * nN, gid = wgid / nig, fm = gid * WGM, gsz = (nM - fm) < WGM ? (nM - fm) : WGM;
        u.pm = fm + ((wgid % nig) % gsz); u.pn = (wgid % nig) / gsz; return true;
    }
    __device__ __forceinline__ void a_ready(const Unit&) const {}
    __device__ __forceinline__ void done(const Unit&) const {}
};

__device__ __forceinline__ unsigned cvt_pk_bf16(float lo, float hi) { unsigned r; asm volatile("v_cvt_pk_bf16_f32 %0, %1, %2" : "=v"(r) : "v"(lo), "v"(hi)); return r; }
typedef float f32x2 __attribute__((ext_vector_type(2)));
__device__ __forceinline__ f32x2 gelu_pk(f32x2 v) {
    const f32x2 av = __builtin_elementwise_abs(v), d = av * 0.2316418882f + 1.0f;
    f32x2 t; t.x = __builtin_amdgcn_rcpf(d.x); t.y = __builtin_amdgcn_rcpf(d.y);
    f32x2 q = t * 0.5307027145f + (-0.7265760135f); q = q * t + 0.7107068705f; q = q * t + (-0.142248368f); q = q * t + 0.127414796f; q = q * t;
    const f32x2 s = (v * v) * (-0.72134752044f);
    f32x2 e; e.x = __builtin_amdgcn_exp2f(s.x); e.y = __builtin_amdgcn_exp2f(s.y);
    const f32x2 m = v * (q * e), r = v - m;
    f32x2 o; o.x = v.x < 0.f ? m.x : r.x; o.y = v.y < 0.f ? m.y : r.y; return o;
}

template <int ACT  > struct EpiBf16 {
    static constexpr bool PERM = true, AFTER_DRAIN = false; static_assert(ACT == 0 || ACT == 1, "EpiBf16: ACT is 0 (none) or 1 (gelu_pk)");
    bf16_t* O; int ldc; const float* bias; int split_cols; size_t split_stride; float scale0;
    __device__ __forceinline__ void operator()(const f32x4 (&acc)[2][2][4][2], const Unit& u, int wr, int wc, int fr, int fq) const {
        const int row0 = u.pm * BM + wr * 64 + fr; int colt = u.pn * BM; bf16_t* base = O;
        float sc = 1.f; if (split_cols) { const int t = colt / split_cols; base += (size_t)t * split_stride; colt -= t * split_cols; if (t == 0) sc = scale0; }
        const int col0 = colt + wc * 32 + 8 * fq, bcol0 = u.pn * BM + wc * 32 + 8 * fq;
        f32x4 bv[2][2];
#pragma unroll
        for (int bj = 0; bj < 2; ++bj)
#pragma unroll
            for (int n = 0; n < 2; ++n) bv[bj][n] = bias ? *(const f32x4*)(bias + bcol0 + bj * HALF + 4 * n) : (f32x4){0.f, 0.f, 0.f, 0.f};
#pragma unroll
        for (int ai = 0; ai < 2; ++ai)
#pragma unroll
            for (int m = 0; m < 4; ++m) { bf16_t* rowp = base + (size_t)(row0 + ai * HALF + m * 16) * ldc + col0;
#pragma unroll
                for (int bj = 0; bj < 2; ++bj) { f32x4 v0 = acc[ai][bj][m][0] + bv[bj][0], v1 = acc[ai][bj][m][1] + bv[bj][1];
                    if (ACT == 1) { f32x2 a = gelu_pk((f32x2){v0[0], v0[1]}), b = gelu_pk((f32x2){v0[2], v0[3]}), c = gelu_pk((f32x2){v1[0], v1[1]}), d = gelu_pk((f32x2){v1[2], v1[3]});
                        v0 = (f32x4){a.x, a.y, b.x, b.y}; v1 = (f32x4){c.x, c.y, d.x, d.y}; }
                    v0 = v0 * sc; v1 = v1 * sc; u32x4 w; w.x = cvt_pk_bf16(v0[0], v0[1]); w.y = cvt_pk_bf16(v0[2], v0[3]); w.z = cvt_pk_bf16(v1[0], v1[1]); w.w = cvt_pk_bf16(v1[2], v1[3]);
                    *(u32x4*)(rowp + bj * HALF) = w; } }
    }
};
struct EpiF32 {
    static constexpr bool PERM = false, AFTER_DRAIN = false;
    float* C; int ldc; const float* bias;
    __device__ __forceinline__ void operator()(const f32x4 (&acc)[2][2][4][2], const Unit& u, int wr, int wc, int fr, int fq) const {
        const int row0 = u.pm * BM + wr * 64 + fr, col0 = u.pn * BM + wc * 32 + 4 * fq;
        f32x4 bv[2][2];
#pragma unroll
        for (int bj = 0; bj < 2; ++bj)
#pragma unroll
            for (int n = 0; n < 2; ++n) bv[bj][n] = bias ? *(const f32x4*)(bias + col0 + bj * HALF + n * 16) : (f32x4){0.f, 0.f, 0.f, 0.f};
#pragma unroll
        for (int ai = 0; ai < 2; ++ai)
#pragma unroll
            for (int m = 0; m < 4; ++m) { float* rowp = C + (size_t)(row0 + ai * HALF + m * 16) * ldc + col0;
#pragma unroll
                for (int bj = 0; bj < 2; ++bj)
#pragma unroll
                    for (int n = 0; n < 2; ++n) *(f32x4*)(rowp + bj * HALF + n * 16) = acc[ai][bj][m][n] + bv[bj][n]; }
    }
};

template <int CTRL> __device__ __forceinline__ float dpp_mov(float x) { return __builtin_bit_cast(float, __builtin_amdgcn_mov_dpp(__builtin_bit_cast(int, x), CTRL, 0xf, 0xf, true)); }
template <int CTRL> __device__ __forceinline__ float dpp_upd(float old, float x) { return __builtin_bit_cast(float, __builtin_amdgcn_update_dpp(__builtin_bit_cast(int, old), __builtin_bit_cast(int, x), CTRL, 0xf, 0xf, false)); }
__device__ __forceinline__ float gelu_tanh_mul(float v, float up) {
    const float e = __builtin_amdgcn_exp2f(v * fmaf(v * v, -0.10294324f, -2.3022082f));
    return v * up * __builtin_amdgcn_rcpf(1.f + e);
}
struct EpiAct {
    static constexpr bool PERM = true, AFTER_DRAIN = false;
    bf16_t* ACT; int dff; const float* cw; const float* cb; float* HG; float* HU; PG8_LAS float* bnd;
    __device__ __forceinline__ void operator()(const f32x4 (&acc)[2][2][4][2], const Unit& u, int wr, int wc, int fr, int fq) const {
        const int chl = wc * 32 + 8 * fq, ch = u.pn * 128 + chl;
        if (fr == 0) {
#pragma unroll
            for (int ai = 0; ai < 2; ++ai) { PG8_LAS float* p = bnd + ((2 * ai + wr) * 2 + 0) * 128 + chl; *(PG8_LAS f32x4*)p = acc[ai][0][0][0]; *(PG8_LAS f32x4*)(p + 4) = acc[ai][0][0][1]; } }
        if (fr == 15) {
#pragma unroll
            for (int ai = 0; ai < 2; ++ai) { PG8_LAS float* p = bnd + ((2 * ai + wr) * 2 + 1) * 128 + chl; *(PG8_LAS f32x4*)p = acc[ai][0][3][0]; *(PG8_LAS f32x4*)(p + 4) = acc[ai][0][3][1]; } }
        if (wr == 0 && fr <= 1) { float* p = HG + ((size_t)u.pm * 4 + fr) * dff + ch; *(f32x4*)p = acc[0][0][0][0]; *(f32x4*)(p + 4) = acc[0][0][0][1];
            if (fr == 0) { float* q = HU + ((size_t)u.pm * 2 + 0) * dff + ch; *(f32x4*)q = acc[0][1][0][0]; *(f32x4*)(q + 4) = acc[0][1][0][1]; } }
        if (wr == 1 && fr >= 14) { float* p = HG + ((size_t)u.pm * 4 + 2 + (fr - 14)) * dff + ch; *(f32x4*)p = acc[1][0][3][0]; *(f32x4*)(p + 4) = acc[1][0][3][1];
            if (fr == 15) { float* q = HU + ((size_t)u.pm * 2 + 1) * dff + ch; *(f32x4*)q = acc[1][1][3][0]; *(f32x4*)(q + 4) = acc[1][1][3][1]; } }
        f32x4 w0[2], w1[2], w2[2], bb[2];
#pragma unroll
        for (int n = 0; n < 2; ++n) { w0[n] = *(const f32x4*)(cw + ch + 4 * n); w1[n] = *(const f32x4*)(cw + dff + ch + 4 * n); w2[n] = *(const f32x4*)(cw + 2 * dff + ch + 4 * n); bb[n] = *(const f32x4*)(cb + ch + 4 * n); }
        asm volatile("s_waitcnt lgkmcnt(0)" ::: "memory"); __builtin_amdgcn_s_barrier(); asm volatile("" ::: "memory");
        f32x4 bp[2][2], bn[2][2];
#pragma unroll
        for (int ai = 0; ai < 2; ++ai) { const int c = 2 * ai + wr;
#pragma unroll
            for (int n = 0; n < 2; ++n) {
                bp[ai][n] = c > 0 ? *(const PG8_LAS f32x4*)(bnd + ((c - 1) * 2 + 1) * 128 + chl + 4 * n) : (f32x4){0.f, 0.f, 0.f, 0.f};
                bn[ai][n] = c < 3 ? *(const PG8_LAS f32x4*)(bnd + ((c + 1) * 2 + 0) * 128 + chl + 4 * n) : (f32x4){0.f, 0.f, 0.f, 0.f}; } }
        const int row0 = u.pm * BM + wr * 64 + fr;
#pragma unroll
        for (int ai = 0; ai < 2; ++ai)
#pragma unroll
            for (int m = 0; m < 4; ++m) {
                unsigned pk[4];
#pragma unroll
                for (int n = 0; n < 2; ++n) { float r[4];
#pragma unroll
                    for (int i = 0; i < 4; ++i) {
                        const float g = acc[ai][0][m][n][i];
                        const float oldp = (m == 0) ? bp[ai][n][i] : dpp_mov<0x121>(acc[ai][0][m == 0 ? 0 : m - 1][n][i]);
                        const float gp = dpp_upd<0x111>(oldp, g);
                        const float oldn = (m == 3) ? bn[ai][n][i] : dpp_mov<0x12F>(acc[ai][0][m == 3 ? 3 : m + 1][n][i]);
                        const float gn = dpp_upd<0x101>(oldn, g);
                        const float a = fmaf(w0[n][i], gp, fmaf(w1[n][i], g, fmaf(w2[n][i], gn, bb[n][i])));
                        r[i] = gelu_tanh_mul(a, acc[ai][1][m][n][i]);
                    }
                    pk[2 * n] = cvt_pk_bf16(r[0], r[1]); pk[2 * n + 1] = cvt_pk_bf16(r[2], r[3]); }
                u32x4 w; w.x = pk[0]; w.y = pk[1]; w.z = pk[2]; w.w = pk[3];
                *(u32x4*)(ACT + (size_t)(row0 + ai * HALF + m * 16) * dff + ch) = w;
            }
    }
};
template <class Epi, class Sched, bool ALIGN_EPI = false, bool SP2 = false>
__device__ __forceinline__ void gemm_phase(PG8_LAS unsigned char* lds, const Gemm g, const Sched& S, const Epi& E) {
    int tid_ = threadIdx.x; asm volatile("" : "+v"(tid_));
    const int tid = tid_, wid = __builtin_amdgcn_readfirstlane(tid >> 6), lane = tid & 63, wr = wid >> 2, wc = wid & 3, fr = lane & 15, fq = lane >> 4;
    const int K = g.K, nt = K / BK;
    unsigned voffA[2], voffB[2];
#pragma unroll
    for (int i = 0; i < 2; ++i) { int R, C; stage_rc(tid * 16 + i * 8192, R, C); const int Rb = Epi::PERM ? ((R & ~31) + perm32(R & 31)) : R;
        voffA[i] = (unsigned)(R * K + C) * 2u; voffB[i] = (unsigned)(Rb * K + C) * 2u; }
    const size_t kstep = (size_t)(BK * 2);
    const size_t hstep = (size_t)HALF * K * 2;
    const size_t tstep = 2 * hstep;
    const unsigned ldsw = (unsigned)wid * 1024u;
    const int aoff = lds_byte(wr * 64 + fr, fq * 8), boff = lds_byte(wc * 32 + fr, fq * 8);
#define PG8_SA(b, h) (((b) * 2 + (h)) * HTB)
#define PG8_SB(b, h) ((4 + (b) * 2 + (h)) * HTB)
#define PG8_STAGE(bufoff, gbase, voff) do { _Pragma("unroll") for (int _i = 0; _i < 2; ++_i) \
        __builtin_amdgcn_global_load_lds((const unsigned*)((const char*)(gbase) + (voff)[_i]), (PG8_LAS unsigned*)(lds + (bufoff) + ldsw + _i * 8192), 16, 0, 0); } while (0)
#define PG8_LDA(dst, b, h) do { _Pragma("unroll") for (int m = 0; m < 4; ++m) _Pragma("unroll") for (int k = 0; k < 2; ++k) dst[m][k] = *(const PG8_LAS bf16x8*)(lds + PG8_SA(b, h) + aoff + m * 2048 + k * 1024); } while (0)
#define PG8_LDB(dst, b, h) do { _Pragma("unroll") for (int n = 0; n < 2; ++n) _Pragma("unroll") for (int k = 0; k < 2; ++k) dst[n][k] = *(const PG8_LAS bf16x8*)(lds + PG8_SB(b, h) + boff + n * 2048 + k * 1024); } while (0)
#define PG8_MMA(ai, bj, At, Bt) do { __builtin_amdgcn_s_setprio(1); _Pragma("unroll") for (int m = 0; m < 4; ++m) _Pragma("unroll") for (int n = 0; n < 2; ++n) _Pragma("unroll") for (int k = 0; k < 2; ++k) \
        acc[ai][bj][m][n] = __builtin_amdgcn_mfma_f32_16x16x32_bf16(Bt[n][k], At[m][k], acc[ai][bj][m][n], 0, 0, 0); __builtin_amdgcn_s_setprio(0); } while (0)
#define PG8_WAIT_V(n) asm volatile("s_waitcnt vmcnt(" #n ")" ::: "memory")
#define PG8_WAIT_L(n) asm volatile("s_waitcnt lgkmcnt(" #n ")" ::: "memory")
#define PG8_BAR __builtin_amdgcn_s_barrier()
#define PG8_SCHED __builtin_amdgcn_sched_barrier(0)
    Unit cur, nxt; int ui = 0;
    if (!S.next(0, cur)) return;
    f32x4 acc[2][2][4][2];
#pragma unroll
    for (int a = 0; a < 2; ++a)
#pragma unroll
        for (int b = 0; b < 2; ++b)
#pragma unroll
            for (int m = 0; m < 4; ++m)
#pragma unroll
                for (int n = 0; n < 2; ++n) acc[a][b][m][n] = (f32x4){0.f, 0.f, 0.f, 0.f};
    bf16x8 At[4][2], B0[2][2], B1[2][2];
    const char* cA = (const char*)g.A + (size_t)cur.pm * tstep; const char* cB = (const char*)g.Bt + (size_t)cur.pn * tstep;
    S.a_ready(cur);
    if constexpr (SP2) {
        PG8_STAGE(PG8_SB(0, 0), cB, voffB); PG8_STAGE(PG8_SB(0, 1), cB + hstep, voffB); PG8_STAGE(PG8_SA(0, 0), cA, voffA); PG8_STAGE(PG8_SA(0, 1), cA + hstep, voffA);
        if (wr == 1) PG8_BAR;
        PG8_WAIT_V(2); PG8_BAR;
        PG8_STAGE(PG8_SB(1, 0), cB + kstep, voffB); PG8_STAGE(PG8_SA(1, 0), cA + kstep, voffA); PG8_STAGE(PG8_SB(1, 1), cB + hstep + kstep, voffB);
        PG8_WAIT_V(6); PG8_BAR;
    } else {
        PG8_STAGE(PG8_SB(0, 0), cB, voffB); PG8_STAGE(PG8_SA(0, 0), cA, voffA); PG8_STAGE(PG8_SB(0, 1), cB + hstep, voffB); PG8_STAGE(PG8_SA(0, 1), cA + hstep, voffA);
        if (wr == 1) PG8_BAR;
        PG8_WAIT_V(4); PG8_BAR;
        PG8_STAGE(PG8_SB(1, 0), cB + kstep, voffB); PG8_STAGE(PG8_SA(1, 0), cA + kstep, voffA); PG8_STAGE(PG8_SB(1, 1), cB + hstep + kstep, voffB);
        PG8_WAIT_V(6); PG8_BAR;
    }
    for (;;) {
        const bool has_next = S.next(ui + 1, nxt);
        const char* nA = has_next ? (const char*)g.A + (size_t)nxt.pm * tstep : cA; const char* nB = has_next ? (const char*)g.Bt + (size_t)nxt.pn * tstep : cB;
        for (int t = 0; t < nt; t += 2) {
            const bool last = (t == nt - 2);
            const char* a1 = cA + (size_t)(t + 1) * kstep;
            const char* a2 = last ? nA : cA + (size_t)(t + 2) * kstep; const char* b2 = last ? nB : cB + (size_t)(t + 2) * kstep;
            const char* a3 = a2 + kstep; const char* b3 = b2 + kstep;
            if (last && has_next) S.a_ready(nxt);
            if constexpr (SP2) {
            PG8_LDB(B0, 0, 0); PG8_LDB(B1, 0, 1); PG8_SCHED; PG8_LDA(At, 0, 0); PG8_STAGE(PG8_SA(1, 1), a1 + hstep, voffA);
            PG8_WAIT_V(8); PG8_WAIT_L(0); PG8_BAR; PG8_MMA(0, 0, At, B0); PG8_MMA(0, 1, At, B1); PG8_BAR; PG8_SCHED;
            PG8_LDA(At, 0, 1); PG8_STAGE(PG8_SB(0, 0), b2, voffB); PG8_STAGE(PG8_SB(0, 1), b2 + hstep, voffB); PG8_STAGE(PG8_SA(0, 0), a2, voffA);
            PG8_WAIT_V(8); PG8_WAIT_L(0); PG8_BAR; PG8_MMA(1, 0, At, B0); PG8_MMA(1, 1, At, B1); PG8_BAR; PG8_SCHED;
            PG8_LDB(B0, 1, 0); PG8_LDB(B1, 1, 1); PG8_SCHED; PG8_LDA(At, 1, 0); PG8_STAGE(PG8_SA(0, 1), a2 + hstep, voffA);
            PG8_WAIT_V(8); PG8_WAIT_L(0); PG8_BAR; PG8_MMA(0, 0, At, B0); PG8_MMA(0, 1, At, B1); PG8_BAR; PG8_SCHED;
            PG8_LDA(At, 1, 1); PG8_STAGE(PG8_SB(1, 0), b3, voffB); PG8_STAGE(PG8_SB(1, 1), b3 + hstep, voffB); PG8_STAGE(PG8_SA(1, 0), a3, voffA);
            PG8_WAIT_V(8); PG8_WAIT_L(0); PG8_BAR; PG8_MMA(1, 0, At, B0); PG8_MMA(1, 1, At, B1); PG8_BAR; PG8_SCHED;
            } else {
            PG8_LDB(B0, 0, 0); PG8_SCHED; PG8_LDA(At, 0, 0); PG8_STAGE(PG8_SA(1, 1), a1 + hstep, voffA);
            PG8_WAIT_L(8); PG8_BAR; PG8_WAIT_L(0); PG8_MMA(0, 0, At, B0); PG8_BAR; PG8_SCHED;
            PG8_LDB(B1, 0, 1); PG8_STAGE(PG8_SB(0, 0), b2, voffB);
            PG8_BAR; PG8_WAIT_L(0); PG8_MMA(0, 1, At, B1); PG8_BAR;
            PG8_LDA(At, 0, 1); PG8_STAGE(PG8_SA(0, 0), a2, voffA);
            PG8_BAR; PG8_WAIT_L(0); PG8_MMA(1, 0, At, B0); PG8_BAR; PG8_SCHED;
            PG8_STAGE(PG8_SB(0, 1), b2 + hstep, voffB);
            PG8_WAIT_V(6); PG8_BAR; PG8_MMA(1, 1, At, B1); PG8_BAR;
            PG8_LDB(B0, 1, 0); PG8_SCHED; PG8_LDA(At, 1, 0); PG8_STAGE(PG8_SA(0, 1), a2 + hstep, voffA);
            PG8_WAIT_L(8); PG8_BAR; PG8_WAIT_L(0); PG8_MMA(0, 0, At, B0); PG8_BAR; PG8_SCHED;
            PG8_LDB(B1, 1, 1); PG8_STAGE(PG8_SB(1, 0), b3, voffB);
            PG8_BAR; PG8_WAIT_L(0); PG8_MMA(0, 1, At, B1); PG8_BAR;
            PG8_LDA(At, 1, 1); PG8_STAGE(PG8_SA(1, 0), a3, voffA);
            PG8_BAR; PG8_WAIT_L(0); PG8_MMA(1, 0, At, B0); PG8_BAR; PG8_SCHED;
            PG8_STAGE(PG8_SB(1, 1), b3 + hstep, voffB);
            PG8_WAIT_V(6); PG8_BAR; PG8_MMA(1, 1, At, B1); PG8_BAR;
            }
        }
        if constexpr (ALIGN_EPI) { if (wr == 0) PG8_BAR; }
        if constexpr (!Epi::AFTER_DRAIN) { E(acc, cur, wr, wc, fr, fq); S.done(cur); }
        if (!has_next) break;
#pragma unroll
        for (int a = 0; a < 2; ++a)
#pragma unroll
            for (int b = 0; b < 2; ++b)
#pragma unroll
                for (int m = 0; m < 4; ++m)
#pragma unroll
                    for (int n = 0; n < 2; ++n) acc[a][b][m][n] = (f32x4){0.f, 0.f, 0.f, 0.f};
        cur = nxt; cA = nA; cB = nB; ++ui;
        if constexpr (ALIGN_EPI) { if (wr == 1) PG8_BAR; }
    }
    PG8_WAIT_V(0);
    if constexpr (!ALIGN_EPI) { if (wr == 0) PG8_BAR; }
    PG8_BAR;
    if constexpr (Epi::AFTER_DRAIN) { E.fused(acc, cur, wr, wc, fr, fq, lds, wid, lane); S.done(cur); }
#undef PG8_SA
#undef PG8_SB
#undef PG8_STAGE
#undef PG8_LDA
#undef PG8_LDB
#undef PG8_MMA
#undef PG8_WAIT_V
#undef PG8_WAIT_L
#undef PG8_BAR
#undef PG8_SCHED
}
}
namespace att {
typedef unsigned short bf16;
using bf16x8 = __attribute__((ext_vector_type(8))) short;
using s16x4  = __attribute__((ext_vector_type(4))) short;
using f32x16 = __attribute__((ext_vector_type(16))) float;
using u32x4  = __attribute__((ext_vector_type(4))) unsigned;
constexpr int   D = 128, NW = 8, QBLK = 32, KVBLK = 64;
constexpr float SCALE = 0.088388347648318440f;
constexpr float THR = 8.f;
constexpr int SHM_V = KVBLK * D * 2, SHM_K = KVBLK * D * 2, SHM_ATTN = 2 * SHM_V + 2 * SHM_K + NW * 64 * 4;
constexpr float MASKED = -1e30f, M_INIT = -1e28f;
#define KSWZ(row, colB) ((row) * 256 + ((colB) ^ (((row) & 7) << 4)))
#define SBAR() __builtin_amdgcn_sched_barrier(0)
__device__ __forceinline__ int crow(int r, int hi) { return (r & 3) + 8 * (r >> 2) + 4 * hi; }
__device__ __forceinline__ unsigned cvtpk(float lo, float hi) {
  unsigned r; asm volatile("v_cvt_pk_bf16_f32 %0, %1, %2" : "=v"(r) : "v"(lo), "v"(hi)); return r;
}
__device__ __forceinline__ void partialSM(f32x16& p0, f32x16& p1, float& m_reg, float& mn, float& alpha) {
  constexpr float C = SCALE * 1.4426950408889634f;
  float pmax = p0[0];
#pragma unroll
  for (int r = 1; r < 16; ++r) pmax = fmaxf(pmax, p0[r]);
#pragma unroll
  for (int r = 0; r < 16; ++r) pmax = fmaxf(pmax, p1[r]);
  { auto rr = __builtin_amdgcn_permlane32_swap(__float_as_uint(pmax), __float_as_uint(pmax), false, false);
    pmax = fmaxf(__uint_as_float(rr[0]), __uint_as_float(rr[1])); }
  if (__builtin_expect(__all(pmax - m_reg <= THR / SCALE), 1)) { mn = m_reg; alpha = 1.f; }
  else { mn = fmaxf(m_reg, pmax); alpha = __builtin_amdgcn_exp2f((m_reg - mn) * C); m_reg = mn; }
  float mnC = -mn * C;
#pragma unroll
  for (int r = 0; r < 16; ++r) p0[r] = fmaf(p0[r], C, mnC);
#pragma unroll
  for (int r = 0; r < 16; ++r) p1[r] = fmaf(p1[r], C, mnC);
#pragma unroll
  for (int r = 0; r < 16; ++r) p0[r] = __builtin_amdgcn_exp2f(p0[r]);
}
__device__ __forceinline__ void finishSM(f32x16& p0, f32x16& p1, float alpha, float& l_reg, bf16x8& pa0, bf16x8& pa1, bf16x8& pa2, bf16x8& pa3) {
#pragma unroll
  for (int r = 0; r < 16; ++r) p1[r] = __builtin_amdgcn_exp2f(p1[r]);
  float ps = 0;
#pragma unroll
  for (int r = 0; r < 16; ++r) ps += p0[r];
#pragma unroll
  for (int r = 0; r < 16; ++r) ps += p1[r];
  { auto rr = __builtin_amdgcn_permlane32_swap(__float_as_uint(ps), __float_as_uint(ps), false, false);
    ps = __uint_as_float(rr[0]) + __uint_as_float(rr[1]); }
  l_reg = l_reg * alpha + ps;
#define PK4(P, BASE, OUT) do { unsigned a0 = cvtpk(P[BASE + 0], P[BASE + 1]), a1 = cvtpk(P[BASE + 2], P[BASE + 3]);   \
    unsigned b0 = cvtpk(P[BASE + 4], P[BASE + 5]), b1 = cvtpk(P[BASE + 6], P[BASE + 7]);                              \
    auto r0 = __builtin_amdgcn_permlane32_swap(a0, b0, false, false); auto r1 = __builtin_amdgcn_permlane32_swap(a1, b1, false, false); \
    u32x4 w = {r0[0], r1[0], r0[1], r1[1]}; OUT = *reinterpret_cast<bf16x8*>(&w); } while (0)
  PK4(p0, 0, pa0); PK4(p0, 8, pa1); PK4(p1, 0, pa2); PK4(p1, 8, pa3);
#undef PK4
}
template <bool BAND>
__device__ __forceinline__ void qkt(f32x16& p0, f32x16& p1, const bf16* Ks, const bf16x8* qr, int r32, int hi, float dq, float kf0, float nsl, float radius, float Lf, int side) {
  if (!BAND && side != 0) {
    const float ns = side > 0 ? nsl : -nsl, t = ns * dq;
#pragma unroll
    for (int r = 0; r < 16; ++r) { const float c0 = (float)((r & 3) + 8 * (r >> 2)); p0[r] = fmaf(ns, -c0, t); p1[r] = fmaf(ns, -(c0 + 32.f), t); }
  } else
#pragma unroll
  for (int r = 0; r < 16; ++r) {
    const float c0 = (float)((r & 3) + 8 * (r >> 2));
    const float d0 = dq - c0, d1 = dq - (c0 + 32.f);
    float b0 = nsl * fabsf(d0), b1 = nsl * fabsf(d1);
    if (BAND) {
      const float ka = kf0 + c0, kb = kf0 + (c0 + 32.f);
      const bool v0 = (fabsf(d0) <= radius) && (ka >= 0.f) && (ka < Lf);
      const bool v1 = (fabsf(d1) <= radius) && (kb >= 0.f) && (kb < Lf);
      b0 = v0 ? b0 : MASKED; b1 = v1 ? b1 : MASKED;
    }
    p0[r] = b0; p1[r] = b1;
  }
#pragma unroll
  for (int d0 = 0; d0 < 8; ++d0) { int cb = (d0 * 16 + hi * 8) * 2;
    bf16x8 b0 = *reinterpret_cast<const bf16x8*>((const char*)Ks + KSWZ(r32, cb));
    bf16x8 b1 = *reinterpret_cast<const bf16x8*>((const char*)Ks + KSWZ(32 + r32, cb));
    p0 = __builtin_amdgcn_mfma_f32_32x32x16_bf16(b0, qr[d0], p0, 0, 0, 0);
    p1 = __builtin_amdgcn_mfma_f32_32x32x16_bf16(b1, qr[d0], p1, 0, 0, 0); }
}
#define QK_RD(A, B, D0) do { const int ad_ = kb + kx[D0]; asm volatile("ds_read_b128 %0, %1" : "=&v"(A) : "v"(ad_) : "memory"); asm volatile("ds_read_b128 %0, %1 offset:8192" : "=&v"(B) : "v"(ad_) : "memory"); } while (0)
#define QK_WAIT(N, A, B) asm volatile("s_waitcnt lgkmcnt(" #N ")" : "+v"(A), "+v"(B) :: "memory")
#define QK_MM(A, B, D0) do { p0 = __builtin_amdgcn_mfma_f32_32x32x16_bf16(A, qr[D0], p0, 0, 0, 0); p1 = __builtin_amdgcn_mfma_f32_32x32x16_bf16(B, qr[D0], p1, 0, 0, 0); } while (0)
__device__ __forceinline__ void qkt_pipe(f32x16& p0, f32x16& p1, int kb, const int (&kx)[8], const bf16x8* qr, float dq, float nsl, int side) {
  if (side != 0) {
    const float ns = side > 0 ? nsl : -nsl, t = ns * dq;
#pragma unroll
    for (int r = 0; r < 16; ++r) { const float c0 = (float)((r & 3) + 8 * (r >> 2)); p0[r] = fmaf(ns, -c0, t); p1[r] = fmaf(ns, -(c0 + 32.f), t); }
  } else {
#pragma unroll
    for (int r = 0; r < 16; ++r) { const float c0 = (float)((r & 3) + 8 * (r >> 2)); p0[r] = nsl * fabsf(dq - c0); p1[r] = nsl * fabsf(dq - (c0 + 32.f)); }
  }
  bf16x8 a0, b0, a1, b1, a2, b2, a3, b3;
  QK_RD(a0, b0, 0); QK_RD(a1, b1, 1); QK_RD(a2, b2, 2); QK_RD(a3, b3, 3);
  QK_WAIT(6, a0, b0); SBAR(); QK_MM(a0, b0, 0); QK_RD(a0, b0, 4);
  QK_WAIT(6, a1, b1); SBAR(); QK_MM(a1, b1, 1); QK_RD(a1, b1, 5);
  QK_WAIT(6, a2, b2); SBAR(); QK_MM(a2, b2, 2); QK_RD(a2, b2, 6);
  QK_WAIT(6, a3, b3); SBAR(); QK_MM(a3, b3, 3); QK_RD(a3, b3, 7);
  QK_WAIT(6, a0, b0); SBAR(); QK_MM(a0, b0, 4);
  QK_WAIT(4, a1, b1); SBAR(); QK_MM(a1, b1, 5);
  QK_WAIT(2, a2, b2); SBAR(); QK_MM(a2, b2, 6);
  QK_WAIT(0, a3, b3); SBAR(); QK_MM(a3, b3, 7);
}
#undef QK_RD
#undef QK_WAIT
#undef QK_MM
__device__ __forceinline__ int v_st(int k, int c) { const int kk = (k & ~0xC) | ((k & 4) << 1) | ((k & 8) >> 1); return ((kk >> 3) * 4 + (c >> 5)) * 512 + ((kk & 7) * 32 + (c & 31)) * 2; }
__device__ __forceinline__ int v_rd_base(int lane) { return ((lane & 3) << 3) | (((lane >> 2) & 3) << 6) | (((lane >> 4) & 1) << 5) | (((lane >> 5) & 1) << 8); }
constexpr int v_rd_off(int d0, int ks, int half) { return d0 * 512 + ks * 4096 + half * 2048; }
template <int OFF> __device__ __forceinline__ s16x4 tr_read(int vb) {
  s16x4 r; asm volatile("ds_read_b64_tr_b16 %0, %1 offset:%2" : "=&v"(r) : "v"(vb), "i"(OFF) : "memory"); return r;
}
template <int D0> __device__ __forceinline__ void pv_one(f32x16& od, int vb, bf16x8 pa0, bf16x8 pa1, bf16x8 pa2, bf16x8 pa3) {
  const s16x4 l0 = tr_read<v_rd_off(D0, 0, 0)>(vb), h0 = tr_read<v_rd_off(D0, 0, 1)>(vb), l1 = tr_read<v_rd_off(D0, 1, 0)>(vb), h1 = tr_read<v_rd_off(D0, 1, 1)>(vb);
  const s16x4 l2 = tr_read<v_rd_off(D0, 2, 0)>(vb), h2 = tr_read<v_rd_off(D0, 2, 1)>(vb), l3 = tr_read<v_rd_off(D0, 3, 0)>(vb), h3 = tr_read<v_rd_off(D0, 3, 1)>(vb);
  asm volatile("s_waitcnt lgkmcnt(0)" ::: "memory"); SBAR();
#define PK(L, H) (bf16x8){L[0], L[1], L[2], L[3], H[0], H[1], H[2], H[3]}
  od = __builtin_amdgcn_mfma_f32_32x32x16_bf16(pa0, PK(l0, h0), od, 0, 0, 0);
  od = __builtin_amdgcn_mfma_f32_32x32x16_bf16(pa1, PK(l1, h1), od, 0, 0, 0);
  od = __builtin_amdgcn_mfma_f32_32x32x16_bf16(pa2, PK(l2, h2), od, 0, 0, 0);
  od = __builtin_amdgcn_mfma_f32_32x32x16_bf16(pa3, PK(l3, h3), od, 0, 0, 0);
#undef PK
}
__device__ __forceinline__ void pv_d0(f32x16* o, int vb, bf16x8 pa0, bf16x8 pa1, bf16x8 pa2, bf16x8 pa3) {
  pv_one<0>(o[0], vb, pa0, pa1, pa2, pa3); pv_one<1>(o[1], vb, pa0, pa1, pa2, pa3); pv_one<2>(o[2], vb, pa0, pa1, pa2, pa3); pv_one<3>(o[3], vb, pa0, pa1, pa2, pa3);
}

#define PV_RD(F, D0) do { F##0 = tr_read<v_rd_off(D0, 0, 0)>(vb); F##1 = tr_read<v_rd_off(D0, 0, 1)>(vb); F##2 = tr_read<v_rd_off(D0, 1, 0)>(vb); F##3 = tr_read<v_rd_off(D0, 1, 1)>(vb); \
    F##4 = tr_read<v_rd_off(D0, 2, 0)>(vb); F##5 = tr_read<v_rd_off(D0, 2, 1)>(vb); F##6 = tr_read<v_rd_off(D0, 3, 0)>(vb); F##7 = tr_read<v_rd_off(D0, 3, 1)>(vb); } while (0)
#define PV_WAIT(N, F) asm volatile("s_waitcnt lgkmcnt(" #N ")" : "+v"(F##0), "+v"(F##1), "+v"(F##2), "+v"(F##3), "+v"(F##4), "+v"(F##5), "+v"(F##6), "+v"(F##7) :: "memory")
#define PV_PK(L, H) (bf16x8){L[0], L[1], L[2], L[3], H[0], H[1], H[2], H[3]}
#define PV_MM(OD, F) do { OD = __builtin_amdgcn_mfma_f32_32x32x16_bf16(pa0, PV_PK(F##0, F##1), OD, 0, 0, 0); OD = __builtin_amdgcn_mfma_f32_32x32x16_bf16(pa1, PV_PK(F##2, F##3), OD, 0, 0, 0); \
    OD = __builtin_amdgcn_mfma_f32_32x32x16_bf16(pa2, PV_PK(F##4, F##5), OD, 0, 0, 0); OD = __builtin_amdgcn_mfma_f32_32x32x16_bf16(pa3, PV_PK(F##6, F##7), OD, 0, 0, 0); } while (0)
__device__ __forceinline__ void pv_pipe(f32x16* o, int vb, bf16x8 pa0, bf16x8 pa1, bf16x8 pa2, bf16x8 pa3) {
  s16x4 a0, a1, a2, a3, a4, a5, a6, a7, b0, b1, b2, b3, b4, b5, b6, b7;
  PV_RD(a, 0);
  PV_RD(b, 1); PV_WAIT(8, a); SBAR(); PV_MM(o[0], a);
  PV_RD(a, 2); PV_WAIT(8, b); SBAR(); PV_MM(o[1], b);
  PV_RD(b, 3); PV_WAIT(8, a); SBAR(); PV_MM(o[2], a);
  PV_WAIT(0, b); SBAR(); PV_MM(o[3], b);
}
#undef PV_RD
#undef PV_WAIT
#undef PV_PK
#undef PV_MM

#define ATT_GAS __attribute__((address_space(1)))
struct UnitArgs {
  const ATT_GAS bf16* Q; long ldq;
  const ATT_GAS bf16* K; const ATT_GAS bf16* V; long ldk;
  int q0, L, kt0, nt;
  float nsl, radius, m_init, l_init;
  ATT_GAS float* Of; ATT_GAS bf16* Ob; long ldo;
  ATT_GAS float* lse; long ldl;
};

template <bool BAND, int SDEPTH>
__device__ __forceinline__ void attn_unit(const UnitArgs& a_in, char* lds) {
  UnitArgs a = a_in;
  asm volatile("" : "+s"(a.Q), "+s"(a.ldq), "+s"(a.K), "+s"(a.V), "+s"(a.ldk));
  asm volatile("" : "+s"(a.q0), "+s"(a.L), "+s"(a.kt0), "+s"(a.nt));
  asm volatile("" : "+s"(a.Of), "+s"(a.Ob), "+s"(a.ldo), "+s"(a.lse), "+s"(a.ldl));
  int tid_ = threadIdx.x; asm volatile("" : "+v"(tid_));
  const int tid = tid_, wid = tid >> 6, lane = tid & 63, r32 = lane & 31, hi = lane >> 5;
  bf16* V_lds = (bf16*)lds; bf16* K_lds = (bf16*)(lds + 2 * SHM_V);
  float* ws = (float*)(lds + 2 * SHM_V + 2 * SHM_K) + wid * 64; float* li_l = ws; float* al_l = ws + 32;
  float m_reg = a.m_init, l_reg = a.l_init; f32x16 o[4] = {}; bf16x8 qr[8];
  const ATT_GAS bf16* Qw = a.Q + (long)(wid * QBLK + r32) * a.ldq + hi * 8;
#pragma unroll
  for (int d0 = 0; d0 < 8; ++d0) qr[d0] = *reinterpret_cast<const ATT_GAS bf16x8*>(Qw + d0 * 16);
  const int sr = tid >> 4, sc = (tid & 15) * 8, vst0 = v_st(sr, sc), vst1 = v_st(32 + sr, sc);
  const int vb0 = (int)(uintptr_t)V_lds + v_rd_base(lane);
  const float qf = (float)(a.q0 + wid * QBLK + r32), Lf = (float)a.L, nsl = a.nsl, radius = a.radius;
  const int Lm1 = a.L - 1, kt0 = a.kt0, qw0 = a.q0 + __builtin_amdgcn_readfirstlane(wid) * QBLK;
  const ATT_GAS bf16* Kp = a.K; const ATT_GAS bf16* Vp = a.V; const long ldk = a.ldk;
  struct { bf16x8 vs0, vs1, ks0, ks1; } sr_[SDEPTH];
  const unsigned lofs = (unsigned)((sr * ldk + sc) * 2);
  const ATT_GAS char* Kc = (const ATT_GAS char*)Kp; const ATT_GAS char* Vc = (const ATT_GAS char*)Vp; const long ldk32 = 32 * ldk * 2, ldk64 = 64 * ldk * 2;
#define SLOAD(i, t) do { if constexpr (BAND) { const int k0_ = (kt0 + (t)) * KVBLK; int ra_ = k0_ + sr, rb_ = k0_ + 32 + sr;                   \
    ra_ = ra_ < 0 ? 0 : (ra_ > Lm1 ? Lm1 : ra_); rb_ = rb_ < 0 ? 0 : (rb_ > Lm1 ? Lm1 : rb_);                                          \
    sr_[i].vs0 = *reinterpret_cast<const ATT_GAS bf16x8*>(&Vp[(long)ra_ * ldk + sc]); sr_[i].vs1 = *reinterpret_cast<const ATT_GAS bf16x8*>(&Vp[(long)rb_ * ldk + sc]); \
    sr_[i].ks0 = *reinterpret_cast<const ATT_GAS bf16x8*>(&Kp[(long)ra_ * ldk + sc]); sr_[i].ks1 = *reinterpret_cast<const ATT_GAS bf16x8*>(&Kp[(long)rb_ * ldk + sc]); } \
  else { const long tb_ = (long)(kt0 + (t)) * ldk64;                                                                                       \
    sr_[i].vs0 = *reinterpret_cast<const ATT_GAS bf16x8*>(Vc + tb_ + lofs); sr_[i].vs1 = *reinterpret_cast<const ATT_GAS bf16x8*>(Vc + tb_ + ldk32 + lofs); \
    sr_[i].ks0 = *reinterpret_cast<const ATT_GAS bf16x8*>(Kc + tb_ + lofs); sr_[i].ks1 = *reinterpret_cast<const ATT_GAS bf16x8*>(Kc + tb_ + ldk32 + lofs); } } while (0)
#define SWRITE(b, i) do { *(bf16x8*)((char*)V_lds + (b) * SHM_V + vst0) = sr_[i].vs0;          \
    *(bf16x8*)((char*)V_lds + (b) * SHM_V + vst1) = sr_[i].vs1; int kc = sc * 2;               \
    *(bf16x8*)((char*)K_lds + (b) * SHM_K + KSWZ(sr, kc)) = sr_[i].ks0;                       \
    *(bf16x8*)((char*)K_lds + (b) * SHM_K + KSWZ(32 + sr, kc)) = sr_[i].ks1; } while (0)
#define SWAIT() do { if constexpr (SDEPTH == 2) asm volatile("s_waitcnt vmcnt(4)" ::: "memory"); else asm volatile("s_waitcnt vmcnt(0)" ::: "memory"); } while (0)
#define RESC(al) do { if (__any((al) < 1.f)) { if (hi == 0) al_l[r32] = (al); asm volatile("s_waitcnt lgkmcnt(0)" ::: "memory"); \
    _Pragma("unroll") for (int d = 0; d < 4; ++d) _Pragma("unroll") for (int r = 0; r < 16; ++r) o[d][r] *= al_l[crow(r, hi)]; } } while (0)
#define QKT(PA, PB, buf, t) do { const int k0_ = (kt0 + (t)) * KVBLK; const float kf0_ = (float)(k0_ + 4 * hi); \
    const int side_ = (k0_ + KVBLK - 1 < qw0) ? 1 : ((k0_ > qw0 + QBLK - 1) ? -1 : 0); \
    qkt<BAND>(PA, PB, (bf16*)((char*)K_lds + (buf) * SHM_K), qr, r32, hi, qf - kf0_, kf0_, nsl, radius, Lf, side_); } while (0)
  f32x16 pA0, pA1, pB0, pB1; float mnA, mnB, alA, alB; bf16x8 pa0, pa1, pa2, pa3; const int NT = a.nt;
  constexpr int SE = 0, SO = SDEPTH - 1;
  SLOAD(SE, 0); asm volatile("s_waitcnt vmcnt(0)" ::: "memory"); SWRITE(0, SE); __syncthreads();
  QKT(pA0, pA1, 0, 0); partialSM(pA0, pA1, m_reg, mnA, alA);
  SLOAD(SO, 1); if constexpr (SDEPTH == 2) { if (2 < NT) SLOAD(SE, 2); }
  SWAIT(); SWRITE(1, SO); __syncthreads();
  for (int j = 1; j + 1 < NT; j += 2) {
    SBAR(); QKT(pB0, pB1, 1, j);
    finishSM(pA0, pA1, alA, l_reg, pa0, pa1, pa2, pa3); SBAR();
    SLOAD(SO, j + SDEPTH); SBAR();
    pv_d0(o, vb0, pa0, pa1, pa2, pa3); partialSM(pB0, pB1, m_reg, mnB, alB);
    __syncthreads(); SWAIT(); SWRITE(0, SE);
    RESC(alB); __syncthreads();
    SBAR(); QKT(pA0, pA1, 0, j + 1);
    finishSM(pB0, pB1, alB, l_reg, pa0, pa1, pa2, pa3); SBAR();
    if (SDEPTH == 1 || j + 3 < NT) SLOAD(SE, j + 1 + SDEPTH); SBAR();
    pv_d0(o, vb0 + (int)SHM_V, pa0, pa1, pa2, pa3); partialSM(pA0, pA1, m_reg, mnA, alA);
    __syncthreads(); SWAIT(); SWRITE(1, SO);
    RESC(alA); __syncthreads();
  }
  SBAR(); QKT(pB0, pB1, 1, NT - 1);
  finishSM(pA0, pA1, alA, l_reg, pa0, pa1, pa2, pa3); SBAR();
  pv_d0(o, vb0, pa0, pa1, pa2, pa3); partialSM(pB0, pB1, m_reg, mnB, alB);
  __syncthreads(); RESC(alB);
  finishSM(pB0, pB1, alB, l_reg, pa0, pa1, pa2, pa3); SBAR();
  pv_d0(o, vb0 + (int)SHM_V, pa0, pa1, pa2, pa3);
  if (hi == 0) li_l[r32] = l_reg; asm volatile("s_waitcnt lgkmcnt(0)" ::: "memory");
  float rli[16];
#pragma unroll
  for (int r = 0; r < 16; ++r) rli[r] = __builtin_amdgcn_rcpf(li_l[crow(r, hi)]);
  if (a.Of) {
    ATT_GAS float* Ow = a.Of + (long)(wid * QBLK) * a.ldo;
#pragma unroll
    for (int r = 0; r < 16; ++r) { const int orow = crow(r, hi);
#pragma unroll
      for (int d0 = 0; d0 < 4; ++d0) Ow[(long)orow * a.ldo + d0 * 32 + r32] = o[d0][r] * rli[r]; }
  } else {
    ATT_GAS bf16* Ow = a.Ob + (long)(wid * QBLK) * a.ldo;
#pragma unroll
    for (int r = 0; r < 16; ++r) { const int orow = crow(r, hi);
#pragma unroll
      for (int d0 = 0; d0 < 4; ++d0) { const float v = o[d0][r] * rli[r]; Ow[(long)orow * a.ldo + d0 * 32 + r32] = (bf16)(cvtpk(v, v) & 0xffffu); } }
  }
  if (a.lse && hi == 0) a.lse[(long)(wid * QBLK + r32) * a.ldl] = m_reg * SCALE + __logf(l_reg);
  __syncthreads();
#undef SLOAD
#undef SWRITE
#undef SWAIT
#undef RESC
#undef QKT
}

constexpr int PU_K0 = 0, PU_V0 = 32768, PU_PS = 98304, PU_LDS = 131072;
struct PairArgs {
  const ATT_GAS bf16* Q; long ldq;
  const ATT_GAS bf16* K; const ATT_GAS bf16* V; long ldk;
  int q0, kt0, nt;
  float nsl;
  ATT_GAS float* O; long ldo;
};
__device__ __forceinline__ void attn_pair_unit(const PairArgs& a_in, char* lds, float* xs  ) {
  PairArgs a = a_in;
  asm volatile("" : "+s"(a.Q), "+s"(a.ldq), "+s"(a.K), "+s"(a.V), "+s"(a.ldk));
  asm volatile("" : "+s"(a.q0), "+s"(a.kt0), "+s"(a.nt), "+s"(a.O), "+s"(a.ldo));
  int tid_ = threadIdx.x; asm volatile("" : "+v"(tid_));
  const int tid = tid_, wid = tid >> 6, lane = tid & 63, r32 = lane & 31, hi = lane >> 5;
  const int pr = __builtin_amdgcn_readfirstlane(wid & 3), role = __builtin_amdgcn_readfirstlane(wid >> 2);
  constexpr float C = SCALE * 1.4426950408889634f;
  float* AL = xs; float* MX = xs + 256; float* LL = xs + 512; float* FL = xs + 768;
  f32x16 o[4] = {}; bf16x8 qr[8]; bf16x8 pa0, pa1, pa2, pa3; float l_part = 0.f;
  pa0 = pa1 = pa2 = pa3 = bf16x8{};
  const ATT_GAS bf16* Qw = a.Q + (long)(pr * QBLK + r32) * a.ldq + hi * 8;
#pragma unroll
  for (int d0 = 0; d0 < 8; ++d0) qr[d0] = *reinterpret_cast<const ATT_GAS bf16x8*>(Qw + d0 * 16);
  const int sr = tid >> 4, sc = (tid & 15) * 8, vr = tid >> 5, vc = (tid & 31) * 8;
  const int ksw0 = KSWZ(sr, sc * 2), ksw1 = KSWZ(32 + sr, sc * 2);
  const int vhalf = (vc >> 7) * 16384, vcc = vc & 127;
  const int vst[4] = {vhalf + v_st(vr, vcc), vhalf + v_st(vr + 16, vcc), vhalf + v_st(vr + 32, vcc), vhalf + v_st(vr + 48, vcc)};
  const unsigned kofs = (unsigned)((sr * a.ldk + sc) * 2), vofs = (unsigned)((vr * a.ldk + vc) * 2);
  const ATT_GAS char* Kc = (const ATT_GAS char*)a.K; const ATT_GAS char* Vc = (const ATT_GAS char*)a.V;
  const long ldk16 = 16 * a.ldk * 2, ldk32 = 32 * a.ldk * 2, ldk64 = 64 * a.ldk * 2;
  const int vb0 = (int)(uintptr_t)(lds + PU_V0) + role * 16384 + v_rd_base(lane);
  const float qf = (float)(a.q0 + pr * QBLK + r32), nsl = a.nsl; const int kt0 = a.kt0, qw0 = a.q0 + pr * QBLK, NT = a.nt;
  struct { bf16x8 k0, k1, v0, v1, v2, v3; } sg[2];
#define PLOADK(i, t) do { const long tb_ = (long)(kt0 + (t)) * ldk64; sg[i].k0 = *reinterpret_cast<const ATT_GAS bf16x8*>(Kc + tb_ + kofs); sg[i].k1 = *reinterpret_cast<const ATT_GAS bf16x8*>(Kc + tb_ + ldk32 + kofs); } while (0)
#define PLOADV(i, t) do { const long tb_ = (long)(kt0 + (t)) * ldk64; sg[i].v0 = *reinterpret_cast<const ATT_GAS bf16x8*>(Vc + tb_ + vofs); sg[i].v1 = *reinterpret_cast<const ATT_GAS bf16x8*>(Vc + tb_ + ldk16 + vofs); \
    sg[i].v2 = *reinterpret_cast<const ATT_GAS bf16x8*>(Vc + tb_ + 2 * ldk16 + vofs); sg[i].v3 = *reinterpret_cast<const ATT_GAS bf16x8*>(Vc + tb_ + 3 * ldk16 + vofs); } while (0)
#define PWRITEK(b, i) do { char* kb_ = lds + PU_K0 + (b) * 16384; *(bf16x8*)(kb_ + ksw0) = sg[i].k0; *(bf16x8*)(kb_ + ksw1) = sg[i].k1; } while (0)
#define PWRITEV(b, i) do { char* vb_ = lds + PU_V0 + (b) * 32768; *(bf16x8*)(vb_ + vst[0]) = sg[i].v0; *(bf16x8*)(vb_ + vst[1]) = sg[i].v1; *(bf16x8*)(vb_ + vst[2]) = sg[i].v2; *(bf16x8*)(vb_ + vst[3]) = sg[i].v3; } while (0)
#define PSTEP(t, TP) do {                                                                                                                        \
    if ((t) + 2 < NT) PLOADK(TP, (t) + 2);                                                                                                        \
    if ((t) + 1 < NT) PLOADV(TP, (t) + 1);                                                                                                        \
    SBAR();                                                                                                                                       \
    if ((t) >= 1) {                                                                                    \
      const int sp_ = ((TP) ^ 1) * 4 + pr;                                                                                                        \
      if (role == (TP)) {                              \
        const char* ps_ = lds + PU_PS + sp_ * 4096 + lane * 16;                                                                                   \
        pa0 = *(const bf16x8*)(ps_); pa1 = *(const bf16x8*)(ps_ + 1024); pa2 = *(const bf16x8*)(ps_ + 2048); pa3 = *(const bf16x8*)(ps_ + 3072);   \
        l_part *= AL[sp_ * 32 + r32];                                                                                                             \
      }                                                                                                                                           \
      if (__builtin_amdgcn_readfirstlane(__float_as_int(FL[sp_])) != 0) {                                                                         \
        _Pragma("unroll") for (int r = 0; r < 16; ++r) { const float al_ = AL[sp_ * 32 + crow(r, hi)];                                            \
          _Pragma("unroll") for (int d = 0; d < 4; ++d) o[d][r] *= al_; } }                                                                       \
      pv_pipe(o, vb0 + ((TP) ^ 1) * 32768, pa0, pa1, pa2, pa3);                                                                                     \
    }                                                                                                                                             \
    if (role == (TP) && (t) < NT) {                                                                      \
      float m_reg = M_INIT; if ((t) >= 1) m_reg = MX[(((TP) ^ 1) * 4 + pr) * 32 + r32];                                                          \
      f32x16 p0, p1; const int k0_ = (kt0 + (t)) * KVBLK; const float kf0_ = (float)(k0_ + 4 * hi);                                               \
      const int side_ = (k0_ + KVBLK - 1 < qw0) ? 1 : ((k0_ > qw0 + QBLK - 1) ? -1 : 0);                                                          \
      qkt<false>(p0, p1, (const bf16*)(lds + PU_K0 + (TP) * 16384), qr, r32, hi, qf - kf0_, kf0_, nsl, 0.f, 0.f, side_);                          \
      float mn_, al_; partialSM(p0, p1, m_reg, mn_, al_);                                                                                         \
      float l_new = l_part; finishSM(p0, p1, al_, l_new, pa0, pa1, pa2, pa3); l_part = l_new;                                                     \
      const int sc_ = (TP) * 4 + pr; char* ps_ = lds + PU_PS + sc_ * 4096 + lane * 16;                                                            \
      *(bf16x8*)(ps_) = pa0; *(bf16x8*)(ps_ + 1024) = pa1; *(bf16x8*)(ps_ + 2048) = pa2; *(bf16x8*)(ps_ + 3072) = pa3;                           \
      if (hi == 0) { AL[sc_ * 32 + r32] = al_; MX[sc_ * 32 + r32] = mn_; }                                                                        \
      const bool any_ = __any(al_ < 1.f); if (lane == 0) FL[sc_] = any_ ? 1.f : 0.f;                                                              \
    }                                                                                                                                             \
    SBAR();                                                                                                                                       \
    if ((t) + 1 < NT) PWRITEK((TP) ^ 1, (TP) ^ 1);                                    \
    if ((t) < NT) PWRITEV(TP, (TP) ^ 1);                                                                                                 \
    asm volatile("s_waitcnt lgkmcnt(0)" ::: "memory"); __syncthreads();                                                                           \
  } while (0)
  PLOADK(0, 0); PWRITEK(0, 0);
  if (1 < NT) PLOADK(1, 1);
  PLOADV(1, 0);
  asm volatile("s_waitcnt lgkmcnt(0)" ::: "memory"); __syncthreads();
  for (int t = 0; t <= NT; t += 2) {
    PSTEP(t, 0);
    if (t + 1 <= NT) PSTEP(t + 1, 1);
  }
  if (hi == 0) LL[(pr * 2 + role) * 32 + r32] = l_part;
  asm volatile("s_waitcnt lgkmcnt(0)" ::: "memory"); __syncthreads();
  float rli[16];
#pragma unroll
  for (int r = 0; r < 16; ++r) rli[r] = __builtin_amdgcn_rcpf(LL[(pr * 2) * 32 + crow(r, hi)] + LL[(pr * 2 + 1) * 32 + crow(r, hi)]);
  ATT_GAS float* Ow = a.O + (long)(pr * QBLK) * a.ldo + role * 128;
#pragma unroll
  for (int r = 0; r < 16; ++r) { const int orow = crow(r, hi);
#pragma unroll
    for (int d0 = 0; d0 < 4; ++d0) Ow[(long)orow * a.ldo + d0 * 32 + r32] = o[d0][r] * rli[r]; }
  __syncthreads();
#undef PLOADK
#undef PLOADV
#undef PWRITEK
#undef PWRITEV
#undef PSTEP
}

__device__ __forceinline__ void attn_split_unit(const PairArgs& a_in, char* lds, float* xs  ) {
  PairArgs a = a_in;
  asm volatile("" : "+s"(a.Q), "+s"(a.ldq), "+s"(a.K), "+s"(a.V), "+s"(a.ldk));
  asm volatile("" : "+s"(a.q0), "+s"(a.kt0), "+s"(a.nt), "+s"(a.O), "+s"(a.ldo));
  int tid_ = threadIdx.x; asm volatile("" : "+v"(tid_));
  const int tid = tid_, wid = tid >> 6, lane = tid & 63, r32 = lane & 31, hi = lane >> 5;
  const int pr = __builtin_amdgcn_readfirstlane(wid & 3), role = __builtin_amdgcn_readfirstlane(wid >> 2);
  float* AL = xs; float* LL = xs + 256; float* FL = xs + 512;
  const int t8 = tid & 255, sr = t8 >> 4, sc = (t8 & 15) * 8, vr = t8 >> 5, vc = (t8 & 31) * 8;
  const int ksw0 = KSWZ(sr, sc * 2), ksw1 = KSWZ(sr + 16, sc * 2), ksw2 = KSWZ(sr + 32, sc * 2), ksw3 = KSWZ(sr + 48, sc * 2);
  const int vhalf = (vc >> 7) * 16384, vcc = vc & 127;
  const unsigned kofs = (unsigned)((sr * a.ldk + sc) * 2), vofs = (unsigned)((vr * a.ldk + vc) * 2);
  const ATT_GAS char* Kc = (const ATT_GAS char*)a.K; const ATT_GAS char* Vc = (const ATT_GAS char*)a.V;
  const long ldk8 = 8 * a.ldk * 2, ldk16 = 16 * a.ldk * 2, ldk64 = 64 * a.ldk * 2;
  const int kt0 = a.kt0, NT = a.nt;
#define PLOADK(t) do { const long tb_ = (long)(kt0 + (t)) * ldk64; sk0 = *reinterpret_cast<const ATT_GAS bf16x8*>(Kc + tb_ + kofs); sk1 = *reinterpret_cast<const ATT_GAS bf16x8*>(Kc + tb_ + ldk16 + kofs); \
    sk2 = *reinterpret_cast<const ATT_GAS bf16x8*>(Kc + tb_ + 2 * ldk16 + kofs); sk3 = *reinterpret_cast<const ATT_GAS bf16x8*>(Kc + tb_ + 3 * ldk16 + kofs); } while (0)
#define PLOADV(t) do { const ATT_GAS char* vp_ = Vc + (long)(kt0 + (t)) * ldk64 + vofs; sv0 = *reinterpret_cast<const ATT_GAS bf16x8*>(vp_); sv1 = *reinterpret_cast<const ATT_GAS bf16x8*>(vp_ + ldk8); \
    sv2 = *reinterpret_cast<const ATT_GAS bf16x8*>(vp_ + 2 * ldk8); sv3 = *reinterpret_cast<const ATT_GAS bf16x8*>(vp_ + 3 * ldk8); sv4 = *reinterpret_cast<const ATT_GAS bf16x8*>(vp_ + 4 * ldk8); \
    sv5 = *reinterpret_cast<const ATT_GAS bf16x8*>(vp_ + 5 * ldk8); sv6 = *reinterpret_cast<const ATT_GAS bf16x8*>(vp_ + 6 * ldk8); sv7 = *reinterpret_cast<const ATT_GAS bf16x8*>(vp_ + 7 * ldk8); } while (0)
#define PWRITEK(b) do { char* kb_ = lds + PU_K0 + (b) * 16384; *(bf16x8*)(kb_ + ksw0) = sk0; *(bf16x8*)(kb_ + ksw1) = sk1; *(bf16x8*)(kb_ + ksw2) = sk2; *(bf16x8*)(kb_ + ksw3) = sk3; } while (0)
#define PWRITEV(b) do { char* vb_ = lds + PU_V0 + (b) * 32768 + vhalf; *(bf16x8*)(vb_ + v_st(vr, vcc)) = sv0; *(bf16x8*)(vb_ + v_st(vr + 8, vcc)) = sv1; *(bf16x8*)(vb_ + v_st(vr + 16, vcc)) = sv2; \
    *(bf16x8*)(vb_ + v_st(vr + 24, vcc)) = sv3; *(bf16x8*)(vb_ + v_st(vr + 32, vcc)) = sv4; *(bf16x8*)(vb_ + v_st(vr + 40, vcc)) = sv5; *(bf16x8*)(vb_ + v_st(vr + 48, vcc)) = sv6; \
    *(bf16x8*)(vb_ + v_st(vr + 56, vcc)) = sv7; } while (0)
#define SYNC_ONLY() do { asm volatile("s_waitcnt lgkmcnt(0)" ::: "memory"); __syncthreads(); } while (0)
  if (role == 0) {
    bf16x8 sk0, sk1, sk2, sk3;
    PLOADK(0); PWRITEK(0);
    SYNC_ONLY();
    bf16x8 qr[8]; float m_reg = M_INIT, l_reg = 0.f;
    const ATT_GAS bf16* Qw = a.Q + (long)(pr * QBLK + r32) * a.ldq + hi * 8;
#pragma unroll
    for (int d0 = 0; d0 < 8; ++d0) qr[d0] = *reinterpret_cast<const ATT_GAS bf16x8*>(Qw + d0 * 16);
    asm volatile("" : "+v"(qr[0]), "+v"(qr[1]), "+v"(qr[2]), "+v"(qr[3]), "+v"(qr[4]), "+v"(qr[5]), "+v"(qr[6]), "+v"(qr[7]));
    const float qf = (float)(a.q0 + pr * QBLK + r32), nsl = a.nsl; const int qw0 = a.q0 + pr * QBLK;
    const int kb0 = (int)(uintptr_t)(lds + PU_K0) + r32 * 256;
    int kx[8];
#pragma unroll
    for (int d0 = 0; d0 < 8; ++d0) kx[d0] = ((d0 * 16 + hi * 8) * 2) ^ ((r32 & 7) << 4);
#define SSTEP(t, TP) do { if ((t) + 1 < NT) PLOADK((t) + 1); SBAR();                                                                                                      \
      if ((t) < NT) {                                                                                                                             \
        f32x16 p0, p1; const int k0_ = (kt0 + (t)) * KVBLK; const float kf0_ = (float)(k0_ + 4 * hi);                                             \
        const int side_ = (k0_ + KVBLK - 1 < qw0) ? 1 : ((k0_ > qw0 + QBLK - 1) ? -1 : 0);                                                        \
        __builtin_amdgcn_s_setprio(2); qkt_pipe(p0, p1, kb0 + (TP) * 16384, kx, qr, qf - kf0_, nsl, side_); __builtin_amdgcn_s_setprio(0);         \
        float mn_, al_; bf16x8 pa0, pa1, pa2, pa3; partialSM(p0, p1, m_reg, mn_, al_); finishSM(p0, p1, al_, l_reg, pa0, pa1, pa2, pa3);          \
        const int sc_ = (TP) * 4 + pr; char* ps_ = lds + PU_PS + sc_ * 4096 + lane * 16;                                                          \
        *(bf16x8*)(ps_) = pa0; *(bf16x8*)(ps_ + 1024) = pa1; *(bf16x8*)(ps_ + 2048) = pa2; *(bf16x8*)(ps_ + 3072) = pa3;                         \
        if (hi == 0) AL[sc_ * 32 + r32] = al_;                                                                                                    \
        const bool any_ = __any(al_ < 1.f); if (lane == 0) FL[sc_] = any_ ? 1.f : 0.f;                                                            \
      }                                                                                                                                           \
      SBAR(); if ((t) + 1 < NT) PWRITEK((TP) ^ 1); SYNC_ONLY(); } while (0)
    for (int t = 0; t <= NT; t += 2) { SSTEP(t, 0); if (t + 1 <= NT) SSTEP(t + 1, 1); }
#undef SSTEP
    if (hi == 0) LL[pr * 32 + r32] = l_reg;
    asm volatile("s_waitcnt lgkmcnt(0)" ::: "memory"); __syncthreads();
  } else {
    f32x16 o[8] = {};
    const int vb0 = (int)(uintptr_t)(lds + PU_V0) + v_rd_base(lane);
    bf16x8 sv0, sv1, sv2, sv3, sv4, sv5, sv6, sv7;
    SYNC_ONLY();
#define VSTEP(t, TP) do { if ((t) < NT) PLOADV(t); SBAR();                                                                                        \
      if ((t) >= 1) {                                                                                                                             \
        const int sp_ = ((TP) ^ 1) * 4 + pr; const char* ps_ = lds + PU_PS + sp_ * 4096 + lane * 16;                                              \
        const bf16x8 pa0 = *(const bf16x8*)(ps_), pa1 = *(const bf16x8*)(ps_ + 1024), pa2 = *(const bf16x8*)(ps_ + 2048), pa3 = *(const bf16x8*)(ps_ + 3072); \
        if (__builtin_amdgcn_readfirstlane(__float_as_int(FL[sp_])) != 0) {                                                                       \
          _Pragma("unroll") for (int r = 0; r < 16; ++r) { const float al_ = AL[sp_ * 32 + crow(r, hi)];                                          \
            _Pragma("unroll") for (int d = 0; d < 8; ++d) o[d][r] *= al_; } }                                                                     \
        pv_pipe(o, vb0 + ((TP) ^ 1) * 32768, pa0, pa1, pa2, pa3);                                                                                 \
        pv_pipe(o + 4, vb0 + ((TP) ^ 1) * 32768 + 16384, pa0, pa1, pa2, pa3);                                                                     \
      }                                                                                                                                           \
      SBAR(); if ((t) < NT) PWRITEV(TP); SYNC_ONLY(); } while (0)
    for (int t = 0; t <= NT; t += 2) { VSTEP(t, 0); if (t + 1 <= NT) VSTEP(t + 1, 1); }
#undef VSTEP
    asm volatile("s_waitcnt lgkmcnt(0)" ::: "memory"); __syncthreads();
    float rli[16];
#pragma unroll
    for (int r = 0; r < 16; ++r) rli[r] = __builtin_amdgcn_rcpf(LL[pr * 32 + crow(r, hi)]);
    ATT_GAS float* Ow = a.O + (long)(pr * QBLK) * a.ldo;
#pragma unroll
    for (int r = 0; r < 16; ++r) { const int orow = crow(r, hi);
#pragma unroll
      for (int d0 = 0; d0 < 8; ++d0) Ow[(long)orow * a.ldo + d0 * 32 + r32] = o[d0][r] * rli[r]; }
  }
  __syncthreads();
#undef PLOADK
#undef PLOADV
#undef PWRITEK
#undef PWRITEV
#undef SYNC_ONLY
}
#undef KSWZ
#undef SBAR
}
constexpr int DM = 2048, BATCH = 2, SEQ = 4096, DEPTH = 4, M = BATCH * SEQ;
constexpr int AB_IN = 3584, AB_OUT = 1024, C_IN = 6144, DFF = 5504, UPW = 2 * DFF, MODW = 6 * DM;
constexpr float EPS = 1e-6f;
constexpr int NWAVES = 8;
constexpr size_t MiB = 1u << 20;
constexpr size_t WS_CTL = 0, CTL_ZERO_BYTES = 2 * MiB;
constexpr size_t WS_MOD = 2 * MiB;
constexpr size_t WS_PART = 3 * MiB;
constexpr size_t WS_NRM = 12 * MiB;
constexpr size_t WS_WABIN = 16 * MiB;
constexpr size_t WS_WABOUT = 44 * MiB;
constexpr size_t WS_WCIN = 52 * MiB;
constexpr size_t WS_WCOUT = 100 * MiB;
constexpr size_t WS_WUP = 116 * MiB;
constexpr size_t WS_WDOWN = 288 * MiB;
constexpr size_t WS_H = 376 * MiB;
constexpr size_t WS_PROJ = 408 * MiB;
constexpr size_t WS_ATT = 504 * MiB;
constexpr size_t WS_LSE = WS_ATT + 64 * MiB;
constexpr size_t WS_O = 632 * MiB;
constexpr size_t WS_Y = 664 * MiB;
constexpr size_t WS_HG = 728 * MiB;
constexpr size_t WS_HU = 732 * MiB;
constexpr size_t WS_ACT = 900 * MiB;
constexpr size_t WS_END = 986 * MiB;
static_assert(WS_PART + (size_t)DEPTH * 16 * BATCH * MODW * 4 <= WS_WABIN, "ws map");
static_assert(WS_WABIN + (size_t)2 * AB_IN * DM * 2 <= WS_WABOUT && WS_WABOUT + (size_t)2 * DM * AB_OUT * 2 <= WS_WCIN, "ws map");
static_assert(WS_WCIN + (size_t)2 * C_IN * DM * 2 <= WS_WCOUT && WS_WCOUT + (size_t)2 * DM * DM * 2 <= WS_WUP, "ws map");
static_assert(WS_WUP + (size_t)4 * UPW * DM * 2 <= WS_WDOWN && WS_WDOWN + (size_t)4 * DM * DFF * 2 <= WS_H, "ws map");
static_assert(WS_H + (size_t)M * DM * 2 <= WS_PROJ && WS_PROJ + (size_t)M * C_IN * 2 <= WS_ATT && WS_ATT + (size_t)2 * M * DM * 4 <= WS_O, "ws map");
static_assert(WS_ATT + (size_t)3 * M * 512 * 4 <= WS_LSE && WS_LSE + (size_t)3 * M * 4 * 4 <= WS_O, "ws map");
static_assert(WS_O + (size_t)M * DM * 2 <= WS_Y && WS_Y + (size_t)M * DM * 4 <= WS_HG && WS_HG + (size_t)(M / 256) * 4 * DFF * 4 <= WS_HU && WS_HU + (size_t)(M / 256) * 2 * DFF * 4 <= WS_ACT && WS_ACT + (size_t)M * DFF * 2 <= WS_END, "ws map");
constexpr int CW_BAR = 4096;
constexpr int RING_OFF = 0, RING_BYTES = 131072;
constexpr int LDSCTL_OFF = RING_BYTES, MISC_OFF = LDSCTL_OFF + 320, BND_OFF = LDSCTL_OFF + 1024;
constexpr int LDS_BYTES = 147456;
static_assert(att::SHM_ATTN <= RING_BYTES && att::PU_LDS <= RING_BYTES, "attention LDS fits the ring region");

#define GAS __attribute__((address_space(1)))
#define LAS __attribute__((address_space(3)))
typedef unsigned short bf16;
typedef unsigned v4u __attribute__((ext_vector_type(4)));
typedef unsigned v2u __attribute__((ext_vector_type(2)));
typedef float f32x4 __attribute__((ext_vector_type(4)));
typedef GAS unsigned gu32;
#define LDS_WAIT() asm volatile("s_waitcnt lgkmcnt(0)" ::: "memory")
__device__ __forceinline__ unsigned pk2(float lo, float hi) { unsigned r; asm volatile("v_cvt_pk_bf16_f32 %0, %1, %2" : "=v"(r) : "v"(lo), "v"(hi)); return r; }
__device__ __forceinline__ float bf_lo(unsigned w) { return __uint_as_float(w << 16); }
__device__ __forceinline__ float bf_hi(unsigned w) { return __uint_as_float(w & 0xffff0000u); }
#define XB_TMO      128
#define XB_XCNT(j)  (256  + 64 * (j))
#define XB_XSUB(j)  (1280 + 64 * (j))
#define XB_XGEN(j)  (2304 + 64 * (j))
#define XB_TOP      3328
#define XB_TOPGEN   3392
#define XCD_BAR_WORDS 3456
#define XB_SPIN_CAP (1u << 18)

__device__ __forceinline__ unsigned xb_ld(unsigned* p)              { return __hip_atomic_load(p, __ATOMIC_RELAXED, __HIP_MEMORY_SCOPE_AGENT); }
__device__ __forceinline__ unsigned xb_add(unsigned* p, unsigned v) { return __hip_atomic_fetch_add(p, v, __ATOMIC_RELAXED, __HIP_MEMORY_SCOPE_AGENT); }
__device__ __forceinline__ unsigned xb_xcc_id() { return (unsigned)__builtin_amdgcn_s_getreg((3 << 11) | 20) & 0xFu; }
#define XB_SPIN(cond, bar) do { unsigned _sp = 0; while (cond) { __builtin_amdgcn_s_sleep(1); \
    if ((++_sp & 255u) == 0u) { if (xb_ld(&(bar)[XB_TMO])) break; if (_sp > XB_SPIN_CAP) { atomicAdd(&(bar)[XB_TMO], 1u); break; } } } } while (0)

struct XcdBarrier {
    unsigned* bar; unsigned x;
    volatile LAS unsigned* st;
};

__device__ __forceinline__ XcdBarrier xcd_barrier_post(unsigned* bar, volatile LAS unsigned* st) {
    XcdBarrier b; b.bar = bar; b.x = xb_xcc_id(); b.st = st;
    if (threadIdx.x == 0) (void)xb_add(&bar[XB_XCNT(b.x)], 1u);
    return b;
}
__device__ __forceinline__ void xcd_barrier_complete(unsigned* bar, unsigned x, unsigned& nloc, unsigned& nx) {
    const unsigned G = gridDim.x * gridDim.y * gridDim.z;
    unsigned sum, cnt, mine, sp = 0u;
    for (;;) {
        sum = 0u; cnt = 0u; mine = 0u;
#pragma unroll
        for (unsigned j = 0; j < 16; ++j) { const unsigned c = xb_ld(&bar[XB_XCNT(j)]); sum += c; cnt += (c > 0u) ? 1u : 0u; mine = (j == x) ? c : mine; }
        if (sum == G) break;
        __builtin_amdgcn_s_sleep(1);
        if ((++sp & 255u) == 0u) { if (xb_ld(&bar[XB_TMO])) break; if (sp > XB_SPIN_CAP) { atomicAdd(&bar[XB_TMO], 1u); break; } }
    }
    nloc = mine > 0u ? mine : 1u; nx = cnt > 0u ? cnt : 1u;
}

__device__ __forceinline__ void xcd_barrier(const XcdBarrier& b) {
    asm volatile("s_waitcnt vmcnt(0)" ::: "memory");
    __syncthreads();
    if (threadIdx.x == 0) {
        unsigned* bar = b.bar;
        __builtin_amdgcn_s_waitcnt(0);
        unsigned nloc = b.st[0], nx = b.st[1];
        if (nloc == 0u) { xcd_barrier_complete(bar, b.x, nloc, nx); b.st[0] = nloc; b.st[1] = nx; }
        const unsigned old = xb_add(&bar[XB_XSUB(b.x)], 1u);
        const unsigned gen = old / nloc;
        if (old + 1u == (gen + 1u) * nloc) {
            __builtin_amdgcn_fence(__ATOMIC_RELEASE, "agent");
            asm volatile("s_waitcnt vmcnt(0)" ::: "memory");
            const unsigned og = xb_add(&bar[XB_TOP], 1u);
            const unsigned tg = og / nx;
            if (og + 1u == (tg + 1u) * nx) xb_add(&bar[XB_TOPGEN], 1u);
            else XB_SPIN(xb_ld(&bar[XB_TOPGEN]) == tg, bar);
            __builtin_amdgcn_fence(__ATOMIC_ACQUIRE, "agent");
            xb_add(&bar[XB_XGEN(b.x)], 1u);
            asm volatile("s_waitcnt vmcnt(0)" ::: "memory");
        } else {
            XB_SPIN(xb_ld(&bar[XB_XGEN(b.x)]) == gen, bar);
            __builtin_amdgcn_fence(__ATOMIC_ACQUIRE, "agent");
            asm volatile("s_waitcnt vmcnt(0)" ::: "memory");
        }
    }
    __syncthreads();
}
struct Frame {
    LAS unsigned char* lds; char* ldsg;
    int tid, lane, wave, G, gw, NGW;
    const float *x, *c, *ada_w, *ada_b, *norm_g, *ab_w_in, *ab_w_out, *a_sink, *c_w_in, *c_w_out, *c_lambda, *c_subln_g, *w_up, *conv_w, *conv_b, *w_down;
    float* out; unsigned char* ws;
};
#define PHASE_IDS() int tid = threadIdx.x; asm volatile("" : "+v"(tid)); const int lane = tid & 63, wave = __builtin_amdgcn_readfirstlane(tid >> 6), gw = (int)blockIdx.x * NWAVES + wave; (void)lane; (void)gw
__device__ __forceinline__ float wave_sum(float v) {
#pragma unroll
    for (int o = 1; o < 64; o <<= 1) v += __shfl_xor(v, o);
    return v;
}
__device__ __forceinline__ void transpose_item(const float* W, int K, int N, bf16* WT, LAS float* scr, int item, int lane, int remap = 0) {
    const int nblk = N / 32, kb = item / nblk, nb = item % nblk, k0 = 64 * kb, n0 = 32 * nb;
    int d0 = n0; if (remap) { const int isup = n0 >= DFF, c0 = n0 - isup * DFF; d0 = (c0 >> 7) * 256 + isup * 128 + (c0 & 127); }
#pragma unroll 8
    for (int i = 0; i < 32; ++i) { const int kk = 2 * i + (lane >> 5); scr[kk * 33 + (lane & 31)] = W[(size_t)(k0 + kk) * N + n0 + (lane & 31)]; }
    LDS_WAIT(); asm volatile("" ::: "memory");
    const int c = lane & 7;
#pragma unroll
    for (int j = 0; j < 4; ++j) { const int n = (lane >> 3) + 8 * j; const LAS float* s = scr + (8 * c) * 33 + n;
        v4u o; o.x = pk2(s[0 * 33], s[1 * 33]); o.y = pk2(s[2 * 33], s[3 * 33]); o.z = pk2(s[4 * 33], s[5 * 33]); o.w = pk2(s[6 * 33], s[7 * 33]);
        *(GAS v4u*)(WT + (size_t)(d0 + n) * K + k0 + 8 * c) = o; }
    LDS_WAIT(); asm volatile("" ::: "memory");
}
__device__ __forceinline__ float silu_f(float v) { return v / (1.f + __expf(-v)); }

__device__ __forceinline__ void p0a_prologue(Frame& F) {
    PHASE_IDS();
    LAS float* scr = (LAS float*)(F.lds + RING_OFF + wave * 16384);
    constexpr int I_ABIN = (DM / 64) * (AB_IN / 32), I_ABOUT = (AB_OUT / 64) * (DM / 32), I_CIN = (DM / 64) * (C_IN / 32), I_COUT = (DM / 64) * (DM / 32),
                  I_UP = (DM / 64) * (UPW / 32), I_DOWN = (DFF / 64) * (DM / 32);
    constexpr int NT_ITEMS = 2 * I_ABIN + 2 * I_ABOUT + 2 * I_CIN + 2 * I_COUT + 4 * I_UP + 4 * I_DOWN;
    bf16* wabin = (bf16*)(F.ws + WS_WABIN); bf16* wabout = (bf16*)(F.ws + WS_WABOUT); bf16* wcin = (bf16*)(F.ws + WS_WCIN); bf16* wcout = (bf16*)(F.ws + WS_WCOUT);
    bf16* wup = (bf16*)(F.ws + WS_WUP); bf16* wdown = (bf16*)(F.ws + WS_WDOWN);
    for (int it = gw; it < NT_ITEMS; it += F.NGW) {
        int r = it;
        if (r < 2 * I_ABIN) { const int j = r / I_ABIN; transpose_item(F.ab_w_in + (size_t)j * DM * AB_IN, DM, AB_IN, wabin + (size_t)j * AB_IN * DM, scr, r % I_ABIN, lane); continue; } r -= 2 * I_ABIN;
        if (r < 2 * I_ABOUT) { const int j = r / I_ABOUT; transpose_item(F.ab_w_out + (size_t)j * AB_OUT * DM, AB_OUT, DM, wabout + (size_t)j * DM * AB_OUT, scr, r % I_ABOUT, lane); continue; } r -= 2 * I_ABOUT;
        if (r < 2 * I_CIN) { const int j = r / I_CIN; transpose_item(F.c_w_in + (size_t)j * DM * C_IN, DM, C_IN, wcin + (size_t)j * C_IN * DM, scr, r % I_CIN, lane); continue; } r -= 2 * I_CIN;
        if (r < 2 * I_COUT) { const int j = r / I_COUT; transpose_item(F.c_w_out + (size_t)j * DM * DM, DM, DM, wcout + (size_t)j * DM * DM, scr, r % I_COUT, lane); continue; } r -= 2 * I_COUT;
        if (r < 4 * I_UP) { const int j = r / I_UP; transpose_item(F.w_up + (size_t)j * DM * UPW, DM, UPW, wup + (size_t)j * UPW * DM, scr, r % I_UP, lane, 1); continue; } r -= 4 * I_UP;
        { const int j = r / I_DOWN; transpose_item(F.w_down + (size_t)j * DFF * DM, DFF, DM, wdown + (size_t)j * DM * DFF, scr, r % I_DOWN, lane); }
    }
    float* part = (float*)(F.ws + WS_PART);
    constexpr int NCH = MODW / 256, NKC = 16, KCH = DM / NKC;
    for (int it = gw; it < DEPTH * NCH * NKC; it += F.NGW) {
        const int kc = it % NKC, nch = (it / NKC) % NCH, l = it / (NKC * NCH), k0 = kc * KCH;
        const float c0a = silu_f(F.c[k0 + lane]), c0b = silu_f(F.c[k0 + 64 + lane]), c1a = silu_f(F.c[DM + k0 + lane]), c1b = silu_f(F.c[DM + k0 + 64 + lane]);
        const float* wp = F.ada_w + ((size_t)l * DM + k0) * MODW + nch * 256 + 4 * lane;
        f32x4 a0 = {0.f, 0.f, 0.f, 0.f}, a1 = {0.f, 0.f, 0.f, 0.f};
#pragma unroll 8
        for (int k = 0; k < 64; ++k) { const f32x4 w = *(const f32x4*)(wp + (size_t)k * MODW); const float s0 = __shfl(c0a, k), s1 = __shfl(c1a, k); a0 += w * s0; a1 += w * s1; }
#pragma unroll 8
        for (int k = 0; k < 64; ++k) { const f32x4 w = *(const f32x4*)(wp + (size_t)(64 + k) * MODW); const float s0 = __shfl(c0b, k), s1 = __shfl(c1b, k); a0 += w * s0; a1 += w * s1; }
        float* pp = part + (((size_t)l * NKC + kc) * BATCH) * MODW + nch * 256 + 4 * lane;
        *(f32x4*)pp = a0; *(f32x4*)(pp + MODW) = a1;
    }
}
__device__ __forceinline__ void p0b_modreduce(Frame& F) {
    PHASE_IDS();
    const float* part = (const float*)(F.ws + WS_PART); float* mod = (float*)(F.ws + WS_MOD);
    for (int i = blockIdx.x * (NWAVES * 64) + tid; i < DEPTH * BATCH * MODW; i += F.G * NWAVES * 64) {
        const int n = i % MODW, b = (i / MODW) % BATCH, l = i / (MODW * BATCH);
        float s = F.ada_b[l * MODW + n];
#pragma unroll
        for (int kc = 0; kc < 16; ++kc) s += part[(((size_t)l * 16 + kc) * BATCH + b) * MODW + n];
        mod[i] = s;
    }
}
__device__ __forceinline__ void rows_pre(Frame& F, const float* x, const float* ng, const float* scale, const float* shift, bf16* H) {
    PHASE_IDS();
    for (int m = gw; m < M; m += F.NGW) {
        const int b = m / SEQ; f32x4 v[8]; float ss = 0.f;
#pragma unroll
        for (int j = 0; j < 8; ++j) { v[j] = *(const f32x4*)(x + (size_t)m * DM + 4 * lane + 256 * j); ss += (v[j].x * v[j].x + v[j].y * v[j].y) + (v[j].z * v[j].z + v[j].w * v[j].w); }
        const float r = 1.f / sqrtf(wave_sum(ss) * (1.f / DM) + EPS);
#pragma unroll
        for (int j = 0; j < 8; ++j) { const int c = 4 * lane + 256 * j;
            const f32x4 g = *(const f32x4*)(ng + c), sc = *(const f32x4*)(scale + (size_t)b * MODW + c), sh = *(const f32x4*)(shift + (size_t)b * MODW + c);
            const f32x4 h = (v[j] * r) * g * (sc + 1.f) + sh;
            v2u o; o.x = pk2(h.x, h.y); o.y = pk2(h.z, h.w); *(v2u*)(H + (size_t)m * DM + c) = o; }
    }
}
__device__ __forceinline__ void rows_post(Frame& F, const bf16* Y, const float* xs, float* xd, const float* gate, const float* nga,
                                          const float* ngb, const float* scale, const float* shift, bf16* H, bool doH) {
    PHASE_IDS();
    for (int m0 = gw; m0 < M; m0 += 2 * F.NGW) {
        const int m1 = m0 + F.NGW;
        const bool two = m1 < M; const int mm[2] = {m0, two ? m1 : m0};
        v2u yw[2][8]; f32x4 xv[2][8];
#pragma unroll
        for (int q = 0; q < 2; ++q)
#pragma unroll
            for (int j = 0; j < 8; ++j) { yw[q][j] = *(const v2u*)(Y + (size_t)mm[q] * DM + 4 * lane + 256 * j); xv[q][j] = *(const f32x4*)(xs + (size_t)mm[q] * DM + 4 * lane + 256 * j); }
        f32x4 v[2][8]; float ss[2] = {0.f, 0.f};
#pragma unroll
        for (int q = 0; q < 2; ++q)
#pragma unroll
            for (int j = 0; j < 8; ++j) { v[q][j] = (f32x4){bf_lo(yw[q][j].x), bf_hi(yw[q][j].x), bf_lo(yw[q][j].y), bf_hi(yw[q][j].y)};
                ss[q] += (v[q][j].x * v[q][j].x + v[q][j].y * v[q][j].y) + (v[q][j].z * v[q][j].z + v[q][j].w * v[q][j].w); }
        float r[2], ss2[2] = {0.f, 0.f};
#pragma unroll
        for (int q = 0; q < 2; ++q) r[q] = 1.f / sqrtf(wave_sum(ss[q]) * (1.f / DM) + EPS);
#pragma unroll
        for (int q = 0; q < 2; ++q) { const int b = mm[q] / SEQ;
#pragma unroll
            for (int j = 0; j < 8; ++j) { const int c = 4 * lane + 256 * j;
                const f32x4 g = *(const f32x4*)(gate + (size_t)b * MODW + c), na = *(const f32x4*)(nga + c);
                v[q][j] = xv[q][j] + g * ((v[q][j] * r[q]) * na);
                ss2[q] += (v[q][j].x * v[q][j].x + v[q][j].y * v[q][j].y) + (v[q][j].z * v[q][j].z + v[q][j].w * v[q][j].w);
                if (q == 0 || two) *(f32x4*)(xd + (size_t)mm[q] * DM + c) = v[q][j]; } }
        if (doH) {
#pragma unroll
            for (int q = 0; q < 2; ++q) { const int b = mm[q] / SEQ; const float r2 = 1.f / sqrtf(wave_sum(ss2[q]) * (1.f / DM) + EPS);
#pragma unroll
                for (int j = 0; j < 8; ++j) { const int c = 4 * lane + 256 * j;
                    const f32x4 g = *(const f32x4*)(ngb + c), sc = *(const f32x4*)(scale + (size_t)b * MODW + c), sh = *(const f32x4*)(shift + (size_t)b * MODW + c);
                    const f32x4 h = (v[q][j] * r2) * g * (sc + 1.f) + sh;
                    v2u o; o.x = pk2(h.x, h.y); o.y = pk2(h.z, h.w); if (q == 0 || two) *(v2u*)(H + (size_t)mm[q] * DM + c) = o; } }
        }
    }
}
__device__ __forceinline__ void rows_subln(Frame& F, const float* A0, const float* A1, const float* lamp, const float* sg, float lambda_init, bf16* O) {
    PHASE_IDS();
    const float l0 = lamp[lane] * lamp[128 + lane] + lamp[64 + lane] * lamp[128 + 64 + lane];
    const float l1 = lamp[256 + lane] * lamp[384 + lane] + lamp[256 + 64 + lane] * lamp[384 + 64 + lane];
    const float lam = __expf(wave_sum(l0)) - __expf(wave_sum(l1)) + lambda_init;
    const f32x4 g = *(const f32x4*)(sg + 4 * lane) * (1.f - lambda_init);
    for (int m = gw; m < M; m += F.NGW) {
#pragma unroll
        for (int j = 0; j < 8; ++j) { const size_t off = (size_t)m * DM + 4 * lane + 256 * j;
            const f32x4 d = *(const f32x4*)(A0 + off) - *(const f32x4*)(A1 + off) * lam;
            const float ss = wave_sum((d.x * d.x + d.y * d.y) + (d.z * d.z + d.w * d.w));
            const float r = 1.f / sqrtf(ss * (1.f / 256.f) + EPS);
            const f32x4 h = (d * r) * g;
            v2u o; o.x = pk2(h.x, h.y); o.y = pk2(h.z, h.w); *(v2u*)(O + off) = o; }
    }
}
__device__ __forceinline__ void rows_bmerge(Frame& F, const float* OB, const float* LSE, bf16* O) {
    PHASE_IDS();
    for (int m = gw; m < M; m += F.NGW) {
        const int hb = lane >> 4;
        const float e0 = LSE[(size_t)m * 4 + hb], e1 = LSE[((size_t)M + m) * 4 + hb], e2 = LSE[((size_t)2 * M + m) * 4 + hb];
        const float mx = fmaxf(e0, fmaxf(e1, e2));
        float w0 = __expf(e0 - mx), w1 = __expf(e1 - mx), w2 = __expf(e2 - mx); const float inv = 1.f / (w0 + w1 + w2); w0 *= inv; w1 *= inv; w2 *= inv;
        const float* p = OB + (size_t)m * 512 + 8 * lane;
        const f32x4 a0 = *(const f32x4*)p, a1 = *(const f32x4*)(p + 4);
        const f32x4 b0 = *(const f32x4*)(p + (size_t)M * 512), b1 = *(const f32x4*)(p + (size_t)M * 512 + 4);
        const f32x4 c0 = *(const f32x4*)(p + (size_t)2 * M * 512), c1 = *(const f32x4*)(p + (size_t)2 * M * 512 + 4);
        const f32x4 r0 = a0 * w0 + b0 * w1 + c0 * w2, r1 = a1 * w0 + b1 * w1 + c1 * w2;
        v4u o; o.x = pk2(r0.x, r0.y); o.y = pk2(r0.z, r0.w); o.z = pk2(r1.x, r1.y); o.w = pk2(r1.z, r1.w);
        *(v4u*)(O + (size_t)m * AB_OUT + 512 + 8 * lane) = o;
    }
}
__device__ __forceinline__ float gelu_tanh(float v) {
    const float u = 0.7978845608028654f * (v + 0.044715f * v * v * v);
    const float e = __expf(2.f * u);
    const float t = 1.f - 2.f / (e + 1.f);
    return 0.5f * v * (1.f + t);
}
__device__ __forceinline__ void actfix_panel(Frame& F, int pm, const float* cw, const float* cb, bf16* ACT) {
    PHASE_IDS();
    const float* HG = (const float*)(F.ws + WS_HG); const float* HU = (const float*)(F.ws + WS_HU);
    constexpr int NC4 = DFF / 4;
    for (int it = tid; it < 2 * NC4; it += NWAVES * 64) {
        const int c = (it % NC4) * 4, side = it / NC4;
        const f32x4 z = {0.f, 0.f, 0.f, 0.f}; f32x4 gp, gc, gn, up; size_t row;
        if (side == 0) { gp = (pm % (SEQ / 256) == 0) ? z : *(const f32x4*)(HG + ((size_t)(pm - 1) * 4 + 3) * DFF + c); gc = *(const f32x4*)(HG + ((size_t)pm * 4 + 0) * DFF + c);
            gn = *(const f32x4*)(HG + ((size_t)pm * 4 + 1) * DFF + c); up = *(const f32x4*)(HU + ((size_t)pm * 2 + 0) * DFF + c); row = (size_t)pm * 256; }
        else { gp = *(const f32x4*)(HG + ((size_t)pm * 4 + 2) * DFF + c); gc = *(const f32x4*)(HG + ((size_t)pm * 4 + 3) * DFF + c);
            gn = (pm % (SEQ / 256) == SEQ / 256 - 1) ? z : *(const f32x4*)(HG + ((size_t)(pm + 1) * 4 + 0) * DFF + c); up = *(const f32x4*)(HU + ((size_t)pm * 2 + 1) * DFF + c); row = (size_t)pm * 256 + 255; }
        const f32x4 w0 = *(const f32x4*)(cw + c), w1 = *(const f32x4*)(cw + DFF + c), w2 = *(const f32x4*)(cw + 2 * DFF + c), bb = *(const f32x4*)(cb + c);
        float r[4];
#pragma unroll
        for (int i = 0; i < 4; ++i) r[i] = pg8::gelu_tanh_mul(fmaf(w0[i], gp[i], fmaf(w1[i], gc[i], fmaf(w2[i], gn[i], bb[i]))), up[i]);
        v2u o; o.x = pk2(r[0], r[1]); o.y = pk2(r[2], r[3]); *(v2u*)(ACT + row * DFF + c) = o;
    }
    asm volatile("s_waitcnt vmcnt(0)" ::: "memory"); __syncthreads();
}
__device__ __forceinline__ float alibi16(int i) { return exp2f(-0.5f * (float)(i + 1)); }
__device__ __forceinline__ void phase_attn_ab(Frame& F, int jl) {
    const bf16* P = (const bf16*)(F.ws + WS_PROJ); bf16* O = (bf16*)(F.ws + WS_O); float* OB = (float*)(F.ws + WS_ATT); float* LSE = (float*)(F.ws + WS_LSE);
    for (int u = blockIdx.x; u < 512; u += F.G) {
        att::UnitArgs a;
        if (u < 128) {
            const int qb = u % 16, qh = (u / 16) % 4, b = u / 64, q0 = qb * 256; const size_t row0 = (size_t)b * SEQ;
            a.Q = (const GAS bf16*)P + (row0 + q0) * AB_IN + qh * 128; a.ldq = AB_IN;
            a.K = (const GAS bf16*)P + row0 * AB_IN + 512 + (qh >> 1) * 128; a.V = (const GAS bf16*)P + row0 * AB_IN + 768 + (qh >> 1) * 128; a.ldk = AB_IN;
            a.q0 = q0; a.L = SEQ; a.kt0 = q0 / 64 - 2; a.nt = 8;
            a.nsl = -alibi16(qh) / att::SCALE; a.radius = 128.f; a.m_init = F.a_sink[jl * 4 + qh] / att::SCALE; a.l_init = 1.f;
            a.Of = nullptr; a.Ob = (GAS bf16*)O + (row0 + q0) * AB_OUT + qh * 128; a.ldo = AB_OUT; a.lse = nullptr; a.ldl = 0;
        } else {
            const int v = (u - 128) % 128, gi = (u - 128) / 128, dil = gi == 0 ? 1 : (gi == 1 ? 4 : 16), L = SEQ / dil;
            int qb, r, hb, b;
            if (gi == 0) { qb = v % 16; r = 0; hb = (v / 16) % 4; b = v / 64; }
            else if (gi == 1) { qb = v % 4; r = (v / 4) % 4; hb = (v / 16) % 4; b = v / 64; }
            else { qb = 0; r = v % 16; hb = (v / 16) % 4; b = v / 64; }
            const int q0 = qb * 256; const size_t seq0 = (size_t)b * SEQ + r, rowq = seq0 + (size_t)dil * q0;
            a.Q = (const GAS bf16*)P + rowq * AB_IN + 1024 + gi * 512 + hb * 128; a.ldq = (long)dil * AB_IN;
            a.K = (const GAS bf16*)P + seq0 * AB_IN + 2560 + hb * 128; a.V = (const GAS bf16*)P + seq0 * AB_IN + 3072 + hb * 128; a.ldk = (long)dil * AB_IN;
            a.q0 = q0; a.L = L; a.kt0 = q0 / 64 - 1; a.nt = 6;
            a.nsl = -alibi16(4 + gi * 4 + hb) * (float)dil / att::SCALE; a.radius = 64.f; a.m_init = att::M_INIT; a.l_init = 0.f;
            a.Of = (GAS float*)OB + ((size_t)gi * M + rowq) * 512 + hb * 128; a.Ob = nullptr; a.ldo = (long)dil * 512;
            a.lse = (GAS float*)LSE + ((size_t)gi * M + rowq) * 4 + hb; a.ldl = (long)dil * 4;
        }
        att::attn_unit<true, 1>(a, F.ldsg + RING_OFF);
    }
}
__device__ __forceinline__ void phase_cnorm(Frame& F) {
    PHASE_IDS();
    const bf16* P = (const bf16*)(F.ws + WS_PROJ); float* NRM = (float*)(F.ws + WS_NRM);
    for (int it = gw; it < 2048; it += F.NGW) {
        const int tile = it & 63, j = (it >> 6) & 1, h = (it >> 7) & 7, b = (it >> 10) & 1;
        const bf16* base = P + ((size_t)b * SEQ + 64 * tile + (lane >> 4)) * C_IN + h * 256 + j * 128 + (lane & 15) * 8;
        float mq = 0.f, mk = 0.f, ms = 3.0e38f;
#pragma unroll 4
        for (int i = 0; i < 16; ++i) {
            const v4u wq = *(const v4u*)(base + (size_t)(4 * i) * C_IN), wk = *(const v4u*)(base + (size_t)(4 * i) * C_IN + 2048);
            float sq = 0.f, sk = 0.f, dt = 0.f;
#pragma unroll
            for (int q = 0; q < 4; ++q) { const float a = bf_lo(wq[q]), c = bf_hi(wq[q]), e = bf_lo(wk[q]), g = bf_hi(wk[q]); sq += a * a + c * c; sk += e * e + g * g; dt += a * e + c * g; }
#pragma unroll
            for (int o = 1; o < 16; o <<= 1) { sq += __shfl_xor(sq, o); sk += __shfl_xor(sk, o); dt += __shfl_xor(dt, o); }
            mq = fmaxf(mq, sq); mk = fmaxf(mk, sk); ms = fminf(ms, dt);
        }
        mq = fmaxf(mq, __shfl_xor(mq, 16)); mq = fmaxf(mq, __shfl_xor(mq, 32)); mk = fmaxf(mk, __shfl_xor(mk, 16)); mk = fmaxf(mk, __shfl_xor(mk, 32));
        ms = fminf(ms, __shfl_xor(ms, 16)); ms = fminf(ms, __shfl_xor(ms, 32));
        if (lane == 0) { NRM[it] = sqrtf(mq); NRM[2048 + it] = sqrtf(mk); NRM[4096 + it] = att::SCALE * ms; }
    }
}
__device__ __forceinline__ void phase_attn_c(Frame& F, gu32* ctr) {
    PHASE_IDS();
    const bf16* P = (const bf16*)(F.ws + WS_PROJ); float* AT = (float*)(F.ws + WS_ATT); const float* NRM = (const float*)(F.ws + WS_NRM);
    volatile LAS unsigned* slot = (volatile LAS unsigned*)(F.lds + MISC_OFF) + 16;
    for (;;) {
        if (tid == 0) *slot = __hip_atomic_fetch_add(ctr, 1u, __ATOMIC_RELAXED, __HIP_MEMORY_SCOPE_AGENT);
        __syncthreads();
        const int i = __builtin_amdgcn_readfirstlane((int)*slot);
        __syncthreads();
        if (i >= 1024) break;
        const int h = 7 - (i >> 7), qb = i & 31, j = (i >> 5) & 1, b = (i >> 6) & 1, q0 = qb * 128; const size_t row0 = (size_t)b * SEQ;
        const float slope = exp2f(-(float)(h + 1));
        const float* QN = NRM + ((b * 8 + h) * 2 + j) * 64; const float* KN = QN + 2048; const float* SS = QN + 4096;
        const float qn = fmaxf(QN[2 * qb], QN[2 * qb + 1]);
        const float smin = fminf(SS[2 * qb], SS[2 * qb + 1]) - 0.05f;
        const int klo = 64 * lane, d1 = klo - (q0 + 127), d2 = q0 - (klo + 63), dmin = d1 > 0 ? d1 : (d2 > 0 ? d2 : 0);
        const float bound = att::SCALE * 1.02f * qn * KN[lane] - slope * (float)dmin;
        const unsigned long long need = __ballot((bound - smin > -25.f) || (dmin == 0));
        const int t_lo = (int)__builtin_ctzll(need), t_hi = 64 - (int)__builtin_clzll(need);
        att::PairArgs a;
        a.Q = (const GAS bf16*)P + (row0 + q0) * C_IN + h * 256 + j * 128; a.ldq = C_IN;
        a.K = (const GAS bf16*)P + row0 * C_IN + 2048 + h * 256 + j * 128; a.V = (const GAS bf16*)P + row0 * C_IN + 4096 + h * 256; a.ldk = C_IN;
        a.q0 = q0; a.kt0 = t_lo; a.nt = t_hi - t_lo; a.nsl = -slope / att::SCALE;
        a.O = (GAS float*)AT + ((size_t)j * M + row0 + q0) * DM + h * 256; a.ldo = DM;
        att::attn_split_unit(a, F.ldsg + RING_OFF, (float*)(F.ldsg + BND_OFF));
    }
}

#ifndef ENC_DUP
#define ENC_DUP 0
#endif
#define DUP(bit) for (int rep_ = 0; rep_ < (((ENC_DUP) & (bit)) ? 2 : 1); ++rep_)
constexpr int CW_QUEUE = 8192;
struct Args { const float* in[16]; float* out; unsigned char* ws; };
__global__ void __launch_bounds__(NWAVES * 64, 2) enc_fwd(Args args) {
    extern __shared__ __attribute__((aligned(16))) unsigned char lds[];
    Frame F;
    F.lds = (LAS unsigned char*)lds; F.ldsg = (char*)lds;
    F.tid = threadIdx.x; F.lane = F.tid & 63; F.wave = __builtin_amdgcn_readfirstlane(F.tid >> 6);
    F.G = gridDim.x; F.gw = blockIdx.x * NWAVES + F.wave; F.NGW = F.G * NWAVES;
    F.x = args.in[0]; F.c = args.in[1]; F.ada_w = args.in[2]; F.ada_b = args.in[3]; F.norm_g = args.in[4]; F.ab_w_in = args.in[5]; F.ab_w_out = args.in[6]; F.a_sink = args.in[7];
    F.c_w_in = args.in[8]; F.c_w_out = args.in[9]; F.c_lambda = args.in[10]; F.c_subln_g = args.in[11]; F.w_up = args.in[12]; F.conv_w = args.in[13]; F.conv_b = args.in[14]; F.w_down = args.in[15];
    F.out = args.out; F.ws = args.ws;
    gu32* ctl = (gu32*)(F.ws + WS_CTL);
    for (int u = F.tid; u < (LDS_BYTES - LDSCTL_OFF) / 4; u += NWAVES * 64) ((LAS unsigned*)(F.lds + LDSCTL_OFF))[u] = 0u;
    __syncthreads();
    (void)xcd_barrier_post((unsigned*)(ctl + CW_BAR), (volatile LAS unsigned*)(F.lds + MISC_OFF) + 8);
#define GB() do { unsigned char* wsb_ = args.ws; asm volatile("" : "+s"(wsb_)); XcdBarrier bar_; bar_.bar = (unsigned*)(wsb_ + WS_CTL) + CW_BAR; bar_.x = xb_xcc_id(); \
        bar_.st = (volatile LAS unsigned*)(F.lds + MISC_OFF) + 8; xcd_barrier(bar_); } while (0)
    float* mod = (float*)(F.ws + WS_MOD);
    bf16* H = (bf16*)(F.ws + WS_H); bf16* PROJ = (bf16*)(F.ws + WS_PROJ); bf16* O = (bf16*)(F.ws + WS_O); bf16* Y = (bf16*)(F.ws + WS_Y);
    bf16* ACT = (bf16*)(F.ws + WS_ACT); float* AT = (float*)(F.ws + WS_ATT);

    DUP(1) p0a_prologue(F);
    GB();
    p0b_modreduce(F);
    GB();
    rows_pre(F, F.x, F.norm_g, mod + 1 * DM, mod + 0 * DM, H);
    GB();

    for (int s = 0; s < 8; ++s) {
        const int l = s >> 1, sub = s & 1, jl = l >> 1, even = !(l & 1);
        const float* modl = mod + (size_t)l * BATCH * MODW;
        if (sub == 0) {
            pg8::Gemm g; int N;
            if (even) { N = AB_IN; g.Bt = (const bf16*)(F.ws + WS_WABIN) + (size_t)jl * AB_IN * DM; } else { N = C_IN; g.Bt = (const bf16*)(F.ws + WS_WCIN) + (size_t)jl * C_IN * DM; }
            g.A = H; g.M = M; g.N = N; g.K = DM;
            pg8::StaticOrder S; S.init(M, N, F.G, (int)blockIdx.x);
            pg8::EpiBf16<0> E{PROJ, N, nullptr, 0, 0, 1.f};
            DUP(4) pg8::gemm_phase<pg8::EpiBf16<0>, pg8::StaticOrder, true, true>(F.lds + RING_OFF, g, S, E);
        } else {
            pg8::Gemm g; g.A = H; g.Bt = (const bf16*)(F.ws + WS_WUP) + (size_t)l * UPW * DM; g.M = M; g.N = UPW; g.K = DM;
            pg8::StaticOrder S; S.init(M, UPW, F.G, (int)blockIdx.x);
            pg8::EpiAct E{ACT, DFF, F.conv_w + (size_t)l * 3 * DFF, F.conv_b + (size_t)l * DFF, (float*)(F.ws + WS_HG), (float*)(F.ws + WS_HU), (LAS float*)(F.lds + BND_OFF)};
            DUP(4) pg8::gemm_phase<pg8::EpiAct, pg8::StaticOrder, true, true>(F.lds + RING_OFF, g, S, E);
        }
        GB();
        if (sub == 0) {
            if (even) { DUP(16) phase_attn_ab(F, jl); GB(); rows_bmerge(F, AT, (const float*)(F.ws + WS_LSE), O); }
            else { phase_cnorm(F); GB(); phase_attn_c(F, ctl + CW_QUEUE + 64 * jl); GB();
                rows_subln(F, AT, AT + (size_t)M * DM, F.c_lambda + (size_t)jl * 4 * 128, F.c_subln_g + (size_t)jl * 256, 0.8f - 0.6f * __expf(-0.3f * (float)l), O); }
            GB();
        }
        {
            pg8::Gemm g; int K;
            if (sub == 0) { if (even) { K = AB_OUT; g.Bt = (const bf16*)(F.ws + WS_WABOUT) + (size_t)jl * DM * AB_OUT; } else { K = DM; g.Bt = (const bf16*)(F.ws + WS_WCOUT) + (size_t)jl * DM * DM; } g.A = O; }
            else { K = DFF; g.Bt = (const bf16*)(F.ws + WS_WDOWN) + (size_t)l * DM * DFF; g.A = ACT; }
            g.M = M; g.N = DM; g.K = K;
            pg8::StaticOrder S; S.init(M, DM, F.G, (int)blockIdx.x);
            if (sub == 1) { pg8::Unit u0; if (S.next(0, u0)) actfix_panel(F, u0.pm, F.conv_w + (size_t)l * 3 * DFF, F.conv_b + (size_t)l * DFF, ACT); }
            pg8::EpiBf16<0> E{Y, DM, nullptr, 0, 0, 1.f};
            DUP(8) pg8::gemm_phase<pg8::EpiBf16<0>, pg8::StaticOrder, false, true>(F.lds + RING_OFF, g, S, E);
        }
        GB();
        {
            const float* xs = (s == 0) ? F.x : F.out;
            if (sub == 0) rows_post(F, Y, xs, F.out, modl + 2 * DM, F.norm_g + ((size_t)l * 4 + 1) * DM, F.norm_g + ((size_t)l * 4 + 2) * DM, modl + 4 * DM, modl + 3 * DM, H, true);
            else { const int ln = l + 1 < DEPTH ? l + 1 : l; const float* modn = mod + (size_t)ln * BATCH * MODW;
                rows_post(F, Y, xs, F.out, modl + 5 * DM, F.norm_g + ((size_t)l * 4 + 3) * DM, F.norm_g + ((size_t)ln * 4 + 0) * DM, modn + 1 * DM, modn + 0 * DM, H, l + 1 < DEPTH); }
        }
        if (s < 7) GB();
    }
#undef GB
}

extern "C" void kernel_launch(void* const* d_in, const int* in_sizes, int n_in, void* d_out, int out_size, void* d_ws, size_t ws_size, hipStream_t stream) {
    static int grid = 0;
    if (grid == 0) {
        if (n_in != 16 || in_sizes[0] != M * DM || out_size != M * DM || ws_size < WS_END) { fprintf(stderr, "kernel_launch: unexpected shapes (n_in %d, in0 %d, out %d, ws %zu < %zu)\n", n_in, n_in > 0 ? in_sizes[0] : -1, out_size, ws_size, (size_t)WS_END); grid = -1; return; }
        int dev = 0, cus = 0, per_cu = 0;
        if (hipGetDevice(&dev) != hipSuccess || hipDeviceGetAttribute(&cus, hipDeviceAttributeMultiprocessorCount, dev) != hipSuccess) { grid = -1; return; }
        if (hipFuncSetAttribute((const void*)enc_fwd, hipFuncAttributeMaxDynamicSharedMemorySize, LDS_BYTES) != hipSuccess) { fprintf(stderr, "kernel_launch: hipFuncSetAttribute failed\n"); grid = -1; return; }
        if (hipOccupancyMaxActiveBlocksPerMultiprocessor(&per_cu, (const void*)enc_fwd, NWAVES * 64, LDS_BYTES) != hipSuccess || per_cu < 1) { fprintf(stderr, "kernel_launch: occupancy query says %d\n", per_cu); }
        (void)hipGetLastError();
        grid = cus;
    }
    if (grid < 0) return;
    (void)hipMemsetAsync((char*)d_ws + WS_CTL, 0, CTL_ZERO_BYTES, stream);
    Args a{};
    for (int i = 0; i < 16; ++i) a.in[i] = (const float*)d_in[i];
    a.out = (float*)d_out; a.ws = (unsigned char*)d_ws;
    hipLaunchKernelGGL(enc_fwd, dim3(grid), dim3(NWAVES * 64), LDS_BYTES, stream, a);
}
```

```cpp
#include <hip/hip_runtime.h>
#include <cstdio>
#include <cstdint>
namespace pg8 {
#define PG8_LAS __attribute__((address_space(3)))
typedef unsigned short bf16_t;
typedef short bf16x8 __attribute__((ext_vector_type(8)));
typedef float f32x4 __attribute__((ext_vector_type(4)));
typedef unsigned u32x4 __attribute__((ext_vector_type(4)));
constexpr int BM = 256, BK = 64, HALF = 128, HTB = HALF * BK * 2  , STAGE_BYTES = 8 * HTB, NXCD = 8, WGM = 8;

__host__ __device__ __forceinline__ int lds_byte(int r, int c) { const int st = (r >> 4) * 2 + (c >> 5), rr = r & 15, cc = c & 31, ob = rr * 64 + cc * 2; return st * 1024 + (ob ^ (((ob >> 9) & 1) << 5)); }
__host__ __device__ __forceinline__ void stage_rc(int b, int& R, int& C) { const int st = b / 1024, sb = b % 1024, swz = sb ^ (((sb >> 9) & 1) << 5); R = (st >> 1) * 16 + swz / 64; C = (st & 1) * 32 + (swz % 64) / 2; }
__host__ __device__ __forceinline__ int perm32(int rho) { const int n = rho >> 4, i = rho & 15; return 8 * (i >> 2) + 4 * n + (i & 3); }

struct Unit { int pm, pn; };
struct Gemm { const bf16_t* A; const bf16_t* Bt; int M, N, K; };

struct StaticOrder {
    int nM, nN, nwg, G, c;
    __host__ __device__ void init(int M, int N, int G_, int c_) { nM = M / BM; nN = N / BM; nwg = nM * nN; G = G_; c = c_; }
    __host__ __device__ bool next(int i, Unit& u) const {
        const long L = (long)i * G + c; if (L >= nwg) return false;
        int wgid = (int)L; { const int q = nwg / NXCD, r = nwg % NXCD, xcd = wgid % NXCD, off = wgid / NXCD; wgid = (xcd < r ? xcd * (q + 1) : r * (q + 1) + (xcd - r) * q) + off; }
        const int nig = WGM * nN, gid = wgid / nig, fm = gid * WGM, gsz = (nM - fm) < WGM ? (nM - fm) : WGM;
        u.pm = fm + ((wgid % nig) % gsz); u.pn = (wgid % nig) / gsz; return true;
    }
    __device__ __forceinline__ void a_ready(const Unit&) const {}
    __device__ __forceinline__ void done(const Unit&) const {}
};

__device__ __forceinline__ unsigned cvt_pk_bf16(float lo, float hi) { unsigned r; asm volatile("v_cvt_pk_bf16_f32 %0, %1, %2" : "=v"(r) : "v"(lo), "v"(hi)); return r; }
typedef float f32x2 __attribute__((ext_vector_type(2)));
__device__ __forceinline__ f32x2 gelu_pk(f32x2 v) {
    const f32x2 av = __builtin_elementwise_abs(v), d = av * 0.2316418882f + 1.0f;
    f32x2 t; t.x = __builtin_amdgcn_rcpf(d.x); t.y = __builtin_amdgcn_rcpf(d.y);
    f32x2 q = t * 0.5307027145f + (-0.7265760135f); q = q * t + 0.7107068705f; q = q * t + (-0.142248368f); q = q * t + 0.127414796f; q = q * t;
    const f32x2 s = (v * v) * (-0.72134752044f);
    f32x2 e; e.x = __builtin_amdgcn_exp2f(s.x); e.y = __builtin_amdgcn_exp2f(s.y);
    const f32x2 m = v * (q * e), r = v - m;
    f32x2 o; o.x = v.x < 0.f ? m.x : r.x; o.y = v.y < 0.f ? m.y : r.y; return o;
}

template <int ACT  > struct EpiBf16 {
    static constexpr bool PERM = true, AFTER_DRAIN = false; static_assert(ACT == 0 || ACT == 1, "EpiBf16: ACT is 0 (none) or 1 (gelu_pk)");
    bf16_t* O; int ldc; const float* bias; int split_cols; size_t split_stride; float scale0;
    __device__ __forceinline__ void operator()(const f32x4 (&acc)[2][2][4][2], const Unit& u, int wr, int wc, int fr, int fq) const {
        const int row0 = u.pm * BM + wr * 64 + fr; int colt = u.pn * BM; bf16_t* base = O;
        float sc = 1.f; if (split_cols) { const int t = colt / split_cols; base += (size_t)t * split_stride; colt -= t * split_cols; if (t == 0) sc = scale0; }
        const int col0 = colt + wc * 32 + 8 * fq, bcol0 = u.pn * BM + wc * 32 + 8 * fq;
        f32x4 bv[2][2];
#pragma unroll
        for (int bj = 0; bj < 2; ++bj)
#pragma unroll
            for (int n = 0; n < 2; ++n) bv[bj][n] = bias ? *(const f32x4*)(bias + bcol0 + bj * HALF + 4 * n) : (f32x4){0.f, 0.f, 0.f, 0.f};
#pragma unroll
        for (int ai = 0; ai < 2; ++ai)
#pragma unroll
            for (int m = 0; m < 4; ++m) { bf16_t* rowp = base + (size_t)(row0 + ai * HALF + m * 16) * ldc + col0;
#pragma unroll
                for (int bj = 0; bj < 2; ++bj) { f32x4 v0 = acc[ai][bj][m][0] + bv[bj][0], v1 = acc[ai][bj][m][1] + bv[bj][1];
                    if (ACT == 1) { f32x2 a = gelu_pk((f32x2){v0[0], v0[1]}), b = gelu_pk((f32x2){v0[2], v0[3]}), c = gelu_pk((f32x2){v1[0], v1[1]}), d = gelu_pk((f32x2){v1[2], v1[3]});
                        v0 = (f32x4){a.x, a.y, b.x, b.y}; v1 = (f32x4){c.x, c.y, d.x, d.y}; }
                    v0 = v0 * sc; v1 = v1 * sc; u32x4 w; w.x = cvt_pk_bf16(v0[0], v0[1]); w.y = cvt_pk_bf16(v0[2], v0[3]); w.z = cvt_pk_bf16(v1[0], v1[1]); w.w = cvt_pk_bf16(v1[2], v1[3]);
                    *(u32x4*)(rowp + bj * HALF) = w; } }
    }
};
struct EpiF32 {
    static constexpr bool PERM = false, AFTER_DRAIN = false;
    float* C; int ldc; const float* bias;
    __device__ __forceinline__ void operator()(const f32x4 (&acc)[2][2][4][2], const Unit& u, int wr, int wc, int fr, int fq) const {
        const int row0 = u.pm * BM + wr * 64 + fr, col0 = u.pn * BM + wc * 32 + 4 * fq;
        f32x4 bv[2][2];
#pragma unroll
        for (int bj = 0; bj < 2; ++bj)
#pragma unroll
            for (int n = 0; n < 2; ++n) bv[bj][n] = bias ? *(const f32x4*)(bias + col0 + bj * HALF + n * 16) : (f32x4){0.f, 0.f, 0.f, 0.f};
#pragma unroll
        for (int ai = 0; ai < 2; ++ai)
#pragma unroll
            for (int m = 0; m < 4; ++m) { float* rowp = C + (size_t)(row0 + ai * HALF + m * 16) * ldc + col0;
#pragma unroll
                for (int bj = 0; bj < 2; ++bj)
#pragma unroll
                    for (int n = 0; n < 2; ++n) *(f32x4*)(rowp + bj * HALF + n * 16) = acc[ai][bj][m][n] + bv[bj][n]; }
    }
};

template <int CTRL> __device__ __forceinline__ float dpp_mov(float x) { return __builtin_bit_cast(float, __builtin_amdgcn_mov_dpp(__builtin_bit_cast(int, x), CTRL, 0xf, 0xf, true)); }
template <int CTRL> __device__ __forceinline__ float dpp_upd(float old, float x) { return __builtin_bit_cast(float, __builtin_amdgcn_update_dpp(__builtin_bit_cast(int, old), __builtin_bit_cast(int, x), CTRL, 0xf, 0xf, false)); }
__device__ __forceinline__ float gelu_tanh_mul(float v, float up) {
    const float e = __builtin_amdgcn_exp2f(v * fmaf(v * v, -0.10294324f, -2.3022082f));
    return v * up * __builtin_amdgcn_rcpf(1.f + e);
}
struct EpiAct {
    static constexpr bool PERM = true, AFTER_DRAIN = false;
    bf16_t* ACT; int dff; const float* cw; const float* cb; float* HG; float* HU; PG8_LAS float* bnd;
    __device__ __forceinline__ void operator()(const f32x4 (&acc)[2][2][4][2], const Unit& u, int wr, int wc, int fr, int fq) const {
        const int chl = wc * 32 + 8 * fq, ch = u.pn * 128 + chl;
        if (fr == 0) {
#pragma unroll
            for (int ai = 0; ai < 2; ++ai) { PG8_LAS float* p = bnd + ((2 * ai + wr) * 2 + 0) * 128 + chl; *(PG8_LAS f32x4*)p = acc[ai][0][0][0]; *(PG8_LAS f32x4*)(p + 4) = acc[ai][0][0][1]; } }
        if (fr == 15) {
#pragma unroll
            for (int ai = 0; ai < 2; ++ai) { PG8_LAS float* p = bnd + ((2 * ai + wr) * 2 + 1) * 128 + chl; *(PG8_LAS f32x4*)p = acc[ai][0][3][0]; *(PG8_LAS f32x4*)(p + 4) = acc[ai][0][3][1]; } }
        if (wr == 0 && fr <= 1) { float* p = HG + ((size_t)u.pm * 4 + fr) * dff + ch; *(f32x4*)p = acc[0][0][0][0]; *(f32x4*)(p + 4) = acc[0][0][0][1];
            if (fr == 0) { float* q = HU + ((size_t)u.pm * 2 + 0) * dff + ch; *(f32x4*)q = acc[0][1][0][0]; *(f32x4*)(q + 4) = acc[0][1][0][1]; } }
        if (wr == 1 && fr >= 14) { float* p = HG + ((size_t)u.pm * 4 + 2 + (fr - 14)) * dff + ch; *(f32x4*)p = acc[1][0][3][0]; *(f32x4*)(p + 4) = acc[1][0][3][1];
            if (fr == 15) { float* q = HU + ((size_t)u.pm * 2 + 1) * dff + ch; *(f32x4*)q = acc[1][1][3][0]; *(f32x4*)(q + 4) = acc[1][1][3][1]; } }
        f32x4 w0[2], w1[2], w2[2], bb[2];
#pragma unroll
        for (int n = 0; n < 2; ++n) { w0[n] = *(const f32x4*)(cw + ch + 4 * n); w1[n] = *(const f32x4*)(cw + dff + ch + 4 * n); w2[n] = *(const f32x4*)(cw + 2 * dff + ch + 4 * n); bb[n] = *(const f32x4*)(cb + ch + 4 * n); }
        asm volatile("s_waitcnt lgkmcnt(0)" ::: "memory"); __builtin_amdgcn_s_barrier(); asm volatile("" ::: "memory");
        f32x4 bp[2][2], bn[2][2];
#pragma unroll
        for (int ai = 0; ai < 2; ++ai) { const int c = 2 * ai + wr;
#pragma unroll
            for (int n = 0; n < 2; ++n) {
                bp[ai][n] = c > 0 ? *(const PG8_LAS f32x4*)(bnd + ((c - 1) * 2 + 1) * 128 + chl + 4 * n) : (f32x4){0.f, 0.f, 0.f, 0.f};
                bn[ai][n] = c < 3 ? *(const PG8_LAS f32x4*)(bnd + ((c + 1) * 2 + 0) * 128 + chl + 4 * n) : (f32x4){0.f, 0.f, 0.f, 0.f}; } }
        const int row0 = u.pm * BM + wr * 64 + fr;
#pragma unroll
        for (int ai = 0; ai < 2; ++ai)
#pragma unroll
            for (int m = 0; m < 4; ++m) {
                unsigned pk[4];
#pragma unroll
                for (int n = 0; n < 2; ++n) { float r[4];
#pragma unroll
                    for (int i = 0; i < 4; ++i) {
                        const float g = acc[ai][0][m][n][i];
                        const float oldp = (m == 0) ? bp[ai][n][i] : dpp_mov<0x121>(acc[ai][0][m == 0 ? 0 : m - 1][n][i]);
                        const float gp = dpp_upd<0x111>(oldp, g);
                        const float oldn = (m == 3) ? bn[ai][n][i] : dpp_mov<0x12F>(acc[ai][0][m == 3 ? 3 : m + 1][n][i]);
                        const float gn = dpp_upd<0x101>(oldn, g);
                        const float a = fmaf(w0[n][i], gp, fmaf(w1[n][i], g, fmaf(w2[n][i], gn, bb[n][i])));
                        r[i] = gelu_tanh_mul(a, acc[ai][1][m][n][i]);
                    }
                    pk[2 * n] = cvt_pk_bf16(r[0], r[1]); pk[2 * n + 1] = cvt_pk_bf16(r[2], r[3]); }
                u32x4 w; w.x = pk[0]; w.y = pk[1]; w.z = pk[2]; w.w = pk[3];
                *(u32x4*)(ACT + (size_t)(row0 + ai * HALF + m * 16) * dff + ch) = w;
            }
    }
};

struct EpiPost {
    static constexpr bool PERM = true, AFTER_DRAIN = true;
    const float* xs; float* xd; bf16_t* H; int ldc;
    const float* gate; const float* nga; const float* ngb; const float* scale; const float* shift; int bstride, rows_per_batch;
    float* xch1; float* xch2; unsigned* cnt1; unsigned* cnt2; float eps;
    __device__ __forceinline__ void exchange(float* xch, unsigned* cnt, const Unit& u, PG8_LAS float* P, PG8_LAS float* R, int tid, int wid, int lane) const {
        asm volatile("s_waitcnt lgkmcnt(0)" ::: "memory"); __builtin_amdgcn_s_barrier(); asm volatile("" ::: "memory");
        if (tid < 256) { const float t = (P[tid * 4 + 0] + P[tid * 4 + 1]) + (P[tid * 4 + 2] + P[tid * 4 + 3]);
            __hip_atomic_store((unsigned*)xch + ((size_t)u.pm * 8 + u.pn) * 256 + tid, __builtin_bit_cast(unsigned, t), __ATOMIC_RELAXED, __HIP_MEMORY_SCOPE_AGENT); }
        if (wid < 4) { asm volatile("s_waitcnt vmcnt(0)" ::: "memory"); if (lane == 0) (void)__hip_atomic_fetch_add(cnt + 64 * u.pm, 1u, __ATOMIC_RELAXED, __HIP_MEMORY_SCOPE_AGENT); }
        if (wid == 0) { unsigned sp = 0; while ((unsigned)__builtin_amdgcn_readfirstlane((int)__hip_atomic_load(cnt + 64 * u.pm, __ATOMIC_RELAXED, __HIP_MEMORY_SCOPE_AGENT)) < 32u) { __builtin_amdgcn_s_sleep(2); if (++sp > (1u << 22)) break; } }
        asm volatile("s_waitcnt vmcnt(0) lgkmcnt(0)" ::: "memory"); __builtin_amdgcn_s_barrier(); asm volatile("" ::: "memory");
        if (tid < 256) { float tot = 0.f;
#pragma unroll
            for (int q = 0; q < 8; ++q) tot += __builtin_bit_cast(float, __hip_atomic_load((unsigned*)xch + ((size_t)u.pm * 8 + q) * 256 + tid, __ATOMIC_RELAXED, __HIP_MEMORY_SCOPE_AGENT));
            R[tid] = 1.f / sqrtf(tot * (1.f / 2048.f) + eps); }
        asm volatile("s_waitcnt lgkmcnt(0)" ::: "memory"); __builtin_amdgcn_s_barrier(); asm volatile("" ::: "memory");
    }
    __device__ __forceinline__ void fused(f32x4 (&acc)[2][2][4][2], const Unit& u, int wr, int wc, int fr, int fq, PG8_LAS unsigned char* lds, int wid, int lane) const {
        PG8_LAS float* P = (PG8_LAS float*)lds; PG8_LAS float* R = (PG8_LAS float*)(lds + 4096);
        const int tid = wid * 64 + lane, b = (u.pm * BM) / rows_per_batch, col0 = u.pn * BM + wc * 32 + 8 * fq, rl0 = wr * 64 + fr;
#pragma unroll
        for (int ai = 0; ai < 2; ++ai)
#pragma unroll
            for (int m = 0; m < 4; ++m) { float s = 0.f;
#pragma unroll
                for (int bj = 0; bj < 2; ++bj)
#pragma unroll
                    for (int n = 0; n < 2; ++n) { const f32x4 v = acc[ai][bj][m][n]; s += (v[0] * v[0] + v[1] * v[1]) + (v[2] * v[2] + v[3] * v[3]); }
                s += __shfl_xor(s, 16); s += __shfl_xor(s, 32);
                if (fq == 0) P[(rl0 + ai * HALF + m * 16) * 4 + wc] = s; }
        exchange(xch1, cnt1, u, P, R, tid, wid, lane);
        f32x4 gn[2][2];
#pragma unroll
        for (int bj = 0; bj < 2; ++bj)
#pragma unroll
            for (int n = 0; n < 2; ++n) { const int c = col0 + bj * HALF + 4 * n; gn[bj][n] = *(const f32x4*)(gate + (size_t)b * bstride + c) * *(const f32x4*)(nga + c); }
#pragma unroll
        for (int ai = 0; ai < 2; ++ai)
#pragma unroll
            for (int m = 0; m < 4; ++m) { const int rl = rl0 + ai * HALF + m * 16; const size_t ro = (size_t)(u.pm * BM + rl) * ldc; const float r1 = R[rl]; float s = 0.f;
#pragma unroll
                for (int bj = 0; bj < 2; ++bj)
#pragma unroll
                    for (int n = 0; n < 2; ++n) { const int c = col0 + bj * HALF + 4 * n;
                        const f32x4 v = *(const f32x4*)(xs + ro + c) + gn[bj][n] * (acc[ai][bj][m][n] * r1);
                        *(f32x4*)(xd + ro + c) = v; acc[ai][bj][m][n] = v; s += (v[0] * v[0] + v[1] * v[1]) + (v[2] * v[2] + v[3] * v[3]); }
                if (H) { s += __shfl_xor(s, 16); s += __shfl_xor(s, 32); if (fq == 0) P[rl * 4 + wc] = s; } }
        if (!H) return;
        exchange(xch2, cnt2, u, P, R, tid, wid, lane);
        f32x4 hb[2][2], sh[2][2];
#pragma unroll
        for (int bj = 0; bj < 2; ++bj)
#pragma unroll
            for (int n = 0; n < 2; ++n) { const int c = col0 + bj * HALF + 4 * n; hb[bj][n] = *(const f32x4*)(ngb + c) * (*(const f32x4*)(scale + (size_t)b * bstride + c) + 1.f); sh[bj][n] = *(const f32x4*)(shift + (size_t)b * bstride + c); }
#pragma unroll
        for (int ai = 0; ai < 2; ++ai)
#pragma unroll
            for (int m = 0; m < 4; ++m) { const int rl = rl0 + ai * HALF + m * 16; const size_t ro = (size_t)(u.pm * BM + rl) * ldc; const float r2 = R[rl];
#pragma unroll
                for (int bj = 0; bj < 2; ++bj) { const f32x4 h0 = (acc[ai][bj][m][0] * r2) * hb[bj][0] + sh[bj][0], h1 = (acc[ai][bj][m][1] * r2) * hb[bj][1] + sh[bj][1];
                    u32x4 w; w.x = cvt_pk_bf16(h0[0], h0[1]); w.y = cvt_pk_bf16(h0[2], h0[3]); w.z = cvt_pk_bf16(h1[0], h1[1]); w.w = cvt_pk_bf16(h1[2], h1[3]);
                    *(u32x4*)(H + ro + col0 + bj * HALF) = w; } }
    }
};
template <class Epi, class Sched, bool ALIGN_EPI = false, bool SP2 = false>
__device__ __forceinline__ void gemm_phase(PG8_LAS unsigned char* lds, const Gemm g, const Sched& S, const Epi& E) {
    int tid_ = threadIdx.x; asm volatile("" : "+v"(tid_));
    const int tid = tid_, wid = __builtin_amdgcn_readfirstlane(tid >> 6), lane = tid & 63, wr = wid >> 2, wc = wid & 3, fr = lane & 15, fq = lane >> 4;
    const int K = g.K, nt = K / BK;
    unsigned voffA[2], voffB[2];
#pragma unroll
    for (int i = 0; i < 2; ++i) { int R, C; stage_rc(tid * 16 + i * 8192, R, C); const int Rb = Epi::PERM ? ((R & ~31) + perm32(R & 31)) : R;
        voffA[i] = (unsigned)(R * K + C) * 2u; voffB[i] = (unsigned)(Rb * K + C) * 2u; }
    const size_t kstep = (size_t)(BK * 2);
    const size_t hstep = (size_t)HALF * K * 2;
    const size_t tstep = 2 * hstep;
    const unsigned ldsw = (unsigned)wid * 1024u;
    const int aoff = lds_byte(wr * 64 + fr, fq * 8), boff = lds_byte(wc * 32 + fr, fq * 8);
#define PG8_SA(b, h) (((b) * 2 + (h)) * HTB)
#define PG8_SB(b, h) ((4 + (b) * 2 + (h)) * HTB)
#define PG8_STAGE(bufoff, gbase, voff) do { _Pragma("unroll") for (int _i = 0; _i < 2; ++_i) \
        __builtin_amdgcn_global_load_lds((const unsigned*)((const char*)(gbase) + (voff)[_i]), (PG8_LAS unsigned*)(lds + (bufoff) + ldsw + _i * 8192), 16, 0, 0); } while (0)
#define PG8_LDA(dst, b, h) do { _Pragma("unroll") for (int m = 0; m < 4; ++m) _Pragma("unroll") for (int k = 0; k < 2; ++k) dst[m][k] = *(const PG8_LAS bf16x8*)(lds + PG8_SA(b, h) + aoff + m * 2048 + k * 1024); } while (0)
#define PG8_LDB(dst, b, h) do { _Pragma("unroll") for (int n = 0; n < 2; ++n) _Pragma("unroll") for (int k = 0; k < 2; ++k) dst[n][k] = *(const PG8_LAS bf16x8*)(lds + PG8_SB(b, h) + boff + n * 2048 + k * 1024); } while (0)
#define PG8_MMA(ai, bj, At, Bt) do { __builtin_amdgcn_s_setprio(1); _Pragma("unroll") for (int m = 0; m < 4; ++m) _Pragma("unroll") for (int n = 0; n < 2; ++n) _Pragma("unroll") for (int k = 0; k < 2; ++k) \
        acc[ai][bj][m][n] = __builtin_amdgcn_mfma_f32_16x16x32_bf16(Bt[n][k], At[m][k], acc[ai][bj][m][n], 0, 0, 0); __builtin_amdgcn_s_setprio(0); } while (0)
#define PG8_WAIT_V(n) asm volatile("s_waitcnt vmcnt(" #n ")" ::: "memory")
#define PG8_WAIT_L(n) asm volatile("s_waitcnt lgkmcnt(" #n ")" ::: "memory")
#define PG8_BAR __builtin_amdgcn_s_barrier()
#define PG8_SCHED __builtin_amdgcn_sched_barrier(0)
    Unit cur, nxt; int ui = 0;
    if (!S.next(0, cur)) return;
    f32x4 acc[2][2][4][2];
#pragma unroll
    for (int a = 0; a < 2; ++a)
#pragma unroll
        for (int b = 0; b < 2; ++b)
#pragma unroll
            for (int m = 0; m < 4; ++m)
#pragma unroll
                for (int n = 0; n < 2; ++n) acc[a][b][m][n] = (f32x4){0.f, 0.f, 0.f, 0.f};
    bf16x8 At[4][2], B0[2][2], B1[2][2];
    const char* cA = (const char*)g.A + (size_t)cur.pm * tstep; const char* cB = (const char*)g.Bt + (size_t)cur.pn * tstep;
    S.a_ready(cur);
    if constexpr (SP2) {
        PG8_STAGE(PG8_SB(0, 0), cB, voffB); PG8_STAGE(PG8_SB(0, 1), cB + hstep, voffB); PG8_STAGE(PG8_SA(0, 0), cA, voffA); PG8_STAGE(PG8_SA(0, 1), cA + hstep, voffA);
        if (wr == 1) PG8_BAR;
        PG8_WAIT_V(2); PG8_BAR;
        PG8_STAGE(PG8_SB(1, 0), cB + kstep, voffB); PG8_STAGE(PG8_SA(1, 0), cA + kstep, voffA); PG8_STAGE(PG8_SB(1, 1), cB + hstep + kstep, voffB);
        PG8_WAIT_V(6); PG8_BAR;
    } else {
        PG8_STAGE(PG8_SB(0, 0), cB, voffB); PG8_STAGE(PG8_SA(0, 0), cA, voffA); PG8_STAGE(PG8_SB(0, 1), cB + hstep, voffB); PG8_STAGE(PG8_SA(0, 1), cA + hstep, voffA);
        if (wr == 1) PG8_BAR;
        PG8_WAIT_V(4); PG8_BAR;
        PG8_STAGE(PG8_SB(1, 0), cB + kstep, voffB); PG8_STAGE(PG8_SA(1, 0), cA + kstep, voffA); PG8_STAGE(PG8_SB(1, 1), cB + hstep + kstep, voffB);
        PG8_WAIT_V(6); PG8_BAR;
    }
    for (;;) {
        const bool has_next = S.next(ui + 1, nxt);
        const char* nA = has_next ? (const char*)g.A + (size_t)nxt.pm * tstep : cA; const char* nB = has_next ? (const char*)g.Bt + (size_t)nxt.pn * tstep : cB;
        for (int t = 0; t < nt; t += 2) {
            const bool last = (t == nt - 2);
            const char* a1 = cA + (size_t)(t + 1) * kstep;
            const char* a2 = last ? nA : cA + (size_t)(t + 2) * kstep; const char* b2 = last ? nB : cB + (size_t)(t + 2) * kstep;
            const char* a3 = a2 + kstep; const char* b3 = b2 + kstep;
            if (last && has_next) S.a_ready(nxt);
            if constexpr (SP2) {
            PG8_LDB(B0, 0, 0); PG8_LDB(B1, 0, 1); PG8_SCHED; PG8_LDA(At, 0, 0); PG8_STAGE(PG8_SA(1, 1), a1 + hstep, voffA);
            PG8_WAIT_V(8); PG8_WAIT_L(0); PG8_BAR; PG8_MMA(0, 0, At, B0); PG8_MMA(0, 1, At, B1); PG8_BAR; PG8_SCHED;
            PG8_LDA(At, 0, 1); PG8_STAGE(PG8_SB(0, 0), b2, voffB); PG8_STAGE(PG8_SB(0, 1), b2 + hstep, voffB); PG8_STAGE(PG8_SA(0, 0), a2, voffA);
            PG8_WAIT_V(8); PG8_WAIT_L(0); PG8_BAR; PG8_MMA(1, 0, At, B0); PG8_MMA(1, 1, At, B1); PG8_BAR; PG8_SCHED;
            PG8_LDB(B0, 1, 0); PG8_LDB(B1, 1, 1); PG8_SCHED; PG8_LDA(At, 1, 0); PG8_STAGE(PG8_SA(0, 1), a2 + hstep, voffA);
            PG8_WAIT_V(8); PG8_WAIT_L(0); PG8_BAR; PG8_MMA(0, 0, At, B0); PG8_MMA(0, 1, At, B1); PG8_BAR; PG8_SCHED;
            PG8_LDA(At, 1, 1); PG8_STAGE(PG8_SB(1, 0), b3, voffB); PG8_STAGE(PG8_SB(1, 1), b3 + hstep, voffB); PG8_STAGE(PG8_SA(1, 0), a3, voffA);
            PG8_WAIT_V(8); PG8_WAIT_L(0); PG8_BAR; PG8_MMA(1, 0, At, B0); PG8_MMA(1, 1, At, B1); PG8_BAR; PG8_SCHED;
            } else {
            PG8_LDB(B0, 0, 0); PG8_SCHED; PG8_LDA(At, 0, 0); PG8_STAGE(PG8_SA(1, 1), a1 + hstep, voffA);
            PG8_WAIT_L(8); PG8_BAR; PG8_WAIT_L(0); PG8_MMA(0, 0, At, B0); PG8_BAR; PG8_SCHED;
            PG8_LDB(B1, 0, 1); PG8_STAGE(PG8_SB(0, 0), b2, voffB);
            PG8_BAR; PG8_WAIT_L(0); PG8_MMA(0, 1, At, B1); PG8_BAR;
            PG8_LDA(At, 0, 1); PG8_STAGE(PG8_SA(0, 0), a2, voffA);
            PG8_BAR; PG8_WAIT_L(0); PG8_MMA(1, 0, At, B0); PG8_BAR; PG8_SCHED;
            PG8_STAGE(PG8_SB(0, 1), b2 + hstep, voffB);
            PG8_WAIT_V(6); PG8_BAR; PG8_MMA(1, 1, At, B1); PG8_BAR;
            PG8_LDB(B0, 1, 0); PG8_SCHED; PG8_LDA(At, 1, 0); PG8_STAGE(PG8_SA(0, 1), a2 + hstep, voffA);
            PG8_WAIT_L(8); PG8_BAR; PG8_WAIT_L(0); PG8_MMA(0, 0, At, B0); PG8_BAR; PG8_SCHED;
            PG8_LDB(B1, 1, 1); PG8_STAGE(PG8_SB(1, 0), b3, voffB);
            PG8_BAR; PG8_WAIT_L(0); PG8_MMA(0, 1, At, B1); PG8_BAR;
            PG8_LDA(At, 1, 1); PG8_STAGE(PG8_SA(1, 0), a3, voffA);
            PG8_BAR; PG8_WAIT_L(0); PG8_MMA(1, 0, At, B0); PG8_BAR; PG8_SCHED;
            PG8_STAGE(PG8_SB(1, 1), b3 + hstep, voffB);
            PG8_WAIT_V(6); PG8_BAR; PG8_MMA(1, 1, At, B1); PG8_BAR;
            }
        }
        if constexpr (ALIGN_EPI) { if (wr == 0) PG8_BAR; }
        if constexpr (!Epi::AFTER_DRAIN) { E(acc, cur, wr, wc, fr, fq); S.done(cur); }
        if (!has_next) break;
#pragma unroll
        for (int a = 0; a < 2; ++a)
#pragma unroll
            for (int b = 0; b < 2; ++b)
#pragma unroll
                for (int m = 0; m < 4; ++m)
#pragma unroll
                    for (int n = 0; n < 2; ++n) acc[a][b][m][n] = (f32x4){0.f, 0.f, 0.f, 0.f};
        cur = nxt; cA = nA; cB = nB; ++ui;
        if constexpr (ALIGN_EPI) { if (wr == 1) PG8_BAR; }
    }
    PG8_WAIT_V(0);
    if constexpr (!ALIGN_EPI) { if (wr == 0) PG8_BAR; }
    PG8_BAR;
    if constexpr (Epi::AFTER_DRAIN) { E.fused(acc, cur, wr, wc, fr, fq, lds, wid, lane); S.done(cur); }
#undef PG8_SA
#undef PG8_SB
#undef PG8_STAGE
#undef PG8_LDA
#undef PG8_LDB
#undef PG8_MMA
#undef PG8_WAIT_V
#undef PG8_WAIT_L
#undef PG8_BAR
#undef PG8_SCHED
}
}
namespace att {
typedef unsigned short bf16;
using bf16x8 = __attribute__((ext_vector_type(8))) short;
using s16x4  = __attribute__((ext_vector_type(4))) short;
using f32x16 = __attribute__((ext_vector_type(16))) float;
using u32x4  = __attribute__((ext_vector_type(4))) unsigned;
constexpr int   D = 128, NW = 8, QBLK = 32, KVBLK = 64;
constexpr float SCALE = 0.088388347648318440f;
constexpr float THR = 8.f;
constexpr int SHM_V = KVBLK * D * 2, SHM_K = KVBLK * D * 2, SHM_ATTN = 2 * SHM_V + 2 * SHM_K + NW * 64 * 4;
constexpr float MASKED = -1e30f, M_INIT = -1e28f;
#define KSWZ(row, colB) ((row) * 256 + ((colB) ^ (((row) & 7) << 4)))
#define SBAR() __builtin_amdgcn_sched_barrier(0)
__device__ __forceinline__ int crow(int r, int hi) { return (r & 3) + 8 * (r >> 2) + 4 * hi; }
__device__ __forceinline__ unsigned cvtpk(float lo, float hi) {
  unsigned r; asm volatile("v_cvt_pk_bf16_f32 %0, %1, %2" : "=v"(r) : "v"(lo), "v"(hi)); return r;
}
__device__ __forceinline__ void partialSM(f32x16& p0, f32x16& p1, float& m_reg, float& mn, float& alpha) {
  constexpr float C = SCALE * 1.4426950408889634f;
  float pmax = p0[0];
#pragma unroll
  for (int r = 1; r < 16; ++r) pmax = fmaxf(pmax, p0[r]);
#pragma unroll
  for (int r = 0; r < 16; ++r) pmax = fmaxf(pmax, p1[r]);
  { auto rr = __builtin_amdgcn_permlane32_swap(__float_as_uint(pmax), __float_as_uint(pmax), false, false);
    pmax = fmaxf(__uint_as_float(rr[0]), __uint_as_float(rr[1])); }
  if (__builtin_expect(__all(pmax - m_reg <= THR / SCALE), 1)) { mn = m_reg; alpha = 1.f; }
  else { mn = fmaxf(m_reg, pmax); alpha = __builtin_amdgcn_exp2f((m_reg - mn) * C); m_reg = mn; }
  float mnC = -mn * C;
#pragma unroll
  for (int r = 0; r < 16; ++r) p0[r] = fmaf(p0[r], C, mnC);
#pragma unroll
  for (int r = 0; r < 16; ++r) p1[r] = fmaf(p1[r], C, mnC);
#pragma unroll
  for (int r = 0; r < 16; ++r) p0[r] = __builtin_amdgcn_exp2f(p0[r]);
}
__device__ __forceinline__ void finishSM(f32x16& p0, f32x16& p1, float alpha, float& l_reg, bf16x8& pa0, bf16x8& pa1, bf16x8& pa2, bf16x8& pa3) {
#pragma unroll
  for (int r = 0; r < 16; ++r) p1[r] = __builtin_amdgcn_exp2f(p1[r]);
  float ps = 0;
#pragma unroll
  for (int r = 0; r < 16; ++r) ps += p0[r];
#pragma unroll
  for (int r = 0; r < 16; ++r) ps += p1[r];
  { auto rr = __builtin_amdgcn_permlane32_swap(__float_as_uint(ps), __float_as_uint(ps), false, false);
    ps = __uint_as_float(rr[0]) + __uint_as_float(rr[1]); }
  l_reg = l_reg * alpha + ps;
#define PK4(P, BASE, OUT) do { unsigned a0 = cvtpk(P[BASE + 0], P[BASE + 1]), a1 = cvtpk(P[BASE + 2], P[BASE + 3]);   \
    unsigned b0 = cvtpk(P[BASE + 4], P[BASE + 5]), b1 = cvtpk(P[BASE + 6], P[BASE + 7]);                              \
    auto r0 = __builtin_amdgcn_permlane32_swap(a0, b0, false, false); auto r1 = __builtin_amdgcn_permlane32_swap(a1, b1, false, false); \
    u32x4 w = {r0[0], r1[0], r0[1], r1[1]}; OUT = *reinterpret_cast<bf16x8*>(&w); } while (0)
  PK4(p0, 0, pa0); PK4(p0, 8, pa1); PK4(p1, 0, pa2); PK4(p1, 8, pa3);
#undef PK4
}
template <bool BAND>
__device__ __forceinline__ void qkt(f32x16& p0, f32x16& p1, const bf16* Ks, const bf16x8* qr, int r32, int hi, float dq, float kf0, float nsl, float radius, float Lf, int side) {
  if (!BAND && side != 0) {
    const float ns = side > 0 ? nsl : -nsl, t = ns * dq;
#pragma unroll
    for (int r = 0; r < 16; ++r) { const float c0 = (float)((r & 3) + 8 * (r >> 2)); p0[r] = fmaf(ns, -c0, t); p1[r] = fmaf(ns, -(c0 + 32.f), t); }
  } else
#pragma unroll
  for (int r = 0; r < 16; ++r) {
    const float c0 = (float)((r & 3) + 8 * (r >> 2));
    const float d0 = dq - c0, d1 = dq - (c0 + 32.f);
    float b0 = nsl * fabsf(d0), b1 = nsl * fabsf(d1);
    if (BAND) {
      const float ka = kf0 + c0, kb = kf0 + (c0 + 32.f);
      const bool v0 = (fabsf(d0) <= radius) && (ka >= 0.f) && (ka < Lf);
      const bool v1 = (fabsf(d1) <= radius) && (kb >= 0.f) && (kb < Lf);
      b0 = v0 ? b0 : MASKED; b1 = v1 ? b1 : MASKED;
    }
    p0[r] = b0; p1[r] = b1;
  }
#pragma unroll
  for (int d0 = 0; d0 < 8; ++d0) { int cb = (d0 * 16 + hi * 8) * 2;
    bf16x8 b0 = *reinterpret_cast<const bf16x8*>((const char*)Ks + KSWZ(r32, cb));
    bf16x8 b1 = *reinterpret_cast<const bf16x8*>((const char*)Ks + KSWZ(32 + r32, cb));
    p0 = __builtin_amdgcn_mfma_f32_32x32x16_bf16(b0, qr[d0], p0, 0, 0, 0);
    p1 = __builtin_amdgcn_mfma_f32_32x32x16_bf16(b1, qr[d0], p1, 0, 0, 0); }
}
#define QK_RD(A, B, D0) do { const int ad_ = kb + kx[D0]; asm volatile("ds_read_b128 %0, %1" : "=&v"(A) : "v"(ad_) : "memory"); asm volatile("ds_read_b128 %0, %1 offset:8192" : "=&v"(B) : "v"(ad_) : "memory"); } while (0)
#define QK_WAIT(N, A, B) asm volatile("s_waitcnt lgkmcnt(" #N ")" : "+v"(A), "+v"(B) :: "memory")
#define QK_MM(A, B, D0) do { p0 = __builtin_amdgcn_mfma_f32_32x32x16_bf16(A, qr[D0], p0, 0, 0, 0); p1 = __builtin_amdgcn_mfma_f32_32x32x16_bf16(B, qr[D0], p1, 0, 0, 0); } while (0)
__device__ __forceinline__ void qkt_pipe(f32x16& p0, f32x16& p1, int kb, const int (&kx)[8], const bf16x8* qr, float dq, float nsl, int side) {
  if (side != 0) {
    const float ns = side > 0 ? nsl : -nsl, t = ns * dq;
#pragma unroll
    for (int r = 0; r < 16; ++r) { const float c0 = (float)((r & 3) + 8 * (r >> 2)); p0[r] = fmaf(ns, -c0, t); p1[r] = fmaf(ns, -(c0 + 32.f), t); }
  } else {
#pragma unroll
    for (int r = 0; r < 16; ++r) { const float c0 = (float)((r & 3) + 8 * (r >> 2)); p0[r] = nsl * fabsf(dq - c0); p1[r] = nsl * fabsf(dq - (c0 + 32.f)); }
  }
  bf16x8 a0, b0, a1, b1, a2, b2, a3, b3;
  QK_RD(a0, b0, 0); QK_RD(a1, b1, 1); QK_RD(a2, b2, 2); QK_RD(a3, b3, 3);
  QK_WAIT(6, a0, b0); SBAR(); QK_MM(a0, b0, 0); QK_RD(a0, b0, 4);
  QK_WAIT(6, a1, b1); SBAR(); QK_MM(a1, b1, 1); QK_RD(a1, b1, 5);
  QK_WAIT(6, a2, b2); SBAR(); QK_MM(a2, b2, 2); QK_RD(a2, b2, 6);
  QK_WAIT(6, a3, b3); SBAR(); QK_MM(a3, b3, 3); QK_RD(a3, b3, 7);
  QK_WAIT(6, a0, b0); SBAR(); QK_MM(a0, b0, 4);
  QK_WAIT(4, a1, b1); SBAR(); QK_MM(a1, b1, 5);
  QK_WAIT(2, a2, b2); SBAR(); QK_MM(a2, b2, 6);
  QK_WAIT(0, a3, b3); SBAR(); QK_MM(a3, b3, 7);
}
#undef QK_RD
#undef QK_WAIT
#undef QK_MM
__device__ __forceinline__ int v_st(int k, int c) { const int kk = (k & ~0xC) | ((k & 4) << 1) | ((k & 8) >> 1); return ((kk >> 3) * 4 + (c >> 5)) * 512 + ((kk & 7) * 32 + (c & 31)) * 2; }
__device__ __forceinline__ int v_rd_base(int lane) { return ((lane & 3) << 3) | (((lane >> 2) & 3) << 6) | (((lane >> 4) & 1) << 5) | (((lane >> 5) & 1) << 8); }
constexpr int v_rd_off(int d0, int ks, int half) { return d0 * 512 + ks * 4096 + half * 2048; }
template <int OFF> __device__ __forceinline__ s16x4 tr_read(int vb) {
  s16x4 r; asm volatile("ds_read_b64_tr_b16 %0, %1 offset:%2" : "=&v"(r) : "v"(vb), "i"(OFF) : "memory"); return r;
}
template <int D0> __device__ __forceinline__ void pv_one(f32x16& od, int vb, bf16x8 pa0, bf16x8 pa1, bf16x8 pa2, bf16x8 pa3) {
  const s16x4 l0 = tr_read<v_rd_off(D0, 0, 0)>(vb), h0 = tr_read<v_rd_off(D0, 0, 1)>(vb), l1 = tr_read<v_rd_off(D0, 1, 0)>(vb), h1 = tr_read<v_rd_off(D0, 1, 1)>(vb);
  const s16x4 l2 = tr_read<v_rd_off(D0, 2, 0)>(vb), h2 = tr_read<v_rd_off(D0, 2, 1)>(vb), l3 = tr_read<v_rd_off(D0, 3, 0)>(vb), h3 = tr_read<v_rd_off(D0, 3, 1)>(vb);
  asm volatile("s_waitcnt lgkmcnt(0)" ::: "memory"); SBAR();
#define PK(L, H) (bf16x8){L[0], L[1], L[2], L[3], H[0], H[1], H[2], H[3]}
  od = __builtin_amdgcn_mfma_f32_32x32x16_bf16(pa0, PK(l0, h0), od, 0, 0, 0);
  od = __builtin_amdgcn_mfma_f32_32x32x16_bf16(pa1, PK(l1, h1), od, 0, 0, 0);
  od = __builtin_amdgcn_mfma_f32_32x32x16_bf16(pa2, PK(l2, h2), od, 0, 0, 0);
  od = __builtin_amdgcn_mfma_f32_32x32x16_bf16(pa3, PK(l3, h3), od, 0, 0, 0);
#undef PK
}
__device__ __forceinline__ void pv_d0(f32x16* o, int vb, bf16x8 pa0, bf16x8 pa1, bf16x8 pa2, bf16x8 pa3) {
  pv_one<0>(o[0], vb, pa0, pa1, pa2, pa3); pv_one<1>(o[1], vb, pa0, pa1, pa2, pa3); pv_one<2>(o[2], vb, pa0, pa1, pa2, pa3); pv_one<3>(o[3], vb, pa0, pa1, pa2, pa3);
}

#define PV_RD(F, D0) do { F##0 = tr_read<v_rd_off(D0, 0, 0)>(vb); F##1 = tr_read<v_rd_off(D0, 0, 1)>(vb); F##2 = tr_read<v_rd_off(D0, 1, 0)>(vb); F##3 = tr_read<v_rd_off(D0, 1, 1)>(vb); \
    F##4 = tr_read<v_rd_off(D0, 2, 0)>(vb); F##5 = tr_read<v_rd_off(D0, 2, 1)>(vb); F##6 = tr_read<v_rd_off(D0, 3, 0)>(vb); F##7 = tr_read<v_rd_off(D0, 3, 1)>(vb); } while (0)
#define PV_WAIT(N, F) asm volatile("s_waitcnt lgkmcnt(" #N ")" : "+v"(F##0), "+v"(F##1), "+v"(F##2), "+v"(F##3), "+v"(F##4), "+v"(F##5), "+v"(F##6), "+v"(F##7) :: "memory")
#define PV_PK(L, H) (bf16x8){L[0], L[1], L[2], L[3], H[0], H[1], H[2], H[3]}
#define PV_MM(OD, F) do { OD = __builtin_amdgcn_mfma_f32_32x32x16_bf16(pa0, PV_PK(F##0, F##1), OD, 0, 0, 0); OD = __builtin_amdgcn_mfma_f32_32x32x16_bf16(pa1, PV_PK(F##2, F##3), OD, 0, 0, 0); \
    OD = __builtin_amdgcn_mfma_f32_32x32x16_bf16(pa2, PV_PK(F##4, F##5), OD, 0, 0, 0); OD = __builtin_amdgcn_mfma_f32_32x32x16_bf16(pa3, PV_PK(F##6, F##7), OD, 0, 0, 0); } while (0)
__device__ __forceinline__ void pv_pipe(f32x16* o, int vb, bf16x8 pa0, bf16x8 pa1, bf16x8 pa2, bf16x8 pa3) {
  s16x4 a0, a1, a2, a3, a4, a5, a6, a7, b0, b1, b2, b3, b4, b5, b6, b7;
  PV_RD(a, 0);
  PV_RD(b, 1); PV_WAIT(8, a); SBAR(); PV_MM(o[0], a);
  PV_RD(a, 2); PV_WAIT(8, b); SBAR(); PV_MM(o[1], b);
  PV_RD(b, 3); PV_WAIT(8, a); SBAR(); PV_MM(o[2], a);
  PV_WAIT(0, b); SBAR(); PV_MM(o[3], b);
}
#undef PV_RD
#undef PV_WAIT
#undef PV_PK
#undef PV_MM

#define ATT_GAS __attribute__((address_space(1)))
struct UnitArgs {
  const ATT_GAS bf16* Q; long ldq;
  const ATT_GAS bf16* K; const ATT_GAS bf16* V; long ldk;
  int q0, L, kt0, nt;
  float nsl, radius, m_init, l_init;
  ATT_GAS float* Of; ATT_GAS bf16* Ob; long ldo;
  ATT_GAS float* lse; long ldl;
};

template <bool BAND, int SDEPTH>
__device__ __forceinline__ void attn_unit(const UnitArgs& a_in, char* lds) {
  UnitArgs a = a_in;
  asm volatile("" : "+s"(a.Q), "+s"(a.ldq), "+s"(a.K), "+s"(a.V), "+s"(a.ldk));
  asm volatile("" : "+s"(a.q0), "+s"(a.L), "+s"(a.kt0), "+s"(a.nt));
  asm volatile("" : "+s"(a.Of), "+s"(a.Ob), "+s"(a.ldo), "+s"(a.lse), "+s"(a.ldl));
  int tid_ = threadIdx.x; asm volatile("" : "+v"(tid_));
  const int tid = tid_, wid = tid >> 6, lane = tid & 63, r32 = lane & 31, hi = lane >> 5;
  bf16* V_lds = (bf16*)lds; bf16* K_lds = (bf16*)(lds + 2 * SHM_V);
  float* ws = (float*)(lds + 2 * SHM_V + 2 * SHM_K) + wid * 64; float* li_l = ws; float* al_l = ws + 32;
  float m_reg = a.m_init, l_reg = a.l_init; f32x16 o[4] = {}; bf16x8 qr[8];
  const ATT_GAS bf16* Qw = a.Q + (long)(wid * QBLK + r32) * a.ldq + hi * 8;
#pragma unroll
  for (int d0 = 0; d0 < 8; ++d0) qr[d0] = *reinterpret_cast<const ATT_GAS bf16x8*>(Qw + d0 * 16);
  const int sr = tid >> 4, sc = (tid & 15) * 8, vst0 = v_st(sr, sc), vst1 = v_st(32 + sr, sc);
  const int vb0 = (int)(uintptr_t)V_lds + v_rd_base(lane);
  const float qf = (float)(a.q0 + wid * QBLK + r32), Lf = (float)a.L, nsl = a.nsl, radius = a.radius;
  const int Lm1 = a.L - 1, kt0 = a.kt0, qw0 = a.q0 + __builtin_amdgcn_readfirstlane(wid) * QBLK;
  const ATT_GAS bf16* Kp = a.K; const ATT_GAS bf16* Vp = a.V; const long ldk = a.ldk;
  struct { bf16x8 vs0, vs1, ks0, ks1; } sr_[SDEPTH];
  const unsigned lofs = (unsigned)((sr * ldk + sc) * 2);
  const ATT_GAS char* Kc = (const ATT_GAS char*)Kp; const ATT_GAS char* Vc = (const ATT_GAS char*)Vp; const long ldk32 = 32 * ldk * 2, ldk64 = 64 * ldk * 2;
#define SLOAD(i, t) do { if constexpr (BAND) { const int k0_ = (kt0 + (t)) * KVBLK; int ra_ = k0_ + sr, rb_ = k0_ + 32 + sr;                   \
    ra_ = ra_ < 0 ? 0 : (ra_ > Lm1 ? Lm1 : ra_); rb_ = rb_ < 0 ? 0 : (rb_ > Lm1 ? Lm1 : rb_);                                          \
    sr_[i].vs0 = *reinterpret_cast<const ATT_GAS bf16x8*>(&Vp[(long)ra_ * ldk + sc]); sr_[i].vs1 = *reinterpret_cast<const ATT_GAS bf16x8*>(&Vp[(long)rb_ * ldk + sc]); \
    sr_[i].ks0 = *reinterpret_cast<const ATT_GAS bf16x8*>(&Kp[(long)ra_ * ldk + sc]); sr_[i].ks1 = *reinterpret_cast<const ATT_GAS bf16x8*>(&Kp[(long)rb_ * ldk + sc]); } \
  else { const long tb_ = (long)(kt0 + (t)) * ldk64;                                                                                       \
    sr_[i].vs0 = *reinterpret_cast<const ATT_GAS bf16x8*>(Vc + tb_ + lofs); sr_[i].vs1 = *reinterpret_cast<const ATT_GAS bf16x8*>(Vc + tb_ + ldk32 + lofs); \
    sr_[i].ks0 = *reinterpret_cast<const ATT_GAS bf16x8*>(Kc + tb_ + lofs); sr_[i].ks1 = *reinterpret_cast<const ATT_GAS bf16x8*>(Kc + tb_ + ldk32 + lofs); } } while (0)
#define SWRITE(b, i) do { *(bf16x8*)((char*)V_lds + (b) * SHM_V + vst0) = sr_[i].vs0;          \
    *(bf16x8*)((char*)V_lds + (b) * SHM_V + vst1) = sr_[i].vs1; int kc = sc * 2;               \
    *(bf16x8*)((char*)K_lds + (b) * SHM_K + KSWZ(sr, kc)) = sr_[i].ks0;                       \
    *(bf16x8*)((char*)K_lds + (b) * SHM_K + KSWZ(32 + sr, kc)) = sr_[i].ks1; } while (0)
#define SWAIT() do { if constexpr (SDEPTH == 2) asm volatile("s_waitcnt vmcnt(4)" ::: "memory"); else asm volatile("s_waitcnt vmcnt(0)" ::: "memory"); } while (0)
#define RESC(al) do { if (__any((al) < 1.f)) { if (hi == 0) al_l[r32] = (al); asm volatile("s_waitcnt lgkmcnt(0)" ::: "memory"); \
    _Pragma("unroll") for (int d = 0; d < 4; ++d) _Pragma("unroll") for (int r = 0; r < 16; ++r) o[d][r] *= al_l[crow(r, hi)]; } } while (0)
#define QKT(PA, PB, buf, t) do { const int k0_ = (kt0 + (t)) * KVBLK; const float kf0_ = (float)(k0_ + 4 * hi); \
    const int side_ = (k0_ + KVBLK - 1 < qw0) ? 1 : ((k0_ > qw0 + QBLK - 1) ? -1 : 0); \
    qkt<BAND>(PA, PB, (bf16*)((char*)K_lds + (buf) * SHM_K), qr, r32, hi, qf - kf0_, kf0_, nsl, radius, Lf, side_); } while (0)
  f32x16 pA0, pA1, pB0, pB1; float mnA, mnB, alA, alB; bf16x8 pa0, pa1, pa2, pa3; const int NT = a.nt;
  constexpr int SE = 0, SO = SDEPTH - 1;
  SLOAD(SE, 0); asm volatile("s_waitcnt vmcnt(0)" ::: "memory"); SWRITE(0, SE); __syncthreads();
  QKT(pA0, pA1, 0, 0); partialSM(pA0, pA1, m_reg, mnA, alA);
  SLOAD(SO, 1); if constexpr (SDEPTH == 2) { if (2 < NT) SLOAD(SE, 2); }
  SWAIT(); SWRITE(1, SO); __syncthreads();
  for (int j = 1; j + 1 < NT; j += 2) {
    SBAR(); QKT(pB0, pB1, 1, j);
    finishSM(pA0, pA1, alA, l_reg, pa0, pa1, pa2, pa3); SBAR();
    SLOAD(SO, j + SDEPTH); SBAR();
    pv_d0(o, vb0, pa0, pa1, pa2, pa3); partialSM(pB0, pB1, m_reg, mnB, alB);
    __syncthreads(); SWAIT(); SWRITE(0, SE);
    RESC(alB); __syncthreads();
    SBAR(); QKT(pA0, pA1, 0, j + 1);
    finishSM(pB0, pB1, alB, l_reg, pa0, pa1, pa2, pa3); SBAR();
    if (SDEPTH == 1 || j + 3 < NT) SLOAD(SE, j + 1 + SDEPTH); SBAR();
    pv_d0(o, vb0 + (int)SHM_V, pa0, pa1, pa2, pa3); partialSM(pA0, pA1, m_reg, mnA, alA);
    __syncthreads(); SWAIT(); SWRITE(1, SO);
    RESC(alA); __syncthreads();
  }
  SBAR(); QKT(pB0, pB1, 1, NT - 1);
  finishSM(pA0, pA1, alA, l_reg, pa0, pa1, pa2, pa3); SBAR();
  pv_d0(o, vb0, pa0, pa1, pa2, pa3); partialSM(pB0, pB1, m_reg, mnB, alB);
  __syncthreads(); RESC(alB);
  finishSM(pB0, pB1, alB, l_reg, pa0, pa1, pa2, pa3); SBAR();
  pv_d0(o, vb0 + (int)SHM_V, pa0, pa1, pa2, pa3);
  if (hi == 0) li_l[r32] = l_reg; asm volatile("s_waitcnt lgkmcnt(0)" ::: "memory");
  float rli[16];
#pragma unroll
  for (int r = 0; r < 16; ++r) rli[r] = __builtin_amdgcn_rcpf(li_l[crow(r, hi)]);
  if (a.Of) {
    ATT_GAS float* Ow = a.Of + (long)(wid * QBLK) * a.ldo;
#pragma unroll
    for (int r = 0; r < 16; ++r) { const int orow = crow(r, hi);
#pragma unroll
      for (int d0 = 0; d0 < 4; ++d0) Ow[(long)orow * a.ldo + d0 * 32 + r32] = o[d0][r] * rli[r]; }
  } else {
    ATT_GAS bf16* Ow = a.Ob + (long)(wid * QBLK) * a.ldo;
#pragma unroll
    for (int r = 0; r < 16; ++r) { const int orow = crow(r, hi);
#pragma unroll
      for (int d0 = 0; d0 < 4; ++d0) { const float v = o[d0][r] * rli[r]; Ow[(long)orow * a.ldo + d0 * 32 + r32] = (bf16)(cvtpk(v, v) & 0xffffu); } }
  }
  if (a.lse && hi == 0) a.lse[(long)(wid * QBLK + r32) * a.ldl] = m_reg * SCALE + __logf(l_reg);
  __syncthreads();
#undef SLOAD
#undef SWRITE
#undef SWAIT
#undef RESC
#undef QKT
}

constexpr int PU_K0 = 0, PU_V0 = 32768, PU_PS = 98304, PU_LDS = 131072;
struct PairArgs {
  const ATT_GAS bf16* Q; long ldq;
  const ATT_GAS bf16* K; const ATT_GAS bf16* V; long ldk;
  int q0, kt0, nt;
  float nsl;
  ATT_GAS float* O; long ldo;
};
__device__ __forceinline__ void attn_pair_unit(const PairArgs& a_in, char* lds, float* xs  ) {
  PairArgs a = a_in;
  asm volatile("" : "+s"(a.Q), "+s"(a.ldq), "+s"(a.K), "+s"(a.V), "+s"(a.ldk));
  asm volatile("" : "+s"(a.q0), "+s"(a.kt0), "+s"(a.nt), "+s"(a.O), "+s"(a.ldo));
  int tid_ = threadIdx.x; asm volatile("" : "+v"(tid_));
  const int tid = tid_, wid = tid >> 6, lane = tid & 63, r32 = lane & 31, hi = lane >> 5;
  const int pr = __builtin_amdgcn_readfirstlane(wid & 3), role = __builtin_amdgcn_readfirstlane(wid >> 2);
  constexpr float C = SCALE * 1.4426950408889634f;
  float* AL = xs; float* MX = xs + 256; float* LL = xs + 512; float* FL = xs + 768;
  f32x16 o[4] = {}; bf16x8 qr[8]; bf16x8 pa0, pa1, pa2, pa3; float l_part = 0.f;
  pa0 = pa1 = pa2 = pa3 = bf16x8{};
  const ATT_GAS bf16* Qw = a.Q + (long)(pr * QBLK + r32) * a.ldq + hi * 8;
#pragma unroll
  for (int d0 = 0; d0 < 8; ++d0) qr[d0] = *reinterpret_cast<const ATT_GAS bf16x8*>(Qw + d0 * 16);
  const int sr = tid >> 4, sc = (tid & 15) * 8, vr = tid >> 5, vc = (tid & 31) * 8;
  const int ksw0 = KSWZ(sr, sc * 2), ksw1 = KSWZ(32 + sr, sc * 2);
  const int vhalf = (vc >> 7) * 16384, vcc = vc & 127;
  const int vst[4] = {vhalf + v_st(vr, vcc), vhalf + v_st(vr + 16, vcc), vhalf + v_st(vr + 32, vcc), vhalf + v_st(vr + 48, vcc)};
  const unsigned kofs = (unsigned)((sr * a.ldk + sc) * 2), vofs = (unsigned)((vr * a.ldk + vc) * 2);
  const ATT_GAS char* Kc = (const ATT_GAS char*)a.K; const ATT_GAS char* Vc = (const ATT_GAS char*)a.V;
  const long ldk16 = 16 * a.ldk * 2, ldk32 = 32 * a.ldk * 2, ldk64 = 64 * a.ldk * 2;
  const int vb0 = (int)(uintptr_t)(lds + PU_V0) + role * 16384 + v_rd_base(lane);
  const float qf = (float)(a.q0 + pr * QBLK + r32), nsl = a.nsl; const int kt0 = a.kt0, qw0 = a.q0 + pr * QBLK, NT = a.nt;
  struct { bf16x8 k0, k1, v0, v1, v2, v3; } sg[2];
#define PLOADK(i, t) do { const long tb_ = (long)(kt0 + (t)) * ldk64; sg[i].k0 = *reinterpret_cast<const ATT_GAS bf16x8*>(Kc + tb_ + kofs); sg[i].k1 = *reinterpret_cast<const ATT_GAS bf16x8*>(Kc + tb_ + ldk32 + kofs); } while (0)
#define PLOADV(i, t) do { const long tb_ = (long)(kt0 + (t)) * ldk64; sg[i].v0 = *reinterpret_cast<const ATT_GAS bf16x8*>(Vc + tb_ + vofs); sg[i].v1 = *reinterpret_cast<const ATT_GAS bf16x8*>(Vc + tb_ + ldk16 + vofs); \
    sg[i].v2 = *reinterpret_cast<const ATT_GAS bf16x8*>(Vc + tb_ + 2 * ldk16 + vofs); sg[i].v3 = *reinterpret_cast<const ATT_GAS bf16x8*>(Vc + tb_ + 3 * ldk16 + vofs); } while (0)
#define PWRITEK(b, i) do { char* kb_ = lds + PU_K0 + (b) * 16384; *(bf16x8*)(kb_ + ksw0) = sg[i].k0; *(bf16x8*)(kb_ + ksw1) = sg[i].k1; } while (0)
#define PWRITEV(b, i) do { char* vb_ = lds + PU_V0 + (b) * 32768; *(bf16x8*)(vb_ + vst[0]) = sg[i].v0; *(bf16x8*)(vb_ + vst[1]) = sg[i].v1; *(bf16x8*)(vb_ + vst[2]) = sg[i].v2; *(bf16x8*)(vb_ + vst[3]) = sg[i].v3; } while (0)
#define PSTEP(t, TP) do {                                                                                                                        \
    if ((t) + 2 < NT) PLOADK(TP, (t) + 2);                                                                                                        \
    if ((t) + 1 < NT) PLOADV(TP, (t) + 1);                                                                                                        \
    SBAR();                                                                                                                                       \
    if ((t) >= 1) {                                                                                    \
      const int sp_ = ((TP) ^ 1) * 4 + pr;                                                                                                        \
      if (role == (TP)) {                              \
        const char* ps_ = lds + PU_PS + sp_ * 4096 + lane * 16;                                                                                   \
        pa0 = *(const bf16x8*)(ps_); pa1 = *(const bf16x8*)(ps_ + 1024); pa2 = *(const bf16x8*)(ps_ + 2048); pa3 = *(const bf16x8*)(ps_ + 3072);   \
        l_part *= AL[sp_ * 32 + r32];                                                                                                             \
      }                                                                                                                                           \
      if (__builtin_amdgcn_readfirstlane(__float_as_int(FL[sp_])) != 0) {                                                                         \
        _Pragma("unroll") for (int r = 0; r < 16; ++r) { const float al_ = AL[sp_ * 32 + crow(r, hi)];                                            \
          _Pragma("unroll") for (int d = 0; d < 4; ++d) o[d][r] *= al_; } }                                                                       \
      pv_pipe(o, vb0 + ((TP) ^ 1) * 32768, pa0, pa1, pa2, pa3);                                                                                     \
    }                                                                                                                                             \
    if (role == (TP) && (t) < NT) {                                                                      \
      float m_reg = M_INIT; if ((t) >= 1) m_reg = MX[(((TP) ^ 1) * 4 + pr) * 32 + r32];                                                          \
      f32x16 p0, p1; const int k0_ = (kt0 + (t)) * KVBLK; const float kf0_ = (float)(k0_ + 4 * hi);                                               \
      const int side_ = (k0_ + KVBLK - 1 < qw0) ? 1 : ((k0_ > qw0 + QBLK - 1) ? -1 : 0);                                                          \
      qkt<false>(p0, p1, (const bf16*)(lds + PU_K0 + (TP) * 16384), qr, r32, hi, qf - kf0_, kf0_, nsl, 0.f, 0.f, side_);                          \
      float mn_, al_; partialSM(p0, p1, m_reg, mn_, al_);                                                                                         \
      float l_new = l_part; finishSM(p0, p1, al_, l_new, pa0, pa1, pa2, pa3); l_part = l_new;                                                     \
      const int sc_ = (TP) * 4 + pr; char* ps_ = lds + PU_PS + sc_ * 4096 + lane * 16;                                                            \
      *(bf16x8*)(ps_) = pa0; *(bf16x8*)(ps_ + 1024) = pa1; *(bf16x8*)(ps_ + 2048) = pa2; *(bf16x8*)(ps_ + 3072) = pa3;                           \
      if (hi == 0) { AL[sc_ * 32 + r32] = al_; MX[sc_ * 32 + r32] = mn_; }                                                                        \
      const bool any_ = __any(al_ < 1.f); if (lane == 0) FL[sc_] = any_ ? 1.f : 0.f;                                                              \
    }                                                                                                                                             \
    SBAR();                                                                                                                                       \
    if ((t) + 1 < NT) PWRITEK((TP) ^ 1, (TP) ^ 1);                                    \
    if ((t) < NT) PWRITEV(TP, (TP) ^ 1);                                                                                                 \
    asm volatile("s_waitcnt lgkmcnt(0)" ::: "memory"); __syncthreads();                                                                           \
  } while (0)
  PLOADK(0, 0); PWRITEK(0, 0);
  if (1 < NT) PLOADK(1, 1);
  PLOADV(1, 0);
  asm volatile("s_waitcnt lgkmcnt(0)" ::: "memory"); __syncthreads();
  for (int t = 0; t <= NT; t += 2) {
    PSTEP(t, 0);
    if (t + 1 <= NT) PSTEP(t + 1, 1);
  }
  if (hi == 0) LL[(pr * 2 + role) * 32 + r32] = l_part;
  asm volatile("s_waitcnt lgkmcnt(0)" ::: "memory"); __syncthreads();
  float rli[16];
#pragma unroll
  for (int r = 0; r < 16; ++r) rli[r] = __builtin_amdgcn_rcpf(LL[(pr * 2) * 32 + crow(r, hi)] + LL[(pr * 2 + 1) * 32 + crow(r, hi)]);
  ATT_GAS float* Ow = a.O + (long)(pr * QBLK) * a.ldo + role * 128;
#pragma unroll
  for (int r = 0; r < 16; ++r) { const int orow = crow(r, hi);
#pragma unroll
    for (int d0 = 0; d0 < 4; ++d0) Ow[(long)orow * a.ldo + d0 * 32 + r32] = o[d0][r] * rli[r]; }
  __syncthreads();
#undef PLOADK
#undef PLOADV
#undef PWRITEK
#undef PWRITEV
#undef PSTEP
}

__device__ __forceinline__ void attn_split_unit(const PairArgs& a_in, char* lds, float* xs  ) {
  PairArgs a = a_in;
  asm volatile("" : "+s"(a.Q), "+s"(a.ldq), "+s"(a.K), "+s"(a.V), "+s"(a.ldk));
  asm volatile("" : "+s"(a.q0), "+s"(a.kt0), "+s"(a.nt), "+s"(a.O), "+s"(a.ldo));
  int tid_ = threadIdx.x; asm volatile("" : "+v"(tid_));
  const int tid = tid_, wid = tid >> 6, lane = tid & 63, r32 = lane & 31, hi = lane >> 5;
  const int pr = __builtin_amdgcn_readfirstlane(wid & 3), role = __builtin_amdgcn_readfirstlane(wid >> 2);
  float* AL = xs; float* LL = xs + 256; float* FL = xs + 512;
  const int t8 = tid & 255, sr = t8 >> 4, sc = (t8 & 15) * 8, vr = t8 >> 5, vc = (t8 & 31) * 8;
  const int ksw0 = KSWZ(sr, sc * 2), ksw1 = KSWZ(sr + 16, sc * 2), ksw2 = KSWZ(sr + 32, sc * 2), ksw3 = KSWZ(sr + 48, sc * 2);
  const int vhalf = (vc >> 7) * 16384, vcc = vc & 127;
  const unsigned kofs = (unsigned)((sr * a.ldk + sc) * 2), vofs = (unsigned)((vr * a.ldk + vc) * 2);
  const ATT_GAS char* Kc = (const ATT_GAS char*)a.K; const ATT_GAS char* Vc = (const ATT_GAS char*)a.V;
  const long ldk8 = 8 * a.ldk * 2, ldk16 = 16 * a.ldk * 2, ldk64 = 64 * a.ldk * 2;
  const int kt0 = a.kt0, NT = a.nt;
#define PLOADK(t) do { const long tb_ = (long)(kt0 + (t)) * ldk64; sk0 = *reinterpret_cast<const ATT_GAS bf16x8*>(Kc + tb_ + kofs); sk1 = *reinterpret_cast<const ATT_GAS bf16x8*>(Kc + tb_ + ldk16 + kofs); \
    sk2 = *reinterpret_cast<const ATT_GAS bf16x8*>(Kc + tb_ + 2 * ldk16 + kofs); sk3 = *reinterpret_cast<const ATT_GAS bf16x8*>(Kc + tb_ + 3 * ldk16 + kofs); } while (0)
#define PLOADV(t) do { const ATT_GAS char* vp_ = Vc + (long)(kt0 + (t)) * ldk64 + vofs; sv0 = *reinterpret_cast<const ATT_GAS bf16x8*>(vp_); sv1 = *reinterpret_cast<const ATT_GAS bf16x8*>(vp_ + ldk8); \
    sv2 = *reinterpret_cast<const ATT_GAS bf16x8*>(vp_ + 2 * ldk8); sv3 = *reinterpret_cast<const ATT_GAS bf16x8*>(vp_ + 3 * ldk8); sv4 = *reinterpret_cast<const ATT_GAS bf16x8*>(vp_ + 4 * ldk8); \
    sv5 = *reinterpret_cast<const ATT_GAS bf16x8*>(vp_ + 5 * ldk8); sv6 = *reinterpret_cast<const ATT_GAS bf16x8*>(vp_ + 6 * ldk8); sv7 = *reinterpret_cast<const ATT_GAS bf16x8*>(vp_ + 7 * ldk8); } while (0)
#define PWRITEK(b) do { char* kb_ = lds + PU_K0 + (b) * 16384; *(bf16x8*)(kb_ + ksw0) = sk0; *(bf16x8*)(kb_ + ksw1) = sk1; *(bf16x8*)(kb_ + ksw2) = sk2; *(bf16x8*)(kb_ + ksw3) = sk3; } while (0)
#define PWRITEV(b) do { char* vb_ = lds + PU_V0 + (b) * 32768 + vhalf; *(bf16x8*)(vb_ + v_st(vr, vcc)) = sv0; *(bf16x8*)(vb_ + v_st(vr + 8, vcc)) = sv1; *(bf16x8*)(vb_ + v_st(vr + 16, vcc)) = sv2; \
    *(bf16x8*)(vb_ + v_st(vr + 24, vcc)) = sv3; *(bf16x8*)(vb_ + v_st(vr + 32, vcc)) = sv4; *(bf16x8*)(vb_ + v_st(vr + 40, vcc)) = sv5; *(bf16x8*)(vb_ + v_st(vr + 48, vcc)) = sv6; \
    *(bf16x8*)(vb_ + v_st(vr + 56, vcc)) = sv7; } while (0)
#define SYNC_ONLY() do { asm volatile("s_waitcnt lgkmcnt(0)" ::: "memory"); __syncthreads(); } while (0)
  if (role == 0) {
    bf16x8 sk0, sk1, sk2, sk3;
    PLOADK(0); PWRITEK(0);
    SYNC_ONLY();
    bf16x8 qr[8]; float m_reg = M_INIT, l_reg = 0.f;
    const ATT_GAS bf16* Qw = a.Q + (long)(pr * QBLK + r32) * a.ldq + hi * 8;
#pragma unroll
    for (int d0 = 0; d0 < 8; ++d0) qr[d0] = *reinterpret_cast<const ATT_GAS bf16x8*>(Qw + d0 * 16);
    asm volatile("" : "+v"(qr[0]), "+v"(qr[1]), "+v"(qr[2]), "+v"(qr[3]), "+v"(qr[4]), "+v"(qr[5]), "+v"(qr[6]), "+v"(qr[7]));
    const float qf = (float)(a.q0 + pr * QBLK + r32), nsl = a.nsl; const int qw0 = a.q0 + pr * QBLK;
    const int kb0 = (int)(uintptr_t)(lds + PU_K0) + r32 * 256;
    int kx[8];
#pragma unroll
    for (int d0 = 0; d0 < 8; ++d0) kx[d0] = ((d0 * 16 + hi * 8) * 2) ^ ((r32 & 7) << 4);
#define SSTEP(t, TP) do { if ((t) + 1 < NT) PLOADK((t) + 1); SBAR();                                                                                                      \
      if ((t) < NT) {                                                                                                                             \
        f32x16 p0, p1; const int k0_ = (kt0 + (t)) * KVBLK; const float kf0_ = (float)(k0_ + 4 * hi);                                             \
        const int side_ = (k0_ + KVBLK - 1 < qw0) ? 1 : ((k0_ > qw0 + QBLK - 1) ? -1 : 0);                                                        \
        __builtin_amdgcn_s_setprio(2); qkt_pipe(p0, p1, kb0 + (TP) * 16384, kx, qr, qf - kf0_, nsl, side_); __builtin_amdgcn_s_setprio(0);         \
        float mn_, al_; bf16x8 pa0, pa1, pa2, pa3; partialSM(p0, p1, m_reg, mn_, al_); finishSM(p0, p1, al_, l_reg, pa0, pa1, pa2, pa3);          \
        const int sc_ = (TP) * 4 + pr; char* ps_ = lds + PU_PS + sc_ * 4096 + lane * 16;                                                          \
        *(bf16x8*)(ps_) = pa0; *(bf16x8*)(ps_ + 1024) = pa1; *(bf16x8*)(ps_ + 2048) = pa2; *(bf16x8*)(ps_ + 3072) = pa3;                         \
        if (hi == 0) AL[sc_ * 32 + r32] = al_;                                                                                                    \
        const bool any_ = __any(al_ < 1.f); if (lane == 0) FL[sc_] = any_ ? 1.f : 0.f;                                                            \
      }                                                                                                                                           \
      SBAR(); if ((t) + 1 < NT) PWRITEK((TP) ^ 1); SYNC_ONLY(); } while (0)
    for (int t = 0; t <= NT; t += 2) { SSTEP(t, 0); if (t + 1 <= NT) SSTEP(t + 1, 1); }
#undef SSTEP
    if (hi == 0) LL[pr * 32 + r32] = l_reg;
    asm volatile("s_waitcnt lgkmcnt(0)" ::: "memory"); __syncthreads();
  } else {
    f32x16 o[8] = {};
    const int vb0 = (int)(uintptr_t)(lds + PU_V0) + v_rd_base(lane);
    bf16x8 sv0, sv1, sv2, sv3, sv4, sv5, sv6, sv7;
    SYNC_ONLY();
#define VSTEP(t, TP) do { if ((t) < NT) PLOADV(t); SBAR();                                                                                        \
      if ((t) >= 1) {                                                                                                                             \
        const int sp_ = ((TP) ^ 1) * 4 + pr; const char* ps_ = lds + PU_PS + sp_ * 4096 + lane * 16;                                              \
        const bf16x8 pa0 = *(const bf16x8*)(ps_), pa1 = *(const bf16x8*)(ps_ + 1024), pa2 = *(const bf16x8*)(ps_ + 2048), pa3 = *(const bf16x8*)(ps_ + 3072); \
        if (__builtin_amdgcn_readfirstlane(__float_as_int(FL[sp_])) != 0) {                                                                       \
          _Pragma("unroll") for (int r = 0; r < 16; ++r) { const float al_ = AL[sp_ * 32 + crow(r, hi)];                                          \
            _Pragma("unroll") for (int d = 0; d < 8; ++d) o[d][r] *= al_; } }                                                                     \
        pv_pipe(o, vb0 + ((TP) ^ 1) * 32768, pa0, pa1, pa2, pa3);                                                                                 \
        pv_pipe(o + 4, vb0 + ((TP) ^ 1) * 32768 + 16384, pa0, pa1, pa2, pa3);                                                                     \
      }                                                                                                                                           \
      SBAR(); if ((t) < NT) PWRITEV(TP); SYNC_ONLY(); } while (0)
    for (int t = 0; t <= NT; t += 2) { VSTEP(t, 0); if (t + 1 <= NT) VSTEP(t + 1, 1); }
#undef VSTEP
    asm volatile("s_waitcnt lgkmcnt(0)" ::: "memory"); __syncthreads();
    float rli[16];
#pragma unroll
    for (int r = 0; r < 16; ++r) rli[r] = __builtin_amdgcn_rcpf(LL[pr * 32 + crow(r, hi)]);
    ATT_GAS float* Ow = a.O + (long)(pr * QBLK) * a.ldo;
#pragma unroll
    for (int r = 0; r < 16; ++r) { const int orow = crow(r, hi);
#pragma unroll
      for (int d0 = 0; d0 < 8; ++d0) Ow[(long)orow * a.ldo + d0 * 32 + r32] = o[d0][r] * rli[r]; }
  }
  __syncthreads();
#undef PLOADK
#undef PLOADV
#undef PWRITEK
#undef PWRITEV
#undef SYNC_ONLY
}
#undef KSWZ
#undef SBAR
}
constexpr int DM = 2048, BATCH = 2, SEQ = 4096, DEPTH = 4, M = BATCH * SEQ;
constexpr int AB_IN = 3584, AB_OUT = 1024, C_IN = 6144, DFF = 5504, UPW = 2 * DFF, MODW = 6 * DM;
constexpr float EPS = 1e-6f;
constexpr int NWAVES = 8;
constexpr size_t MiB = 1u << 20;
constexpr size_t WS_CTL = 0, CTL_ZERO_BYTES = 2 * MiB;
constexpr size_t WS_MOD = 2 * MiB;
constexpr size_t WS_PART = 3 * MiB;
constexpr size_t WS_NRM = 12 * MiB;
constexpr size_t WS_WABIN = 16 * MiB;
constexpr size_t WS_WABOUT = 44 * MiB;
constexpr size_t WS_WCIN = 52 * MiB;
constexpr size_t WS_WCOUT = 100 * MiB;
constexpr size_t WS_WUP = 116 * MiB;
constexpr size_t WS_WDOWN = 288 * MiB;
constexpr size_t WS_H = 376 * MiB;
constexpr size_t WS_PROJ = 408 * MiB;
constexpr size_t WS_ATT = 504 * MiB;
constexpr size_t WS_LSE = WS_ATT + 64 * MiB;
constexpr size_t WS_O = 632 * MiB;
constexpr size_t WS_Y = 664 * MiB;
constexpr size_t WS_XCH = 736 * MiB;
constexpr size_t WS_HG = 728 * MiB;
constexpr size_t WS_HU = 732 * MiB;
constexpr size_t WS_ACT = 900 * MiB;
constexpr size_t WS_END = 986 * MiB;
static_assert(WS_PART + (size_t)DEPTH * 16 * BATCH * MODW * 4 <= WS_WABIN, "ws map");
static_assert(WS_WABIN + (size_t)2 * AB_IN * DM * 2 <= WS_WABOUT && WS_WABOUT + (size_t)2 * DM * AB_OUT * 2 <= WS_WCIN, "ws map");
static_assert(WS_WCIN + (size_t)2 * C_IN * DM * 2 <= WS_WCOUT && WS_WCOUT + (size_t)2 * DM * DM * 2 <= WS_WUP, "ws map");
static_assert(WS_WUP + (size_t)4 * UPW * DM * 2 <= WS_WDOWN && WS_WDOWN + (size_t)4 * DM * DFF * 2 <= WS_H, "ws map");
static_assert(WS_H + (size_t)M * DM * 2 <= WS_PROJ && WS_PROJ + (size_t)M * C_IN * 2 <= WS_ATT && WS_ATT + (size_t)2 * M * DM * 4 <= WS_O, "ws map");
static_assert(WS_ATT + (size_t)3 * M * 512 * 4 <= WS_LSE && WS_LSE + (size_t)3 * M * 4 * 4 <= WS_O, "ws map");
static_assert(WS_O + (size_t)M * DM * 2 <= WS_Y && WS_Y + (size_t)M * DM * 4 <= WS_HG && WS_HG + (size_t)(M / 256) * 4 * DFF * 4 <= WS_HU && WS_HU + (size_t)(M / 256) * 2 * DFF * 4 <= WS_ACT && WS_ACT + (size_t)M * DFF * 2 <= WS_END, "ws map");
constexpr int CW_CNT = 16384;
constexpr int CW_BAR = 4096;
constexpr int RING_OFF = 0, RING_BYTES = 131072;
constexpr int LDSCTL_OFF = RING_BYTES, MISC_OFF = LDSCTL_OFF + 320, BND_OFF = LDSCTL_OFF + 1024;
constexpr int LDS_BYTES = 147456;
static_assert(att::SHM_ATTN <= RING_BYTES && att::PU_LDS <= RING_BYTES, "attention LDS fits the ring region");

#define GAS __attribute__((address_space(1)))
#define LAS __attribute__((address_space(3)))
typedef unsigned short bf16;
typedef unsigned v4u __attribute__((ext_vector_type(4)));
typedef unsigned v2u __attribute__((ext_vector_type(2)));
typedef float f32x4 __attribute__((ext_vector_type(4)));
typedef GAS unsigned gu32;
#define LDS_WAIT() asm volatile("s_waitcnt lgkmcnt(0)" ::: "memory")
__device__ __forceinline__ unsigned pk2(float lo, float hi) { unsigned r; asm volatile("v_cvt_pk_bf16_f32 %0, %1, %2" : "=v"(r) : "v"(lo), "v"(hi)); return r; }
__device__ __forceinline__ float bf_lo(unsigned w) { return __uint_as_float(w << 16); }
__device__ __forceinline__ float bf_hi(unsigned w) { return __uint_as_float(w & 0xffff0000u); }
#define XB_TMO      128
#define XB_XCNT(j)  (256  + 64 * (j))
#define XB_XSUB(j)  (1280 + 64 * (j))
#define XB_XGEN(j)  (2304 + 64 * (j))
#define XB_TOP      3328
#define XB_TOPGEN   3392
#define XCD_BAR_WORDS 3456
#define XB_SPIN_CAP (1u << 18)

__device__ __forceinline__ unsigned xb_ld(unsigned* p)              { return __hip_atomic_load(p, __ATOMIC_RELAXED, __HIP_MEMORY_SCOPE_AGENT); }
__device__ __forceinline__ unsigned xb_add(unsigned* p, unsigned v) { return __hip_atomic_fetch_add(p, v, __ATOMIC_RELAXED, __HIP_MEMORY_SCOPE_AGENT); }
__device__ __forceinline__ unsigned xb_xcc_id() { return (unsigned)__builtin_amdgcn_s_getreg((3 << 11) | 20) & 0xFu; }
#define XB_SPIN(cond, bar) do { unsigned _sp = 0; while (cond) { __builtin_amdgcn_s_sleep(1); \
    if ((++_sp & 255u) == 0u) { if (xb_ld(&(bar)[XB_TMO])) break; if (_sp > XB_SPIN_CAP) { atomicAdd(&(bar)[XB_TMO], 1u); break; } } } } while (0)

struct XcdBarrier {
    unsigned* bar; unsigned x;
    volatile LAS unsigned* st;
};

__device__ __forceinline__ XcdBarrier xcd_barrier_post(unsigned* bar, volatile LAS unsigned* st) {
    XcdBarrier b; b.bar = bar; b.x = xb_xcc_id(); b.st = st;
    if (threadIdx.x == 0) (void)xb_add(&bar[XB_XCNT(b.x)], 1u);
    return b;
}
__device__ __forceinline__ void xcd_barrier_complete(unsigned* bar, unsigned x, unsigned& nloc, unsigned& nx) {
    const unsigned G = gridDim.x * gridDim.y * gridDim.z;
    unsigned sum, cnt, mine, sp = 0u;
    for (;;) {
        sum = 0u; cnt = 0u; mine = 0u;
#pragma unroll
        for (unsigned j = 0; j < 16; ++j) { const unsigned c = xb_ld(&bar[XB_XCNT(j)]); sum += c; cnt += (c > 0u) ? 1u : 0u; mine = (j == x) ? c : mine; }
        if (sum == G) break;
        __builtin_amdgcn_s_sleep(1);
        if ((++sp & 255u) == 0u) { if (xb_ld(&bar[XB_TMO])) break; if (sp > XB_SPIN_CAP) { atomicAdd(&bar[XB_TMO], 1u); break; } }
    }
    nloc = mine > 0u ? mine : 1u; nx = cnt > 0u ? cnt : 1u;
}

__device__ __forceinline__ void xcd_barrier(const XcdBarrier& b) {
    asm volatile("s_waitcnt vmcnt(0)" ::: "memory");
    __syncthreads();
    if (threadIdx.x == 0) {
        unsigned* bar = b.bar;
        __builtin_amdgcn_s_waitcnt(0);
        unsigned nloc = b.st[0], nx = b.st[1];
        if (nloc == 0u) { xcd_barrier_complete(bar, b.x, nloc, nx); b.st[0] = nloc; b.st[1] = nx; }
        const unsigned old = xb_add(&bar[XB_XSUB(b.x)], 1u);
        const unsigned gen = old / nloc;
        if (old + 1u == (gen + 1u) * nloc) {
            __builtin_amdgcn_fence(__ATOMIC_RELEASE, "agent");
            asm volatile("s_waitcnt vmcnt(0)" ::: "memory");
            const unsigned og = xb_add(&bar[XB_TOP], 1u);
            const unsigned tg = og / nx;
            if (og + 1u == (tg + 1u) * nx) xb_add(&bar[XB_TOPGEN], 1u);
            else XB_SPIN(xb_ld(&bar[XB_TOPGEN]) == tg, bar);
            __builtin_amdgcn_fence(__ATOMIC_ACQUIRE, "agent");
            xb_add(&bar[XB_XGEN(b.x)], 1u);
            asm volatile("s_waitcnt vmcnt(0)" ::: "memory");
        } else {
            XB_SPIN(xb_ld(&bar[XB_XGEN(b.x)]) == gen, bar);
            __builtin_amdgcn_fence(__ATOMIC_ACQUIRE, "agent");
            asm volatile("s_waitcnt vmcnt(0)" ::: "memory");
        }
    }
    __syncthreads();
}
struct Frame {
    LAS unsigned char* lds; char* ldsg;
    int tid, lane, wave, G, gw, NGW;
    const float *x, *c, *ada_w, *ada_b, *norm_g, *ab_w_in, *ab_w_out, *a_sink, *c_w_in, *c_w_out, *c_lambda, *c_subln_g, *w_up, *conv_w, *conv_b, *w_down;
    float* out; unsigned char* ws;
};
#define PHASE_IDS() int tid = threadIdx.x; asm volatile("" : "+v"(tid)); const int lane = tid & 63, wave = __builtin_amdgcn_readfirstlane(tid >> 6), gw = (int)blockIdx.x * NWAVES + wave; (void)lane; (void)gw
__device__ __forceinline__ float wave_sum(float v) {
#pragma unroll
    for (int o = 1; o < 64; o <<= 1) v += __shfl_xor(v, o);
    return v;
}
__device__ __forceinline__ void transpose_item(const float* W, int K, int N, bf16* WT, LAS float* scr, int item, int lane, int remap = 0) {
    const int nblk = N / 32, kb = item / nblk, nb = item % nblk, k0 = 64 * kb, n0 = 32 * nb;
    int d0 = n0; if (remap) { const int isup = n0 >= DFF, c0 = n0 - isup * DFF; d0 = (c0 >> 7) * 256 + isup * 128 + (c0 & 127); }
    f32x4 w[8];
#pragma unroll
    for (int i = 0; i < 8; ++i) w[i] = *(const f32x4*)(W + (size_t)(k0 + (lane >> 3) + 8 * i) * N + n0 + (lane & 7) * 4);
#pragma unroll
    for (int i = 0; i < 8; ++i) { LAS float* d = scr + ((lane >> 3) + 8 * i) * 33 + (lane & 7) * 4; d[0] = w[i].x; d[1] = w[i].y; d[2] = w[i].z; d[3] = w[i].w; }
    LDS_WAIT(); asm volatile("" ::: "memory");
    const int c = lane & 7;
#pragma unroll
    for (int j = 0; j < 4; ++j) { const int n = (lane >> 3) + 8 * j; const LAS float* s = scr + (8 * c) * 33 + n;
        v4u o; o.x = pk2(s[0 * 33], s[1 * 33]); o.y = pk2(s[2 * 33], s[3 * 33]); o.z = pk2(s[4 * 33], s[5 * 33]); o.w = pk2(s[6 * 33], s[7 * 33]);
        *(GAS v4u*)(WT + (size_t)(d0 + n) * K + k0 + 8 * c) = o; }
    LDS_WAIT(); asm volatile("" ::: "memory");
}
__device__ __forceinline__ float silu_f(float v) { return v / (1.f + __expf(-v)); }

__device__ __forceinline__ void p0a_prologue(Frame& F) {
    PHASE_IDS();
    LAS float* scr = (LAS float*)(F.lds + RING_OFF + wave * 16384);
    constexpr int I_ABIN = (DM / 64) * (AB_IN / 32), I_ABOUT = (AB_OUT / 64) * (DM / 32), I_CIN = (DM / 64) * (C_IN / 32), I_COUT = (DM / 64) * (DM / 32),
                  I_UP = (DM / 64) * (UPW / 32), I_DOWN = (DFF / 64) * (DM / 32);
    constexpr int NT_ITEMS = 2 * I_ABIN + 2 * I_ABOUT + 2 * I_CIN + 2 * I_COUT + 4 * I_UP + 4 * I_DOWN;
    bf16* wabin = (bf16*)(F.ws + WS_WABIN); bf16* wabout = (bf16*)(F.ws + WS_WABOUT); bf16* wcin = (bf16*)(F.ws + WS_WCIN); bf16* wcout = (bf16*)(F.ws + WS_WCOUT);
    bf16* wup = (bf16*)(F.ws + WS_WUP); bf16* wdown = (bf16*)(F.ws + WS_WDOWN);
    for (int it = gw; it < NT_ITEMS; it += F.NGW) {
        int r = it;
        if (r < 2 * I_ABIN) { const int j = r / I_ABIN; transpose_item(F.ab_w_in + (size_t)j * DM * AB_IN, DM, AB_IN, wabin + (size_t)j * AB_IN * DM, scr, r % I_ABIN, lane); continue; } r -= 2 * I_ABIN;
        if (r < 2 * I_ABOUT) { const int j = r / I_ABOUT; transpose_item(F.ab_w_out + (size_t)j * AB_OUT * DM, AB_OUT, DM, wabout + (size_t)j * DM * AB_OUT, scr, r % I_ABOUT, lane); continue; } r -= 2 * I_ABOUT;
        if (r < 2 * I_CIN) { const int j = r / I_CIN; transpose_item(F.c_w_in + (size_t)j * DM * C_IN, DM, C_IN, wcin + (size_t)j * C_IN * DM, scr, r % I_CIN, lane); continue; } r -= 2 * I_CIN;
        if (r < 2 * I_COUT) { const int j = r / I_COUT; transpose_item(F.c_w_out + (size_t)j * DM * DM, DM, DM, wcout + (size_t)j * DM * DM, scr, r % I_COUT, lane); continue; } r -= 2 * I_COUT;
        if (r < 4 * I_UP) { const int j = r / I_UP; transpose_item(F.w_up + (size_t)j * DM * UPW, DM, UPW, wup + (size_t)j * UPW * DM, scr, r % I_UP, lane, 1); continue; } r -= 4 * I_UP;
        { const int j = r / I_DOWN; transpose_item(F.w_down + (size_t)j * DFF * DM, DFF, DM, wdown + (size_t)j * DM * DFF, scr, r % I_DOWN, lane); }
    }
    float* part = (float*)(F.ws + WS_PART);
    constexpr int NCH = MODW / 256, NKC = 16, KCH = DM / NKC;
    for (int it = gw; it < DEPTH * NCH * NKC; it += F.NGW) {
        const int kc = it % NKC, nch = (it / NKC) % NCH, l = it / (NKC * NCH), k0 = kc * KCH;
        const float c0a = silu_f(F.c[k0 + lane]), c0b = silu_f(F.c[k0 + 64 + lane]), c1a = silu_f(F.c[DM + k0 + lane]), c1b = silu_f(F.c[DM + k0 + 64 + lane]);
        const float* wp = F.ada_w + ((size_t)l * DM + k0) * MODW + nch * 256 + 4 * lane;
        f32x4 a0 = {0.f, 0.f, 0.f, 0.f}, a1 = {0.f, 0.f, 0.f, 0.f};
#pragma unroll 8
        for (int k = 0; k < 64; ++k) { const f32x4 w = *(const f32x4*)(wp + (size_t)k * MODW); const float s0 = __shfl(c0a, k), s1 = __shfl(c1a, k); a0 += w * s0; a1 += w * s1; }
#pragma unroll 8
        for (int k = 0; k < 64; ++k) { const f32x4 w = *(const f32x4*)(wp + (size_t)(64 + k) * MODW); const float s0 = __shfl(c0b, k), s1 = __shfl(c1b, k); a0 += w * s0; a1 += w * s1; }
        float* pp = part + (((size_t)l * NKC + kc) * BATCH) * MODW + nch * 256 + 4 * lane;
        *(f32x4*)pp = a0; *(f32x4*)(pp + MODW) = a1;
    }
}
__device__ __forceinline__ void p0b_modreduce(Frame& F) {
    PHASE_IDS();
    const float* part = (const float*)(F.ws + WS_PART); float* mod = (float*)(F.ws + WS_MOD);
    for (int i = blockIdx.x * (NWAVES * 64) + tid; i < DEPTH * BATCH * MODW; i += F.G * NWAVES * 64) {
        const int n = i % MODW, b = (i / MODW) % BATCH, l = i / (MODW * BATCH);
        float s = F.ada_b[l * MODW + n];
#pragma unroll
        for (int kc = 0; kc < 16; ++kc) s += part[(((size_t)l * 16 + kc) * BATCH + b) * MODW + n];
        mod[i] = s;
    }
}
__device__ __forceinline__ void rows_pre(Frame& F, const float* x, const float* ng, const float* scale, const float* shift, bf16* H) {
    PHASE_IDS();
    for (int m = gw; m < M; m += F.NGW) {
        const int b = m / SEQ; f32x4 v[8]; float ss = 0.f;
#pragma unroll
        for (int j = 0; j < 8; ++j) { v[j] = *(const f32x4*)(x + (size_t)m * DM + 4 * lane + 256 * j); ss += (v[j].x * v[j].x + v[j].y * v[j].y) + (v[j].z * v[j].z + v[j].w * v[j].w); }
        const float r = 1.f / sqrtf(wave_sum(ss) * (1.f / DM) + EPS);
#pragma unroll
        for (int j = 0; j < 8; ++j) { const int c = 4 * lane + 256 * j;
            const f32x4 g = *(const f32x4*)(ng + c), sc = *(const f32x4*)(scale + (size_t)b * MODW + c), sh = *(const f32x4*)(shift + (size_t)b * MODW + c);
            const f32x4 h = (v[j] * r) * g * (sc + 1.f) + sh;
            v2u o; o.x = pk2(h.x, h.y); o.y = pk2(h.z, h.w); *(v2u*)(H + (size_t)m * DM + c) = o; }
    }
}
__device__ __forceinline__ void rows_post(Frame& F, const bf16* Y, const float* xs, float* xd, const float* gate, const float* nga,
                                          const float* ngb, const float* scale, const float* shift, bf16* H, bool doH) {
    PHASE_IDS();
    for (int m0 = gw; m0 < M; m0 += 2 * F.NGW) {
        const int m1 = m0 + F.NGW;
        const bool two = m1 < M; const int mm[2] = {m0, two ? m1 : m0};
        v2u yw[2][8]; f32x4 xv[2][8];
#pragma unroll
        for (int q = 0; q < 2; ++q)
#pragma unroll
            for (int j = 0; j < 8; ++j) { yw[q][j] = *(const v2u*)(Y + (size_t)mm[q] * DM + 4 * lane + 256 * j); xv[q][j] = *(const f32x4*)(xs + (size_t)mm[q] * DM + 4 * lane + 256 * j); }
        f32x4 v[2][8]; float ss[2] = {0.f, 0.f};
#pragma unroll
        for (int q = 0; q < 2; ++q)
#pragma unroll
            for (int j = 0; j < 8; ++j) { v[q][j] = (f32x4){bf_lo(yw[q][j].x), bf_hi(yw[q][j].x), bf_lo(yw[q][j].y), bf_hi(yw[q][j].y)};
                ss[q] += (v[q][j].x * v[q][j].x + v[q][j].y * v[q][j].y) + (v[q][j].z * v[q][j].z + v[q][j].w * v[q][j].w); }
        float r[2], ss2[2] = {0.f, 0.f};
#pragma unroll
        for (int q = 0; q < 2; ++q) r[q] = 1.f / sqrtf(wave_sum(ss[q]) * (1.f / DM) + EPS);
#pragma unroll
        for (int q = 0; q < 2; ++q) { const int b = mm[q] / SEQ;
#pragma unroll
            for (int j = 0; j < 8; ++j) { const int c = 4 * lane + 256 * j;
                const f32x4 g = *(const f32x4*)(gate + (size_t)b * MODW + c), na = *(const f32x4*)(nga + c);
                v[q][j] = xv[q][j] + g * ((v[q][j] * r[q]) * na);
                ss2[q] += (v[q][j].x * v[q][j].x + v[q][j].y * v[q][j].y) + (v[q][j].z * v[q][j].z + v[q][j].w * v[q][j].w);
                if (q == 0 || two) *(f32x4*)(xd + (size_t)mm[q] * DM + c) = v[q][j]; } }
        if (doH) {
#pragma unroll
            for (int q = 0; q < 2; ++q) { const int b = mm[q] / SEQ; const float r2 = 1.f / sqrtf(wave_sum(ss2[q]) * (1.f / DM) + EPS);
#pragma unroll
                for (int j = 0; j < 8; ++j) { const int c = 4 * lane + 256 * j;
                    const f32x4 g = *(const f32x4*)(ngb + c), sc = *(const f32x4*)(scale + (size_t)b * MODW + c), sh = *(const f32x4*)(shift + (size_t)b * MODW + c);
                    const f32x4 h = (v[q][j] * r2) * g * (sc + 1.f) + sh;
                    v2u o; o.x = pk2(h.x, h.y); o.y = pk2(h.z, h.w); if (q == 0 || two) *(v2u*)(H + (size_t)mm[q] * DM + c) = o; } }
        }
    }
}
__device__ __forceinline__ void rows_subln(Frame& F, const float* A0, const float* A1, const float* lamp, const float* sg, float lambda_init, bf16* O) {
    PHASE_IDS();
    const float l0 = lamp[lane] * lamp[128 + lane] + lamp[64 + lane] * lamp[128 + 64 + lane];
    const float l1 = lamp[256 + lane] * lamp[384 + lane] + lamp[256 + 64 + lane] * lamp[384 + 64 + lane];
    const float lam = __expf(wave_sum(l0)) - __expf(wave_sum(l1)) + lambda_init;
    const f32x4 g = *(const f32x4*)(sg + 4 * lane) * (1.f - lambda_init);
    for (int m = gw; m < M; m += F.NGW) {
#pragma unroll
        for (int j = 0; j < 8; ++j) { const size_t off = (size_t)m * DM + 4 * lane + 256 * j;
            const f32x4 d = *(const f32x4*)(A0 + off) - *(const f32x4*)(A1 + off) * lam;
            const float ss = wave_sum((d.x * d.x + d.y * d.y) + (d.z * d.z + d.w * d.w));
            const float r = 1.f / sqrtf(ss * (1.f / 256.f) + EPS);
            const f32x4 h = (d * r) * g;
            v2u o; o.x = pk2(h.x, h.y); o.y = pk2(h.z, h.w); *(v2u*)(O + off) = o; }
    }
}
__device__ __forceinline__ void rows_bmerge(Frame& F, const float* OB, const float* LSE, bf16* O) {
    PHASE_IDS();
    for (int m = gw; m < M; m += F.NGW) {
        const int hb = lane >> 4;
        const float e0 = LSE[(size_t)m * 4 + hb], e1 = LSE[((size_t)M + m) * 4 + hb], e2 = LSE[((size_t)2 * M + m) * 4 + hb];
        const float mx = fmaxf(e0, fmaxf(e1, e2));
        float w0 = __expf(e0 - mx), w1 = __expf(e1 - mx), w2 = __expf(e2 - mx); const float inv = 1.f / (w0 + w1 + w2); w0 *= inv; w1 *= inv; w2 *= inv;
        const float* p = OB + (size_t)m * 512 + 8 * lane;
        const f32x4 a0 = *(const f32x4*)p, a1 = *(const f32x4*)(p + 4);
        const f32x4 b0 = *(const f32x4*)(p + (size_t)M * 512), b1 = *(const f32x4*)(p + (size_t)M * 512 + 4);
        const f32x4 c0 = *(const f32x4*)(p + (size_t)2 * M * 512), c1 = *(const f32x4*)(p + (size_t)2 * M * 512 + 4);
        const f32x4 r0 = a0 * w0 + b0 * w1 + c0 * w2, r1 = a1 * w0 + b1 * w1 + c1 * w2;
        v4u o; o.x = pk2(r0.x, r0.y); o.y = pk2(r0.z, r0.w); o.z = pk2(r1.x, r1.y); o.w = pk2(r1.z, r1.w);
        *(v4u*)(O + (size_t)m * AB_OUT + 512 + 8 * lane) = o;
    }
}
__device__ __forceinline__ float gelu_tanh(float v) {
    const float u = 0.7978845608028654f * (v + 0.044715f * v * v * v);
    const float e = __expf(2.f * u);
    const float t = 1.f - 2.f / (e + 1.f);
    return 0.5f * v * (1.f + t);
}
__device__ __forceinline__ void actfix_panel(Frame& F, int pm, const float* cw, const float* cb, bf16* ACT) {
    PHASE_IDS();
    const float* HG = (const float*)(F.ws + WS_HG); const float* HU = (const float*)(F.ws + WS_HU);
    constexpr int NC4 = DFF / 4;
    for (int it = tid; it < 2 * NC4; it += NWAVES * 64) {
        const int c = (it % NC4) * 4, side = it / NC4;
        const f32x4 z = {0.f, 0.f, 0.f, 0.f}; f32x4 gp, gc, gn, up; size_t row;
        if (side == 0) { gp = (pm % (SEQ / 256) == 0) ? z : *(const f32x4*)(HG + ((size_t)(pm - 1) * 4 + 3) * DFF + c); gc = *(const f32x4*)(HG + ((size_t)pm * 4 + 0) * DFF + c);
            gn = *(const f32x4*)(HG + ((size_t)pm * 4 + 1) * DFF + c); up = *(const f32x4*)(HU + ((size_t)pm * 2 + 0) * DFF + c); row = (size_t)pm * 256; }
        else { gp = *(const f32x4*)(HG + ((size_t)pm * 4 + 2) * DFF + c); gc = *(const f32x4*)(HG + ((size_t)pm * 4 + 3) * DFF + c);
            gn = (pm % (SEQ / 256) == SEQ / 256 - 1) ? z : *(const f32x4*)(HG + ((size_t)(pm + 1) * 4 + 0) * DFF + c); up = *(const f32x4*)(HU + ((size_t)pm * 2 + 1) * DFF + c); row = (size_t)pm * 256 + 255; }
        const f32x4 w0 = *(const f32x4*)(cw + c), w1 = *(const f32x4*)(cw + DFF + c), w2 = *(const f32x4*)(cw + 2 * DFF + c), bb = *(const f32x4*)(cb + c);
        float r[4];
#pragma unroll
        for (int i = 0; i < 4; ++i) r[i] = pg8::gelu_tanh_mul(fmaf(w0[i], gp[i], fmaf(w1[i], gc[i], fmaf(w2[i], gn[i], bb[i]))), up[i]);
        v2u o; o.x = pk2(r[0], r[1]); o.y = pk2(r[2], r[3]); *(v2u*)(ACT + row * DFF + c) = o;
    }
    asm volatile("s_waitcnt vmcnt(0)" ::: "memory"); __syncthreads();
}
__device__ __forceinline__ float alibi16(int i) { return exp2f(-0.5f * (float)(i + 1)); }
__device__ __forceinline__ void phase_attn_ab(Frame& F, int jl) {
    const bf16* P = (const bf16*)(F.ws + WS_PROJ); bf16* O = (bf16*)(F.ws + WS_O); float* OB = (float*)(F.ws + WS_ATT); float* LSE = (float*)(F.ws + WS_LSE);
    for (int u = blockIdx.x; u < 512; u += F.G) {
        att::UnitArgs a;
        if (u < 128) {
            const int qb = u % 16, qh = (u / 16) % 4, b = u / 64, q0 = qb * 256; const size_t row0 = (size_t)b * SEQ;
            a.Q = (const GAS bf16*)P + (row0 + q0) * AB_IN + qh * 128; a.ldq = AB_IN;
            a.K = (const GAS bf16*)P + row0 * AB_IN + 512 + (qh >> 1) * 128; a.V = (const GAS bf16*)P + row0 * AB_IN + 768 + (qh >> 1) * 128; a.ldk = AB_IN;
            a.q0 = q0; a.L = SEQ; a.kt0 = q0 / 64 - 2; a.nt = 8;
            a.nsl = -alibi16(qh) / att::SCALE; a.radius = 128.f; a.m_init = F.a_sink[jl * 4 + qh] / att::SCALE; a.l_init = 1.f;
            a.Of = nullptr; a.Ob = (GAS bf16*)O + (row0 + q0) * AB_OUT + qh * 128; a.ldo = AB_OUT; a.lse = nullptr; a.ldl = 0;
        } else {
            const int v = (u - 128) % 128, gi = (u - 128) / 128, dil = gi == 0 ? 1 : (gi == 1 ? 4 : 16), L = SEQ / dil;
            int qb, r, hb, b;
            if (gi == 0) { qb = v % 16; r = 0; hb = (v / 16) % 4; b = v / 64; }
            else if (gi == 1) { qb = v % 4; r = (v / 4) % 4; hb = (v / 16) % 4; b = v / 64; }
            else { qb = 0; r = v % 16; hb = (v / 16) % 4; b = v / 64; }
            const int q0 = qb * 256; const size_t seq0 = (size_t)b * SEQ + r, rowq = seq0 + (size_t)dil * q0;
            a.Q = (const GAS bf16*)P + rowq * AB_IN + 1024 + gi * 512 + hb * 128; a.ldq = (long)dil * AB_IN;
            a.K = (const GAS bf16*)P + seq0 * AB_IN + 2560 + hb * 128; a.V = (const GAS bf16*)P + seq0 * AB_IN + 3072 + hb * 128; a.ldk = (long)dil * AB_IN;
            a.q0 = q0; a.L = L; a.kt0 = q0 / 64 - 1; a.nt = 6;
            a.nsl = -alibi16(4 + gi * 4 + hb) * (float)dil / att::SCALE; a.radius = 64.f; a.m_init = att::M_INIT; a.l_init = 0.f;
            a.Of = (GAS float*)OB + ((size_t)gi * M + rowq) * 512 + hb * 128; a.Ob = nullptr; a.ldo = (long)dil * 512;
            a.lse = (GAS float*)LSE + ((size_t)gi * M + rowq) * 4 + hb; a.ldl = (long)dil * 4;
        }
        att::attn_unit<true, 1>(a, F.ldsg + RING_OFF);
    }
}
__device__ __forceinline__ void phase_cnorm(Frame& F) {
    PHASE_IDS();
    const bf16* P = (const bf16*)(F.ws + WS_PROJ); float* NRM = (float*)(F.ws + WS_NRM);
    for (int it = gw; it < 2048; it += F.NGW) {
        const int tile = it & 63, j = (it >> 6) & 1, h = (it >> 7) & 7, b = (it >> 10) & 1;
        const bf16* base = P + ((size_t)b * SEQ + 64 * tile + (lane >> 4)) * C_IN + h * 256 + j * 128 + (lane & 15) * 8;
        float mq = 0.f, mk = 0.f, ms = 3.0e38f;
#pragma unroll 4
        for (int i = 0; i < 16; ++i) {
            const v4u wq = *(const v4u*)(base + (size_t)(4 * i) * C_IN), wk = *(const v4u*)(base + (size_t)(4 * i) * C_IN + 2048);
            float sq = 0.f, sk = 0.f, dt = 0.f;
#pragma unroll
            for (int q = 0; q < 4; ++q) { const float a = bf_lo(wq[q]), c = bf_hi(wq[q]), e = bf_lo(wk[q]), g = bf_hi(wk[q]); sq += a * a + c * c; sk += e * e + g * g; dt += a * e + c * g; }
#pragma unroll
            for (int o = 1; o < 16; o <<= 1) { sq += __shfl_xor(sq, o); sk += __shfl_xor(sk, o); dt += __shfl_xor(dt, o); }
            mq = fmaxf(mq, sq); mk = fmaxf(mk, sk); ms = fminf(ms, dt);
        }
        mq = fmaxf(mq, __shfl_xor(mq, 16)); mq = fmaxf(mq, __shfl_xor(mq, 32)); mk = fmaxf(mk, __shfl_xor(mk, 16)); mk = fmaxf(mk, __shfl_xor(mk, 32));
        ms = fminf(ms, __shfl_xor(ms, 16)); ms = fminf(ms, __shfl_xor(ms, 32));
        if (lane == 0) { NRM[it] = sqrtf(mq); NRM[2048 + it] = sqrtf(mk); NRM[4096 + it] = att::SCALE * ms; }
    }
}
__device__ __forceinline__ void phase_attn_c(Frame& F, gu32* ctr) {
    PHASE_IDS();
    const bf16* P = (const bf16*)(F.ws + WS_PROJ); float* AT = (float*)(F.ws + WS_ATT); const float* NRM = (const float*)(F.ws + WS_NRM);
    volatile LAS unsigned* slot = (volatile LAS unsigned*)(F.lds + MISC_OFF) + 16;
    for (;;) {
        if (tid == 0) *slot = __hip_atomic_fetch_add(ctr, 1u, __ATOMIC_RELAXED, __HIP_MEMORY_SCOPE_AGENT);
        __syncthreads();
        const int i = __builtin_amdgcn_readfirstlane((int)*slot);
        __syncthreads();
        if (i >= 1024) break;
        const int h = 7 - (i >> 7), qb = i & 31, j = (i >> 5) & 1, b = (i >> 6) & 1, q0 = qb * 128; const size_t row0 = (size_t)b * SEQ;
        const float slope = exp2f(-(float)(h + 1));
        const float* QN = NRM + ((b * 8 + h) * 2 + j) * 64; const float* KN = QN + 2048; const float* SS = QN + 4096;
        const float qn = fmaxf(QN[2 * qb], QN[2 * qb + 1]);
        const float smin = fminf(SS[2 * qb], SS[2 * qb + 1]) - 0.05f;
        const int klo = 64 * lane, d1 = klo - (q0 + 127), d2 = q0 - (klo + 63), dmin = d1 > 0 ? d1 : (d2 > 0 ? d2 : 0);
        const float bound = att::SCALE * 1.02f * qn * KN[lane] - slope * (float)dmin;
        const unsigned long long need = __ballot((bound - smin > -25.f) || (dmin == 0));
        const int t_lo = (int)__builtin_ctzll(need), t_hi = 64 - (int)__builtin_clzll(need);
        att::PairArgs a;
        a.Q = (const GAS bf16*)P + (row0 + q0) * C_IN + h * 256 + j * 128; a.ldq = C_IN;
        a.K = (const GAS bf16*)P + row0 * C_IN + 2048 + h * 256 + j * 128; a.V = (const GAS bf16*)P + row0 * C_IN + 4096 + h * 256; a.ldk = C_IN;
        a.q0 = q0; a.kt0 = t_lo; a.nt = t_hi - t_lo; a.nsl = -slope / att::SCALE;
        a.O = (GAS float*)AT + ((size_t)j * M + row0 + q0) * DM + h * 256; a.ldo = DM;
        att::attn_split_unit(a, F.ldsg + RING_OFF, (float*)(F.ldsg + BND_OFF));
    }
}

#ifndef ENC_DUP
#define ENC_DUP 0
#endif
#define DUP(bit) for (int rep_ = 0; rep_ < (((ENC_DUP) & (bit)) ? 2 : 1); ++rep_)
constexpr int CW_QUEUE = 8192;
struct Args { const float* in[16]; float* out; unsigned char* ws; };
__global__ void __launch_bounds__(NWAVES * 64, 2) enc_fwd(Args args) {
    extern __shared__ __attribute__((aligned(16))) unsigned char lds[];
    Frame F;
    F.lds = (LAS unsigned char*)lds; F.ldsg = (char*)lds;
    F.tid = threadIdx.x; F.lane = F.tid & 63; F.wave = __builtin_amdgcn_readfirstlane(F.tid >> 6);
    F.G = gridDim.x; F.gw = blockIdx.x * NWAVES + F.wave; F.NGW = F.G * NWAVES;
    F.x = args.in[0]; F.c = args.in[1]; F.ada_w = args.in[2]; F.ada_b = args.in[3]; F.norm_g = args.in[4]; F.ab_w_in = args.in[5]; F.ab_w_out = args.in[6]; F.a_sink = args.in[7];
    F.c_w_in = args.in[8]; F.c_w_out = args.in[9]; F.c_lambda = args.in[10]; F.c_subln_g = args.in[11]; F.w_up = args.in[12]; F.conv_w = args.in[13]; F.conv_b = args.in[14]; F.w_down = args.in[15];
    F.out = args.out; F.ws = args.ws;
    gu32* ctl = (gu32*)(F.ws + WS_CTL);
    for (int u = F.tid; u < (LDS_BYTES - LDSCTL_OFF) / 4; u += NWAVES * 64) ((LAS unsigned*)(F.lds + LDSCTL_OFF))[u] = 0u;
    __syncthreads();
    (void)xcd_barrier_post((unsigned*)(ctl + CW_BAR), (volatile LAS unsigned*)(F.lds + MISC_OFF) + 8);
#define GB() do { unsigned char* wsb_ = args.ws; asm volatile("" : "+s"(wsb_)); XcdBarrier bar_; bar_.bar = (unsigned*)(wsb_ + WS_CTL) + CW_BAR; bar_.x = xb_xcc_id(); \
        bar_.st = (volatile LAS unsigned*)(F.lds + MISC_OFF) + 8; xcd_barrier(bar_); } while (0)
    float* mod = (float*)(F.ws + WS_MOD);
    bf16* H = (bf16*)(F.ws + WS_H); bf16* PROJ = (bf16*)(F.ws + WS_PROJ); bf16* O = (bf16*)(F.ws + WS_O); bf16* Y = (bf16*)(F.ws + WS_Y);
    bf16* ACT = (bf16*)(F.ws + WS_ACT); float* AT = (float*)(F.ws + WS_ATT);

    DUP(1) p0a_prologue(F);
    GB();
    p0b_modreduce(F);
    GB();
    rows_pre(F, F.x, F.norm_g, mod + 1 * DM, mod + 0 * DM, H);
    GB();

    for (int s = 0; s < 8; ++s) {
        const int l = s >> 1, sub = s & 1, jl = l >> 1, even = !(l & 1);
        const float* modl = mod + (size_t)l * BATCH * MODW;
        if (sub == 0) {
            pg8::Gemm g; int N;
            if (even) { N = AB_IN; g.Bt = (const bf16*)(F.ws + WS_WABIN) + (size_t)jl * AB_IN * DM; } else { N = C_IN; g.Bt = (const bf16*)(F.ws + WS_WCIN) + (size_t)jl * C_IN * DM; }
            g.A = H; g.M = M; g.N = N; g.K = DM;
            pg8::StaticOrder S; S.init(M, N, F.G, (int)blockIdx.x);
            pg8::EpiBf16<0> E{PROJ, N, nullptr, 0, 0, 1.f};
            DUP(4) pg8::gemm_phase<pg8::EpiBf16<0>, pg8::StaticOrder, true, true>(F.lds + RING_OFF, g, S, E);
        } else {
            pg8::Gemm g; g.A = H; g.Bt = (const bf16*)(F.ws + WS_WUP) + (size_t)l * UPW * DM; g.M = M; g.N = UPW; g.K = DM;
            pg8::StaticOrder S; S.init(M, UPW, F.G, (int)blockIdx.x);
            pg8::EpiAct E{ACT, DFF, F.conv_w + (size_t)l * 3 * DFF, F.conv_b + (size_t)l * DFF, (float*)(F.ws + WS_HG), (float*)(F.ws + WS_HU), (LAS float*)(F.lds + BND_OFF)};
            DUP(4) pg8::gemm_phase<pg8::EpiAct, pg8::StaticOrder, true, true>(F.lds + RING_OFF, g, S, E);
        }
        GB();
        if (sub == 0) {
            if (even) { DUP(16) phase_attn_ab(F, jl); GB(); rows_bmerge(F, AT, (const float*)(F.ws + WS_LSE), O); }
            else { phase_cnorm(F); GB(); phase_attn_c(F, ctl + CW_QUEUE + 64 * jl); GB();
                rows_subln(F, AT, AT + (size_t)M * DM, F.c_lambda + (size_t)jl * 4 * 128, F.c_subln_g + (size_t)jl * 256, 0.8f - 0.6f * __expf(-0.3f * (float)l), O); }
            GB();
        }
        {
            pg8::Gemm g; int K;
            if (sub == 0) { if (even) { K = AB_OUT; g.Bt = (const bf16*)(F.ws + WS_WABOUT) + (size_t)jl * DM * AB_OUT; } else { K = DM; g.Bt = (const bf16*)(F.ws + WS_WCOUT) + (size_t)jl * DM * DM; } g.A = O; }
            else { K = DFF; g.Bt = (const bf16*)(F.ws + WS_WDOWN) + (size_t)l * DM * DFF; g.A = ACT; }
            g.M = M; g.N = DM; g.K = K;
            pg8::StaticOrder S; S.init(M, DM, F.G, (int)blockIdx.x);
            if (sub == 1) { pg8::Unit u0; if (S.next(0, u0)) actfix_panel(F, u0.pm, F.conv_w + (size_t)l * 3 * DFF, F.conv_b + (size_t)l * DFF, ACT); }
            const float* xs = (s == 0) ? F.x : F.out;
            const int ln = (sub == 1 && l + 1 < DEPTH) ? l + 1 : l; const float* modn = mod + (size_t)ln * BATCH * MODW;
            const float* gate = modl + (sub == 0 ? 2 : 5) * DM; const float* nga = F.norm_g + ((size_t)l * 4 + (sub == 0 ? 1 : 3)) * DM;
            const float* ngb = (sub == 0) ? F.norm_g + ((size_t)l * 4 + 2) * DM : F.norm_g + ((size_t)ln * 4 + 0) * DM;
            const float* scl = (sub == 0) ? modl + 4 * DM : modn + 1 * DM; const float* shf = (sub == 0) ? modl + 3 * DM : modn + 0 * DM;
            const bool doH = (sub == 0) || (l + 1 < DEPTH);
            if (F.G == 256) {
                float* xch = (float*)(F.ws + WS_XCH) + (size_t)s * 2 * (M / 256) * 8 * 256; unsigned* cnt = (unsigned*)(ctl + CW_CNT) + (size_t)s * 2 * (M / 256) * 64;
                pg8::EpiPost E{xs, F.out, doH ? H : nullptr, DM, gate, nga, ngb, scl, shf, MODW, SEQ, xch, xch + (M / 256) * 8 * 256, cnt, cnt + (M / 256) * 64, EPS};
                DUP(8) pg8::gemm_phase<pg8::EpiPost, pg8::StaticOrder, false, true>(F.lds + RING_OFF, g, S, E);
            } else {
                pg8::EpiBf16<0> E{Y, DM, nullptr, 0, 0, 1.f};
                pg8::gemm_phase<pg8::EpiBf16<0>, pg8::StaticOrder, false, true>(F.lds + RING_OFF, g, S, E);
                GB();
                rows_post(F, Y, xs, F.out, gate, nga, ngb, scl, shf, H, doH);
            }
        }
        if (s < 7) GB();
    }
#undef GB
}

extern "C" void kernel_launch(void* const* d_in, const int* in_sizes, int n_in, void* d_out, int out_size, void* d_ws, size_t ws_size, hipStream_t stream) {
    static int grid = 0;
    if (grid == 0) {
        if (n_in != 16 || in_sizes[0] != M * DM || out_size != M * DM || ws_size < WS_END) { fprintf(stderr, "kernel_launch: unexpected shapes (n_in %d, in0 %d, out %d, ws %zu < %zu)\n", n_in, n_in > 0 ? in_sizes[0] : -1, out_size, ws_size, (size_t)WS_END); grid = -1; return; }
        int dev = 0, cus = 0, per_cu = 0;
        if (hipGetDevice(&dev) != hipSuccess || hipDeviceGetAttribute(&cus, hipDeviceAttributeMultiprocessorCount, dev) != hipSuccess) { grid = -1; return; }
        if (hipFuncSetAttribute((const void*)enc_fwd, hipFuncAttributeMaxDynamicSharedMemorySize, LDS_BYTES) != hipSuccess) { fprintf(stderr, "kernel_launch: hipFuncSetAttribute failed\n"); grid = -1; return; }
        if (hipOccupancyMaxActiveBlocksPerMultiprocessor(&per_cu, (const void*)enc_fwd, NWAVES * 64, LDS_BYTES) != hipSuccess || per_cu < 1) { fprintf(stderr, "kernel_launch: occupancy query says %d\n", per_cu); }
        (void)hipGetLastError();
        grid = cus;
    }
    if (grid < 0) return;
    (void)hipMemsetAsync((char*)d_ws + WS_CTL, 0, CTL_ZERO_BYTES, stream);
    Args a{};
    for (int i = 0; i < 16; ++i) a.in[i] = (const float*)d_in[i];
    a.out = (float*)d_out; a.ws = (unsigned char*)d_ws;
    hipLaunchKernelGGL(enc_fwd, dim3(grid), dim3(NWAVES * 64), LDS_BYTES, stream, a);
}
```

```cpp
#include <hip/hip_runtime.h>
#include <cstdio>
#include <cstdint>
#define ENC_PROBE 0
__device__ __forceinline__ int lane_now() { int l; asm volatile("v_mbcnt_lo_u32_b32 %0, -1, 0\n\tv_mbcnt_hi_u32_b32 %0, -1, %0" : "=v"(l)); return l; }
__device__ __forceinline__ float swz_xor16(float x) { return __builtin_bit_cast(float, __builtin_amdgcn_ds_swizzle(__builtin_bit_cast(int, x), 0x401F)); }
__device__ __forceinline__ float sum_xor32(float x) { return x + __builtin_bit_cast(float, __builtin_amdgcn_ds_bpermute((lane_now() ^ 32) << 2, __builtin_bit_cast(int, x))); }
namespace pg8 {
#define PG8_LAS __attribute__((address_space(3)))
typedef unsigned short bf16_t;
typedef short bf16x8 __attribute__((ext_vector_type(8)));
typedef float f32x4 __attribute__((ext_vector_type(4)));
typedef unsigned u32x4 __attribute__((ext_vector_type(4)));
constexpr int BM = 256, BK = 64, HALF = 128, HTB = HALF * BK * 2  , STAGE_BYTES = 8 * HTB, NXCD = 8, WGM = 8;

__host__ __device__ __forceinline__ int lds_byte(int r, int c) { const int st = (r >> 4) * 2 + (c >> 5), rr = r & 15, cc = c & 31, ob = rr * 64 + cc * 2; return st * 1024 + (ob ^ (((ob >> 9) & 1) << 5)); }
__host__ __device__ __forceinline__ void stage_rc(int b, int& R, int& C) { const int st = b / 1024, sb = b % 1024, swz = sb ^ (((sb >> 9) & 1) << 5); R = (st >> 1) * 16 + swz / 64; C = (st & 1) * 32 + (swz % 64) / 2; }
__host__ __device__ __forceinline__ int perm32(int rho) { const int n = rho >> 4, i = rho & 15; return 8 * (i >> 2) + 4 * n + (i & 3); }

struct Unit { int pm, pn; };
struct Gemm { const bf16_t* A; const bf16_t* Bt; int M, N, K; };

struct StaticOrder {
    int nM, nN, nwg, G, c;
    __host__ __device__ void init(int M, int N, int G_, int c_) { nM = M / BM; nN = N / BM; nwg = nM * nN; G = G_; c = c_; }
    __host__ __device__ bool next(int i, Unit& u) const {
        const long L = (long)i * G + c; if (L >= nwg) return false;
        int wgid = (int)L; { const int q = nwg / NXCD, r = nwg % NXCD, xcd = wgid % NXCD, off = wgid / NXCD; wgid = (xcd < r ? xcd * (q + 1) : r * (q + 1) + (xcd - r) * q) + off; }
        const int nig = WGM * nN, gid = wgid / nig, fm = gid * WGM, gsz = (nM - fm) < WGM ? (nM - fm) : WGM;
        u.pm = fm + ((wgid % nig) % gsz); u.pn = (wgid % nig) / gsz; return true;
    }
    __device__ __forceinline__ void a_ready(const Unit&) const {}
    __device__ __forceinline__ void done(const Unit&) const {}
};

__device__ __forceinline__ unsigned cvt_pk_bf16(float lo, float hi) { unsigned r; asm volatile("v_cvt_pk_bf16_f32 %0, %1, %2" : "=v"(r) : "v"(lo), "v"(hi)); return r; }
typedef float f32x2 __attribute__((ext_vector_type(2)));
__device__ __forceinline__ f32x2 gelu_pk(f32x2 v) {
    const f32x2 av = __builtin_elementwise_abs(v), d = av * 0.2316418882f + 1.0f;
    f32x2 t; t.x = __builtin_amdgcn_rcpf(d.x); t.y = __builtin_amdgcn_rcpf(d.y);
    f32x2 q = t * 0.5307027145f + (-0.7265760135f); q = q * t + 0.7107068705f; q = q * t + (-0.142248368f); q = q * t + 0.127414796f; q = q * t;
    const f32x2 s = (v * v) * (-0.72134752044f);
    f32x2 e; e.x = __builtin_amdgcn_exp2f(s.x); e.y = __builtin_amdgcn_exp2f(s.y);
    const f32x2 m = v * (q * e), r = v - m;
    f32x2 o; o.x = v.x < 0.f ? m.x : r.x; o.y = v.y < 0.f ? m.y : r.y; return o;
}

template <int ACT  > struct EpiBf16 {
    static constexpr bool PERM = true, AFTER_DRAIN = false; static_assert(ACT == 0 || ACT == 1, "EpiBf16: ACT is 0 (none) or 1 (gelu_pk)");
    bf16_t* O; int ldc; const float* bias; int split_cols; size_t split_stride; float scale0;
    __device__ __forceinline__ void operator()(const f32x4 (&acc)[2][2][4][2], const Unit& u, int wr, int wc, int fr, int fq) const {
        const int row0 = u.pm * BM + wr * 64 + fr; int colt = u.pn * BM; bf16_t* base = O;
        float sc = 1.f; if (split_cols) { const int t = colt / split_cols; base += (size_t)t * split_stride; colt -= t * split_cols; if (t == 0) sc = scale0; }
        const int col0 = colt + wc * 32 + 8 * fq, bcol0 = u.pn * BM + wc * 32 + 8 * fq;
        f32x4 bv[2][2];
#pragma unroll
        for (int bj = 0; bj < 2; ++bj)
#pragma unroll
            for (int n = 0; n < 2; ++n) bv[bj][n] = bias ? *(const f32x4*)(bias + bcol0 + bj * HALF + 4 * n) : (f32x4){0.f, 0.f, 0.f, 0.f};
#pragma unroll
        for (int ai = 0; ai < 2; ++ai)
#pragma unroll
            for (int m = 0; m < 4; ++m) { bf16_t* rowp = base + (size_t)(row0 + ai * HALF + m * 16) * ldc + col0;
#pragma unroll
                for (int bj = 0; bj < 2; ++bj) { f32x4 v0 = acc[ai][bj][m][0] + bv[bj][0], v1 = acc[ai][bj][m][1] + bv[bj][1];
                    if (ACT == 1) { f32x2 a = gelu_pk((f32x2){v0[0], v0[1]}), b = gelu_pk((f32x2){v0[2], v0[3]}), c = gelu_pk((f32x2){v1[0], v1[1]}), d = gelu_pk((f32x2){v1[2], v1[3]});
                        v0 = (f32x4){a.x, a.y, b.x, b.y}; v1 = (f32x4){c.x, c.y, d.x, d.y}; }
                    v0 = v0 * sc; v1 = v1 * sc; u32x4 w; w.x = cvt_pk_bf16(v0[0], v0[1]); w.y = cvt_pk_bf16(v0[2], v0[3]); w.z = cvt_pk_bf16(v1[0], v1[1]); w.w = cvt_pk_bf16(v1[2], v1[3]);
                    *(u32x4*)(rowp + bj * HALF) = w; } }
    }
};
struct EpiF32 {
    static constexpr bool PERM = false, AFTER_DRAIN = false;
    float* C; int ldc; const float* bias;
    __device__ __forceinline__ void operator()(const f32x4 (&acc)[2][2][4][2], const Unit& u, int wr, int wc, int fr, int fq) const {
        const int row0 = u.pm * BM + wr * 64 + fr, col0 = u.pn * BM + wc * 32 + 4 * fq;
        f32x4 bv[2][2];
#pragma unroll
        for (int bj = 0; bj < 2; ++bj)
#pragma unroll
            for (int n = 0; n < 2; ++n) bv[bj][n] = bias ? *(const f32x4*)(bias + col0 + bj * HALF + n * 16) : (f32x4){0.f, 0.f, 0.f, 0.f};
#pragma unroll
        for (int ai = 0; ai < 2; ++ai)
#pragma unroll
            for (int m = 0; m < 4; ++m) { float* rowp = C + (size_t)(row0 + ai * HALF + m * 16) * ldc + col0;
#pragma unroll
                for (int bj = 0; bj < 2; ++bj)
#pragma unroll
                    for (int n = 0; n < 2; ++n) *(f32x4*)(rowp + bj * HALF + n * 16) = acc[ai][bj][m][n] + bv[bj][n]; }
    }
};

template <int CTRL> __device__ __forceinline__ float dpp_mov(float x) { return __builtin_bit_cast(float, __builtin_amdgcn_mov_dpp(__builtin_bit_cast(int, x), CTRL, 0xf, 0xf, true)); }
template <int CTRL> __device__ __forceinline__ float dpp_upd(float old, float x) { return __builtin_bit_cast(float, __builtin_amdgcn_update_dpp(__builtin_bit_cast(int, old), __builtin_bit_cast(int, x), CTRL, 0xf, 0xf, false)); }
__device__ __forceinline__ float gelu_tanh_mul(float v, float up) {
    const float e = __builtin_amdgcn_exp2f(v * fmaf(v * v, -0.10294324f, -2.3022082f));
    return v * up * __builtin_amdgcn_rcpf(1.f + e);
}
struct EpiAct {
    static constexpr bool PERM = true, AFTER_DRAIN = false;
    bf16_t* ACT; int dff; const float* cw; const float* cb; float* HG; float* HU; PG8_LAS float* bnd;
    __device__ __forceinline__ void operator()(const f32x4 (&acc)[2][2][4][2], const Unit& u, int wr, int wc, int fr, int fq) const {
        const int chl = wc * 32 + 8 * fq, ch = u.pn * 128 + chl;
        if (fr == 0) {
#pragma unroll
            for (int ai = 0; ai < 2; ++ai) { PG8_LAS float* p = bnd + ((2 * ai + wr) * 2 + 0) * 128 + chl; *(PG8_LAS f32x4*)p = acc[ai][0][0][0]; *(PG8_LAS f32x4*)(p + 4) = acc[ai][0][0][1]; } }
        if (fr == 15) {
#pragma unroll
            for (int ai = 0; ai < 2; ++ai) { PG8_LAS float* p = bnd + ((2 * ai + wr) * 2 + 1) * 128 + chl; *(PG8_LAS f32x4*)p = acc[ai][0][3][0]; *(PG8_LAS f32x4*)(p + 4) = acc[ai][0][3][1]; } }
        if (wr == 0 && fr <= 1) { float* p = HG + ((size_t)u.pm * 4 + fr) * dff + ch; *(f32x4*)p = acc[0][0][0][0]; *(f32x4*)(p + 4) = acc[0][0][0][1];
            if (fr == 0) { float* q = HU + ((size_t)u.pm * 2 + 0) * dff + ch; *(f32x4*)q = acc[0][1][0][0]; *(f32x4*)(q + 4) = acc[0][1][0][1]; } }
        if (wr == 1 && fr >= 14) { float* p = HG + ((size_t)u.pm * 4 + 2 + (fr - 14)) * dff + ch; *(f32x4*)p = acc[1][0][3][0]; *(f32x4*)(p + 4) = acc[1][0][3][1];
            if (fr == 15) { float* q = HU + ((size_t)u.pm * 2 + 1) * dff + ch; *(f32x4*)q = acc[1][1][3][0]; *(f32x4*)(q + 4) = acc[1][1][3][1]; } }
        f32x4 w0[2], w1[2], w2[2], bb[2];
#pragma unroll
        for (int n = 0; n < 2; ++n) { w0[n] = *(const f32x4*)(cw + ch + 4 * n); w1[n] = *(const f32x4*)(cw + dff + ch + 4 * n); w2[n] = *(const f32x4*)(cw + 2 * dff + ch + 4 * n); bb[n] = *(const f32x4*)(cb + ch + 4 * n); }
        asm volatile("s_waitcnt lgkmcnt(0)" ::: "memory"); __builtin_amdgcn_s_barrier(); asm volatile("" ::: "memory");
        f32x4 bp[2][2], bn[2][2];
#pragma unroll
        for (int ai = 0; ai < 2; ++ai) { const int c = 2 * ai + wr;
#pragma unroll
            for (int n = 0; n < 2; ++n) {
                bp[ai][n] = c > 0 ? *(const PG8_LAS f32x4*)(bnd + ((c - 1) * 2 + 1) * 128 + chl + 4 * n) : (f32x4){0.f, 0.f, 0.f, 0.f};
                bn[ai][n] = c < 3 ? *(const PG8_LAS f32x4*)(bnd + ((c + 1) * 2 + 0) * 128 + chl + 4 * n) : (f32x4){0.f, 0.f, 0.f, 0.f}; } }
        const int row0 = u.pm * BM + wr * 64 + fr;
#pragma unroll
        for (int ai = 0; ai < 2; ++ai)
#pragma unroll
            for (int m = 0; m < 4; ++m) {
                unsigned pk[4];
#pragma unroll
                for (int n = 0; n < 2; ++n) { float r[4];
#pragma unroll
                    for (int i = 0; i < 4; ++i) {
                        const float g = acc[ai][0][m][n][i];
                        const float oldp = (m == 0) ? bp[ai][n][i] : dpp_mov<0x121>(acc[ai][0][m == 0 ? 0 : m - 1][n][i]);
                        const float gp = dpp_upd<0x111>(oldp, g);
                        const float oldn = (m == 3) ? bn[ai][n][i] : dpp_mov<0x12F>(acc[ai][0][m == 3 ? 3 : m + 1][n][i]);
                        const float gn = dpp_upd<0x101>(oldn, g);
                        const float a = fmaf(w0[n][i], gp, fmaf(w1[n][i], g, fmaf(w2[n][i], gn, bb[n][i])));
                        r[i] = gelu_tanh_mul(a, acc[ai][1][m][n][i]);
                    }
                    pk[2 * n] = cvt_pk_bf16(r[0], r[1]); pk[2 * n + 1] = cvt_pk_bf16(r[2], r[3]); }
                u32x4 w; w.x = pk[0]; w.y = pk[1]; w.z = pk[2]; w.w = pk[3];
                *(u32x4*)(ACT + (size_t)(row0 + ai * HALF + m * 16) * dff + ch) = w;
            }
    }
};

struct EpiPost {
    static constexpr bool PERM = true, AFTER_DRAIN = true;
    const float* xs; float* xd; bf16_t* H; int ldc;
    const float* gate; const float* nga; const float* ngb; const float* scale; const float* shift; int bstride, rows_per_batch;
    float* xch1; float* xch2; unsigned* cnt1; unsigned* cnt2; float eps;
    __device__ __forceinline__ void exchange(float* xch, unsigned* cnt, const Unit& u, PG8_LAS float* P, PG8_LAS float* R, int tid, int wid, int lane) const {
        asm volatile("s_waitcnt lgkmcnt(0)" ::: "memory"); __builtin_amdgcn_s_barrier(); asm volatile("" ::: "memory");
        if (tid < 256) { const float t = (P[tid * 4 + 0] + P[tid * 4 + 1]) + (P[tid * 4 + 2] + P[tid * 4 + 3]);
            __hip_atomic_store((unsigned*)xch + ((size_t)u.pm * 8 + u.pn) * 256 + tid, __builtin_bit_cast(unsigned, t), __ATOMIC_RELAXED, __HIP_MEMORY_SCOPE_AGENT); }
        if (wid < 4) { asm volatile("s_waitcnt vmcnt(0)" ::: "memory"); if (lane == 0) (void)__hip_atomic_fetch_add(cnt + 64 * u.pm, 1u, __ATOMIC_RELAXED, __HIP_MEMORY_SCOPE_AGENT); }
        if (wid == 0) { unsigned sp = 0; while ((unsigned)__builtin_amdgcn_readfirstlane((int)__hip_atomic_load(cnt + 64 * u.pm, __ATOMIC_RELAXED, __HIP_MEMORY_SCOPE_AGENT)) < 32u) { __builtin_amdgcn_s_sleep(2); if (++sp > (1u << 22)) break; } }
        asm volatile("s_waitcnt vmcnt(0) lgkmcnt(0)" ::: "memory"); __builtin_amdgcn_s_barrier(); asm volatile("" ::: "memory");
        if (tid < 256) { float tot = 0.f;
#pragma unroll
            for (int q = 0; q < 8; ++q) tot += __builtin_bit_cast(float, __hip_atomic_load((unsigned*)xch + ((size_t)u.pm * 8 + q) * 256 + tid, __ATOMIC_RELAXED, __HIP_MEMORY_SCOPE_AGENT));
            R[tid] = 1.f / sqrtf(tot * (1.f / 2048.f) + eps); }
        asm volatile("s_waitcnt lgkmcnt(0)" ::: "memory"); __builtin_amdgcn_s_barrier(); asm volatile("" ::: "memory");
    }
    __device__ __forceinline__ void fused(f32x4 (&acc)[2][2][4][2], const Unit& u, int wr, int wc, int fr, int fq, PG8_LAS unsigned char* lds, int wid, int lane) const {
        PG8_LAS float* P = (PG8_LAS float*)lds; PG8_LAS float* R = (PG8_LAS float*)(lds + 4096);
        const int tid = wid * 64 + lane, b = (u.pm * BM) / rows_per_batch, col0 = u.pn * BM + wc * 32 + 8 * fq, rl0 = wr * 64 + fr;
#pragma unroll
        for (int ai = 0; ai < 2; ++ai)
#pragma unroll
            for (int m = 0; m < 4; ++m) { float s = 0.f;
#pragma unroll
                for (int bj = 0; bj < 2; ++bj)
#pragma unroll
                    for (int n = 0; n < 2; ++n) { const f32x4 v = acc[ai][bj][m][n]; s += (v[0] * v[0] + v[1] * v[1]) + (v[2] * v[2] + v[3] * v[3]); }
                s += swz_xor16(s); s = sum_xor32(s);
                if (fq == 0) P[(rl0 + ai * HALF + m * 16) * 4 + wc] = s; }
        f32x4 xv[4][2][2];
#pragma unroll
        for (int m = 0; m < 4; ++m) { const size_t ro = (size_t)(u.pm * BM + rl0 + m * 16) * ldc;
#pragma unroll
            for (int bj = 0; bj < 2; ++bj)
#pragma unroll
                for (int n = 0; n < 2; ++n) xv[m][bj][n] = *(const f32x4*)(xs + ro + col0 + bj * HALF + 4 * n); }
        exchange(xch1, cnt1, u, P, R, tid, wid, lane);
        f32x4 gn[2][2];
#pragma unroll
        for (int bj = 0; bj < 2; ++bj)
#pragma unroll
            for (int n = 0; n < 2; ++n) { const int c = col0 + bj * HALF + 4 * n; gn[bj][n] = *(const f32x4*)(gate + (size_t)b * bstride + c) * *(const f32x4*)(nga + c); }
#pragma unroll
        for (int ai = 0; ai < 2; ++ai) {
#pragma unroll
            for (int m = 0; m < 4; ++m) { if (ai == 0) break; const size_t ro = (size_t)(u.pm * BM + rl0 + ai * HALF + m * 16) * ldc;
#pragma unroll
                for (int bj = 0; bj < 2; ++bj)
#pragma unroll
                    for (int n = 0; n < 2; ++n) xv[m][bj][n] = *(const f32x4*)(xs + ro + col0 + bj * HALF + 4 * n); }
#pragma unroll
            for (int m = 0; m < 4; ++m) { const int rl = rl0 + ai * HALF + m * 16; const size_t ro = (size_t)(u.pm * BM + rl) * ldc; const float r1 = R[rl]; float s = 0.f;
#pragma unroll
                for (int bj = 0; bj < 2; ++bj)
#pragma unroll
                    for (int n = 0; n < 2; ++n) { const int c = col0 + bj * HALF + 4 * n;
                        const f32x4 v = xv[m][bj][n] + gn[bj][n] * (acc[ai][bj][m][n] * r1);
                        *(f32x4*)(xd + ro + c) = v; acc[ai][bj][m][n] = v; s += (v[0] * v[0] + v[1] * v[1]) + (v[2] * v[2] + v[3] * v[3]); }
                if (H) { s += swz_xor16(s); s = sum_xor32(s); if (fq == 0) P[rl * 4 + wc] = s; } }
        }
        if (!H) return;
        exchange(xch2, cnt2, u, P, R, tid, wid, lane);
        f32x4 hb[2][2], sh[2][2];
#pragma unroll
        for (int bj = 0; bj < 2; ++bj)
#pragma unroll
            for (int n = 0; n < 2; ++n) { const int c = col0 + bj * HALF + 4 * n; hb[bj][n] = *(const f32x4*)(ngb + c) * (*(const f32x4*)(scale + (size_t)b * bstride + c) + 1.f); sh[bj][n] = *(const f32x4*)(shift + (size_t)b * bstride + c); }
#pragma unroll
        for (int ai = 0; ai < 2; ++ai)
#pragma unroll
            for (int m = 0; m < 4; ++m) { const int rl = rl0 + ai * HALF + m * 16; const size_t ro = (size_t)(u.pm * BM + rl) * ldc; const float r2 = R[rl];
#pragma unroll
                for (int bj = 0; bj < 2; ++bj) { const f32x4 h0 = (acc[ai][bj][m][0] * r2) * hb[bj][0] + sh[bj][0], h1 = (acc[ai][bj][m][1] * r2) * hb[bj][1] + sh[bj][1];
                    u32x4 w; w.x = cvt_pk_bf16(h0[0], h0[1]); w.y = cvt_pk_bf16(h0[2], h0[3]); w.z = cvt_pk_bf16(h1[0], h1[1]); w.w = cvt_pk_bf16(h1[2], h1[3]);
                    *(u32x4*)(H + ro + col0 + bj * HALF) = w; } }
    }
};
template <class Epi, class Sched, bool ALIGN_EPI = false, bool SP2 = false>
__device__ __forceinline__ void gemm_phase(PG8_LAS unsigned char* lds, const Gemm g, const Sched& S, const Epi& E, int wv  ) {
    const int tid_ = wv * 64 + lane_now();
    const int tid = tid_, wid = __builtin_amdgcn_readfirstlane(tid >> 6), lane = tid & 63, wr = wid >> 2, wc = wid & 3, fr = lane & 15, fq = lane >> 4;
    const int K = g.K, nt = K / BK;
    unsigned voffA[2], voffB[2];
#pragma unroll
    for (int i = 0; i < 2; ++i) { int R, C; stage_rc(tid * 16 + i * 8192, R, C); const int Rb = Epi::PERM ? ((R & ~31) + perm32(R & 31)) : R;
        voffA[i] = (unsigned)(R * K + C) * 2u; voffB[i] = (unsigned)(Rb * K + C) * 2u; }
    const size_t kstep = (size_t)(BK * 2);
    const size_t hstep = (size_t)HALF * K * 2;
    const size_t tstep = 2 * hstep;
    const unsigned ldsw = (unsigned)wid * 1024u;
    const int aoff = lds_byte(wr * 64 + fr, fq * 8), boff = lds_byte(wc * 32 + fr, fq * 8);
#define PG8_SA(b, h) (((b) * 2 + (h)) * HTB)
#define PG8_SB(b, h) ((4 + (b) * 2 + (h)) * HTB)
#define PG8_STAGE(bufoff, gbase, voff) do { _Pragma("unroll") for (int _i = 0; _i < 2; ++_i) \
        __builtin_amdgcn_global_load_lds((const unsigned*)((const char*)(gbase) + (voff)[_i]), (PG8_LAS unsigned*)(lds + (bufoff) + ldsw + _i * 8192), 16, 0, 0); } while (0)
#define PG8_LDA(dst, b, h) do { _Pragma("unroll") for (int m = 0; m < 4; ++m) _Pragma("unroll") for (int k = 0; k < 2; ++k) dst[m][k] = *(const PG8_LAS bf16x8*)(lds + PG8_SA(b, h) + aoff + m * 2048 + k * 1024); } while (0)
#define PG8_LDB(dst, b, h) do { _Pragma("unroll") for (int n = 0; n < 2; ++n) _Pragma("unroll") for (int k = 0; k < 2; ++k) dst[n][k] = *(const PG8_LAS bf16x8*)(lds + PG8_SB(b, h) + boff + n * 2048 + k * 1024); } while (0)
#define PG8_MMA(ai, bj, At, Bt) do { __builtin_amdgcn_s_setprio(1); _Pragma("unroll") for (int m = 0; m < 4; ++m) _Pragma("unroll") for (int n = 0; n < 2; ++n) _Pragma("unroll") for (int k = 0; k < 2; ++k) \
        acc[ai][bj][m][n] = __builtin_amdgcn_mfma_f32_16x16x32_bf16(Bt[n][k], At[m][k], acc[ai][bj][m][n], 0, 0, 0); __builtin_amdgcn_s_setprio(0); } while (0)
#define PG8_WAIT_V(n) asm volatile("s_waitcnt vmcnt(" #n ")" ::: "memory")
#define PG8_WAIT_L(n) asm volatile("s_waitcnt lgkmcnt(" #n ")" ::: "memory")
#define PG8_BAR __builtin_amdgcn_s_barrier()
#define PG8_SCHED __builtin_amdgcn_sched_barrier(0)
    Unit cur, nxt; int ui = 0;
    if (!S.next(0, cur)) return;
    f32x4 acc[2][2][4][2];
#pragma unroll
    for (int a = 0; a < 2; ++a)
#pragma unroll
        for (int b = 0; b < 2; ++b)
#pragma unroll
            for (int m = 0; m < 4; ++m)
#pragma unroll
                for (int n = 0; n < 2; ++n) acc[a][b][m][n] = (f32x4){0.f, 0.f, 0.f, 0.f};
    bf16x8 At[4][2], B0[2][2], B1[2][2];
    const char* cA = (const char*)g.A + (size_t)cur.pm * tstep; const char* cB = (const char*)g.Bt + (size_t)cur.pn * tstep;
    S.a_ready(cur);
    if constexpr (SP2) {
        PG8_STAGE(PG8_SB(0, 0), cB, voffB); PG8_STAGE(PG8_SB(0, 1), cB + hstep, voffB); PG8_STAGE(PG8_SA(0, 0), cA, voffA); PG8_STAGE(PG8_SA(0, 1), cA + hstep, voffA);
        if (wr == 1) PG8_BAR;
        PG8_WAIT_V(2); PG8_BAR;
        PG8_STAGE(PG8_SB(1, 0), cB + kstep, voffB); PG8_STAGE(PG8_SA(1, 0), cA + kstep, voffA); PG8_STAGE(PG8_SB(1, 1), cB + hstep + kstep, voffB);
        PG8_WAIT_V(6); PG8_BAR;
    } else {
        PG8_STAGE(PG8_SB(0, 0), cB, voffB); PG8_STAGE(PG8_SA(0, 0), cA, voffA); PG8_STAGE(PG8_SB(0, 1), cB + hstep, voffB); PG8_STAGE(PG8_SA(0, 1), cA + hstep, voffA);
        if (wr == 1) PG8_BAR;
        PG8_WAIT_V(4); PG8_BAR;
        PG8_STAGE(PG8_SB(1, 0), cB + kstep, voffB); PG8_STAGE(PG8_SA(1, 0), cA + kstep, voffA); PG8_STAGE(PG8_SB(1, 1), cB + hstep + kstep, voffB);
        PG8_WAIT_V(6); PG8_BAR;
    }
    for (;;) {
        const bool has_next = S.next(ui + 1, nxt);
        const char* nA = has_next ? (const char*)g.A + (size_t)nxt.pm * tstep : cA; const char* nB = has_next ? (const char*)g.Bt + (size_t)nxt.pn * tstep : cB;
        for (int t = 0; t < nt; t += 2) {
            const bool last = (t == nt - 2);
            const char* a1 = cA + (size_t)(t + 1) * kstep;
            const char* a2 = last ? nA : cA + (size_t)(t + 2) * kstep; const char* b2 = last ? nB : cB + (size_t)(t + 2) * kstep;
            const char* a3 = a2 + kstep; const char* b3 = b2 + kstep;
            if (last && has_next) S.a_ready(nxt);
            if constexpr (SP2) {
            PG8_LDB(B0, 0, 0); PG8_LDB(B1, 0, 1); PG8_SCHED; PG8_LDA(At, 0, 0); PG8_STAGE(PG8_SA(1, 1), a1 + hstep, voffA);
            PG8_WAIT_V(8); PG8_WAIT_L(0); PG8_BAR; PG8_MMA(0, 0, At, B0); PG8_MMA(0, 1, At, B1); PG8_BAR; PG8_SCHED;
            PG8_LDA(At, 0, 1); PG8_STAGE(PG8_SB(0, 0), b2, voffB); PG8_STAGE(PG8_SB(0, 1), b2 + hstep, voffB); PG8_STAGE(PG8_SA(0, 0), a2, voffA);
            PG8_WAIT_V(8); PG8_WAIT_L(0); PG8_BAR; PG8_MMA(1, 0, At, B0); PG8_MMA(1, 1, At, B1); PG8_BAR; PG8_SCHED;
            PG8_LDB(B0, 1, 0); PG8_LDB(B1, 1, 1); PG8_SCHED; PG8_LDA(At, 1, 0); PG8_STAGE(PG8_SA(0, 1), a2 + hstep, voffA);
            PG8_WAIT_V(8); PG8_WAIT_L(0); PG8_BAR; PG8_MMA(0, 0, At, B0); PG8_MMA(0, 1, At, B1); PG8_BAR; PG8_SCHED;
            PG8_LDA(At, 1, 1); PG8_STAGE(PG8_SB(1, 0), b3, voffB); PG8_STAGE(PG8_SB(1, 1), b3 + hstep, voffB); PG8_STAGE(PG8_SA(1, 0), a3, voffA);
            PG8_WAIT_V(8); PG8_WAIT_L(0); PG8_BAR; PG8_MMA(1, 0, At, B0); PG8_MMA(1, 1, At, B1); PG8_BAR; PG8_SCHED;
            } else {
            PG8_LDB(B0, 0, 0); PG8_SCHED; PG8_LDA(At, 0, 0); PG8_STAGE(PG8_SA(1, 1), a1 + hstep, voffA);
            PG8_WAIT_L(8); PG8_BAR; PG8_WAIT_L(0); PG8_MMA(0, 0, At, B0); PG8_BAR; PG8_SCHED;
            PG8_LDB(B1, 0, 1); PG8_STAGE(PG8_SB(0, 0), b2, voffB);
            PG8_BAR; PG8_WAIT_L(0); PG8_MMA(0, 1, At, B1); PG8_BAR;
            PG8_LDA(At, 0, 1); PG8_STAGE(PG8_SA(0, 0), a2, voffA);
            PG8_BAR; PG8_WAIT_L(0); PG8_MMA(1, 0, At, B0); PG8_BAR; PG8_SCHED;
            PG8_STAGE(PG8_SB(0, 1), b2 + hstep, voffB);
            PG8_WAIT_V(6); PG8_BAR; PG8_MMA(1, 1, At, B1); PG8_BAR;
            PG8_LDB(B0, 1, 0); PG8_SCHED; PG8_LDA(At, 1, 0); PG8_STAGE(PG8_SA(0, 1), a2 + hstep, voffA);
            PG8_WAIT_L(8); PG8_BAR; PG8_WAIT_L(0); PG8_MMA(0, 0, At, B0); PG8_BAR; PG8_SCHED;
            PG8_LDB(B1, 1, 1); PG8_STAGE(PG8_SB(1, 0), b3, voffB);
            PG8_BAR; PG8_WAIT_L(0); PG8_MMA(0, 1, At, B1); PG8_BAR;
            PG8_LDA(At, 1, 1); PG8_STAGE(PG8_SA(1, 0), a3, voffA);
            PG8_BAR; PG8_WAIT_L(0); PG8_MMA(1, 0, At, B0); PG8_BAR; PG8_SCHED;
            PG8_STAGE(PG8_SB(1, 1), b3 + hstep, voffB);
            PG8_WAIT_V(6); PG8_BAR; PG8_MMA(1, 1, At, B1); PG8_BAR;
            }
        }
        if constexpr (ALIGN_EPI) { if (wr == 0) PG8_BAR; }
        if constexpr (!Epi::AFTER_DRAIN) { E(acc, cur, wr, wc, fr, fq); S.done(cur); }
        if (!has_next) break;
#pragma unroll
        for (int a = 0; a < 2; ++a)
#pragma unroll
            for (int b = 0; b < 2; ++b)
#pragma unroll
                for (int m = 0; m < 4; ++m)
#pragma unroll
                    for (int n = 0; n < 2; ++n) acc[a][b][m][n] = (f32x4){0.f, 0.f, 0.f, 0.f};
        cur = nxt; cA = nA; cB = nB; ++ui;
        if constexpr (ALIGN_EPI) { if (wr == 1) PG8_BAR; }
    }
    PG8_WAIT_V(0);
    if constexpr (!ALIGN_EPI) { if (wr == 0) PG8_BAR; }
    PG8_BAR;
    if constexpr (Epi::AFTER_DRAIN) { E.fused(acc, cur, wr, wc, fr, fq, lds, wid, lane); S.done(cur); }
#undef PG8_SA
#undef PG8_SB
#undef PG8_STAGE
#undef PG8_LDA
#undef PG8_LDB
#undef PG8_MMA
#undef PG8_WAIT_V
#undef PG8_WAIT_L
#undef PG8_BAR
#undef PG8_SCHED
}
}
namespace att {
typedef unsigned short bf16;
using bf16x8 = __attribute__((ext_vector_type(8))) short;
using s16x4  = __attribute__((ext_vector_type(4))) short;
using f32x16 = __attribute__((ext_vector_type(16))) float;
using u32x4  = __attribute__((ext_vector_type(4))) unsigned;
constexpr int   D = 128, NW = 8, QBLK = 32, KVBLK = 64;
constexpr float SCALE = 0.088388347648318440f;
constexpr float THR = 8.f;
constexpr int SHM_V = KVBLK * D * 2, SHM_K = KVBLK * D * 2, SHM_ATTN = 2 * SHM_V + 2 * SHM_K + NW * 64 * 4;
constexpr float MASKED = -1e30f, M_INIT = -1e28f;
#define KSWZ(row, colB) ((row) * 256 + ((colB) ^ (((row) & 7) << 4)))
#define SBAR() __builtin_amdgcn_sched_barrier(0)
__device__ __forceinline__ int crow(int r, int hi) { return (r & 3) + 8 * (r >> 2) + 4 * hi; }
__device__ __forceinline__ unsigned cvtpk(float lo, float hi) {
  unsigned r; asm volatile("v_cvt_pk_bf16_f32 %0, %1, %2" : "=v"(r) : "v"(lo), "v"(hi)); return r;
}
__device__ __forceinline__ void partialSM(f32x16& p0, f32x16& p1, float& m_reg, float& mn, float& alpha) {
  constexpr float C = SCALE * 1.4426950408889634f;
  float pmax = p0[0];
#pragma unroll
  for (int r = 1; r < 16; ++r) pmax = fmaxf(pmax, p0[r]);
#pragma unroll
  for (int r = 0; r < 16; ++r) pmax = fmaxf(pmax, p1[r]);
  { auto rr = __builtin_amdgcn_permlane32_swap(__float_as_uint(pmax), __float_as_uint(pmax), false, false);
    pmax = fmaxf(__uint_as_float(rr[0]), __uint_as_float(rr[1])); }
  if (__builtin_expect(__all(pmax - m_reg <= THR / SCALE), 1)) { mn = m_reg; alpha = 1.f; }
  else { mn = fmaxf(m_reg, pmax); alpha = __builtin_amdgcn_exp2f((m_reg - mn) * C); m_reg = mn; }
  float mnC = -mn * C;
#pragma unroll
  for (int r = 0; r < 16; ++r) p0[r] = fmaf(p0[r], C, mnC);
#pragma unroll
  for (int r = 0; r < 16; ++r) p1[r] = fmaf(p1[r], C, mnC);
#pragma unroll
  for (int r = 0; r < 16; ++r) p0[r] = __builtin_amdgcn_exp2f(p0[r]);
}
__device__ __forceinline__ void finishSM(f32x16& p0, f32x16& p1, float alpha, float& l_reg, bf16x8& pa0, bf16x8& pa1, bf16x8& pa2, bf16x8& pa3) {
#pragma unroll
  for (int r = 0; r < 16; ++r) p1[r] = __builtin_amdgcn_exp2f(p1[r]);
  float ps = 0;
#pragma unroll
  for (int r = 0; r < 16; ++r) ps += p0[r];
#pragma unroll
  for (int r = 0; r < 16; ++r) ps += p1[r];
  { auto rr = __builtin_amdgcn_permlane32_swap(__float_as_uint(ps), __float_as_uint(ps), false, false);
    ps = __uint_as_float(rr[0]) + __uint_as_float(rr[1]); }
  l_reg = l_reg * alpha + ps;
#define PK4(P, BASE, OUT) do { unsigned a0 = cvtpk(P[BASE + 0], P[BASE + 1]), a1 = cvtpk(P[BASE + 2], P[BASE + 3]);   \
    unsigned b0 = cvtpk(P[BASE + 4], P[BASE + 5]), b1 = cvtpk(P[BASE + 6], P[BASE + 7]);                              \
    auto r0 = __builtin_amdgcn_permlane32_swap(a0, b0, false, false); auto r1 = __builtin_amdgcn_permlane32_swap(a1, b1, false, false); \
    u32x4 w = {r0[0], r1[0], r0[1], r1[1]}; OUT = *reinterpret_cast<bf16x8*>(&w); } while (0)
  PK4(p0, 0, pa0); PK4(p0, 8, pa1); PK4(p1, 0, pa2); PK4(p1, 8, pa3);
#undef PK4
}
template <bool BAND>
__device__ __forceinline__ void qkt(f32x16& p0, f32x16& p1, const bf16* Ks, const bf16x8* qr, int r32, int hi, float dq, float kf0, float nsl, float radius, float Lf, int side) {
  if (!BAND && side != 0) {
    const float ns = side > 0 ? nsl : -nsl, t = ns * dq;
#pragma unroll
    for (int r = 0; r < 16; ++r) { const float c0 = (float)((r & 3) + 8 * (r >> 2)); p0[r] = fmaf(ns, -c0, t); p1[r] = fmaf(ns, -(c0 + 32.f), t); }
  } else
#pragma unroll
  for (int r = 0; r < 16; ++r) {
    const float c0 = (float)((r & 3) + 8 * (r >> 2));
    const float d0 = dq - c0, d1 = dq - (c0 + 32.f);
    float b0 = nsl * fabsf(d0), b1 = nsl * fabsf(d1);
    if (BAND) {
      const float ka = kf0 + c0, kb = kf0 + (c0 + 32.f);
      const bool v0 = (fabsf(d0) <= radius) && (ka >= 0.f) && (ka < Lf);
      const bool v1 = (fabsf(d1) <= radius) && (kb >= 0.f) && (kb < Lf);
      b0 = v0 ? b0 : MASKED; b1 = v1 ? b1 : MASKED;
    }
    p0[r] = b0; p1[r] = b1;
  }
#pragma unroll
  for (int d0 = 0; d0 < 8; ++d0) { int cb = (d0 * 16 + hi * 8) * 2;
    bf16x8 b0 = *reinterpret_cast<const bf16x8*>((const char*)Ks + KSWZ(r32, cb));
    bf16x8 b1 = *reinterpret_cast<const bf16x8*>((const char*)Ks + KSWZ(32 + r32, cb));
    p0 = __builtin_amdgcn_mfma_f32_32x32x16_bf16(b0, qr[d0], p0, 0, 0, 0);
    p1 = __builtin_amdgcn_mfma_f32_32x32x16_bf16(b1, qr[d0], p1, 0, 0, 0); }
}
#define QK_RD(A, B, D0) do { const int ad_ = kb + kx[D0]; asm volatile("ds_read_b128 %0, %1" : "=&v"(A) : "v"(ad_) : "memory"); asm volatile("ds_read_b128 %0, %1 offset:8192" : "=&v"(B) : "v"(ad_) : "memory"); } while (0)
#define QK_WAIT(N, A, B) asm volatile("s_waitcnt lgkmcnt(" #N ")" : "+v"(A), "+v"(B) :: "memory")
#define QK_MM(A, B, D0) do { p0 = __builtin_amdgcn_mfma_f32_32x32x16_bf16(A, qr[D0], p0, 0, 0, 0); p1 = __builtin_amdgcn_mfma_f32_32x32x16_bf16(B, qr[D0], p1, 0, 0, 0); } while (0)
__device__ __forceinline__ void qkt_pipe(f32x16& p0, f32x16& p1, int kb, const int (&kx)[8], const bf16x8* qr, float dq, float nsl, int side) {
  if (side != 0) {
    const float ns = side > 0 ? nsl : -nsl, t = ns * dq;
#pragma unroll
    for (int r = 0; r < 16; ++r) { const float c0 = (float)((r & 3) + 8 * (r >> 2)); p0[r] = fmaf(ns, -c0, t); p1[r] = fmaf(ns, -(c0 + 32.f), t); }
  } else {
#pragma unroll
    for (int r = 0; r < 16; ++r) { const float c0 = (float)((r & 3) + 8 * (r >> 2)); p0[r] = nsl * fabsf(dq - c0); p1[r] = nsl * fabsf(dq - (c0 + 32.f)); }
  }
  bf16x8 a0, b0, a1, b1, a2, b2, a3, b3;
  QK_RD(a0, b0, 0); QK_RD(a1, b1, 1); QK_RD(a2, b2, 2); QK_RD(a3, b3, 3);
  QK_WAIT(6, a0, b0); SBAR(); QK_MM(a0, b0, 0); QK_RD(a0, b0, 4);
  QK_WAIT(6, a1, b1); SBAR(); QK_MM(a1, b1, 1); QK_RD(a1, b1, 5);
  QK_WAIT(6, a2, b2); SBAR(); QK_MM(a2, b2, 2); QK_RD(a2, b2, 6);
  QK_WAIT(6, a3, b3); SBAR(); QK_MM(a3, b3, 3); QK_RD(a3, b3, 7);
  QK_WAIT(6, a0, b0); SBAR(); QK_MM(a0, b0, 4);
  QK_WAIT(4, a1, b1); SBAR(); QK_MM(a1, b1, 5);
  QK_WAIT(2, a2, b2); SBAR(); QK_MM(a2, b2, 6);
  QK_WAIT(0, a3, b3); SBAR(); QK_MM(a3, b3, 7);
}
#undef QK_RD
#undef QK_WAIT
#undef QK_MM
__device__ __forceinline__ int v_st(int k, int c) { const int kk = (k & ~0xC) | ((k & 4) << 1) | ((k & 8) >> 1); return ((kk >> 3) * 4 + (c >> 5)) * 512 + ((kk & 7) * 32 + (c & 31)) * 2; }
__device__ __forceinline__ int v_rd_base(int lane) { return ((lane & 3) << 3) | (((lane >> 2) & 3) << 6) | (((lane >> 4) & 1) << 5) | (((lane >> 5) & 1) << 8); }
constexpr int v_rd_off(int d0, int ks, int half) { return d0 * 512 + ks * 4096 + half * 2048; }
template <int OFF> __device__ __forceinline__ s16x4 tr_read(int vb) {
  s16x4 r; asm volatile("ds_read_b64_tr_b16 %0, %1 offset:%2" : "=&v"(r) : "v"(vb), "i"(OFF) : "memory"); return r;
}
template <int D0> __device__ __forceinline__ void pv_one(f32x16& od, int vb, bf16x8 pa0, bf16x8 pa1, bf16x8 pa2, bf16x8 pa3) {
  const s16x4 l0 = tr_read<v_rd_off(D0, 0, 0)>(vb), h0 = tr_read<v_rd_off(D0, 0, 1)>(vb), l1 = tr_read<v_rd_off(D0, 1, 0)>(vb), h1 = tr_read<v_rd_off(D0, 1, 1)>(vb);
  const s16x4 l2 = tr_read<v_rd_off(D0, 2, 0)>(vb), h2 = tr_read<v_rd_off(D0, 2, 1)>(vb), l3 = tr_read<v_rd_off(D0, 3, 0)>(vb), h3 = tr_read<v_rd_off(D0, 3, 1)>(vb);
  asm volatile("s_waitcnt lgkmcnt(0)" ::: "memory"); SBAR();
#define PK(L, H) (bf16x8){L[0], L[1], L[2], L[3], H[0], H[1], H[2], H[3]}
  od = __builtin_amdgcn_mfma_f32_32x32x16_bf16(pa0, PK(l0, h0), od, 0, 0, 0);
  od = __builtin_amdgcn_mfma_f32_32x32x16_bf16(pa1, PK(l1, h1), od, 0, 0, 0);
  od = __builtin_amdgcn_mfma_f32_32x32x16_bf16(pa2, PK(l2, h2), od, 0, 0, 0);
  od = __builtin_amdgcn_mfma_f32_32x32x16_bf16(pa3, PK(l3, h3), od, 0, 0, 0);
#undef PK
}
__device__ __forceinline__ void pv_d0(f32x16* o, int vb, bf16x8 pa0, bf16x8 pa1, bf16x8 pa2, bf16x8 pa3) {
  pv_one<0>(o[0], vb, pa0, pa1, pa2, pa3); pv_one<1>(o[1], vb, pa0, pa1, pa2, pa3); pv_one<2>(o[2], vb, pa0, pa1, pa2, pa3); pv_one<3>(o[3], vb, pa0, pa1, pa2, pa3);
}

#define PV_RD(F, D0) do { F##0 = tr_read<v_rd_off(D0, 0, 0)>(vb); F##1 = tr_read<v_rd_off(D0, 0, 1)>(vb); F##2 = tr_read<v_rd_off(D0, 1, 0)>(vb); F##3 = tr_read<v_rd_off(D0, 1, 1)>(vb); \
    F##4 = tr_read<v_rd_off(D0, 2, 0)>(vb); F##5 = tr_read<v_rd_off(D0, 2, 1)>(vb); F##6 = tr_read<v_rd_off(D0, 3, 0)>(vb); F##7 = tr_read<v_rd_off(D0, 3, 1)>(vb); } while (0)
#define PV_WAIT(N, F) asm volatile("s_waitcnt lgkmcnt(" #N ")" : "+v"(F##0), "+v"(F##1), "+v"(F##2), "+v"(F##3), "+v"(F##4), "+v"(F##5), "+v"(F##6), "+v"(F##7) :: "memory")
#define PV_PK(L, H) (bf16x8){L[0], L[1], L[2], L[3], H[0], H[1], H[2], H[3]}
#define PV_MM(OD, F) do { OD = __builtin_amdgcn_mfma_f32_32x32x16_bf16(pa0, PV_PK(F##0, F##1), OD, 0, 0, 0); OD = __builtin_amdgcn_mfma_f32_32x32x16_bf16(pa1, PV_PK(F##2, F##3), OD, 0, 0, 0); \
    OD = __builtin_amdgcn_mfma_f32_32x32x16_bf16(pa2, PV_PK(F##4, F##5), OD, 0, 0, 0); OD = __builtin_amdgcn_mfma_f32_32x32x16_bf16(pa3, PV_PK(F##6, F##7), OD, 0, 0, 0); } while (0)
__device__ __forceinline__ void pv_pipe(f32x16* o, int vb, bf16x8 pa0, bf16x8 pa1, bf16x8 pa2, bf16x8 pa3) {
  s16x4 a0, a1, a2, a3, a4, a5, a6, a7, b0, b1, b2, b3, b4, b5, b6, b7;
  PV_RD(a, 0);
  PV_RD(b, 1); PV_WAIT(8, a); SBAR(); PV_MM(o[0], a);
  PV_RD(a, 2); PV_WAIT(8, b); SBAR(); PV_MM(o[1], b);
  PV_RD(b, 3); PV_WAIT(8, a); SBAR(); PV_MM(o[2], a);
  PV_WAIT(0, b); SBAR(); PV_MM(o[3], b);
}
#undef PV_RD
#undef PV_WAIT
#undef PV_PK
#undef PV_MM

#define ATT_GAS __attribute__((address_space(1)))
struct UnitArgs {
  const ATT_GAS bf16* Q; long ldq;
  const ATT_GAS bf16* K; const ATT_GAS bf16* V; long ldk;
  int q0, L, kt0, nt;
  float nsl, radius, m_init, l_init;
  ATT_GAS float* Of; ATT_GAS bf16* Ob; long ldo;
  ATT_GAS float* lse; long ldl;
};

template <bool BAND, int SDEPTH>
__device__ __forceinline__ void attn_unit(const UnitArgs& a_in, char* lds, int wv) {
  UnitArgs a = a_in;
  asm volatile("" : "+s"(a.Q), "+s"(a.ldq), "+s"(a.K), "+s"(a.V), "+s"(a.ldk));
  asm volatile("" : "+s"(a.q0), "+s"(a.L), "+s"(a.kt0), "+s"(a.nt));
  asm volatile("" : "+s"(a.Of), "+s"(a.Ob), "+s"(a.ldo), "+s"(a.lse), "+s"(a.ldl));
  const int tid_ = wv * 64 + lane_now();
  const int tid = tid_, wid = tid >> 6, lane = tid & 63, r32 = lane & 31, hi = lane >> 5;
  bf16* V_lds = (bf16*)lds; bf16* K_lds = (bf16*)(lds + 2 * SHM_V);
  float* ws = (float*)(lds + 2 * SHM_V + 2 * SHM_K) + wid * 64; float* li_l = ws; float* al_l = ws + 32;
  float m_reg = a.m_init, l_reg = a.l_init; f32x16 o[4] = {}; bf16x8 qr[8];
  const ATT_GAS bf16* Qw = a.Q + (long)(wid * QBLK + r32) * a.ldq + hi * 8;
#pragma unroll
  for (int d0 = 0; d0 < 8; ++d0) qr[d0] = *reinterpret_cast<const ATT_GAS bf16x8*>(Qw + d0 * 16);
  const int sr = tid >> 4, sc = (tid & 15) * 8, vst0 = v_st(sr, sc), vst1 = v_st(32 + sr, sc);
  const int vb0 = (int)(uintptr_t)V_lds + v_rd_base(lane);
  const float qf = (float)(a.q0 + wid * QBLK + r32), Lf = (float)a.L, nsl = a.nsl, radius = a.radius;
  const int Lm1 = a.L - 1, kt0 = a.kt0, qw0 = a.q0 + __builtin_amdgcn_readfirstlane(wid) * QBLK;
  const ATT_GAS bf16* Kp = a.K; const ATT_GAS bf16* Vp = a.V; const long ldk = a.ldk;
  struct { bf16x8 vs0, vs1, ks0, ks1; } sr_[SDEPTH];
  const unsigned lofs = (unsigned)((sr * ldk + sc) * 2);
  const ATT_GAS char* Kc = (const ATT_GAS char*)Kp; const ATT_GAS char* Vc = (const ATT_GAS char*)Vp; const long ldk32 = 32 * ldk * 2, ldk64 = 64 * ldk * 2;
#define SLOAD(i, t) do { if constexpr (BAND) { const int k0_ = (kt0 + (t)) * KVBLK; int ra_ = k0_ + sr, rb_ = k0_ + 32 + sr;                   \
    ra_ = ra_ < 0 ? 0 : (ra_ > Lm1 ? Lm1 : ra_); rb_ = rb_ < 0 ? 0 : (rb_ > Lm1 ? Lm1 : rb_);                                          \
    sr_[i].vs0 = *reinterpret_cast<const ATT_GAS bf16x8*>(&Vp[(long)ra_ * ldk + sc]); sr_[i].vs1 = *reinterpret_cast<const ATT_GAS bf16x8*>(&Vp[(long)rb_ * ldk + sc]); \
    sr_[i].ks0 = *reinterpret_cast<const ATT_GAS bf16x8*>(&Kp[(long)ra_ * ldk + sc]); sr_[i].ks1 = *reinterpret_cast<const ATT_GAS bf16x8*>(&Kp[(long)rb_ * ldk + sc]); } \
  else { const long tb_ = (long)(kt0 + (t)) * ldk64;                                                                                       \
    sr_[i].vs0 = *reinterpret_cast<const ATT_GAS bf16x8*>(Vc + tb_ + lofs); sr_[i].vs1 = *reinterpret_cast<const ATT_GAS bf16x8*>(Vc + tb_ + ldk32 + lofs); \
    sr_[i].ks0 = *reinterpret_cast<const ATT_GAS bf16x8*>(Kc + tb_ + lofs); sr_[i].ks1 = *reinterpret_cast<const ATT_GAS bf16x8*>(Kc + tb_ + ldk32 + lofs); } } while (0)
#define SWRITE(b, i) do { *(bf16x8*)((char*)V_lds + (b) * SHM_V + vst0) = sr_[i].vs0;          \
    *(bf16x8*)((char*)V_lds + (b) * SHM_V + vst1) = sr_[i].vs1; int kc = sc * 2;               \
    *(bf16x8*)((char*)K_lds + (b) * SHM_K + KSWZ(sr, kc)) = sr_[i].ks0;                       \
    *(bf16x8*)((char*)K_lds + (b) * SHM_K + KSWZ(32 + sr, kc)) = sr_[i].ks1; } while (0)
#define SWAIT() do { if constexpr (SDEPTH == 2) asm volatile("s_waitcnt vmcnt(4)" ::: "memory"); else asm volatile("s_waitcnt vmcnt(0)" ::: "memory"); } while (0)
#define RESC(al) do { if (__any((al) < 1.f)) { if (hi == 0) al_l[r32] = (al); asm volatile("s_waitcnt lgkmcnt(0)" ::: "memory"); \
    _Pragma("unroll") for (int d = 0; d < 4; ++d) _Pragma("unroll") for (int r = 0; r < 16; ++r) o[d][r] *= al_l[crow(r, hi)]; } } while (0)
#define QKT(PA, PB, buf, t) do { const int k0_ = (kt0 + (t)) * KVBLK; const float kf0_ = (float)(k0_ + 4 * hi); \
    const int side_ = (k0_ + KVBLK - 1 < qw0) ? 1 : ((k0_ > qw0 + QBLK - 1) ? -1 : 0); \
    qkt<BAND>(PA, PB, (bf16*)((char*)K_lds + (buf) * SHM_K), qr, r32, hi, qf - kf0_, kf0_, nsl, radius, Lf, side_); } while (0)
  f32x16 pA0, pA1, pB0, pB1; float mnA, mnB, alA, alB; bf16x8 pa0, pa1, pa2, pa3; const int NT = a.nt;
  constexpr int SE = 0, SO = SDEPTH - 1;
  SLOAD(SE, 0); asm volatile("s_waitcnt vmcnt(0)" ::: "memory"); SWRITE(0, SE); __syncthreads();
  QKT(pA0, pA1, 0, 0); partialSM(pA0, pA1, m_reg, mnA, alA);
  SLOAD(SO, 1); if constexpr (SDEPTH == 2) { if (2 < NT) SLOAD(SE, 2); }
  SWAIT(); SWRITE(1, SO); __syncthreads();
  for (int j = 1; j + 1 < NT; j += 2) {
    SBAR(); QKT(pB0, pB1, 1, j);
    finishSM(pA0, pA1, alA, l_reg, pa0, pa1, pa2, pa3); SBAR();
    SLOAD(SO, j + SDEPTH); SBAR();
    pv_d0(o, vb0, pa0, pa1, pa2, pa3); partialSM(pB0, pB1, m_reg, mnB, alB);
    __syncthreads(); SWAIT(); SWRITE(0, SE);
    RESC(alB); __syncthreads();
    SBAR(); QKT(pA0, pA1, 0, j + 1);
    finishSM(pB0, pB1, alB, l_reg, pa0, pa1, pa2, pa3); SBAR();
    if (SDEPTH == 1 || j + 3 < NT) SLOAD(SE, j + 1 + SDEPTH); SBAR();
    pv_d0(o, vb0 + (int)SHM_V, pa0, pa1, pa2, pa3); partialSM(pA0, pA1, m_reg, mnA, alA);
    __syncthreads(); SWAIT(); SWRITE(1, SO);
    RESC(alA); __syncthreads();
  }
  SBAR(); QKT(pB0, pB1, 1, NT - 1);
  finishSM(pA0, pA1, alA, l_reg, pa0, pa1, pa2, pa3); SBAR();
  pv_d0(o, vb0, pa0, pa1, pa2, pa3); partialSM(pB0, pB1, m_reg, mnB, alB);
  __syncthreads(); RESC(alB);
  finishSM(pB0, pB1, alB, l_reg, pa0, pa1, pa2, pa3); SBAR();
  pv_d0(o, vb0 + (int)SHM_V, pa0, pa1, pa2, pa3);
  if (hi == 0) li_l[r32] = l_reg; asm volatile("s_waitcnt lgkmcnt(0)" ::: "memory");
  float rli[16];
#pragma unroll
  for (int r = 0; r < 16; ++r) rli[r] = __builtin_amdgcn_rcpf(li_l[crow(r, hi)]);
  if (a.Of) {
    ATT_GAS float* Ow = a.Of + (long)(wid * QBLK) * a.ldo;
#pragma unroll
    for (int r = 0; r < 16; ++r) { const int orow = crow(r, hi);
#pragma unroll
      for (int d0 = 0; d0 < 4; ++d0) Ow[(long)orow * a.ldo + d0 * 32 + r32] = o[d0][r] * rli[r]; }
  } else {
    ATT_GAS bf16* Ow = a.Ob + (long)(wid * QBLK) * a.ldo;
#pragma unroll
    for (int r = 0; r < 16; ++r) { const int orow = crow(r, hi);
#pragma unroll
      for (int d0 = 0; d0 < 4; ++d0) { const float v = o[d0][r] * rli[r]; Ow[(long)orow * a.ldo + d0 * 32 + r32] = (bf16)(cvtpk(v, v) & 0xffffu); } }
  }
  if (a.lse && hi == 0) a.lse[(long)(wid * QBLK + r32) * a.ldl] = m_reg * SCALE + __logf(l_reg);
  __syncthreads();
#undef SLOAD
#undef SWRITE
#undef SWAIT
#undef RESC
#undef QKT
}

constexpr int PU_K0 = 0, PU_V0 = 32768, PU_PS = 98304, PU_LDS = 131072;
struct PairArgs {
  const ATT_GAS bf16* Q; long ldq;
  const ATT_GAS bf16* K; const ATT_GAS bf16* V; long ldk;
  int q0, kt0, nt;
  float nsl;
  ATT_GAS float* O; long ldo;
};
__device__ __forceinline__ void attn_split_unit(const PairArgs& a_in, char* lds, float* xs  , int wv) {
  PairArgs a = a_in;
  asm volatile("" : "+s"(a.Q), "+s"(a.ldq), "+s"(a.K), "+s"(a.V), "+s"(a.ldk));
  asm volatile("" : "+s"(a.q0), "+s"(a.kt0), "+s"(a.nt), "+s"(a.O), "+s"(a.ldo));
  const int tid_ = wv * 64 + lane_now();
  const int tid = tid_, wid = tid >> 6, lane = tid & 63, r32 = lane & 31, hi = lane >> 5;
  const int pr = __builtin_amdgcn_readfirstlane(wid & 3), role = __builtin_amdgcn_readfirstlane(wid >> 2);
  float* AL = xs; float* LL = xs + 256; float* FL = xs + 512;
  const int t8 = tid & 255, sr = t8 >> 4, sc = (t8 & 15) * 8, vr = t8 >> 5, vc = (t8 & 31) * 8;
  const int ksw0 = KSWZ(sr, sc * 2), ksw1 = KSWZ(sr + 16, sc * 2), ksw2 = KSWZ(sr + 32, sc * 2), ksw3 = KSWZ(sr + 48, sc * 2);
  const int vhalf = (vc >> 7) * 16384, vcc = vc & 127;
  const unsigned kofs = (unsigned)((sr * a.ldk + sc) * 2), vofs = (unsigned)((vr * a.ldk + vc) * 2);
  const ATT_GAS char* Kc = (const ATT_GAS char*)a.K; const ATT_GAS char* Vc = (const ATT_GAS char*)a.V;
  const long ldk8 = 8 * a.ldk * 2, ldk16 = 16 * a.ldk * 2, ldk64 = 64 * a.ldk * 2;
  const int kt0 = a.kt0, NT = a.nt;
#define PLOADK(t) do { const long tb_ = (long)(kt0 + (t)) * ldk64; sk0 = *reinterpret_cast<const ATT_GAS bf16x8*>(Kc + tb_ + kofs); sk1 = *reinterpret_cast<const ATT_GAS bf16x8*>(Kc + tb_ + ldk16 + kofs); \
    sk2 = *reinterpret_cast<const ATT_GAS bf16x8*>(Kc + tb_ + 2 * ldk16 + kofs); sk3 = *reinterpret_cast<const ATT_GAS bf16x8*>(Kc + tb_ + 3 * ldk16 + kofs); } while (0)
#define PLOADV(t) do { const ATT_GAS char* vp_ = Vc + (long)(kt0 + (t)) * ldk64 + vofs; sv0 = *reinterpret_cast<const ATT_GAS bf16x8*>(vp_); sv1 = *reinterpret_cast<const ATT_GAS bf16x8*>(vp_ + ldk8); \
    sv2 = *reinterpret_cast<const ATT_GAS bf16x8*>(vp_ + 2 * ldk8); sv3 = *reinterpret_cast<const ATT_GAS bf16x8*>(vp_ + 3 * ldk8); sv4 = *reinterpret_cast<const ATT_GAS bf16x8*>(vp_ + 4 * ldk8); \
    sv5 = *reinterpret_cast<const ATT_GAS bf16x8*>(vp_ + 5 * ldk8); sv6 = *reinterpret_cast<const ATT_GAS bf16x8*>(vp_ + 6 * ldk8); sv7 = *reinterpret_cast<const ATT_GAS bf16x8*>(vp_ + 7 * ldk8); } while (0)
#define PWRITEK(b) do { char* kb_ = lds + PU_K0 + (b) * 16384; *(bf16x8*)(kb_ + ksw0) = sk0; *(bf16x8*)(kb_ + ksw1) = sk1; *(bf16x8*)(kb_ + ksw2) = sk2; *(bf16x8*)(kb_ + ksw3) = sk3; } while (0)
#define PWRITEV(b) do { char* vb_ = lds + PU_V0 + (b) * 32768 + vhalf; *(bf16x8*)(vb_ + v_st(vr, vcc)) = sv0; *(bf16x8*)(vb_ + v_st(vr + 8, vcc)) = sv1; *(bf16x8*)(vb_ + v_st(vr + 16, vcc)) = sv2; \
    *(bf16x8*)(vb_ + v_st(vr + 24, vcc)) = sv3; *(bf16x8*)(vb_ + v_st(vr + 32, vcc)) = sv4; *(bf16x8*)(vb_ + v_st(vr + 40, vcc)) = sv5; *(bf16x8*)(vb_ + v_st(vr + 48, vcc)) = sv6; \
    *(bf16x8*)(vb_ + v_st(vr + 56, vcc)) = sv7; } while (0)
#define SYNC_ONLY() do { asm volatile("s_waitcnt lgkmcnt(0)" ::: "memory"); __syncthreads(); } while (0)
  if (role == 0) {
    bf16x8 sk0, sk1, sk2, sk3;
    PLOADK(0); PWRITEK(0);
    SYNC_ONLY();
    bf16x8 qr[8]; float m_reg = M_INIT, l_reg = 0.f;
    const ATT_GAS bf16* Qw = a.Q + (long)(pr * QBLK + r32) * a.ldq + hi * 8;
#pragma unroll
    for (int d0 = 0; d0 < 8; ++d0) qr[d0] = *reinterpret_cast<const ATT_GAS bf16x8*>(Qw + d0 * 16);
    asm volatile("" : "+v"(qr[0]), "+v"(qr[1]), "+v"(qr[2]), "+v"(qr[3]), "+v"(qr[4]), "+v"(qr[5]), "+v"(qr[6]), "+v"(qr[7]));
    const float qf = (float)(a.q0 + pr * QBLK + r32), nsl = a.nsl; const int qw0 = a.q0 + pr * QBLK;
    const int kb0 = (int)(uintptr_t)(lds + PU_K0) + r32 * 256;
    int kx[8];
#pragma unroll
    for (int d0 = 0; d0 < 8; ++d0) kx[d0] = ((d0 * 16 + hi * 8) * 2) ^ ((r32 & 7) << 4);
#define SSTEP(t, TP) do { if ((t) + 1 < NT) PLOADK((t) + 1); SBAR();                                                                                                      \
      if ((t) < NT) {                                                                                                                             \
        f32x16 p0, p1; const int k0_ = (kt0 + (t)) * KVBLK; const float kf0_ = (float)(k0_ + 4 * hi);                                             \
        const int side_ = (k0_ + KVBLK - 1 < qw0) ? 1 : ((k0_ > qw0 + QBLK - 1) ? -1 : 0);                                                        \
        __builtin_amdgcn_s_setprio(2); qkt_pipe(p0, p1, kb0 + (TP) * 16384, kx, qr, qf - kf0_, nsl, side_); __builtin_amdgcn_s_setprio(0);         \
        float mn_, al_; bf16x8 pa0, pa1, pa2, pa3; partialSM(p0, p1, m_reg, mn_, al_); finishSM(p0, p1, al_, l_reg, pa0, pa1, pa2, pa3);          \
        const int sc_ = (TP) * 4 + pr; char* ps_ = lds + PU_PS + sc_ * 4096 + lane * 16;                                                          \
        *(bf16x8*)(ps_) = pa0; *(bf16x8*)(ps_ + 1024) = pa1; *(bf16x8*)(ps_ + 2048) = pa2; *(bf16x8*)(ps_ + 3072) = pa3;                         \
        if (hi == 0) AL[sc_ * 32 + r32] = al_;                                                                                                    \
        const bool any_ = __any(al_ < 1.f); if (lane == 0) FL[sc_] = any_ ? 1.f : 0.f;                                                            \
      }                                                                                                                                           \
      SBAR(); if ((t) + 1 < NT) PWRITEK((TP) ^ 1); SYNC_ONLY(); } while (0)
    for (int t = 0; t <= NT; t += 2) { SSTEP(t, 0); if (t + 1 <= NT) SSTEP(t + 1, 1); }
#undef SSTEP
    if (hi == 0) LL[pr * 32 + r32] = l_reg;
    asm volatile("s_waitcnt lgkmcnt(0)" ::: "memory"); __syncthreads();
  } else {
    f32x16 o[8] = {};
    const int vb0 = (int)(uintptr_t)(lds + PU_V0) + v_rd_base(lane);
    bf16x8 sv0, sv1, sv2, sv3, sv4, sv5, sv6, sv7;
    SYNC_ONLY();
#define VSTEP(t, TP) do { if ((t) < NT) PLOADV(t); SBAR();                                                                                        \
      if ((t) >= 1) {                                                                                                                             \
        const int sp_ = ((TP) ^ 1) * 4 + pr; const char* ps_ = lds + PU_PS + sp_ * 4096 + lane * 16;                                              \
        const bf16x8 pa0 = *(const bf16x8*)(ps_), pa1 = *(const bf16x8*)(ps_ + 1024), pa2 = *(const bf16x8*)(ps_ + 2048), pa3 = *(const bf16x8*)(ps_ + 3072); \
        if (__builtin_amdgcn_readfirstlane(__float_as_int(FL[sp_])) != 0) {                                                                       \
          _Pragma("unroll") for (int r = 0; r < 16; ++r) { const float al_ = AL[sp_ * 32 + crow(r, hi)];                                          \
            _Pragma("unroll") for (int d = 0; d < 8; ++d) o[d][r] *= al_; } }                                                                     \
        pv_pipe(o, vb0 + ((TP) ^ 1) * 32768, pa0, pa1, pa2, pa3);                                                                                 \
        pv_pipe(o + 4, vb0 + ((TP) ^ 1) * 32768 + 16384, pa0, pa1, pa2, pa3);                                                                     \
      }                                                                                                                                           \
      SBAR(); if ((t) < NT) PWRITEV(TP); SYNC_ONLY(); } while (0)
    for (int t = 0; t <= NT; t += 2) { VSTEP(t, 0); if (t + 1 <= NT) VSTEP(t + 1, 1); }
#undef VSTEP
    asm volatile("s_waitcnt lgkmcnt(0)" ::: "memory"); __syncthreads();
    float rli[16];
#pragma unroll
    for (int r = 0; r < 16; ++r) rli[r] = __builtin_amdgcn_rcpf(LL[pr * 32 + crow(r, hi)]);
    ATT_GAS float* Ow = a.O + (long)(pr * QBLK) * a.ldo;
#pragma unroll
    for (int r = 0; r < 16; ++r) { const int orow = crow(r, hi);
#pragma unroll
      for (int d0 = 0; d0 < 8; ++d0) Ow[(long)orow * a.ldo + d0 * 32 + r32] = o[d0][r] * rli[r]; }
  }
  __syncthreads();
#undef PLOADK
#undef PLOADV
#undef PWRITEK
#undef PWRITEV
#undef SYNC_ONLY
}
#undef KSWZ
#undef SBAR
}
constexpr int DM = 2048, BATCH = 2, SEQ = 4096, DEPTH = 4, M = BATCH * SEQ;
constexpr int AB_IN = 3584, AB_OUT = 1024, C_IN = 6144, DFF = 5504, UPW = 2 * DFF, MODW = 6 * DM;
constexpr float EPS = 1e-6f;
constexpr int NWAVES = 8;
constexpr size_t MiB = 1u << 20;
constexpr size_t WS_CTL = 0, CTL_ZERO_BYTES = 256 * 1024;
constexpr size_t WS_MOD = 2 * MiB;
constexpr size_t WS_PART = 3 * MiB;
constexpr size_t WS_NRM = 12 * MiB;
constexpr size_t WS_WABIN = 16 * MiB;
constexpr size_t WS_WABOUT = 44 * MiB;
constexpr size_t WS_WCIN = 52 * MiB;
constexpr size_t WS_WCOUT = 100 * MiB;
constexpr size_t WS_WUP = 116 * MiB;
constexpr size_t WS_WDOWN = 288 * MiB;
constexpr size_t WS_H = 376 * MiB;
constexpr size_t WS_PROJ = 408 * MiB;
constexpr size_t WS_ATT = 504 * MiB;
constexpr size_t WS_LSE = WS_ATT + 64 * MiB;
constexpr size_t WS_O = 632 * MiB;
constexpr size_t WS_Y = 664 * MiB;
constexpr size_t WS_XCH = 736 * MiB;
constexpr size_t WS_HG = 728 * MiB;
constexpr size_t WS_HU = 732 * MiB;
constexpr size_t WS_ACT = 900 * MiB;
constexpr size_t WS_END = 986 * MiB;
static_assert(WS_PART + (size_t)DEPTH * 16 * BATCH * MODW * 4 <= WS_WABIN, "ws map");
static_assert(WS_WABIN + (size_t)2 * AB_IN * DM * 2 <= WS_WABOUT && WS_WABOUT + (size_t)2 * DM * AB_OUT * 2 <= WS_WCIN, "ws map");
static_assert(WS_WCIN + (size_t)2 * C_IN * DM * 2 <= WS_WCOUT && WS_WCOUT + (size_t)2 * DM * DM * 2 <= WS_WUP, "ws map");
static_assert(WS_WUP + (size_t)4 * UPW * DM * 2 <= WS_WDOWN && WS_WDOWN + (size_t)4 * DM * DFF * 2 <= WS_H, "ws map");
static_assert(WS_H + (size_t)M * DM * 2 <= WS_PROJ && WS_PROJ + (size_t)M * C_IN * 2 <= WS_ATT && WS_ATT + (size_t)2 * M * DM * 4 <= WS_O, "ws map");
static_assert(WS_ATT + (size_t)3 * M * 512 * 4 <= WS_LSE && WS_LSE + (size_t)3 * M * 4 * 4 <= WS_O, "ws map");
static_assert(WS_O + (size_t)M * DM * 2 <= WS_Y && WS_Y + (size_t)M * DM * 4 <= WS_HG && WS_HG + (size_t)(M / 256) * 4 * DFF * 4 <= WS_HU && WS_HU + (size_t)(M / 256) * 2 * DFF * 4 <= WS_ACT && WS_ACT + (size_t)M * DFF * 2 <= WS_END, "ws map");
constexpr int CW_CNT = 16384;
constexpr int CW_BAR = 4096;
constexpr int RING_OFF = 0, RING_BYTES = 131072;
constexpr int LDSCTL_OFF = RING_BYTES, MISC_OFF = LDSCTL_OFF + 320, BND_OFF = LDSCTL_OFF + 1024;
constexpr int LDS_BYTES = 147456;
static_assert(att::SHM_ATTN <= RING_BYTES && att::PU_LDS <= RING_BYTES, "attention LDS fits the ring region");

#define GAS __attribute__((address_space(1)))
#define LAS __attribute__((address_space(3)))
typedef unsigned short bf16;
typedef unsigned v4u __attribute__((ext_vector_type(4)));
typedef unsigned v2u __attribute__((ext_vector_type(2)));
typedef float f32x4 __attribute__((ext_vector_type(4)));
typedef GAS unsigned gu32;
#define LDS_WAIT() asm volatile("s_waitcnt lgkmcnt(0)" ::: "memory")
__device__ __forceinline__ unsigned pk2(float lo, float hi) { unsigned r; asm volatile("v_cvt_pk_bf16_f32 %0, %1, %2" : "=v"(r) : "v"(lo), "v"(hi)); return r; }
__device__ __forceinline__ float bf_lo(unsigned w) { return __uint_as_float(w << 16); }
__device__ __forceinline__ float bf_hi(unsigned w) { return __uint_as_float(w & 0xffff0000u); }
#define XB_TMO      128
#define XB_XCNT(j)  (256  + 64 * (j))
#define XB_XSUB(j)  (1280 + 64 * (j))
#define XB_XGEN(j)  (2304 + 64 * (j))
#define XB_TOP      3328
#define XB_TOPGEN   3392
#define XCD_BAR_WORDS 3456
#define XB_SPIN_CAP (1u << 18)

__device__ __forceinline__ unsigned xb_ld(unsigned* p)              { return __hip_atomic_load(p, __ATOMIC_RELAXED, __HIP_MEMORY_SCOPE_AGENT); }
__device__ __forceinline__ unsigned xb_add(unsigned* p, unsigned v) { return __hip_atomic_fetch_add(p, v, __ATOMIC_RELAXED, __HIP_MEMORY_SCOPE_AGENT); }
__device__ __forceinline__ unsigned xb_xcc_id() { return (unsigned)__builtin_amdgcn_s_getreg((3 << 11) | 20) & 0xFu; }
#define XB_SPIN(cond, bar) do { unsigned _sp = 0; while (cond) { __builtin_amdgcn_s_sleep(1); \
    if ((++_sp & 255u) == 0u) { if (xb_ld(&(bar)[XB_TMO])) break; if (_sp > XB_SPIN_CAP) { atomicAdd(&(bar)[XB_TMO], 1u); break; } } } } while (0)

struct XcdBarrier {
    int tid;
    unsigned* bar; unsigned x;
    volatile LAS unsigned* st;
};

__device__ __forceinline__ XcdBarrier xcd_barrier_post(unsigned* bar, volatile LAS unsigned* st) {
    XcdBarrier b; b.tid = (int)threadIdx.x; b.bar = bar; b.x = xb_xcc_id(); b.st = st;
    if (threadIdx.x == 0) (void)xb_add(&bar[XB_XCNT(b.x)], 1u);
    return b;
}
__device__ __forceinline__ void xcd_barrier_complete(unsigned* bar, unsigned x, unsigned& nloc, unsigned& nx) {
    const unsigned G = gridDim.x * gridDim.y * gridDim.z;
    unsigned sum, cnt, mine, sp = 0u;
    for (;;) {
        sum = 0u; cnt = 0u; mine = 0u;
#pragma unroll
        for (unsigned j = 0; j < 16; ++j) { const unsigned c = xb_ld(&bar[XB_XCNT(j)]); sum += c; cnt += (c > 0u) ? 1u : 0u; mine = (j == x) ? c : mine; }
        if (sum == G) break;
        __builtin_amdgcn_s_sleep(1);
        if ((++sp & 255u) == 0u) { if (xb_ld(&bar[XB_TMO])) break; if (sp > XB_SPIN_CAP) { atomicAdd(&bar[XB_TMO], 1u); break; } }
    }
    nloc = mine > 0u ? mine : 1u; nx = cnt > 0u ? cnt : 1u;
}

__device__ __forceinline__ void xcd_barrier(const XcdBarrier& b) {
    asm volatile("s_waitcnt vmcnt(0)" ::: "memory");
    __syncthreads();
    if (b.tid == 0) {
        unsigned* bar = b.bar;
        __builtin_amdgcn_s_waitcnt(0);
        unsigned nloc = b.st[0], nx = b.st[1];
        if (nloc == 0u) { xcd_barrier_complete(bar, b.x, nloc, nx); b.st[0] = nloc; b.st[1] = nx; }
        const unsigned old = xb_add(&bar[XB_XSUB(b.x)], 1u);
        const unsigned gen = old / nloc;
        if (old + 1u == (gen + 1u) * nloc) {
            __builtin_amdgcn_fence(__ATOMIC_RELEASE, "agent");
            asm volatile("s_waitcnt vmcnt(0)" ::: "memory");
            const unsigned og = xb_add(&bar[XB_TOP], 1u);
            const unsigned tg = og / nx;
            if (og + 1u == (tg + 1u) * nx) xb_add(&bar[XB_TOPGEN], 1u);
            else XB_SPIN(xb_ld(&bar[XB_TOPGEN]) == tg, bar);
            __builtin_amdgcn_fence(__ATOMIC_ACQUIRE, "agent");
            xb_add(&bar[XB_XGEN(b.x)], 1u);
            asm volatile("s_waitcnt vmcnt(0)" ::: "memory");
        } else {
            XB_SPIN(xb_ld(&bar[XB_XGEN(b.x)]) == gen, bar);
            __builtin_amdgcn_fence(__ATOMIC_ACQUIRE, "agent");
            asm volatile("s_waitcnt vmcnt(0)" ::: "memory");
        }
    }
    __syncthreads();
}
struct Frame {
    LAS unsigned char* lds; char* ldsg;
    int wave, G, gw, NGW;
    const float *x, *c, *ada_w, *ada_b, *norm_g, *ab_w_in, *ab_w_out, *a_sink, *c_w_in, *c_w_out, *c_lambda, *c_subln_g, *w_up, *conv_w, *conv_b, *w_down;
    float* out; unsigned char* ws;
};
#define PHASE_IDS() const int lane = lane_now(), wave = F.wave, tid = wave * 64 + lane, gw = (int)blockIdx.x * NWAVES + wave; (void)tid; (void)gw
template <int CTRL> __device__ __forceinline__ float dppf(float x) { return __builtin_bit_cast(float, __builtin_amdgcn_mov_dpp(__builtin_bit_cast(int, x), CTRL, 0xf, 0xf, true)); }
__device__ __forceinline__ float row16_sum(float v) { v += dppf<0xB1>(v); v += dppf<0x4E>(v); v += dppf<0x141>(v); v += dppf<0x140>(v); return v; }
__device__ __forceinline__ float wave_sum(float v) { v = row16_sum(v); v += swz_xor16(v); return sum_xor32(v); }
__device__ __forceinline__ void transpose_item(const float* W, int K, int N, bf16* WT, LAS float* scr, int item, int lane, int remap = 0) {
    const int nblk = N / 32, kb = item / nblk, nb = item % nblk, k0 = 64 * kb, n0 = 32 * nb;
    int d0 = n0; if (remap) { const int isup = n0 >= DFF, c0 = n0 - isup * DFF; d0 = (c0 >> 7) * 256 + isup * 128 + (c0 & 127); }
    f32x4 w[8];
#pragma unroll
    for (int i = 0; i < 8; ++i) w[i] = __builtin_nontemporal_load((const f32x4*)(W + (size_t)(k0 + (lane >> 3) + 8 * i) * N + n0 + (lane & 7) * 4));
#pragma unroll
    for (int i = 0; i < 8; ++i) { LAS float* d = scr + ((lane >> 3) + 8 * i) * 33 + (lane & 7) * 4; d[0] = w[i].x; d[1] = w[i].y; d[2] = w[i].z; d[3] = w[i].w; }
    LDS_WAIT(); asm volatile("" ::: "memory");
    const int c = lane & 7;
#pragma unroll
    for (int j = 0; j < 4; ++j) { const int n = (lane >> 3) + 8 * j; const LAS float* s = scr + (8 * c) * 33 + n;
        v4u o; o.x = pk2(s[0 * 33], s[1 * 33]); o.y = pk2(s[2 * 33], s[3 * 33]); o.z = pk2(s[4 * 33], s[5 * 33]); o.w = pk2(s[6 * 33], s[7 * 33]);
        *(GAS v4u*)(WT + (size_t)(d0 + n) * K + k0 + 8 * c) = o; }
    LDS_WAIT(); asm volatile("" ::: "memory");
}
__device__ __forceinline__ float silu_f(float v) { return v / (1.f + __expf(-v)); }

__device__ __forceinline__ void p0a_prologue(Frame& F) {
    PHASE_IDS();
    LAS float* scr = (LAS float*)(F.lds + RING_OFF + wave * 16384);
    constexpr int I_ABIN = (DM / 64) * (AB_IN / 32), I_ABOUT = (AB_OUT / 64) * (DM / 32), I_CIN = (DM / 64) * (C_IN / 32), I_COUT = (DM / 64) * (DM / 32),
                  I_UP = (DM / 64) * (UPW / 32), I_DOWN = (DFF / 64) * (DM / 32);
    const int nffn = (F.G == 256) ? 1 : 4;
    const int NT_ITEMS = 2 * I_ABIN + 2 * I_ABOUT + 2 * I_CIN + 2 * I_COUT + nffn * I_UP + nffn * I_DOWN;
    bf16* wabin = (bf16*)(F.ws + WS_WABIN); bf16* wabout = (bf16*)(F.ws + WS_WABOUT); bf16* wcin = (bf16*)(F.ws + WS_WCIN); bf16* wcout = (bf16*)(F.ws + WS_WCOUT);
    bf16* wup = (bf16*)(F.ws + WS_WUP); bf16* wdown = (bf16*)(F.ws + WS_WDOWN);
    for (int it = gw; it < NT_ITEMS; it += F.NGW) {
        int r = it;
        if (r < 2 * I_ABIN) { const int j = r / I_ABIN; transpose_item(F.ab_w_in + (size_t)j * DM * AB_IN, DM, AB_IN, wabin + (size_t)j * AB_IN * DM, scr, r % I_ABIN, lane); continue; } r -= 2 * I_ABIN;
        if (r < 2 * I_ABOUT) { const int j = r / I_ABOUT; transpose_item(F.ab_w_out + (size_t)j * AB_OUT * DM, AB_OUT, DM, wabout + (size_t)j * DM * AB_OUT, scr, r % I_ABOUT, lane); continue; } r -= 2 * I_ABOUT;
        if (r < 2 * I_CIN) { const int j = r / I_CIN; transpose_item(F.c_w_in + (size_t)j * DM * C_IN, DM, C_IN, wcin + (size_t)j * C_IN * DM, scr, r % I_CIN, lane); continue; } r -= 2 * I_CIN;
        if (r < 2 * I_COUT) { const int j = r / I_COUT; transpose_item(F.c_w_out + (size_t)j * DM * DM, DM, DM, wcout + (size_t)j * DM * DM, scr, r % I_COUT, lane); continue; } r -= 2 * I_COUT;
        if (r < nffn * I_UP) { const int j = r / I_UP; transpose_item(F.w_up + (size_t)j * DM * UPW, DM, UPW, wup + (size_t)j * UPW * DM, scr, r % I_UP, lane, 1); continue; } r -= nffn * I_UP;
        { const int j = r / I_DOWN; transpose_item(F.w_down + (size_t)j * DFF * DM, DFF, DM, wdown + (size_t)j * DM * DFF, scr, r % I_DOWN, lane); }
    }
    float* part = (float*)(F.ws + WS_PART);
    constexpr int NCH = MODW / 256, NKC = 16, KCH = DM / NKC;
    for (int it = gw; it < DEPTH * NCH * NKC; it += F.NGW) {
        const int kc = it % NKC, nch = (it / NKC) % NCH, l = it / (NKC * NCH), k0 = kc * KCH;
        const float c0a = silu_f(F.c[k0 + lane]), c0b = silu_f(F.c[k0 + 64 + lane]), c1a = silu_f(F.c[DM + k0 + lane]), c1b = silu_f(F.c[DM + k0 + 64 + lane]);
        const float* wp = F.ada_w + ((size_t)l * DM + k0) * MODW + nch * 256 + 4 * lane;
        f32x4 a0 = {0.f, 0.f, 0.f, 0.f}, a1 = {0.f, 0.f, 0.f, 0.f};
#pragma unroll 8
        for (int k = 0; k < 64; ++k) { const f32x4 w = __builtin_nontemporal_load((const f32x4*)(wp + (size_t)k * MODW)); const float s0 = __builtin_bit_cast(float, __builtin_amdgcn_readlane(__builtin_bit_cast(int, c0a), k)), s1 = __builtin_bit_cast(float, __builtin_amdgcn_readlane(__builtin_bit_cast(int, c1a), k)); a0 += w * s0; a1 += w * s1; }
#pragma unroll 8
        for (int k = 0; k < 64; ++k) { const f32x4 w = __builtin_nontemporal_load((const f32x4*)(wp + (size_t)(64 + k) * MODW)); const float s0 = __builtin_bit_cast(float, __builtin_amdgcn_readlane(__builtin_bit_cast(int, c0b), k)), s1 = __builtin_bit_cast(float, __builtin_amdgcn_readlane(__builtin_bit_cast(int, c1b), k)); a0 += w * s0; a1 += w * s1; }
        float* pp = part + (((size_t)l * NKC + kc) * BATCH) * MODW + nch * 256 + 4 * lane;
        *(f32x4*)pp = a0; *(f32x4*)(pp + MODW) = a1;
    }
}
__device__ __forceinline__ void tail_convert_ffn(Frame& F, int ln, int first, int nidle) {
    PHASE_IDS();
    if ((int)blockIdx.x < first) return;
    LAS float* scr = (LAS float*)(F.lds + RING_OFF + wave * 16384);
    constexpr int I_UP = (DM / 64) * (UPW / 32), I_DOWN = (DFF / 64) * (DM / 32);
    bf16* wup = (bf16*)(F.ws + WS_WUP) + (size_t)ln * UPW * DM; bf16* wdown = (bf16*)(F.ws + WS_WDOWN) + (size_t)ln * DM * DFF;
    for (int it = ((int)blockIdx.x - first) * NWAVES + wave; it < I_UP + I_DOWN; it += nidle * NWAVES) {
        if (it < I_UP) transpose_item(F.w_up + (size_t)ln * DM * UPW, DM, UPW, wup, scr, it, lane, 1);
        else transpose_item(F.w_down + (size_t)ln * DFF * DM, DFF, DM, wdown, scr, it - I_UP, lane);
    }
}
__device__ __forceinline__ void p0b_modreduce(Frame& F) {
    PHASE_IDS();
    const float* part = (const float*)(F.ws + WS_PART); float* mod = (float*)(F.ws + WS_MOD);
    for (int i = blockIdx.x * (NWAVES * 64) + tid; i < DEPTH * BATCH * MODW; i += F.G * NWAVES * 64) {
        const int n = i % MODW, b = (i / MODW) % BATCH, l = i / (MODW * BATCH);
        float s = F.ada_b[l * MODW + n];
#pragma unroll
        for (int kc = 0; kc < 16; ++kc) s += part[(((size_t)l * 16 + kc) * BATCH + b) * MODW + n];
        mod[i] = s;
    }
}
__device__ __forceinline__ void rows_pre(Frame& F, const float* x, const float* ng, const float* scale, const float* shift, bf16* H) {
    PHASE_IDS();
    for (int m = gw; m < M; m += F.NGW) {
        const int b = m / SEQ; f32x4 v[8]; float ss = 0.f;
#pragma unroll
        for (int j = 0; j < 8; ++j) { v[j] = *(const f32x4*)(x + (size_t)m * DM + 4 * lane + 256 * j); ss += (v[j].x * v[j].x + v[j].y * v[j].y) + (v[j].z * v[j].z + v[j].w * v[j].w); }
        const float r = 1.f / sqrtf(wave_sum(ss) * (1.f / DM) + EPS);
#pragma unroll
        for (int j = 0; j < 8; ++j) { const int c = 4 * lane + 256 * j;
            const f32x4 g = *(const f32x4*)(ng + c), sc = *(const f32x4*)(scale + (size_t)b * MODW + c), sh = *(const f32x4*)(shift + (size_t)b * MODW + c);
            const f32x4 h = (v[j] * r) * g * (sc + 1.f) + sh;
            v2u o; o.x = pk2(h.x, h.y); o.y = pk2(h.z, h.w); *(v2u*)(H + (size_t)m * DM + c) = o; }
    }
}
__device__ __forceinline__ void rows_post(Frame& F, const bf16* Y, const float* xs, float* xd, const float* gate, const float* nga,
                                          const float* ngb, const float* scale, const float* shift, bf16* H, bool doH) {
    PHASE_IDS();
    for (int m0 = gw; m0 < M; m0 += 2 * F.NGW) {
        const int m1 = m0 + F.NGW;
        const bool two = m1 < M; const int mm[2] = {m0, two ? m1 : m0};
        v2u yw[2][8]; f32x4 xv[2][8];
#pragma unroll
        for (int q = 0; q < 2; ++q)
#pragma unroll
            for (int j = 0; j < 8; ++j) { yw[q][j] = *(const v2u*)(Y + (size_t)mm[q] * DM + 4 * lane + 256 * j); xv[q][j] = *(const f32x4*)(xs + (size_t)mm[q] * DM + 4 * lane + 256 * j); }
        f32x4 v[2][8]; float ss[2] = {0.f, 0.f};
#pragma unroll
        for (int q = 0; q < 2; ++q)
#pragma unroll
            for (int j = 0; j < 8; ++j) { v[q][j] = (f32x4){bf_lo(yw[q][j].x), bf_hi(yw[q][j].x), bf_lo(yw[q][j].y), bf_hi(yw[q][j].y)};
                ss[q] += (v[q][j].x * v[q][j].x + v[q][j].y * v[q][j].y) + (v[q][j].z * v[q][j].z + v[q][j].w * v[q][j].w); }
        float r[2], ss2[2] = {0.f, 0.f};
#pragma unroll
        for (int q = 0; q < 2; ++q) r[q] = 1.f / sqrtf(wave_sum(ss[q]) * (1.f / DM) + EPS);
#pragma unroll
        for (int q = 0; q < 2; ++q) { const int b = mm[q] / SEQ;
#pragma unroll
            for (int j = 0; j < 8; ++j) { const int c = 4 * lane + 256 * j;
                const f32x4 g = *(const f32x4*)(gate + (size_t)b * MODW + c), na = *(const f32x4*)(nga + c);
                v[q][j] = xv[q][j] + g * ((v[q][j] * r[q]) * na);
                ss2[q] += (v[q][j].x * v[q][j].x + v[q][j].y * v[q][j].y) + (v[q][j].z * v[q][j].z + v[q][j].w * v[q][j].w);
                if (q == 0 || two) *(f32x4*)(xd + (size_t)mm[q] * DM + c) = v[q][j]; } }
        if (doH) {
#pragma unroll
            for (int q = 0; q < 2; ++q) { const int b = mm[q] / SEQ; const float r2 = 1.f / sqrtf(wave_sum(ss2[q]) * (1.f / DM) + EPS);
#pragma unroll
                for (int j = 0; j < 8; ++j) { const int c = 4 * lane + 256 * j;
                    const f32x4 g = *(const f32x4*)(ngb + c), sc = *(const f32x4*)(scale + (size_t)b * MODW + c), sh = *(const f32x4*)(shift + (size_t)b * MODW + c);
                    const f32x4 h = (v[q][j] * r2) * g * (sc + 1.f) + sh;
                    v2u o; o.x = pk2(h.x, h.y); o.y = pk2(h.z, h.w); if (q == 0 || two) *(v2u*)(H + (size_t)mm[q] * DM + c) = o; } }
        }
    }
}
__device__ __forceinline__ void rows_subln(Frame& F, const float* A0, const float* A1, const float* lamp, const float* sg, float lambda_init, bf16* O) {
    PHASE_IDS();
    const float l0 = lamp[lane] * lamp[128 + lane] + lamp[64 + lane] * lamp[128 + 64 + lane];
    const float l1 = lamp[256 + lane] * lamp[384 + lane] + lamp[256 + 64 + lane] * lamp[384 + 64 + lane];
    const float lam = __expf(wave_sum(l0)) - __expf(wave_sum(l1)) + lambda_init;
    const f32x4 g = *(const f32x4*)(sg + 4 * lane) * (1.f - lambda_init);
    for (int m = gw; m < M; m += F.NGW) {
#pragma unroll
        for (int j = 0; j < 8; ++j) { const size_t off = (size_t)m * DM + 4 * lane + 256 * j;
            const f32x4 d = *(const f32x4*)(A0 + off) - *(const f32x4*)(A1 + off) * lam;
            const float ss = wave_sum((d.x * d.x + d.y * d.y) + (d.z * d.z + d.w * d.w));
            const float r = 1.f / sqrtf(ss * (1.f / 256.f) + EPS);
            const f32x4 h = (d * r) * g;
            v2u o; o.x = pk2(h.x, h.y); o.y = pk2(h.z, h.w); *(v2u*)(O + off) = o; }
    }
}
__device__ __forceinline__ void rows_bmerge(Frame& F, const float* OB, const float* LSE, bf16* O) {
    PHASE_IDS();
    for (int m = gw; m < M; m += F.NGW) {
        const int hb = lane >> 4;
        const float e0 = LSE[(size_t)m * 4 + hb], e1 = LSE[((size_t)M + m) * 4 + hb], e2 = LSE[((size_t)2 * M + m) * 4 + hb];
        const float mx = fmaxf(e0, fmaxf(e1, e2));
        float w0 = __expf(e0 - mx), w1 = __expf(e1 - mx), w2 = __expf(e2 - mx); const float inv = 1.f / (w0 + w1 + w2); w0 *= inv; w1 *= inv; w2 *= inv;
        const float* p = OB + (size_t)m * 512 + 8 * lane;
        const f32x4 a0 = *(const f32x4*)p, a1 = *(const f32x4*)(p + 4);
        const f32x4 b0 = *(const f32x4*)(p + (size_t)M * 512), b1 = *(const f32x4*)(p + (size_t)M * 512 + 4);
        const f32x4 c0 = *(const f32x4*)(p + (size_t)2 * M * 512), c1 = *(const f32x4*)(p + (size_t)2 * M * 512 + 4);
        const f32x4 r0 = a0 * w0 + b0 * w1 + c0 * w2, r1 = a1 * w0 + b1 * w1 + c1 * w2;
        v4u o; o.x = pk2(r0.x, r0.y); o.y = pk2(r0.z, r0.w); o.z = pk2(r1.x, r1.y); o.w = pk2(r1.z, r1.w);
        *(v4u*)(O + (size_t)m * AB_OUT + 512 + 8 * lane) = o;
    }
}
__device__ __forceinline__ float gelu_tanh(float v) {
    const float u = 0.7978845608028654f * (v + 0.044715f * v * v * v);
    const float e = __expf(2.f * u);
    const float t = 1.f - 2.f / (e + 1.f);
    return 0.5f * v * (1.f + t);
}
__device__ __forceinline__ void actfix_panel(Frame& F, int pm, const float* cw, const float* cb, bf16* ACT) {
    PHASE_IDS();
    const float* HG = (const float*)(F.ws + WS_HG); const float* HU = (const float*)(F.ws + WS_HU);
    constexpr int NC4 = DFF / 4;
    for (int it = tid; it < 2 * NC4; it += NWAVES * 64) {
        const int c = (it % NC4) * 4, side = it / NC4;
        const f32x4 z = {0.f, 0.f, 0.f, 0.f}; f32x4 gp, gc, gn, up; size_t row;
        if (side == 0) { gp = (pm % (SEQ / 256) == 0) ? z : *(const f32x4*)(HG + ((size_t)(pm - 1) * 4 + 3) * DFF + c); gc = *(const f32x4*)(HG + ((size_t)pm * 4 + 0) * DFF + c);
            gn = *(const f32x4*)(HG + ((size_t)pm * 4 + 1) * DFF + c); up = *(const f32x4*)(HU + ((size_t)pm * 2 + 0) * DFF + c); row = (size_t)pm * 256; }
        else { gp = *(const f32x4*)(HG + ((size_t)pm * 4 + 2) * DFF + c); gc = *(const f32x4*)(HG + ((size_t)pm * 4 + 3) * DFF + c);
            gn = (pm % (SEQ / 256) == SEQ / 256 - 1) ? z : *(const f32x4*)(HG + ((size_t)(pm + 1) * 4 + 0) * DFF + c); up = *(const f32x4*)(HU + ((size_t)pm * 2 + 1) * DFF + c); row = (size_t)pm * 256 + 255; }
        const f32x4 w0 = *(const f32x4*)(cw + c), w1 = *(const f32x4*)(cw + DFF + c), w2 = *(const f32x4*)(cw + 2 * DFF + c), bb = *(const f32x4*)(cb + c);
        float r[4];
#pragma unroll
        for (int i = 0; i < 4; ++i) r[i] = pg8::gelu_tanh_mul(fmaf(w0[i], gp[i], fmaf(w1[i], gc[i], fmaf(w2[i], gn[i], bb[i]))), up[i]);
        v2u o; o.x = pk2(r[0], r[1]); o.y = pk2(r[2], r[3]); *(v2u*)(ACT + row * DFF + c) = o;
    }
    asm volatile("s_waitcnt vmcnt(0)" ::: "memory"); __syncthreads();
}
__device__ __forceinline__ float alibi16(int i) { return exp2f(-0.5f * (float)(i + 1)); }
__device__ __forceinline__ void phase_attn_ab(Frame& F, int jl) {
    const bf16* P = (const bf16*)(F.ws + WS_PROJ); bf16* O = (bf16*)(F.ws + WS_O); float* OB = (float*)(F.ws + WS_ATT); float* LSE = (float*)(F.ws + WS_LSE);
    for (int u = blockIdx.x; u < 512; u += F.G) {
        att::UnitArgs a;
        if (u < 128) {
            const int qb = u % 16, qh = (u / 16) % 4, b = u / 64, q0 = qb * 256; const size_t row0 = (size_t)b * SEQ;
            a.Q = (const GAS bf16*)P + (row0 + q0) * AB_IN + qh * 128; a.ldq = AB_IN;
            a.K = (const GAS bf16*)P + row0 * AB_IN + 512 + (qh >> 1) * 128; a.V = (const GAS bf16*)P + row0 * AB_IN + 768 + (qh >> 1) * 128; a.ldk = AB_IN;
            a.q0 = q0; a.L = SEQ; a.kt0 = q0 / 64 - 2; a.nt = 8;
            a.nsl = -alibi16(qh) / att::SCALE; a.radius = 128.f; a.m_init = F.a_sink[jl * 4 + qh] / att::SCALE; a.l_init = 1.f;
            a.Of = nullptr; a.Ob = (GAS bf16*)O + (row0 + q0) * AB_OUT + qh * 128; a.ldo = AB_OUT; a.lse = nullptr; a.ldl = 0;
        } else {
            const int v = (u - 128) % 128, gi = (u - 128) / 128, dil = gi == 0 ? 1 : (gi == 1 ? 4 : 16), L = SEQ / dil;
            int qb, r, hb, b;
            if (gi == 0) { qb = v % 16; r = 0; hb = (v / 16) % 4; b = v / 64; }
            else if (gi == 1) { qb = v % 4; r = (v / 4) % 4; hb = (v / 16) % 4; b = v / 64; }
            else { qb = 0; r = v % 16; hb = (v / 16) % 4; b = v / 64; }
            const int q0 = qb * 256; const size_t seq0 = (size_t)b * SEQ + r, rowq = seq0 + (size_t)dil * q0;
            a.Q = (const GAS bf16*)P + rowq * AB_IN + 1024 + gi * 512 + hb * 128; a.ldq = (long)dil * AB_IN;
            a.K = (const GAS bf16*)P + seq0 * AB_IN + 2560 + hb * 128; a.V = (const GAS bf16*)P + seq0 * AB_IN + 3072 + hb * 128; a.ldk = (long)dil * AB_IN;
            a.q0 = q0; a.L = L; a.kt0 = q0 / 64 - 1; a.nt = 6;
            a.nsl = -alibi16(4 + gi * 4 + hb) * (float)dil / att::SCALE; a.radius = 64.f; a.m_init = att::M_INIT; a.l_init = 0.f;
            a.Of = (GAS float*)OB + ((size_t)gi * M + rowq) * 512 + hb * 128; a.Ob = nullptr; a.ldo = (long)dil * 512;
            a.lse = (GAS float*)LSE + ((size_t)gi * M + rowq) * 4 + hb; a.ldl = (long)dil * 4;
        }
        att::attn_unit<true, 1>(a, F.ldsg + RING_OFF, F.wave);
    }
}
__device__ __forceinline__ void phase_cnorm(Frame& F) {
    PHASE_IDS();
    const bf16* P = (const bf16*)(F.ws + WS_PROJ); float* NRM = (float*)(F.ws + WS_NRM);
    for (int it = gw; it < 2048; it += F.NGW) {
        const int tile = it & 63, j = (it >> 6) & 1, h = (it >> 7) & 7, b = (it >> 10) & 1;
        const bf16* base = P + ((size_t)b * SEQ + 64 * tile + (lane >> 4)) * C_IN + h * 256 + j * 128 + (lane & 15) * 8;
        float mq = 0.f, mk = 0.f, ms = 3.0e38f;
#pragma unroll 4
        for (int i = 0; i < 16; ++i) {
            const v4u wq = *(const v4u*)(base + (size_t)(4 * i) * C_IN), wk = *(const v4u*)(base + (size_t)(4 * i) * C_IN + 2048);
            float sq = 0.f, sk = 0.f, dt = 0.f;
#pragma unroll
            for (int q = 0; q < 4; ++q) { const float a = bf_lo(wq[q]), c = bf_hi(wq[q]), e = bf_lo(wk[q]), g = bf_hi(wk[q]); sq += a * a + c * c; sk += e * e + g * g; dt += a * e + c * g; }
            sq = row16_sum(sq); sk = row16_sum(sk); dt = row16_sum(dt);
            mq = fmaxf(mq, sq); mk = fmaxf(mk, sk); ms = fminf(ms, dt);
        }
#define X32_(op, x) do { auto rr_ = __builtin_amdgcn_permlane32_swap(__builtin_bit_cast(unsigned, x), __builtin_bit_cast(unsigned, x), false, false); x = op(__builtin_bit_cast(float, rr_[0]), __builtin_bit_cast(float, rr_[1])); } while (0)
        mq = fmaxf(mq, swz_xor16(mq)); X32_(fmaxf, mq); mk = fmaxf(mk, swz_xor16(mk)); X32_(fmaxf, mk); ms = fminf(ms, swz_xor16(ms)); X32_(fminf, ms);
#undef X32_
        if (lane == 0) { NRM[it] = sqrtf(mq); NRM[2048 + it] = sqrtf(mk); NRM[4096 + it] = att::SCALE * ms; }
    }
}
__device__ __forceinline__ void phase_attn_c(Frame& F, gu32* ctr) {
    PHASE_IDS();
    const bf16* P = (const bf16*)(F.ws + WS_PROJ); float* AT = (float*)(F.ws + WS_ATT); const float* NRM = (const float*)(F.ws + WS_NRM);
    volatile LAS unsigned* slot = (volatile LAS unsigned*)(F.lds + MISC_OFF) + 16;
    for (;;) {
        if (tid == 0) *slot = __hip_atomic_fetch_add(ctr, 1u, __ATOMIC_RELAXED, __HIP_MEMORY_SCOPE_AGENT);
        __syncthreads();
        const int i = __builtin_amdgcn_readfirstlane((int)*slot);
        __syncthreads();
        if (i >= 1024) break;
        const int h = 7 - (i >> 7), qb = i & 31, j = (i >> 5) & 1, b = (i >> 6) & 1, q0 = qb * 128; const size_t row0 = (size_t)b * SEQ;
        const float slope = exp2f(-(float)(h + 1));
        const float* QN = NRM + ((b * 8 + h) * 2 + j) * 64; const float* KN = QN + 2048; const float* SS = QN + 4096;
        const float qn = fmaxf(QN[2 * qb], QN[2 * qb + 1]);
        const float smin = fminf(SS[2 * qb], SS[2 * qb + 1]) - 0.05f;
        const int klo = 64 * lane, d1 = klo - (q0 + 127), d2 = q0 - (klo + 63), dmin = d1 > 0 ? d1 : (d2 > 0 ? d2 : 0);
        const float bound = att::SCALE * 1.02f * qn * KN[lane] - slope * (float)dmin;
        const unsigned long long need = __ballot((bound - smin > -25.f) || (dmin == 0));
        const int t_lo = (int)__builtin_ctzll(need), t_hi = 64 - (int)__builtin_clzll(need);
        att::PairArgs a;
        a.Q = (const GAS bf16*)P + (row0 + q0) * C_IN + h * 256 + j * 128; a.ldq = C_IN;
        a.K = (const GAS bf16*)P + row0 * C_IN + 2048 + h * 256 + j * 128; a.V = (const GAS bf16*)P + row0 * C_IN + 4096 + h * 256; a.ldk = C_IN;
        a.q0 = q0; a.kt0 = t_lo; a.nt = t_hi - t_lo; a.nsl = -slope / att::SCALE;
        a.O = (GAS float*)AT + ((size_t)j * M + row0 + q0) * DM + h * 256; a.ldo = DM;
        att::attn_split_unit(a, F.ldsg + RING_OFF, (float*)(F.ldsg + BND_OFF), F.wave);
    }
}

#ifndef ENC_DUP
#define ENC_DUP 0
#endif
#define DUP(bit) for (int rep_ = 0; rep_ < (((ENC_DUP) & (bit)) ? 2 : 1); ++rep_)
constexpr int CW_QUEUE = 8192;
struct Args { const float* in[16]; float* out; unsigned char* ws; };
__global__ void __launch_bounds__(NWAVES * 64, 2) enc_fwd(Args args) {
    extern __shared__ __attribute__((aligned(16))) unsigned char lds[];
    Frame F;
    F.lds = (LAS unsigned char*)lds; F.ldsg = (char*)lds;
    F.wave = __builtin_amdgcn_readfirstlane((int)threadIdx.x >> 6);
    F.G = gridDim.x; F.gw = blockIdx.x * NWAVES + F.wave; F.NGW = F.G * NWAVES;
    F.x = args.in[0]; F.c = args.in[1]; F.ada_w = args.in[2]; F.ada_b = args.in[3]; F.norm_g = args.in[4]; F.ab_w_in = args.in[5]; F.ab_w_out = args.in[6]; F.a_sink = args.in[7];
    F.c_w_in = args.in[8]; F.c_w_out = args.in[9]; F.c_lambda = args.in[10]; F.c_subln_g = args.in[11]; F.w_up = args.in[12]; F.conv_w = args.in[13]; F.conv_b = args.in[14]; F.w_down = args.in[15];
    F.out = args.out; F.ws = args.ws;
    gu32* ctl = (gu32*)(F.ws + WS_CTL);
    for (int u = (int)threadIdx.x; u < (LDS_BYTES - LDSCTL_OFF) / 4; u += NWAVES * 64) ((LAS unsigned*)(F.lds + LDSCTL_OFF))[u] = 0u;
    __syncthreads();
    (void)xcd_barrier_post((unsigned*)(ctl + CW_BAR), (volatile LAS unsigned*)(F.lds + MISC_OFF) + 8);
#if ENC_PROBE
#define PH(k) do { const long long n_ = __builtin_readcyclecounter(); if (blockIdx.x == 0 && F.wave == 0 && lane_now() == 0) ((volatile long long*)(F.ldsg + BND_OFF - 512))[16 + (k)] += n_ - ph_t_; ph_t_ = n_; } while (0)
#define PHSET(k) ph_cur_ = (k)
    long long ph_t_ = __builtin_readcyclecounter(); int ph_cur_ = 0;
#else
#define PH(k) do {} while (0)
#define PHSET(k) do {} while (0)
#endif
#define GB() do { PH(ph_cur_); unsigned char* wsb_ = args.ws; asm volatile("" : "+s"(wsb_)); XcdBarrier bar_; bar_.bar = (unsigned*)(wsb_ + WS_CTL) + CW_BAR; bar_.x = xb_xcc_id(); \
        bar_.st = (volatile LAS unsigned*)(F.lds + MISC_OFF) + 8; bar_.tid = F.wave * 64 + lane_now(); xcd_barrier(bar_); PH(12); } while (0)
    float* mod = (float*)(F.ws + WS_MOD);
    bf16* H = (bf16*)(F.ws + WS_H); bf16* PROJ = (bf16*)(F.ws + WS_PROJ); bf16* O = (bf16*)(F.ws + WS_O); bf16* Y = (bf16*)(F.ws + WS_Y);
    bf16* ACT = (bf16*)(F.ws + WS_ACT); float* AT = (float*)(F.ws + WS_ATT);

    PHSET(0); DUP(1) p0a_prologue(F);
    GB();
    PHSET(1); p0b_modreduce(F);
    GB();
    rows_pre(F, F.x, F.norm_g, mod + 1 * DM, mod + 0 * DM, H);
    GB();

    for (int s = 0; s < 8; ++s) {
        const int l = s >> 1, sub = s & 1, jl = l >> 1, even = !(l & 1);
        const float* modl = mod + (size_t)l * BATCH * MODW;
        PHSET(sub == 0 ? 2 : 10);
        if (sub == 0) {
            pg8::Gemm g; int N;
            if (even) { N = AB_IN; g.Bt = (const bf16*)(F.ws + WS_WABIN) + (size_t)jl * AB_IN * DM; } else { N = C_IN; g.Bt = (const bf16*)(F.ws + WS_WCIN) + (size_t)jl * C_IN * DM; }
            g.A = H; g.M = M; g.N = N; g.K = DM;
            pg8::StaticOrder S; S.init(M, N, F.G, (int)blockIdx.x);
            pg8::EpiBf16<0> E{PROJ, N, nullptr, 0, 0, 1.f};
            DUP(4) pg8::gemm_phase<pg8::EpiBf16<0>, pg8::StaticOrder, true, true>(F.lds + RING_OFF, g, S, E, F.wave);
        } else {
            pg8::Gemm g; g.A = H; g.Bt = (const bf16*)(F.ws + WS_WUP) + (size_t)l * UPW * DM; g.M = M; g.N = UPW; g.K = DM;
            pg8::StaticOrder S; S.init(M, UPW, F.G, (int)blockIdx.x);
            pg8::EpiAct E{ACT, DFF, F.conv_w + (size_t)l * 3 * DFF, F.conv_b + (size_t)l * DFF, (float*)(F.ws + WS_HG), (float*)(F.ws + WS_HU), (LAS float*)(F.lds + BND_OFF)};
            DUP(4) pg8::gemm_phase<pg8::EpiAct, pg8::StaticOrder, true, true>(F.lds + RING_OFF, g, S, E, F.wave);
            constexpr int NU = (M / 256) * (UPW / 256), NFULL = NU % 256;
            if (F.G == 256 && l + 1 < DEPTH) tail_convert_ffn(F, l + 1, NFULL, 256 - NFULL);
        }
        GB();
        if (sub == 0) {
            if (even) { PHSET(3); DUP(16) phase_attn_ab(F, jl); GB(); PHSET(4); rows_bmerge(F, AT, (const float*)(F.ws + WS_LSE), O); }
            else { PHSET(5); phase_cnorm(F); GB(); PHSET(6); phase_attn_c(F, ctl + CW_QUEUE + 64 * jl); GB();
                PHSET(7); rows_subln(F, AT, AT + (size_t)M * DM, F.c_lambda + (size_t)jl * 4 * 128, F.c_subln_g + (size_t)jl * 256, 0.8f - 0.6f * __expf(-0.3f * (float)l), O); }
            GB();
        }
        PHSET(sub == 0 ? 8 : 11);
        {
            pg8::Gemm g; int K;
            if (sub == 0) { if (even) { K = AB_OUT; g.Bt = (const bf16*)(F.ws + WS_WABOUT) + (size_t)jl * DM * AB_OUT; } else { K = DM; g.Bt = (const bf16*)(F.ws + WS_WCOUT) + (size_t)jl * DM * DM; } g.A = O; }
            else { K = DFF; g.Bt = (const bf16*)(F.ws + WS_WDOWN) + (size_t)l * DM * DFF; g.A = ACT; }
            g.M = M; g.N = DM; g.K = K;
            pg8::StaticOrder S; S.init(M, DM, F.G, (int)blockIdx.x);
            if (sub == 1) { pg8::Unit u0; if (S.next(0, u0)) actfix_panel(F, u0.pm, F.conv_w + (size_t)l * 3 * DFF, F.conv_b + (size_t)l * DFF, ACT); }
            const float* xs = (s == 0) ? F.x : F.out;
            const int ln = (sub == 1 && l + 1 < DEPTH) ? l + 1 : l; const float* modn = mod + (size_t)ln * BATCH * MODW;
            const float* gate = modl + (sub == 0 ? 2 : 5) * DM; const float* nga = F.norm_g + ((size_t)l * 4 + (sub == 0 ? 1 : 3)) * DM;
            const float* ngb = (sub == 0) ? F.norm_g + ((size_t)l * 4 + 2) * DM : F.norm_g + ((size_t)ln * 4 + 0) * DM;
            const float* scl = (sub == 0) ? modl + 4 * DM : modn + 1 * DM; const float* shf = (sub == 0) ? modl + 3 * DM : modn + 0 * DM;
            const bool doH = (sub == 0) || (l + 1 < DEPTH);
            if (F.G == 256) {
                float* xch = (float*)(F.ws + WS_XCH) + (size_t)s * 2 * (M / 256) * 8 * 256; unsigned* cnt = (unsigned*)(ctl + CW_CNT) + (size_t)s * 2 * (M / 256) * 64;
                pg8::EpiPost E{xs, F.out, doH ? H : nullptr, DM, gate, nga, ngb, scl, shf, MODW, SEQ, xch, xch + (M / 256) * 8 * 256, cnt, cnt + (M / 256) * 64, EPS};
                pg8::gemm_phase<pg8::EpiPost, pg8::StaticOrder, false, true>(F.lds + RING_OFF, g, S, E, F.wave);
            } else {
                pg8::EpiBf16<0> E{Y, DM, nullptr, 0, 0, 1.f};
                pg8::gemm_phase<pg8::EpiBf16<0>, pg8::StaticOrder, false, true>(F.lds + RING_OFF, g, S, E, F.wave);
                GB();
                rows_post(F, Y, xs, F.out, gate, nga, ngb, scl, shf, H, doH);
            }
        }
        if (s < 7) GB(); else PH(ph_cur_);
    }
#if ENC_PROBE
    if (blockIdx.x == 0 && F.wave == 0 && lane_now() == 0) {
        const long long tot_ = ((volatile long long*)(F.ldsg + BND_OFF - 512))[(ENC_PROBE) - 1]; const long long s_ = __builtin_readcyclecounter(); const long long cap_ = tot_ < 20000000ll ? tot_ : 20000000ll;
        while (__builtin_readcyclecounter() - s_ < cap_) __builtin_amdgcn_s_sleep(8); }
#endif
#undef GB
}

extern "C" void kernel_launch(void* const* d_in, const int* in_sizes, int n_in, void* d_out, int out_size, void* d_ws, size_t ws_size, hipStream_t stream) {
    static int grid = 0;
    if (grid == 0) {
        if (n_in != 16 || in_sizes[0] != M * DM || out_size != M * DM || ws_size < WS_END) { fprintf(stderr, "kernel_launch: unexpected shapes (n_in %d, in0 %d, out %d, ws %zu < %zu)\n", n_in, n_in > 0 ? in_sizes[0] : -1, out_size, ws_size, (size_t)WS_END); grid = -1; return; }
        int dev = 0, cus = 0, per_cu = 0;
        if (hipGetDevice(&dev) != hipSuccess || hipDeviceGetAttribute(&cus, hipDeviceAttributeMultiprocessorCount, dev) != hipSuccess) { grid = -1; return; }
        if (hipFuncSetAttribute((const void*)enc_fwd, hipFuncAttributeMaxDynamicSharedMemorySize, LDS_BYTES) != hipSuccess) { fprintf(stderr, "kernel_launch: hipFuncSetAttribute failed\n"); grid = -1; return; }
        if (hipOccupancyMaxActiveBlocksPerMultiprocessor(&per_cu, (const void*)enc_fwd, NWAVES * 64, LDS_BYTES) != hipSuccess || per_cu < 1) { fprintf(stderr, "kernel_launch: occupancy query says %d\n", per_cu); }
        (void)hipGetLastError();
        grid = cus;
    }
    if (grid < 0) return;
    (void)hipMemsetAsync((char*)d_ws + WS_CTL, 0, CTL_ZERO_BYTES, stream);
    Args a{};
    for (int i = 0; i < 16; ++i) a.in[i] = (const float*)d_in[i];
    a.out = (float*)d_out; a.ws = (unsigned char*)d_ws;
    hipLaunchKernelGGL(enc_fwd, dim3(grid), dim3(NWAVES * 64), LDS_BYTES, stream, a);
}
```

```cpp
#include <hip/hip_runtime.h>
#include <cstdio>
#include <cstdint>
#define ENC_PROBE 0
__device__ __forceinline__ int lane_now() { int l; asm volatile("v_mbcnt_lo_u32_b32 %0, -1, 0\n\tv_mbcnt_hi_u32_b32 %0, -1, %0" : "=v"(l)); return l; }
__device__ __forceinline__ float swz_xor16(float x) { return __builtin_bit_cast(float, __builtin_amdgcn_ds_swizzle(__builtin_bit_cast(int, x), 0x401F)); }
__device__ __forceinline__ float sum_xor32(float x) { return x + __builtin_bit_cast(float, __builtin_amdgcn_ds_bpermute((lane_now() ^ 32) << 2, __builtin_bit_cast(int, x))); }
namespace pg8 {
#define PG8_LAS __attribute__((address_space(3)))
typedef unsigned short bf16_t;
typedef short bf16x8 __attribute__((ext_vector_type(8)));
typedef float f32x4 __attribute__((ext_vector_type(4)));
typedef unsigned u32x4 __attribute__((ext_vector_type(4)));
constexpr int BM = 256, BK = 64, HALF = 128, HTB = HALF * BK * 2  , STAGE_BYTES = 8 * HTB, NXCD = 8, WGM = 8;

__host__ __device__ __forceinline__ int lds_byte(int r, int c) { const int st = (r >> 4) * 2 + (c >> 5), rr = r & 15, cc = c & 31, ob = rr * 64 + cc * 2; return st * 1024 + (ob ^ (((ob >> 9) & 1) << 5)); }
__host__ __device__ __forceinline__ void stage_rc(int b, int& R, int& C) { const int st = b / 1024, sb = b % 1024, swz = sb ^ (((sb >> 9) & 1) << 5); R = (st >> 1) * 16 + swz / 64; C = (st & 1) * 32 + (swz % 64) / 2; }
__host__ __device__ __forceinline__ int perm32(int rho) { const int n = rho >> 4, i = rho & 15; return 8 * (i >> 2) + 4 * n + (i & 3); }

struct Unit { int pm, pn; };
struct Gemm { const bf16_t* A; const bf16_t* Bt; int M, N, K; };

struct StaticOrder {
    int nM, nN, nwg, G, c;
    __host__ __device__ void init(int M, int N, int G_, int c_) { nM = M / BM; nN = N / BM; nwg = nM * nN; G = G_; c = c_; }
    __host__ __device__ bool next(int i, Unit& u) const {
        const long L = (long)i * G + c; if (L >= nwg) return false;
        int wgid = (int)L; { const int q = nwg / NXCD, r = nwg % NXCD, xcd = wgid % NXCD, off = wgid / NXCD; wgid = (xcd < r ? xcd * (q + 1) : r * (q + 1) + (xcd - r) * q) + off; }
        const int nig = WGM * nN, gid = wgid / nig, fm = gid * WGM, gsz = (nM - fm) < WGM ? (nM - fm) : WGM;
        u.pm = fm + ((wgid % nig) % gsz); u.pn = (wgid % nig) / gsz; return true;
    }
    __device__ __forceinline__ void a_ready(const Unit&) const {}
    __device__ __forceinline__ void done(const Unit&) const {}
};

__device__ __forceinline__ unsigned cvt_pk_bf16(float lo, float hi) { unsigned r; asm volatile("v_cvt_pk_bf16_f32 %0, %1, %2" : "=v"(r) : "v"(lo), "v"(hi)); return r; }
typedef float f32x2 __attribute__((ext_vector_type(2)));
__device__ __forceinline__ f32x2 gelu_pk(f32x2 v) {
    const f32x2 av = __builtin_elementwise_abs(v), d = av * 0.2316418882f + 1.0f;
    f32x2 t; t.x = __builtin_amdgcn_rcpf(d.x); t.y = __builtin_amdgcn_rcpf(d.y);
    f32x2 q = t * 0.5307027145f + (-0.7265760135f); q = q * t + 0.7107068705f; q = q * t + (-0.142248368f); q = q * t + 0.127414796f; q = q * t;
    const f32x2 s = (v * v) * (-0.72134752044f);
    f32x2 e; e.x = __builtin_amdgcn_exp2f(s.x); e.y = __builtin_amdgcn_exp2f(s.y);
    const f32x2 m = v * (q * e), r = v - m;
    f32x2 o; o.x = v.x < 0.f ? m.x : r.x; o.y = v.y < 0.f ? m.y : r.y; return o;
}

template <int ACT  > struct EpiBf16 {
    static constexpr bool PERM = true, AFTER_DRAIN = false; static_assert(ACT == 0 || ACT == 1, "EpiBf16: ACT is 0 (none) or 1 (gelu_pk)");
    bf16_t* O; int ldc; const float* bias; int split_cols; size_t split_stride; float scale0;
    __device__ __forceinline__ void operator()(const f32x4 (&acc)[2][2][4][2], const Unit& u, int wr, int wc, int fr, int fq) const {
        const int row0 = u.pm * BM + wr * 64 + fr; int colt = u.pn * BM; bf16_t* base = O;
        float sc = 1.f; if (split_cols) { const int t = colt / split_cols; base += (size_t)t * split_stride; colt -= t * split_cols; if (t == 0) sc = scale0; }
        const int col0 = colt + wc * 32 + 8 * fq, bcol0 = u.pn * BM + wc * 32 + 8 * fq;
        f32x4 bv[2][2];
#pragma unroll
        for (int bj = 0; bj < 2; ++bj)
#pragma unroll
            for (int n = 0; n < 2; ++n) bv[bj][n] = bias ? *(const f32x4*)(bias + bcol0 + bj * HALF + 4 * n) : (f32x4){0.f, 0.f, 0.f, 0.f};
#pragma unroll
        for (int ai = 0; ai < 2; ++ai)
#pragma unroll
            for (int m = 0; m < 4; ++m) { bf16_t* rowp = base + (size_t)(row0 + ai * HALF + m * 16) * ldc + col0;
#pragma unroll
                for (int bj = 0; bj < 2; ++bj) { f32x4 v0 = acc[ai][bj][m][0] + bv[bj][0], v1 = acc[ai][bj][m][1] + bv[bj][1];
                    if (ACT == 1) { f32x2 a = gelu_pk((f32x2){v0[0], v0[1]}), b = gelu_pk((f32x2){v0[2], v0[3]}), c = gelu_pk((f32x2){v1[0], v1[1]}), d = gelu_pk((f32x2){v1[2], v1[3]});
                        v0 = (f32x4){a.x, a.y, b.x, b.y}; v1 = (f32x4){c.x, c.y, d.x, d.y}; }
                    v0 = v0 * sc; v1 = v1 * sc; u32x4 w; w.x = cvt_pk_bf16(v0[0], v0[1]); w.y = cvt_pk_bf16(v0[2], v0[3]); w.z = cvt_pk_bf16(v1[0], v1[1]); w.w = cvt_pk_bf16(v1[2], v1[3]);
                    *(u32x4*)(rowp + bj * HALF) = w; } }
    }
};
struct EpiF32 {
    static constexpr bool PERM = false, AFTER_DRAIN = false;
    float* C; int ldc; const float* bias;
    __device__ __forceinline__ void operator()(const f32x4 (&acc)[2][2][4][2], const Unit& u, int wr, int wc, int fr, int fq) const {
        const int row0 = u.pm * BM + wr * 64 + fr, col0 = u.pn * BM + wc * 32 + 4 * fq;
        f32x4 bv[2][2];
#pragma unroll
        for (int bj = 0; bj < 2; ++bj)
#pragma unroll
            for (int n = 0; n < 2; ++n) bv[bj][n] = bias ? *(const f32x4*)(bias + col0 + bj * HALF + n * 16) : (f32x4){0.f, 0.f, 0.f, 0.f};
#pragma unroll
        for (int ai = 0; ai < 2; ++ai)
#pragma unroll
            for (int m = 0; m < 4; ++m) { float* rowp = C + (size_t)(row0 + ai * HALF + m * 16) * ldc + col0;
#pragma unroll
                for (int bj = 0; bj < 2; ++bj)
#pragma unroll
                    for (int n = 0; n < 2; ++n) *(f32x4*)(rowp + bj * HALF + n * 16) = acc[ai][bj][m][n] + bv[bj][n]; }
    }
};

template <int CTRL> __device__ __forceinline__ float dpp_mov(float x) { return __builtin_bit_cast(float, __builtin_amdgcn_mov_dpp(__builtin_bit_cast(int, x), CTRL, 0xf, 0xf, true)); }
template <int CTRL> __device__ __forceinline__ float dpp_upd(float old, float x) { return __builtin_bit_cast(float, __builtin_amdgcn_update_dpp(__builtin_bit_cast(int, old), __builtin_bit_cast(int, x), CTRL, 0xf, 0xf, false)); }
__device__ __forceinline__ float gelu_tanh_mul(float v, float up) {
    const float e = __builtin_amdgcn_exp2f(v * fmaf(v * v, -0.10294324f, -2.3022082f));
    return v * up * __builtin_amdgcn_rcpf(1.f + e);
}
struct EpiAct {
    static constexpr bool PERM = true, AFTER_DRAIN = false;
    bf16_t* ACT; int dff; const float* cw; const float* cb; float* HG; float* HU; PG8_LAS float* bnd;
    __device__ __forceinline__ void operator()(const f32x4 (&acc)[2][2][4][2], const Unit& u, int wr, int wc, int fr, int fq) const {
        const int chl = wc * 32 + 8 * fq, ch = u.pn * 128 + chl;
        if (fr == 0) {
#pragma unroll
            for (int ai = 0; ai < 2; ++ai) { PG8_LAS float* p = bnd + ((2 * ai + wr) * 2 + 0) * 128 + chl; *(PG8_LAS f32x4*)p = acc[ai][0][0][0]; *(PG8_LAS f32x4*)(p + 4) = acc[ai][0][0][1]; } }
        if (fr == 15) {
#pragma unroll
            for (int ai = 0; ai < 2; ++ai) { PG8_LAS float* p = bnd + ((2 * ai + wr) * 2 + 1) * 128 + chl; *(PG8_LAS f32x4*)p = acc[ai][0][3][0]; *(PG8_LAS f32x4*)(p + 4) = acc[ai][0][3][1]; } }
        if (wr == 0 && fr <= 1) { float* p = HG + ((size_t)u.pm * 4 + fr) * dff + ch; *(f32x4*)p = acc[0][0][0][0]; *(f32x4*)(p + 4) = acc[0][0][0][1];
            if (fr == 0) { float* q = HU + ((size_t)u.pm * 2 + 0) * dff + ch; *(f32x4*)q = acc[0][1][0][0]; *(f32x4*)(q + 4) = acc[0][1][0][1]; } }
        if (wr == 1 && fr >= 14) { float* p = HG + ((size_t)u.pm * 4 + 2 + (fr - 14)) * dff + ch; *(f32x4*)p = acc[1][0][3][0]; *(f32x4*)(p + 4) = acc[1][0][3][1];
            if (fr == 15) { float* q = HU + ((size_t)u.pm * 2 + 1) * dff + ch; *(f32x4*)q = acc[1][1][3][0]; *(f32x4*)(q + 4) = acc[1][1][3][1]; } }
        f32x4 w0[2], w1[2], w2[2], bb[2];
#pragma unroll
        for (int n = 0; n < 2; ++n) { w0[n] = *(const f32x4*)(cw + ch + 4 * n); w1[n] = *(const f32x4*)(cw + dff + ch + 4 * n); w2[n] = *(const f32x4*)(cw + 2 * dff + ch + 4 * n); bb[n] = *(const f32x4*)(cb + ch + 4 * n); }
        asm volatile("s_waitcnt lgkmcnt(0)" ::: "memory"); __builtin_amdgcn_s_barrier(); asm volatile("" ::: "memory");
        f32x4 bp[2][2], bn[2][2];
#pragma unroll
        for (int ai = 0; ai < 2; ++ai) { const int c = 2 * ai + wr;
#pragma unroll
            for (int n = 0; n < 2; ++n) {
                bp[ai][n] = c > 0 ? *(const PG8_LAS f32x4*)(bnd + ((c - 1) * 2 + 1) * 128 + chl + 4 * n) : (f32x4){0.f, 0.f, 0.f, 0.f};
                bn[ai][n] = c < 3 ? *(const PG8_LAS f32x4*)(bnd + ((c + 1) * 2 + 0) * 128 + chl + 4 * n) : (f32x4){0.f, 0.f, 0.f, 0.f}; } }
        const int row0 = u.pm * BM + wr * 64 + fr;
#pragma unroll
        for (int ai = 0; ai < 2; ++ai)
#pragma unroll
            for (int m = 0; m < 4; ++m) {
                unsigned pk[4];
#pragma unroll
                for (int n = 0; n < 2; ++n) { float r[4];
#pragma unroll
                    for (int i = 0; i < 4; ++i) {
                        const float g = acc[ai][0][m][n][i];
                        const float oldp = (m == 0) ? bp[ai][n][i] : dpp_mov<0x121>(acc[ai][0][m == 0 ? 0 : m - 1][n][i]);
                        const float gp = dpp_upd<0x111>(oldp, g);
                        const float oldn = (m == 3) ? bn[ai][n][i] : dpp_mov<0x12F>(acc[ai][0][m == 3 ? 3 : m + 1][n][i]);
                        const float gn = dpp_upd<0x101>(oldn, g);
                        const float a = fmaf(w0[n][i], gp, fmaf(w1[n][i], g, fmaf(w2[n][i], gn, bb[n][i])));
                        r[i] = gelu_tanh_mul(a, acc[ai][1][m][n][i]);
                    }
                    pk[2 * n] = cvt_pk_bf16(r[0], r[1]); pk[2 * n + 1] = cvt_pk_bf16(r[2], r[3]); }
                u32x4 w; w.x = pk[0]; w.y = pk[1]; w.z = pk[2]; w.w = pk[3];
                *(u32x4*)(ACT + (size_t)(row0 + ai * HALF + m * 16) * dff + ch) = w;
            }
    }
};

struct EpiPost {
    static constexpr bool PERM = true, AFTER_DRAIN = true;
    const float* xs; float* xd; bf16_t* H; int ldc;
    typedef _Float16 xh8 __attribute__((ext_vector_type(8)));
    const _Float16* xsb; _Float16* xdb;
    const float* gate; const float* nga; const float* ngb; const float* scale; const float* shift; int bstride, rows_per_batch;
    float* xch1; float* xch2; unsigned* cnt1; unsigned* cnt2; float eps;
    __device__ __forceinline__ void exchange(float* xch, unsigned* cnt, const Unit& u, PG8_LAS float* P, PG8_LAS float* R, int tid, int wid, int lane) const {
        asm volatile("s_waitcnt lgkmcnt(0)" ::: "memory"); __builtin_amdgcn_s_barrier(); asm volatile("" ::: "memory");
        if (tid < 256) { const float t = (P[tid * 4 + 0] + P[tid * 4 + 1]) + (P[tid * 4 + 2] + P[tid * 4 + 3]);
            __hip_atomic_store((unsigned*)xch + ((size_t)u.pm * 8 + u.pn) * 256 + tid, __builtin_bit_cast(unsigned, t), __ATOMIC_RELAXED, __HIP_MEMORY_SCOPE_AGENT); }
        if (wid < 4) { asm volatile("s_waitcnt vmcnt(0)" ::: "memory"); if (lane == 0) (void)__hip_atomic_fetch_add(cnt + 64 * u.pm, 1u, __ATOMIC_RELAXED, __HIP_MEMORY_SCOPE_AGENT); }
        if (wid == 0) { unsigned sp = 0; while ((unsigned)__builtin_amdgcn_readfirstlane((int)__hip_atomic_load(cnt + 64 * u.pm, __ATOMIC_RELAXED, __HIP_MEMORY_SCOPE_AGENT)) < 32u) { __builtin_amdgcn_s_sleep(2); if (++sp > (1u << 22)) break; } }
        asm volatile("s_waitcnt vmcnt(0) lgkmcnt(0)" ::: "memory"); __builtin_amdgcn_s_barrier(); asm volatile("" ::: "memory");
        if (tid < 256) { float tot = 0.f;
#pragma unroll
            for (int q = 0; q < 8; ++q) tot += __builtin_bit_cast(float, __hip_atomic_load((unsigned*)xch + ((size_t)u.pm * 8 + q) * 256 + tid, __ATOMIC_RELAXED, __HIP_MEMORY_SCOPE_AGENT));
            R[tid] = 1.f / sqrtf(tot * (1.f / 2048.f) + eps); }
        asm volatile("s_waitcnt lgkmcnt(0)" ::: "memory"); __builtin_amdgcn_s_barrier(); asm volatile("" ::: "memory");
    }
    __device__ __forceinline__ void fused(f32x4 (&acc)[2][2][4][2], const Unit& u, int wr, int wc, int fr, int fq, PG8_LAS unsigned char* lds, int wid, int lane) const {
        PG8_LAS float* P = (PG8_LAS float*)lds;
        PG8_LAS float* R1 = (PG8_LAS float*)(lds + 16384); PG8_LAS float* R2 = (PG8_LAS float*)(lds + 16384 + 1024);
        const int tid = wid * 64 + lane, b = (u.pm * BM) / rows_per_batch, col0 = u.pn * BM + wc * 32 + 8 * fq, rl0 = wr * 64 + fr;
        xh8 xp[2][4][2];
#pragma unroll
        for (int ai = 0; ai < 2; ++ai)
#pragma unroll
            for (int m = 0; m < 4; ++m) { const unsigned ro = (unsigned)((u.pm * BM + rl0 + ai * HALF + m * 16) * ldc);
#pragma unroll
                for (int bj = 0; bj < 2; ++bj) xp[ai][m][bj] = *(const xh8*)(xsb + ro + col0 + bj * HALF); }
        {
            f32x4 gm[2][2];
#pragma unroll
            for (int bj = 0; bj < 2; ++bj)
#pragma unroll
                for (int n = 0; n < 2; ++n) { const int c = col0 + bj * HALF + 4 * n; gm[bj][n] = *(const f32x4*)(gate + (size_t)b * bstride + c) * *(const f32x4*)(nga + c); }
#pragma unroll
            for (int ai = 0; ai < 2; ++ai)
#pragma unroll
                for (int m = 0; m < 4; ++m) { float sy = 0.f, sx = 0.f, sxt = 0.f, st = 0.f;
#pragma unroll
                    for (int bj = 0; bj < 2; ++bj) { const xh8 w = xp[ai][m][bj];
#pragma unroll
                        for (int n = 0; n < 2; ++n) { const f32x4 y = acc[ai][bj][m][n], t = gm[bj][n] * y;
                            const f32x4 x = {(float)w[4 * n + 0], (float)w[4 * n + 1], (float)w[4 * n + 2], (float)w[4 * n + 3]};
#pragma unroll
                            for (int i = 0; i < 4; ++i) { sy = fmaf(y[i], y[i], sy); sx = fmaf(x[i], x[i], sx); sxt = fmaf(x[i], t[i], sxt); st = fmaf(t[i], t[i], st); } } }
                    sy += swz_xor16(sy); sy = sum_xor32(sy); sx += swz_xor16(sx); sx = sum_xor32(sx); sxt += swz_xor16(sxt); sxt = sum_xor32(sxt); st += swz_xor16(st); st = sum_xor32(st);
                    if (fq == 0) { const int pi = (rl0 + ai * HALF + m * 16) * 4 + wc; P[pi] = sy; P[1024 + pi] = sx; P[2048 + pi] = sxt; P[3072 + pi] = st; } }
        }
        asm volatile("s_waitcnt lgkmcnt(0)" ::: "memory"); __builtin_amdgcn_s_barrier(); asm volatile("" ::: "memory");
        unsigned* xw = (unsigned*)xch1 + (size_t)u.pm * 8 * 256 + tid;
        if (tid < 256) {
#pragma unroll
            for (int k = 0; k < 4; ++k) { const float t = (P[k * 1024 + tid * 4 + 0] + P[k * 1024 + tid * 4 + 1]) + (P[k * 1024 + tid * 4 + 2] + P[k * 1024 + tid * 4 + 3]);
                __hip_atomic_store(xw + k * 65536 + u.pn * 256, __builtin_bit_cast(unsigned, t), __ATOMIC_RELAXED, __HIP_MEMORY_SCOPE_AGENT); } }
        if (wid < 4) { asm volatile("s_waitcnt vmcnt(0)" ::: "memory"); if (lane == 0) (void)__hip_atomic_fetch_add(cnt1 + 64 * u.pm, 1u, __ATOMIC_RELAXED, __HIP_MEMORY_SCOPE_AGENT); }
        if (wid == 0) { unsigned sp = 0; while ((unsigned)__builtin_amdgcn_readfirstlane((int)__hip_atomic_load(cnt1 + 64 * u.pm, __ATOMIC_RELAXED, __HIP_MEMORY_SCOPE_AGENT)) < 32u) { __builtin_amdgcn_s_sleep(2); if (++sp > (1u << 22)) break; } }
        asm volatile("s_waitcnt vmcnt(0) lgkmcnt(0)" ::: "memory"); __builtin_amdgcn_s_barrier(); asm volatile("" ::: "memory");
        if (tid < 256) { float tot[4];
#pragma unroll
            for (int k = 0; k < 4; ++k) { unsigned v[8];
#pragma unroll
                for (int q = 0; q < 8; ++q) v[q] = __hip_atomic_load(xw + k * 65536 + q * 256, __ATOMIC_RELAXED, __HIP_MEMORY_SCOPE_AGENT);
                float a = 0.f;
#pragma unroll
                for (int q = 0; q < 8; ++q) a += __builtin_bit_cast(float, v[q]);
                tot[k] = a; }
            const float r1 = 1.f / sqrtf(tot[0] * (1.f / 2048.f) + eps);
            const float sxp = tot[1] + r1 * (2.f * tot[2] + r1 * tot[3]);
            R1[tid] = r1; R2[tid] = 1.f / sqrtf(fmaxf(sxp, 0.f) * (1.f / 2048.f) + eps); }
        asm volatile("s_waitcnt lgkmcnt(0)" ::: "memory"); __builtin_amdgcn_s_barrier(); asm volatile("" ::: "memory");
#pragma unroll
        for (int ai = 0; ai < 2; ++ai)
#pragma unroll
            for (int m = 0; m < 4; ++m) { asm volatile("" : "+v"(xp[ai][m][0]), "+v"(xp[ai][m][1])); }
        f32x4 gn[2][2];
#pragma unroll
        for (int bj = 0; bj < 2; ++bj)
#pragma unroll
            for (int n = 0; n < 2; ++n) { const int c = col0 + bj * HALF + 4 * n; gn[bj][n] = *(const f32x4*)(gate + (size_t)b * bstride + c) * *(const f32x4*)(nga + c); }
#pragma unroll
        for (int ai = 0; ai < 2; ++ai)
#pragma unroll
            for (int m = 0; m < 4; ++m) { const int rl = rl0 + ai * HALF + m * 16; const unsigned ro = (unsigned)((u.pm * BM + rl) * ldc); const float r1 = R1[rl];
#pragma unroll
                for (int bj = 0; bj < 2; ++bj) { const xh8 w = xp[ai][m][bj];
#pragma unroll
                    for (int n = 0; n < 2; ++n) { const int c = col0 + bj * HALF + 4 * n;
                        const f32x4 x = {(float)w[4 * n + 0], (float)w[4 * n + 1], (float)w[4 * n + 2], (float)w[4 * n + 3]};
                        const f32x4 v = x + r1 * (gn[bj][n] * acc[ai][bj][m][n]);
                        if (!xdb) *(f32x4*)(xd + ro + c) = v;
                        acc[ai][bj][m][n] = v; }
                    if (xdb) { const f32x4 v0 = acc[ai][bj][m][0], v1 = acc[ai][bj][m][1];
                        const xh8 o = {(_Float16)v0[0], (_Float16)v0[1], (_Float16)v0[2], (_Float16)v0[3], (_Float16)v1[0], (_Float16)v1[1], (_Float16)v1[2], (_Float16)v1[3]};
                        *(xh8*)(xdb + ro + col0 + bj * HALF) = o; } } }
        if (!H) return;
        f32x4 hb[2][2], sh[2][2];
#pragma unroll
        for (int bj = 0; bj < 2; ++bj)
#pragma unroll
            for (int n = 0; n < 2; ++n) { const int c = col0 + bj * HALF + 4 * n; hb[bj][n] = *(const f32x4*)(ngb + c) * (*(const f32x4*)(scale + (size_t)b * bstride + c) + 1.f); sh[bj][n] = *(const f32x4*)(shift + (size_t)b * bstride + c); }
#pragma unroll
        for (int ai = 0; ai < 2; ++ai)
#pragma unroll
            for (int m = 0; m < 4; ++m) { const int rl = rl0 + ai * HALF + m * 16; const unsigned ro = (unsigned)((u.pm * BM + rl) * ldc); const float r2 = R2[rl];
#pragma unroll
                for (int bj = 0; bj < 2; ++bj) { const f32x4 h0 = (acc[ai][bj][m][0] * r2) * hb[bj][0] + sh[bj][0], h1 = (acc[ai][bj][m][1] * r2) * hb[bj][1] + sh[bj][1];
                    u32x4 w; w.x = cvt_pk_bf16(h0[0], h0[1]); w.y = cvt_pk_bf16(h0[2], h0[3]); w.z = cvt_pk_bf16(h1[0], h1[1]); w.w = cvt_pk_bf16(h1[2], h1[3]);
                    *(u32x4*)(H + ro + col0 + bj * HALF) = w; } }
    }
};
template <class Epi, class Sched, bool ALIGN_EPI = false, bool SP2 = false>
__device__ __forceinline__ void gemm_phase(PG8_LAS unsigned char* lds, const Gemm g, const Sched& S, const Epi& E, int wv  ) {
    const int tid_ = wv * 64 + lane_now();
    const int tid = tid_, wid = __builtin_amdgcn_readfirstlane(tid >> 6), lane = tid & 63, wr = wid >> 2, wc = wid & 3, fr = lane & 15, fq = lane >> 4;
    const int K = g.K, nt = K / BK;
    unsigned voffA[2], voffB[2];
#pragma unroll
    for (int i = 0; i < 2; ++i) { int R, C; stage_rc(tid * 16 + i * 8192, R, C); const int Rb = Epi::PERM ? ((R & ~31) + perm32(R & 31)) : R;
        voffA[i] = (unsigned)(R * K + C) * 2u; voffB[i] = (unsigned)(Rb * K + C) * 2u; }
    const size_t kstep = (size_t)(BK * 2);
    const size_t hstep = (size_t)HALF * K * 2;
    const size_t tstep = 2 * hstep;
    const unsigned ldsw = (unsigned)wid * 1024u;
    const int aoff = lds_byte(wr * 64 + fr, fq * 8), boff = lds_byte(wc * 32 + fr, fq * 8);
#define PG8_SA(b, h) (((b) * 2 + (h)) * HTB)
#define PG8_SB(b, h) ((4 + (b) * 2 + (h)) * HTB)
#define PG8_STAGE(bufoff, gbase, voff) do { _Pragma("unroll") for (int _i = 0; _i < 2; ++_i) \
        __builtin_amdgcn_global_load_lds((const unsigned*)((const char*)(gbase) + (voff)[_i]), (PG8_LAS unsigned*)(lds + (bufoff) + ldsw + _i * 8192), 16, 0, 0); } while (0)
#define PG8_LDA(dst, b, h) do { _Pragma("unroll") for (int m = 0; m < 4; ++m) _Pragma("unroll") for (int k = 0; k < 2; ++k) dst[m][k] = *(const PG8_LAS bf16x8*)(lds + PG8_SA(b, h) + aoff + m * 2048 + k * 1024); } while (0)
#define PG8_LDB(dst, b, h) do { _Pragma("unroll") for (int n = 0; n < 2; ++n) _Pragma("unroll") for (int k = 0; k < 2; ++k) dst[n][k] = *(const PG8_LAS bf16x8*)(lds + PG8_SB(b, h) + boff + n * 2048 + k * 1024); } while (0)
#define PG8_MMA(ai, bj, At, Bt) do { __builtin_amdgcn_s_setprio(1); _Pragma("unroll") for (int m = 0; m < 4; ++m) _Pragma("unroll") for (int n = 0; n < 2; ++n) _Pragma("unroll") for (int k = 0; k < 2; ++k) \
        acc[ai][bj][m][n] = __builtin_amdgcn_mfma_f32_16x16x32_bf16(Bt[n][k], At[m][k], acc[ai][bj][m][n], 0, 0, 0); __builtin_amdgcn_s_setprio(0); } while (0)
#define PG8_WAIT_V(n) asm volatile("s_waitcnt vmcnt(" #n ")" ::: "memory")
#define PG8_WAIT_L(n) asm volatile("s_waitcnt lgkmcnt(" #n ")" ::: "memory")
#define PG8_BAR __builtin_amdgcn_s_barrier()
#define PG8_SCHED __builtin_amdgcn_sched_barrier(0)
    Unit cur, nxt; int ui = 0;
    if (!S.next(0, cur)) return;
    f32x4 acc[2][2][4][2];
#pragma unroll
    for (int a = 0; a < 2; ++a)
#pragma unroll
        for (int b = 0; b < 2; ++b)
#pragma unroll
            for (int m = 0; m < 4; ++m)
#pragma unroll
                for (int n = 0; n < 2; ++n) acc[a][b][m][n] = (f32x4){0.f, 0.f, 0.f, 0.f};
    bf16x8 At[4][2], B0[2][2], B1[2][2];
    const char* cA = (const char*)g.A + (size_t)cur.pm * tstep; const char* cB = (const char*)g.Bt + (size_t)cur.pn * tstep;
    S.a_ready(cur);
    if constexpr (SP2) {
        PG8_STAGE(PG8_SB(0, 0), cB, voffB); PG8_STAGE(PG8_SB(0, 1), cB + hstep, voffB); PG8_STAGE(PG8_SA(0, 0), cA, voffA); PG8_STAGE(PG8_SA(0, 1), cA + hstep, voffA);
        if (wr == 1) PG8_BAR;
        PG8_WAIT_V(2); PG8_BAR;
        PG8_STAGE(PG8_SB(1, 0), cB + kstep, voffB); PG8_STAGE(PG8_SA(1, 0), cA + kstep, voffA); PG8_STAGE(PG8_SB(1, 1), cB + hstep + kstep, voffB);
        PG8_WAIT_V(6); PG8_BAR;
    } else {
        PG8_STAGE(PG8_SB(0, 0), cB, voffB); PG8_STAGE(PG8_SA(0, 0), cA, voffA); PG8_STAGE(PG8_SB(0, 1), cB + hstep, voffB); PG8_STAGE(PG8_SA(0, 1), cA + hstep, voffA);
        if (wr == 1) PG8_BAR;
        PG8_WAIT_V(4); PG8_BAR;
        PG8_STAGE(PG8_SB(1, 0), cB + kstep, voffB); PG8_STAGE(PG8_SA(1, 0), cA + kstep, voffA); PG8_STAGE(PG8_SB(1, 1), cB + hstep + kstep, voffB);
        PG8_WAIT_V(6); PG8_BAR;
    }
    for (;;) {
        const bool has_next = S.next(ui + 1, nxt);
        const char* nA = has_next ? (const char*)g.A + (size_t)nxt.pm * tstep : cA; const char* nB = has_next ? (const char*)g.Bt + (size_t)nxt.pn * tstep : cB;
        for (int t = 0; t < nt; t += 2) {
            const bool last = (t == nt - 2);
            const char* a1 = cA + (size_t)(t + 1) * kstep;
            const char* a2 = last ? nA : cA + (size_t)(t + 2) * kstep; const char* b2 = last ? nB : cB + (size_t)(t + 2) * kstep;
            const char* a3 = a2 + kstep; const char* b3 = b2 + kstep;
            if (last && has_next) S.a_ready(nxt);
            if constexpr (SP2) {
            PG8_LDB(B0, 0, 0); PG8_LDB(B1, 0, 1); PG8_SCHED; PG8_LDA(At, 0, 0); PG8_STAGE(PG8_SA(1, 1), a1 + hstep, voffA);
            PG8_WAIT_V(8); PG8_WAIT_L(0); PG8_BAR; PG8_MMA(0, 0, At, B0); PG8_MMA(0, 1, At, B1); PG8_BAR; PG8_SCHED;
            PG8_LDA(At, 0, 1); PG8_STAGE(PG8_SB(0, 0), b2, voffB); PG8_STAGE(PG8_SB(0, 1), b2 + hstep, voffB); PG8_STAGE(PG8_SA(0, 0), a2, voffA);
            PG8_WAIT_V(8); PG8_WAIT_L(0); PG8_BAR; PG8_MMA(1, 0, At, B0); PG8_MMA(1, 1, At, B1); PG8_BAR; PG8_SCHED;
            PG8_LDB(B0, 1, 0); PG8_LDB(B1, 1, 1); PG8_SCHED; PG8_LDA(At, 1, 0); PG8_STAGE(PG8_SA(0, 1), a2 + hstep, voffA);
            PG8_WAIT_V(8); PG8_WAIT_L(0); PG8_BAR; PG8_MMA(0, 0, At, B0); PG8_MMA(0, 1, At, B1); PG8_BAR; PG8_SCHED;
            PG8_LDA(At, 1, 1); PG8_STAGE(PG8_SB(1, 0), b3, voffB); PG8_STAGE(PG8_SB(1, 1), b3 + hstep, voffB); PG8_STAGE(PG8_SA(1, 0), a3, voffA);
            PG8_WAIT_V(8); PG8_WAIT_L(0); PG8_BAR; PG8_MMA(1, 0, At, B0); PG8_MMA(1, 1, At, B1); PG8_BAR; PG8_SCHED;
            } else {
            PG8_LDB(B0, 0, 0); PG8_SCHED; PG8_LDA(At, 0, 0); PG8_STAGE(PG8_SA(1, 1), a1 + hstep, voffA);
            PG8_WAIT_L(8); PG8_BAR; PG8_WAIT_L(0); PG8_MMA(0, 0, At, B0); PG8_BAR; PG8_SCHED;
            PG8_LDB(B1, 0, 1); PG8_STAGE(PG8_SB(0, 0), b2, voffB);
            PG8_BAR; PG8_WAIT_L(0); PG8_MMA(0, 1, At, B1); PG8_BAR;
            PG8_LDA(At, 0, 1); PG8_STAGE(PG8_SA(0, 0), a2, voffA);
            PG8_BAR; PG8_WAIT_L(0); PG8_MMA(1, 0, At, B0); PG8_BAR; PG8_SCHED;
            PG8_STAGE(PG8_SB(0, 1), b2 + hstep, voffB);
            PG8_WAIT_V(6); PG8_BAR; PG8_MMA(1, 1, At, B1); PG8_BAR;
            PG8_LDB(B0, 1, 0); PG8_SCHED; PG8_LDA(At, 1, 0); PG8_STAGE(PG8_SA(0, 1), a2 + hstep, voffA);
            PG8_WAIT_L(8); PG8_BAR; PG8_WAIT_L(0); PG8_MMA(0, 0, At, B0); PG8_BAR; PG8_SCHED;
            PG8_LDB(B1, 1, 1); PG8_STAGE(PG8_SB(1, 0), b3, voffB);
            PG8_BAR; PG8_WAIT_L(0); PG8_MMA(0, 1, At, B1); PG8_BAR;
            PG8_LDA(At, 1, 1); PG8_STAGE(PG8_SA(1, 0), a3, voffA);
            PG8_BAR; PG8_WAIT_L(0); PG8_MMA(1, 0, At, B0); PG8_BAR; PG8_SCHED;
            PG8_STAGE(PG8_SB(1, 1), b3 + hstep, voffB);
            PG8_WAIT_V(6); PG8_BAR; PG8_MMA(1, 1, At, B1); PG8_BAR;
            }
        }
        if constexpr (ALIGN_EPI) { if (wr == 0) PG8_BAR; }
        if constexpr (!Epi::AFTER_DRAIN) { E(acc, cur, wr, wc, fr, fq); S.done(cur); }
        if (!has_next) break;
#pragma unroll
        for (int a = 0; a < 2; ++a)
#pragma unroll
            for (int b = 0; b < 2; ++b)
#pragma unroll
                for (int m = 0; m < 4; ++m)
#pragma unroll
                    for (int n = 0; n < 2; ++n) acc[a][b][m][n] = (f32x4){0.f, 0.f, 0.f, 0.f};
        cur = nxt; cA = nA; cB = nB; ++ui;
        if constexpr (ALIGN_EPI) { if (wr == 1) PG8_BAR; }
    }
    PG8_WAIT_V(0);
    if constexpr (!ALIGN_EPI) { if (wr == 0) PG8_BAR; }
    PG8_BAR;
    if constexpr (Epi::AFTER_DRAIN) { E.fused(acc, cur, wr, wc, fr, fq, lds, wid, lane); S.done(cur); }
#undef PG8_SA
#undef PG8_SB
#undef PG8_STAGE
#undef PG8_LDA
#undef PG8_LDB
#undef PG8_MMA
#undef PG8_WAIT_V
#undef PG8_WAIT_L
#undef PG8_BAR
#undef PG8_SCHED
}
}
namespace att {
typedef unsigned short bf16;
using bf16x8 = __attribute__((ext_vector_type(8))) short;
using s16x4  = __attribute__((ext_vector_type(4))) short;
using f32x16 = __attribute__((ext_vector_type(16))) float;
using u32x4  = __attribute__((ext_vector_type(4))) unsigned;
constexpr int   D = 128, NW = 8, QBLK = 32, KVBLK = 64;
constexpr float SCALE = 0.088388347648318440f;
constexpr float THR = 8.f;
constexpr int SHM_V = KVBLK * D * 2, SHM_K = KVBLK * D * 2, SHM_ATTN = 3 * SHM_V + 3 * SHM_K + NW * 64 * 4;
constexpr float MASKED = -1e30f, M_INIT = -1e28f;
#define KSWZ(row, colB) ((row) * 256 + ((colB) ^ (((row) & 7) << 4)))
#define SBAR() __builtin_amdgcn_sched_barrier(0)
__device__ __forceinline__ int crow(int r, int hi) { return (r & 3) + 8 * (r >> 2) + 4 * hi; }
__device__ __forceinline__ unsigned cvtpk(float lo, float hi) {
  unsigned r; asm volatile("v_cvt_pk_bf16_f32 %0, %1, %2" : "=v"(r) : "v"(lo), "v"(hi)); return r;
}
__device__ __forceinline__ void partialSM(f32x16& p0, f32x16& p1, float& m_reg, float& mn, float& alpha) {
  constexpr float C = SCALE * 1.4426950408889634f;
  float pmax = p0[0];
#pragma unroll
  for (int r = 1; r < 16; ++r) pmax = fmaxf(pmax, p0[r]);
#pragma unroll
  for (int r = 0; r < 16; ++r) pmax = fmaxf(pmax, p1[r]);
  { auto rr = __builtin_amdgcn_permlane32_swap(__float_as_uint(pmax), __float_as_uint(pmax), false, false);
    pmax = fmaxf(__uint_as_float(rr[0]), __uint_as_float(rr[1])); }
  if (__builtin_expect(__all(pmax - m_reg <= THR / SCALE), 1)) { mn = m_reg; alpha = 1.f; }
  else { mn = fmaxf(m_reg, pmax); alpha = __builtin_amdgcn_exp2f((m_reg - mn) * C); m_reg = mn; }
  float mnC = -mn * C;
#pragma unroll
  for (int r = 0; r < 16; ++r) p0[r] = fmaf(p0[r], C, mnC);
#pragma unroll
  for (int r = 0; r < 16; ++r) p1[r] = fmaf(p1[r], C, mnC);
#pragma unroll
  for (int r = 0; r < 16; ++r) p0[r] = __builtin_amdgcn_exp2f(p0[r]);
}
__device__ __forceinline__ void finishSM(f32x16& p0, f32x16& p1, float alpha, float& l_reg, bf16x8& pa0, bf16x8& pa1, bf16x8& pa2, bf16x8& pa3) {
#pragma unroll
  for (int r = 0; r < 16; ++r) p1[r] = __builtin_amdgcn_exp2f(p1[r]);
  float ps = 0;
#pragma unroll
  for (int r = 0; r < 16; ++r) ps += p0[r];
#pragma unroll
  for (int r = 0; r < 16; ++r) ps += p1[r];
  { auto rr = __builtin_amdgcn_permlane32_swap(__float_as_uint(ps), __float_as_uint(ps), false, false);
    ps = __uint_as_float(rr[0]) + __uint_as_float(rr[1]); }
  l_reg = l_reg * alpha + ps;
#define PK4(P, BASE, OUT) do { unsigned a0 = cvtpk(P[BASE + 0], P[BASE + 1]), a1 = cvtpk(P[BASE + 2], P[BASE + 3]);   \
    unsigned b0 = cvtpk(P[BASE + 4], P[BASE + 5]), b1 = cvtpk(P[BASE + 6], P[BASE + 7]);                              \
    auto r0 = __builtin_amdgcn_permlane32_swap(a0, b0, false, false); auto r1 = __builtin_amdgcn_permlane32_swap(a1, b1, false, false); \
    u32x4 w = {r0[0], r1[0], r0[1], r1[1]}; OUT = *reinterpret_cast<bf16x8*>(&w); } while (0)
  PK4(p0, 0, pa0); PK4(p0, 8, pa1); PK4(p1, 0, pa2); PK4(p1, 8, pa3);
#undef PK4
}
__device__ __forceinline__ void staticSM(f32x16& p0, f32x16& p1, float nmc, float& l_reg, bf16x8& pa0, bf16x8& pa1, bf16x8& pa2, bf16x8& pa3) {
  constexpr float C = SCALE * 1.4426950408889634f;
#pragma unroll
  for (int r = 0; r < 16; ++r) p0[r] = __builtin_amdgcn_exp2f(fmaf(p0[r], C, nmc));
#pragma unroll
  for (int r = 0; r < 16; ++r) p1[r] = __builtin_amdgcn_exp2f(fmaf(p1[r], C, nmc));
  float ps = 0;
#pragma unroll
  for (int r = 0; r < 16; ++r) ps += p0[r];
#pragma unroll
  for (int r = 0; r < 16; ++r) ps += p1[r];
  { auto rr = __builtin_amdgcn_permlane32_swap(__float_as_uint(ps), __float_as_uint(ps), false, false);
    ps = __uint_as_float(rr[0]) + __uint_as_float(rr[1]); }
  l_reg += ps;
#define PK4(P, BASE, OUT) do { unsigned a0 = cvtpk(P[BASE + 0], P[BASE + 1]), a1 = cvtpk(P[BASE + 2], P[BASE + 3]);   \
    unsigned b0 = cvtpk(P[BASE + 4], P[BASE + 5]), b1 = cvtpk(P[BASE + 6], P[BASE + 7]);                              \
    auto r0 = __builtin_amdgcn_permlane32_swap(a0, b0, false, false); auto r1 = __builtin_amdgcn_permlane32_swap(a1, b1, false, false); \
    u32x4 w = {r0[0], r1[0], r0[1], r1[1]}; OUT = *reinterpret_cast<bf16x8*>(&w); } while (0)
  PK4(p0, 0, pa0); PK4(p0, 8, pa1); PK4(p1, 0, pa2); PK4(p1, 8, pa3);
#undef PK4
}
template <bool BAND>
__device__ __forceinline__ void qkt_init(f32x16& p0, f32x16& p1, float dq, float kf0, float nsl, float radius, float Lf, int side, bool interior) {
  const bool nomask = !BAND || interior;
  if (nomask && side != 0) {
    const float ns = side > 0 ? nsl : -nsl, t = ns * dq;
#pragma unroll
    for (int r = 0; r < 16; ++r) { const float c0 = (float)((r & 3) + 8 * (r >> 2)); p0[r] = fmaf(ns, -c0, t); p1[r] = fmaf(ns, -(c0 + 32.f), t); }
  } else if (nomask) {
#pragma unroll
    for (int r = 0; r < 16; ++r) { const float c0 = (float)((r & 3) + 8 * (r >> 2)); p0[r] = nsl * fabsf(dq - c0); p1[r] = nsl * fabsf(dq - (c0 + 32.f)); }
  } else
#pragma unroll
  for (int r = 0; r < 16; ++r) {
    const float c0 = (float)((r & 3) + 8 * (r >> 2));
    const float d0 = dq - c0, d1 = dq - (c0 + 32.f);
    float b0 = nsl * fabsf(d0), b1 = nsl * fabsf(d1);
    if (BAND) {
      const float ka = kf0 + c0, kb = kf0 + (c0 + 32.f);
      const bool v0 = (fabsf(d0) <= radius) && (ka >= 0.f) && (ka < Lf);
      const bool v1 = (fabsf(d1) <= radius) && (kb >= 0.f) && (kb < Lf);
      b0 = v0 ? b0 : MASKED; b1 = v1 ? b1 : MASKED;
    }
    p0[r] = b0; p1[r] = b1;
  }
}
template <bool BAND>
__device__ __forceinline__ void qkt(f32x16& p0, f32x16& p1, const bf16* Ks, const bf16x8* qr, int r32, int hi, float dq, float kf0, float nsl, float radius, float Lf, int side, bool interior = false) {
  qkt_init<BAND>(p0, p1, dq, kf0, nsl, radius, Lf, side, interior);
#pragma unroll
  for (int d0 = 0; d0 < 8; ++d0) { int cb = (d0 * 16 + hi * 8) * 2;
    bf16x8 b0 = *reinterpret_cast<const bf16x8*>((const char*)Ks + KSWZ(r32, cb));
    bf16x8 b1 = *reinterpret_cast<const bf16x8*>((const char*)Ks + KSWZ(32 + r32, cb));
    p0 = __builtin_amdgcn_mfma_f32_32x32x16_bf16(b0, qr[d0], p0, 0, 0, 0);
    p1 = __builtin_amdgcn_mfma_f32_32x32x16_bf16(b1, qr[d0], p1, 0, 0, 0); }
}
#define QK_RD(A, B, D0) do { const int ad_ = kb + kx[D0]; asm volatile("ds_read_b128 %0, %1" : "=&v"(A) : "v"(ad_) : "memory"); asm volatile("ds_read_b128 %0, %1 offset:8192" : "=&v"(B) : "v"(ad_) : "memory"); } while (0)
#define QK_WAIT(N, A, B) asm volatile("s_waitcnt lgkmcnt(" #N ")" : "+v"(A), "+v"(B) :: "memory")
#define QK_MM(A, B, D0) do { p0 = __builtin_amdgcn_mfma_f32_32x32x16_bf16(A, qr[D0], p0, 0, 0, 0); p1 = __builtin_amdgcn_mfma_f32_32x32x16_bf16(B, qr[D0], p1, 0, 0, 0); } while (0)
__device__ __forceinline__ void qkt_pipe(f32x16& p0, f32x16& p1, int kb, const int (&kx)[8], const bf16x8* qr, float dq, float nsl, int side) {
  bf16x8 a0, b0, a1, b1, a2, b2, a3, b3;
  QK_RD(a0, b0, 0); QK_RD(a1, b1, 1); QK_RD(a2, b2, 2); QK_RD(a3, b3, 3);
  if (side != 0) {
    const float ns = side > 0 ? nsl : -nsl, t = ns * dq;
#pragma unroll
    for (int r = 0; r < 16; ++r) { const float c0 = (float)((r & 3) + 8 * (r >> 2)); p0[r] = fmaf(ns, -c0, t); p1[r] = fmaf(ns, -(c0 + 32.f), t); }
  } else {
#pragma unroll
    for (int r = 0; r < 16; ++r) { const float c0 = (float)((r & 3) + 8 * (r >> 2)); p0[r] = nsl * fabsf(dq - c0); p1[r] = nsl * fabsf(dq - (c0 + 32.f)); }
  }
  QK_WAIT(6, a0, b0); SBAR(); QK_MM(a0, b0, 0); QK_RD(a0, b0, 4);
  QK_WAIT(6, a1, b1); SBAR(); QK_MM(a1, b1, 1); QK_RD(a1, b1, 5);
  QK_WAIT(6, a2, b2); SBAR(); QK_MM(a2, b2, 2); QK_RD(a2, b2, 6);
  QK_WAIT(6, a3, b3); SBAR(); QK_MM(a3, b3, 3); QK_RD(a3, b3, 7);
  QK_WAIT(6, a0, b0); SBAR(); QK_MM(a0, b0, 4);
  QK_WAIT(4, a1, b1); SBAR(); QK_MM(a1, b1, 5);
  QK_WAIT(2, a2, b2); SBAR(); QK_MM(a2, b2, 6);
  QK_WAIT(0, a3, b3); SBAR(); QK_MM(a3, b3, 7);
}
#define QK_RDX(A, B, D0) do { const int ad_ = kb + (((D0) * 32) ^ bx); asm volatile("ds_read_b128 %0, %1" : "=&v"(A) : "v"(ad_) : "memory"); asm volatile("ds_read_b128 %0, %1 offset:8192" : "=&v"(B) : "v"(ad_) : "memory"); } while (0)
template <bool BAND>
__device__ __forceinline__ void qkt_bp(f32x16& p0, f32x16& p1, int kb, int bx, const bf16x8* qr, float dq, float kf0, float nsl, float radius, float Lf, int side, bool interior) {
  bf16x8 a0, b0, a1, b1, a2, b2, a3, b3;
  QK_RDX(a0, b0, 0); QK_RDX(a1, b1, 1); QK_RDX(a2, b2, 2); QK_RDX(a3, b3, 3);
  qkt_init<BAND>(p0, p1, dq, kf0, nsl, radius, Lf, side, interior);
  QK_WAIT(6, a0, b0); SBAR(); QK_MM(a0, b0, 0); QK_RDX(a0, b0, 4);
  QK_WAIT(6, a1, b1); SBAR(); QK_MM(a1, b1, 1); QK_RDX(a1, b1, 5);
  QK_WAIT(6, a2, b2); SBAR(); QK_MM(a2, b2, 2); QK_RDX(a2, b2, 6);
  QK_WAIT(6, a3, b3); SBAR(); QK_MM(a3, b3, 3); QK_RDX(a3, b3, 7);
  QK_WAIT(6, a0, b0); SBAR(); QK_MM(a0, b0, 4);
  QK_WAIT(4, a1, b1); SBAR(); QK_MM(a1, b1, 5);
  QK_WAIT(2, a2, b2); SBAR(); QK_MM(a2, b2, 6);
  QK_WAIT(0, a3, b3); SBAR(); QK_MM(a3, b3, 7);
}
#undef QK_RDX
#undef QK_RD
#undef QK_WAIT
#undef QK_MM
__device__ __forceinline__ int v_st(int k, int c) { const int kk = (k & ~0xC) | ((k & 4) << 1) | ((k & 8) >> 1); return ((kk >> 3) * 4 + (c >> 5)) * 512 + ((kk & 7) * 32 + (c & 31)) * 2; }
__device__ __forceinline__ int v_rd_base(int lane) { return ((lane & 3) << 3) | (((lane >> 2) & 3) << 6) | (((lane >> 4) & 1) << 5) | (((lane >> 5) & 1) << 8); }
constexpr int v_rd_off(int d0, int ks, int half) { return d0 * 512 + ks * 4096 + half * 2048; }
template <int OFF> __device__ __forceinline__ s16x4 tr_read(int vb) {
  s16x4 r; asm volatile("ds_read_b64_tr_b16 %0, %1 offset:%2" : "=&v"(r) : "v"(vb), "i"(OFF) : "memory"); return r;
}
template <int D0> __device__ __forceinline__ void pv_one(f32x16& od, int vb, bf16x8 pa0, bf16x8 pa1, bf16x8 pa2, bf16x8 pa3) {
  const s16x4 l0 = tr_read<v_rd_off(D0, 0, 0)>(vb), h0 = tr_read<v_rd_off(D0, 0, 1)>(vb), l1 = tr_read<v_rd_off(D0, 1, 0)>(vb), h1 = tr_read<v_rd_off(D0, 1, 1)>(vb);
  const s16x4 l2 = tr_read<v_rd_off(D0, 2, 0)>(vb), h2 = tr_read<v_rd_off(D0, 2, 1)>(vb), l3 = tr_read<v_rd_off(D0, 3, 0)>(vb), h3 = tr_read<v_rd_off(D0, 3, 1)>(vb);
  asm volatile("s_waitcnt lgkmcnt(0)" ::: "memory"); SBAR();
#define PK(L, H) (bf16x8){L[0], L[1], L[2], L[3], H[0], H[1], H[2], H[3]}
  od = __builtin_amdgcn_mfma_f32_32x32x16_bf16(pa0, PK(l0, h0), od, 0, 0, 0);
  od = __builtin_amdgcn_mfma_f32_32x32x16_bf16(pa1, PK(l1, h1), od, 0, 0, 0);
  od = __builtin_amdgcn_mfma_f32_32x32x16_bf16(pa2, PK(l2, h2), od, 0, 0, 0);
  od = __builtin_amdgcn_mfma_f32_32x32x16_bf16(pa3, PK(l3, h3), od, 0, 0, 0);
#undef PK
}
__device__ __forceinline__ void pv_d0(f32x16* o, int vb, bf16x8 pa0, bf16x8 pa1, bf16x8 pa2, bf16x8 pa3) {
  pv_one<0>(o[0], vb, pa0, pa1, pa2, pa3); pv_one<1>(o[1], vb, pa0, pa1, pa2, pa3); pv_one<2>(o[2], vb, pa0, pa1, pa2, pa3); pv_one<3>(o[3], vb, pa0, pa1, pa2, pa3);
}

#define PV_RD(F, D0) do { F##0 = tr_read<v_rd_off(D0, 0, 0)>(vb); F##1 = tr_read<v_rd_off(D0, 0, 1)>(vb); F##2 = tr_read<v_rd_off(D0, 1, 0)>(vb); F##3 = tr_read<v_rd_off(D0, 1, 1)>(vb); \
    F##4 = tr_read<v_rd_off(D0, 2, 0)>(vb); F##5 = tr_read<v_rd_off(D0, 2, 1)>(vb); F##6 = tr_read<v_rd_off(D0, 3, 0)>(vb); F##7 = tr_read<v_rd_off(D0, 3, 1)>(vb); } while (0)
#define PV_WAIT(N, F) asm volatile("s_waitcnt lgkmcnt(" #N ")" : "+v"(F##0), "+v"(F##1), "+v"(F##2), "+v"(F##3), "+v"(F##4), "+v"(F##5), "+v"(F##6), "+v"(F##7) :: "memory")
#define PV_PK(L, H) (bf16x8){L[0], L[1], L[2], L[3], H[0], H[1], H[2], H[3]}
#define PV_MM(OD, F) do { OD = __builtin_amdgcn_mfma_f32_32x32x16_bf16(pa0, PV_PK(F##0, F##1), OD, 0, 0, 0); OD = __builtin_amdgcn_mfma_f32_32x32x16_bf16(pa1, PV_PK(F##2, F##3), OD, 0, 0, 0); \
    OD = __builtin_amdgcn_mfma_f32_32x32x16_bf16(pa2, PV_PK(F##4, F##5), OD, 0, 0, 0); OD = __builtin_amdgcn_mfma_f32_32x32x16_bf16(pa3, PV_PK(F##6, F##7), OD, 0, 0, 0); } while (0)
__device__ __forceinline__ void pv_pipe(f32x16* o, int vb, bf16x8 pa0, bf16x8 pa1, bf16x8 pa2, bf16x8 pa3) {
  s16x4 a0, a1, a2, a3, a4, a5, a6, a7, b0, b1, b2, b3, b4, b5, b6, b7;
  PV_RD(a, 0);
  PV_RD(b, 1); PV_WAIT(8, a); SBAR(); PV_MM(o[0], a);
  PV_RD(a, 2); PV_WAIT(8, b); SBAR(); PV_MM(o[1], b);
  PV_RD(b, 3); PV_WAIT(8, a); SBAR(); PV_MM(o[2], a);
  PV_WAIT(0, b); SBAR(); PV_MM(o[3], b);
}
#define PV_RD2(F, BLK) do { constexpr int B_ = ((BLK) >> 2) * 16384, D_ = (BLK) & 3;                                                                             \
    F##0 = tr_read<B_ + v_rd_off(D_, 0, 0)>(vb); F##1 = tr_read<B_ + v_rd_off(D_, 0, 1)>(vb); F##2 = tr_read<B_ + v_rd_off(D_, 1, 0)>(vb); F##3 = tr_read<B_ + v_rd_off(D_, 1, 1)>(vb); \
    F##4 = tr_read<B_ + v_rd_off(D_, 2, 0)>(vb); F##5 = tr_read<B_ + v_rd_off(D_, 2, 1)>(vb); F##6 = tr_read<B_ + v_rd_off(D_, 3, 0)>(vb); F##7 = tr_read<B_ + v_rd_off(D_, 3, 1)>(vb); } while (0)
__device__ __forceinline__ void pv8_pipe(f32x16* o, int vb, int ps_addr, int fl_addr, const float* al_row, int hi) {
  bf16x8 pa0, pa1, pa2, pa3; int fl = 0;
  asm volatile("ds_read_b128 %0, %1" : "=&v"(pa0) : "v"(ps_addr) : "memory");
  asm volatile("ds_read_b128 %0, %1 offset:1024" : "=&v"(pa1) : "v"(ps_addr) : "memory");
  asm volatile("ds_read_b128 %0, %1 offset:2048" : "=&v"(pa2) : "v"(ps_addr) : "memory");
  asm volatile("ds_read_b128 %0, %1 offset:3072" : "=&v"(pa3) : "v"(ps_addr) : "memory");
  s16x4 a0, a1, a2, a3, a4, a5, a6, a7, b0, b1, b2, b3, b4, b5, b6, b7;
  PV_RD2(a, 0);
  asm volatile("s_waitcnt lgkmcnt(8)" : "+v"(pa0), "+v"(pa1), "+v"(pa2), "+v"(pa3) :: "memory");
  (void)fl; (void)fl_addr; (void)al_row; (void)hi;
  PV_RD2(b, 1); PV_WAIT(8, a); SBAR(); PV_MM(o[0], a);
  PV_RD2(a, 2); PV_WAIT(8, b); SBAR(); PV_MM(o[1], b);
  PV_RD2(b, 3); PV_WAIT(8, a); SBAR(); PV_MM(o[2], a);
  PV_RD2(a, 4); PV_WAIT(8, b); SBAR(); PV_MM(o[3], b);
  PV_RD2(b, 5); PV_WAIT(8, a); SBAR(); PV_MM(o[4], a);
  PV_RD2(a, 6); PV_WAIT(8, b); SBAR(); PV_MM(o[5], b);
  PV_RD2(b, 7); PV_WAIT(8, a); SBAR(); PV_MM(o[6], a);
  PV_WAIT(0, b); SBAR(); PV_MM(o[7], b);
}
#undef PV_RD2
#undef PV_RD
#undef PV_WAIT
#undef PV_PK
#undef PV_MM

#define ATT_GAS __attribute__((address_space(1)))
struct UnitArgs {
  const ATT_GAS bf16* Q; long ldq;
  const ATT_GAS bf16* K; const ATT_GAS bf16* V; long ldk;
  int q0, L, kt0, nt;
  float nsl, radius, m_init, l_init;
  ATT_GAS float* Of; ATT_GAS bf16* Ob; long ldo;
  ATT_GAS float* lse; long ldl;
};

#define ATT_LAS __attribute__((address_space(3)))
template <bool BAND, int SDEPTH>
__device__ __forceinline__ void attn_unit(const UnitArgs& a_in, char* lds, ATT_LAS unsigned char* ldsl, int wv) {
  UnitArgs a = a_in;
  asm volatile("" : "+s"(a.Q), "+s"(a.ldq), "+s"(a.K), "+s"(a.V), "+s"(a.ldk));
  asm volatile("" : "+s"(a.q0), "+s"(a.L), "+s"(a.kt0), "+s"(a.nt));
  asm volatile("" : "+s"(a.Of), "+s"(a.Ob), "+s"(a.ldo), "+s"(a.lse), "+s"(a.ldl));
  const int tid_ = wv * 64 + lane_now();
  const int tid = tid_, wid = tid >> 6, lane = tid & 63, r32 = lane & 31, hi = lane >> 5;
  constexpr int RV = 0, RK = 3 * SHM_V, RS = 3 * SHM_V + 3 * SHM_K;
  char* K_lds = lds + RK;
  float* ws = (float*)(lds + RS) + wid * 64; float* li_l = ws; float* al_l = ws + 32;
  float m_reg = a.m_init, l_reg = a.l_init; f32x16 o[4] = {}; bf16x8 qr[8];
  const ATT_GAS bf16* Qw = a.Q + (long)(wid * QBLK + r32) * a.ldq + hi * 8;
#pragma unroll
  for (int d0 = 0; d0 < 8; ++d0) qr[d0] = *reinterpret_cast<const ATT_GAS bf16x8*>(Qw + d0 * 16);
  const int vb0 = (int)(uintptr_t)(lds + RV) + v_rd_base(lane);
  const int kbv = (int)(uintptr_t)K_lds + r32 * 256, bxv = (hi * 16) ^ ((r32 & 7) << 4);
  const float qf = (float)(a.q0 + wid * QBLK + r32), Lf = (float)a.L, nsl = a.nsl, radius = a.radius;
  const int wq = __builtin_amdgcn_readfirstlane(wid);
  const int Lm1 = a.L - 1, kt0 = a.kt0, qw0 = a.q0 + wq * QBLK;
  const ATT_GAS char* Kc = (const ATT_GAS char*)a.K; const ATT_GAS char* Vc = (const ATT_GAS char*)a.V; const long ldkb = a.ldk * 2;
  int rK0, rK1, cK0, cK1, rV0, rV1, cV0, cV1;
  { const int g0 = 2 * wq, g1 = g0 + 1;
    rK0 = g0 * 4 + (lane >> 4); rK1 = g1 * 4 + (lane >> 4); cK0 = ((lane & 15) ^ (rK0 & 7)) * 16; cK1 = ((lane & 15) ^ (rK1 & 7)) * 16;
    const int b0 = g0 * 2 + (lane >> 5), b1 = g1 * 2 + (lane >> 5), k0 = (b0 >> 2) * 8 + ((lane & 31) >> 2), k1 = (b1 >> 2) * 8 + ((lane & 31) >> 2);
    rV0 = (k0 & ~0xC) | ((k0 & 4) << 1) | ((k0 & 8) >> 1); rV1 = (k1 & ~0xC) | ((k1 & 4) << 1) | ((k1 & 8) >> 1);
    cV0 = ((b0 & 3) * 32 + (lane & 3) * 8) * 2; cV1 = ((b1 & 3) * 32 + (lane & 3) * 8) * 2; }
  const int NT = a.nt;
#define DMA_ROW(base, r, c, ldst) do { int r_ = (r); if constexpr (BAND) r_ = r_ < 0 ? 0 : (r_ > Lm1 ? Lm1 : r_);        \
    __builtin_amdgcn_global_load_lds((const unsigned*)(const char*)((base) + (long)r_ * ldkb + (c)), (ATT_LAS unsigned*)(ldst), 16, 0, 0); } while (0)
#define DMA_K(t, bofs) do { const int tt_ = (t) < NT ? (t) : NT - 1, k0_ = (kt0 + tt_) * KVBLK; ATT_LAS unsigned char* d_ = ldsl + RK + (bofs) + wq * 2048;   \
    DMA_ROW(Kc, k0_ + rK0, cK0, d_); DMA_ROW(Kc, k0_ + rK1, cK1, d_ + 1024); } while (0)
#define DMA_V(t, bofs) do { const int tt_ = (t) < NT ? (t) : NT - 1, k0_ = (kt0 + tt_) * KVBLK; ATT_LAS unsigned char* d_ = ldsl + RV + (bofs) + wq * 2048;   \
    DMA_ROW(Vc, k0_ + rV0, cV0, d_); DMA_ROW(Vc, k0_ + rV1, cV1, d_ + 1024); } while (0)
#define VM_WAIT(n) asm volatile("s_waitcnt vmcnt(" #n ")" ::: "memory")
#define RESC(al) do { if (__any((al) < 1.f)) { if (hi == 0) al_l[r32] = (al); asm volatile("s_waitcnt lgkmcnt(0)" ::: "memory"); \
    _Pragma("unroll") for (int d = 0; d < 4; ++d) _Pragma("unroll") for (int r = 0; r < 16; ++r) o[d][r] *= al_l[crow(r, hi)]; } } while (0)
#define QKT(PA, PB, bofs, t, inter) do { const int k0_ = (kt0 + (t)) * KVBLK; const float kf0_ = (float)(k0_ + 4 * hi); \
    const int side_ = (k0_ + KVBLK - 1 < qw0) ? 1 : ((k0_ > qw0 + QBLK - 1) ? -1 : 0); \
    qkt_bp<BAND>(PA, PB, kbv + (bofs), bxv, qr, qf - kf0_, kf0_, nsl, radius, Lf, side_, inter); } while (0)
  const int Rr = BAND ? (int)radius : 0x3fffffff;
#define TCLS(t) ([&]() -> int { const int lo_ = (kt0 + (t)) * KVBLK, hi_ = lo_ + KVBLK - 1;                                                    \
    if (BAND && (hi_ < qw0 - Rr || lo_ > qw0 + QBLK - 1 + Rr || hi_ < 0 || lo_ > Lm1)) return 0;                                                \
    return (!BAND || (lo_ >= qw0 + QBLK - 1 - Rr && hi_ <= qw0 + Rr && lo_ >= 0 && hi_ <= Lm1)) ? 1 : 2; }())
#define WG_BAR() do { asm volatile("s_waitcnt lgkmcnt(0)" ::: "memory"); __builtin_amdgcn_s_barrier(); asm volatile("" ::: "memory"); } while (0)
#define ROT() do { const int t_ = oa; oa = ob; ob = oc; oc = t_; } while (0)
  f32x16 pA0, pA1, pB0, pB1; float mnA, mnB, alA, alB; bf16x8 pa0, pa1, pa2, pa3;
  int oa = 0, ob = SHM_K, oc = 2 * SHM_K;
  DMA_K(0, 0); DMA_K(1, SHM_K); DMA_V(0, 0); DMA_K(2, 2 * SHM_K); DMA_V(1, SHM_V);
  VM_WAIT(8); WG_BAR();
  int cP = TCLS(0), cC;
  if (cP) { QKT(pA0, pA1, oa, 0, cP == 1); partialSM(pA0, pA1, m_reg, mnA, alA); }
  VM_WAIT(4); WG_BAR(); ROT();
  for (int j = 1; j + 1 < NT; j += 2) {
    DMA_K(j + 2, oc); DMA_V(j + 1, ob); SBAR();
    cC = TCLS(j);
    if (cC) QKT(pB0, pB1, oa, j, cC == 1);
    if (cP) { finishSM(pA0, pA1, alA, l_reg, pa0, pa1, pa2, pa3); SBAR(); pv_d0(o, vb0 + oc, pa0, pa1, pa2, pa3); }
    if (cC) { partialSM(pB0, pB1, m_reg, mnB, alB); RESC(alB); }
    VM_WAIT(4); WG_BAR(); ROT(); cP = cC;
    DMA_K(j + 3, oc); DMA_V(j + 2, ob); SBAR();
    cC = TCLS(j + 1);
    if (cC) QKT(pA0, pA1, oa, j + 1, cC == 1);
    if (cP) { finishSM(pB0, pB1, alB, l_reg, pa0, pa1, pa2, pa3); SBAR(); pv_d0(o, vb0 + oc, pa0, pa1, pa2, pa3); }
    if (cC) { partialSM(pA0, pA1, m_reg, mnA, alA); RESC(alA); }
    VM_WAIT(4); WG_BAR(); ROT(); cP = cC;
  }
  SBAR(); cC = TCLS(NT - 1);
  if (cC) QKT(pB0, pB1, oa, NT - 1, cC == 1);
  if (cP) { finishSM(pA0, pA1, alA, l_reg, pa0, pa1, pa2, pa3); SBAR(); pv_d0(o, vb0 + oc, pa0, pa1, pa2, pa3); }
  if (cC) partialSM(pB0, pB1, m_reg, mnB, alB);
  VM_WAIT(0); __syncthreads();
  if (cC) { RESC(alB); finishSM(pB0, pB1, alB, l_reg, pa0, pa1, pa2, pa3); SBAR(); pv_d0(o, vb0 + oa, pa0, pa1, pa2, pa3); }
  if (hi == 0) li_l[r32] = l_reg; asm volatile("s_waitcnt lgkmcnt(0)" ::: "memory");
  float rli[16];
#pragma unroll
  for (int r = 0; r < 16; ++r) rli[r] = __builtin_amdgcn_rcpf(li_l[crow(r, hi)]);
  if (a.Of) {
    ATT_GAS float* Ow = a.Of + (long)(wid * QBLK) * a.ldo;
#pragma unroll
    for (int r = 0; r < 16; ++r) { const int orow = crow(r, hi);
#pragma unroll
      for (int d0 = 0; d0 < 4; ++d0) Ow[(long)orow * a.ldo + d0 * 32 + r32] = o[d0][r] * rli[r]; }
  } else {
    ATT_GAS bf16* Ow = a.Ob + (long)(wid * QBLK) * a.ldo;
#pragma unroll
    for (int r = 0; r < 16; ++r) { const int orow = crow(r, hi);
#pragma unroll
      for (int d0 = 0; d0 < 4; ++d0) { const float v = o[d0][r] * rli[r]; Ow[(long)orow * a.ldo + d0 * 32 + r32] = (bf16)(cvtpk(v, v) & 0xffffu); } }
  }
  if (a.lse && hi == 0) a.lse[(long)(wid * QBLK + r32) * a.ldl] = m_reg * SCALE + __logf(l_reg);
  __syncthreads();
#undef DMA_ROW
#undef DMA_K
#undef DMA_V
#undef VM_WAIT
#undef RESC
#undef QKT
#undef ROT
#undef TCLS
#undef WG_BAR
}

constexpr int PU_K0 = 0, PU_V0 = 32768, PU_PS = 98304, PU_LDS = 131072;
struct PairArgs {
  const ATT_GAS bf16* Q; long ldq;
  const ATT_GAS bf16* K; const ATT_GAS bf16* V; long ldk;
  int q0, kt0, nt;
  float nsl;
  float m0;
  ATT_GAS bf16* O; long ldo;
};
__device__ __forceinline__ void attn_split_unit(const PairArgs& a_in, char* lds, float* xs  , int wv, ATT_LAS unsigned char* ldsl  ) {
  PairArgs a = a_in;
  asm volatile("" : "+s"(a.Q), "+s"(a.ldq), "+s"(a.K), "+s"(a.V), "+s"(a.ldk));
  asm volatile("" : "+s"(a.q0), "+s"(a.kt0), "+s"(a.nt), "+s"(a.O), "+s"(a.ldo));
  const int tid_ = wv * 64 + lane_now();
  const int tid = tid_, wid = tid >> 6, lane = tid & 63, r32 = lane & 31, hi = lane >> 5;
  const int pr = __builtin_amdgcn_readfirstlane(wid & 3), role = __builtin_amdgcn_readfirstlane(wid >> 2);
  float* AL = xs; float* LL = xs + 256; float* FL = xs + 512;
  const int t8 = tid & 255, sr = t8 >> 4, sc = (t8 & 15) * 8, vr = t8 >> 5, vc = (t8 & 31) * 8;
  const int ksw0 = KSWZ(sr, sc * 2), ksw1 = KSWZ(sr + 16, sc * 2), ksw2 = KSWZ(sr + 32, sc * 2), ksw3 = KSWZ(sr + 48, sc * 2);
  const int vhalf = (vc >> 7) * 16384, vcc = vc & 127;
  const unsigned kofs = (unsigned)((sr * a.ldk + sc) * 2), vofs = (unsigned)((vr * a.ldk + vc) * 2);
  const ATT_GAS char* Kc = (const ATT_GAS char*)a.K; const ATT_GAS char* Vc = (const ATT_GAS char*)a.V;
  const long ldk8 = 8 * a.ldk * 2, ldk16 = 16 * a.ldk * 2, ldk64 = 64 * a.ldk * 2;
  const int kt0 = a.kt0, NT = a.nt;
#define PLOADK(t) do { const long tb_ = (long)(kt0 + (t)) * ldk64; sk0 = *reinterpret_cast<const ATT_GAS bf16x8*>(Kc + tb_ + kofs); sk1 = *reinterpret_cast<const ATT_GAS bf16x8*>(Kc + tb_ + ldk16 + kofs); \
    sk2 = *reinterpret_cast<const ATT_GAS bf16x8*>(Kc + tb_ + 2 * ldk16 + kofs); sk3 = *reinterpret_cast<const ATT_GAS bf16x8*>(Kc + tb_ + 3 * ldk16 + kofs); } while (0)
#define PLOADV(t) do { const ATT_GAS char* vp_ = Vc + (long)(kt0 + (t)) * ldk64 + vofs; sv0 = *reinterpret_cast<const ATT_GAS bf16x8*>(vp_); sv1 = *reinterpret_cast<const ATT_GAS bf16x8*>(vp_ + ldk8); \
    sv2 = *reinterpret_cast<const ATT_GAS bf16x8*>(vp_ + 2 * ldk8); sv3 = *reinterpret_cast<const ATT_GAS bf16x8*>(vp_ + 3 * ldk8); sv4 = *reinterpret_cast<const ATT_GAS bf16x8*>(vp_ + 4 * ldk8); \
    sv5 = *reinterpret_cast<const ATT_GAS bf16x8*>(vp_ + 5 * ldk8); sv6 = *reinterpret_cast<const ATT_GAS bf16x8*>(vp_ + 6 * ldk8); sv7 = *reinterpret_cast<const ATT_GAS bf16x8*>(vp_ + 7 * ldk8); } while (0)
#define PWRITEK(b) do { char* kb_ = lds + PU_K0 + (b) * 16384; *(bf16x8*)(kb_ + ksw0) = sk0; *(bf16x8*)(kb_ + ksw1) = sk1; *(bf16x8*)(kb_ + ksw2) = sk2; *(bf16x8*)(kb_ + ksw3) = sk3; } while (0)
#define PWRITEV(b) do { char* vb_ = lds + PU_V0 + (b) * 32768 + vhalf; *(bf16x8*)(vb_ + v_st(vr, vcc)) = sv0; *(bf16x8*)(vb_ + v_st(vr + 8, vcc)) = sv1; *(bf16x8*)(vb_ + v_st(vr + 16, vcc)) = sv2; \
    *(bf16x8*)(vb_ + v_st(vr + 24, vcc)) = sv3; *(bf16x8*)(vb_ + v_st(vr + 32, vcc)) = sv4; *(bf16x8*)(vb_ + v_st(vr + 40, vcc)) = sv5; *(bf16x8*)(vb_ + v_st(vr + 48, vcc)) = sv6; \
    *(bf16x8*)(vb_ + v_st(vr + 56, vcc)) = sv7; } while (0)
#define SYNC_ONLY() do { asm volatile("s_waitcnt lgkmcnt(0)" ::: "memory"); __syncthreads(); } while (0)
    unsigned kdo[4];
#pragma unroll
    for (int i = 0; i < 4; ++i) { const int row = 16 * pr + 4 * i + (lane >> 4); kdo[i] = (unsigned)(row * a.ldk * 2 + (((lane & 15) ^ (row & 7)) * 16)); }
#define KDMA(t, b) do { const ATT_GAS char* kt_ = Kc + (long)(kt0 + (t)) * ldk64; ATT_LAS unsigned char* kd_ = ldsl + PU_K0 + (b) * 16384 + pr * 4096;                    \
      _Pragma("unroll") for (int i_ = 0; i_ < 4; ++i_)                                                                                            \
        __builtin_amdgcn_global_load_lds((const unsigned*)(const char*)(kt_ + kdo[i_]), (ATT_LAS unsigned*)(kd_ + i_ * 1024), 16, 0, 0); } while (0)
    if (pr == 0 && lane < 8) FL[lane] = 0.f;
  if (role == 0) {
    SYNC_ONLY();
    bf16x8 qr[8]; float l_reg = 0.f; const float nmc = -a.m0 * (SCALE * 1.4426950408889634f);
    const ATT_GAS bf16* Qw = a.Q + (long)(pr * QBLK + r32) * a.ldq + hi * 8;
#pragma unroll
    for (int d0 = 0; d0 < 8; ++d0) qr[d0] = *reinterpret_cast<const ATT_GAS bf16x8*>(Qw + d0 * 16);
    asm volatile("" : "+v"(qr[0]), "+v"(qr[1]), "+v"(qr[2]), "+v"(qr[3]), "+v"(qr[4]), "+v"(qr[5]), "+v"(qr[6]), "+v"(qr[7]));
    const float qf = (float)(a.q0 + pr * QBLK + r32), nsl = a.nsl; const int qw0 = a.q0 + pr * QBLK;
    const int kb0 = (int)(uintptr_t)(lds + PU_K0) + r32 * 256;
    int kx[8];
#pragma unroll
    for (int d0 = 0; d0 < 8; ++d0) kx[d0] = ((d0 * 16 + hi * 8) * 2) ^ ((r32 & 7) << 4);
#define SSTEP(t, TP) do { SBAR();                                                                                                      \
      if ((t) < NT) {                                                                                                                             \
        f32x16 p0, p1; const int k0_ = (kt0 + (t)) * KVBLK; const float kf0_ = (float)(k0_ + 4 * hi);                                             \
        const int side_ = (k0_ + KVBLK - 1 < qw0) ? 1 : ((k0_ > qw0 + QBLK - 1) ? -1 : 0);                                                        \
        __builtin_amdgcn_s_setprio(2); qkt_pipe(p0, p1, kb0 + (TP) * 16384, kx, qr, qf - kf0_, nsl, side_); __builtin_amdgcn_s_setprio(0);         \
        bf16x8 pa0, pa1, pa2, pa3; staticSM(p0, p1, nmc, l_reg, pa0, pa1, pa2, pa3);                                                            \
        const int sc_ = (TP) * 4 + pr; char* ps_ = lds + PU_PS + sc_ * 4096 + lane * 16;                                                          \
        *(bf16x8*)(ps_) = pa0; *(bf16x8*)(ps_ + 1024) = pa1; *(bf16x8*)(ps_ + 2048) = pa2; *(bf16x8*)(ps_ + 3072) = pa3;                         \
      }                                                                                                                                           \
      SBAR(); SYNC_ONLY(); } while (0)
    for (int t = 0; t <= NT; t += 2) { SSTEP(t, 0); if (t + 1 <= NT) SSTEP(t + 1, 1); }
#undef SSTEP
    if (hi == 0) LL[pr * 32 + r32] = l_reg;
    asm volatile("s_waitcnt lgkmcnt(0)" ::: "memory"); __syncthreads();
  } else {
    f32x16 o[8] = {};
    const int vb0 = (int)(uintptr_t)(lds + PU_V0) + v_rd_base(lane);
    const int ps0 = (int)(uintptr_t)(lds + PU_PS) + lane * 16, fl0 = (int)(uintptr_t)FL;
    unsigned vdo[4];
#pragma unroll
    for (int i = 0; i < 4; ++i) { const int blk = 8 * pr + 2 * i + (lane >> 5), kk = (blk >> 2) * 8 + ((lane & 31) >> 2), k = (kk & ~0xC) | ((kk & 4) << 1) | ((kk & 8) >> 1);
        vdo[i] = (unsigned)((k * a.ldk + (blk & 3) * 32 + (lane & 3) * 8) * 2); }
#define VDMA(t, b) do { const ATT_GAS char* vt_ = Vc + (long)(kt0 + (t)) * ldk64; ATT_LAS unsigned char* vd_ = ldsl + PU_V0 + (b) * 32768 + pr * 4096;                  \
      _Pragma("unroll") for (int h_ = 0; h_ < 2; ++h_) _Pragma("unroll") for (int i_ = 0; i_ < 4; ++i_)                                           \
        __builtin_amdgcn_global_load_lds((const unsigned*)(const char*)(vt_ + vdo[i_] + h_ * 256), (ATT_LAS unsigned*)(vd_ + h_ * 16384 + i_ * 1024), 16, 0, 0); } while (0)
    KDMA(0, 0); asm volatile("s_waitcnt vmcnt(0)" ::: "memory");
    SYNC_ONLY();
#define VSTEP(t, TP) do { if ((t) + 1 < NT) KDMA((t) + 1, (TP) ^ 1); if ((t) < NT) VDMA(t, TP); SBAR();                                                                                      \
      if ((t) >= 1) {                                                                                                                             \
        const int sp_ = ((TP) ^ 1) * 4 + pr;                                                                                                      \
        pv8_pipe(o, vb0 + ((TP) ^ 1) * 32768, ps0 + sp_ * 4096, fl0 + sp_ * 4, AL + sp_ * 32, hi);                                                \
      }                                                                                                                                           \
      SBAR(); asm volatile("s_waitcnt vmcnt(0)" ::: "memory"); SYNC_ONLY(); } while (0)
    for (int t = 0; t <= NT; t += 2) { VSTEP(t, 0); if (t + 1 <= NT) VSTEP(t + 1, 1); }
#undef VSTEP
#undef VDMA
#undef KDMA
    asm volatile("s_waitcnt lgkmcnt(0)" ::: "memory"); __syncthreads();
    float rli[16];
#pragma unroll
    for (int r = 0; r < 16; ++r) rli[r] = __builtin_amdgcn_rcpf(LL[pr * 32 + crow(r, hi)]);
    ATT_GAS bf16* Ow = a.O + (long)(pr * QBLK) * a.ldo;
#pragma unroll
    for (int r = 0; r < 16; ++r) { const int orow = crow(r, hi);
#pragma unroll
      for (int d0 = 0; d0 < 8; ++d0) { const float v = o[d0][r] * rli[r]; Ow[(long)orow * a.ldo + d0 * 32 + r32] = (bf16)(cvtpk(v, v) & 0xffffu); } }
  }
  __syncthreads();
#undef PLOADK
#undef PLOADV
#undef PWRITEK
#undef PWRITEV
#undef SYNC_ONLY
}
#undef KSWZ
#undef SBAR
}
constexpr int DM = 2048, BATCH = 2, SEQ = 4096, DEPTH = 4, M = BATCH * SEQ;
constexpr int AB_IN = 3584, AB_OUT = 1024, C_IN = 6144, DFF = 5504, UPW = 2 * DFF, MODW = 6 * DM;
constexpr float EPS = 1e-6f;
constexpr int NWAVES = 8;
constexpr size_t MiB = 1u << 20;
constexpr size_t WS_CTL = 0, CTL_ZERO_BYTES = 256 * 1024;
constexpr size_t WS_MOD = 2 * MiB;
constexpr size_t WS_PART = 3 * MiB;
constexpr size_t WS_NRM = 12 * MiB;
constexpr size_t WS_WABIN = 16 * MiB;
constexpr size_t WS_WABOUT = 44 * MiB;
constexpr size_t WS_WCIN = 52 * MiB;
constexpr size_t WS_WCOUT = 100 * MiB;
constexpr size_t WS_WUP = 116 * MiB;
constexpr size_t WS_WDOWN = 288 * MiB;
constexpr size_t WS_H = 376 * MiB;
constexpr size_t WS_PROJ = 408 * MiB;
constexpr size_t WS_ATT = 504 * MiB;
constexpr size_t WS_LSE = WS_ATT + 64 * MiB;
constexpr size_t WS_O = 632 * MiB;
constexpr size_t WS_Y = 664 * MiB;
constexpr size_t WS_XCH = 736 * MiB;
constexpr size_t WS_HG = 728 * MiB;
constexpr size_t WS_HU = 732 * MiB;
constexpr size_t WS_ACT = 900 * MiB;
constexpr size_t WS_END = 986 * MiB;
static_assert(WS_PART + (size_t)DEPTH * 16 * BATCH * MODW * 4 <= WS_WABIN, "ws map");
static_assert(WS_WABIN + (size_t)2 * AB_IN * DM * 2 <= WS_WABOUT && WS_WABOUT + (size_t)2 * DM * AB_OUT * 2 <= WS_WCIN, "ws map");
static_assert(WS_WCIN + (size_t)2 * C_IN * DM * 2 <= WS_WCOUT && WS_WCOUT + (size_t)2 * DM * DM * 2 <= WS_WUP, "ws map");
static_assert(WS_WUP + (size_t)4 * UPW * DM * 2 <= WS_WDOWN && WS_WDOWN + (size_t)4 * DM * DFF * 2 <= WS_H, "ws map");
static_assert(WS_H + (size_t)M * DM * 2 <= WS_PROJ && WS_PROJ + (size_t)M * C_IN * 2 <= WS_ATT && WS_ATT + (size_t)2 * M * DM * 4 <= WS_O, "ws map");
static_assert(WS_ATT + (size_t)3 * M * 512 * 4 <= WS_LSE && WS_LSE + (size_t)3 * M * 4 * 4 <= WS_O, "ws map");
static_assert(WS_O + (size_t)M * DM * 2 <= WS_Y && WS_Y + (size_t)M * DM * 4 <= WS_HG && WS_HG + (size_t)(M / 256) * 4 * DFF * 4 <= WS_HU && WS_HU + (size_t)(M / 256) * 2 * DFF * 4 <= WS_ACT && WS_ACT + (size_t)M * DFF * 2 <= WS_END, "ws map");
constexpr int CW_CNT = 16384;
constexpr int CW_BAR = 4096;
constexpr int RING_OFF = 0, RING_BYTES = 131072;
constexpr int LDSCTL_OFF = RING_BYTES, MISC_OFF = LDSCTL_OFF + 320, BND_OFF = LDSCTL_OFF + 1024;
constexpr int LDS_BYTES = 147456;
static_assert(att::SHM_ATTN <= RING_BYTES && att::PU_LDS <= RING_BYTES, "attention LDS fits the ring region");

#define GAS __attribute__((address_space(1)))
#define LAS __attribute__((address_space(3)))
typedef unsigned short bf16;
typedef unsigned v4u __attribute__((ext_vector_type(4)));
typedef unsigned v2u __attribute__((ext_vector_type(2)));
typedef float f32x4 __attribute__((ext_vector_type(4)));
typedef GAS unsigned gu32;
#define LDS_WAIT() asm volatile("s_waitcnt lgkmcnt(0)" ::: "memory")
__device__ __forceinline__ unsigned pk2(float lo, float hi) { unsigned r; asm volatile("v_cvt_pk_bf16_f32 %0, %1, %2" : "=v"(r) : "v"(lo), "v"(hi)); return r; }
__device__ __forceinline__ float bf_lo(unsigned w) { return __uint_as_float(w << 16); }
__device__ __forceinline__ float bf_hi(unsigned w) { return __uint_as_float(w & 0xffff0000u); }
#define XB_TMO      128
#define XB_XCNT(j)  (256  + 64 * (j))
#define XB_XSUB(j)  (1280 + 64 * (j))
#define XB_XGEN(j)  (2304 + 64 * (j))
#define XB_TOP      3328
#define XB_TOPGEN   3392
#define XCD_BAR_WORDS 3456
#define XB_SPIN_CAP (1u << 18)

__device__ __forceinline__ unsigned xb_ld(unsigned* p)              { return __hip_atomic_load(p, __ATOMIC_RELAXED, __HIP_MEMORY_SCOPE_AGENT); }
__device__ __forceinline__ unsigned xb_add(unsigned* p, unsigned v) { return __hip_atomic_fetch_add(p, v, __ATOMIC_RELAXED, __HIP_MEMORY_SCOPE_AGENT); }
__device__ __forceinline__ unsigned xb_xcc_id() { return (unsigned)__builtin_amdgcn_s_getreg((3 << 11) | 20) & 0xFu; }
#define XB_SPIN(cond, bar) do { unsigned _sp = 0; while (cond) { __builtin_amdgcn_s_sleep(1); \
    if ((++_sp & 255u) == 0u) { if (xb_ld(&(bar)[XB_TMO])) break; if (_sp > XB_SPIN_CAP) { atomicAdd(&(bar)[XB_TMO], 1u); break; } } } } while (0)

struct XcdBarrier {
    int tid;
    unsigned* bar; unsigned x;
    volatile LAS unsigned* st;
};

__device__ __forceinline__ XcdBarrier xcd_barrier_post(unsigned* bar, volatile LAS unsigned* st) {
    XcdBarrier b; b.tid = (int)threadIdx.x; b.bar = bar; b.x = xb_xcc_id(); b.st = st;
    if (threadIdx.x == 0) (void)xb_add(&bar[XB_XCNT(b.x)], 1u);
    return b;
}
__device__ __forceinline__ void xcd_barrier_complete(unsigned* bar, unsigned x, unsigned& nloc, unsigned& nx) {
    const unsigned G = gridDim.x * gridDim.y * gridDim.z;
    unsigned sum, cnt, mine, sp = 0u;
    for (;;) {
        sum = 0u; cnt = 0u; mine = 0u;
#pragma unroll
        for (unsigned j = 0; j < 16; ++j) { const unsigned c = xb_ld(&bar[XB_XCNT(j)]); sum += c; cnt += (c > 0u) ? 1u : 0u; mine = (j == x) ? c : mine; }
        if (sum == G) break;
        __builtin_amdgcn_s_sleep(1);
        if ((++sp & 255u) == 0u) { if (xb_ld(&bar[XB_TMO])) break; if (sp > XB_SPIN_CAP) { atomicAdd(&bar[XB_TMO], 1u); break; } }
    }
    nloc = mine > 0u ? mine : 1u; nx = cnt > 0u ? cnt : 1u;
}

__device__ __forceinline__ void xcd_barrier(const XcdBarrier& b) {
    asm volatile("s_waitcnt vmcnt(0)" ::: "memory");
    __syncthreads();
    if (b.tid == 0) {
        unsigned* bar = b.bar;
        __builtin_amdgcn_s_waitcnt(0);
        unsigned nloc = b.st[0], nx = b.st[1];
        if (nloc == 0u) { xcd_barrier_complete(bar, b.x, nloc, nx); b.st[0] = nloc; b.st[1] = nx; }
        const unsigned old = xb_add(&bar[XB_XSUB(b.x)], 1u);
        const unsigned gen = old / nloc;
        if (old + 1u == (gen + 1u) * nloc) {
            __builtin_amdgcn_fence(__ATOMIC_RELEASE, "agent");
            asm volatile("s_waitcnt vmcnt(0)" ::: "memory");
            const unsigned og = xb_add(&bar[XB_TOP], 1u);
            const unsigned tg = og / nx;
            if (og + 1u == (tg + 1u) * nx) xb_add(&bar[XB_TOPGEN], 1u);
            else XB_SPIN(xb_ld(&bar[XB_TOPGEN]) == tg, bar);
            __builtin_amdgcn_fence(__ATOMIC_ACQUIRE, "agent");
            xb_add(&bar[XB_XGEN(b.x)], 1u);
            asm volatile("s_waitcnt vmcnt(0)" ::: "memory");
        } else {
            XB_SPIN(xb_ld(&bar[XB_XGEN(b.x)]) == gen, bar);
            __builtin_amdgcn_fence(__ATOMIC_ACQUIRE, "agent");
            asm volatile("s_waitcnt vmcnt(0)" ::: "memory");
        }
    }
    __syncthreads();
}
struct Frame {
    LAS unsigned char* lds; char* ldsg;
    int wave, G, gw, NGW;
    const float *x, *c, *ada_w, *ada_b, *norm_g, *ab_w_in, *ab_w_out, *a_sink, *c_w_in, *c_w_out, *c_lambda, *c_subln_g, *w_up, *conv_w, *conv_b, *w_down;
    float* out; unsigned char* ws;
};
#define PHASE_IDS() const int lane = lane_now(), wave = F.wave, tid = wave * 64 + lane, gw = (int)blockIdx.x * NWAVES + wave; (void)tid; (void)gw
template <int CTRL> __device__ __forceinline__ float dppf(float x) { return __builtin_bit_cast(float, __builtin_amdgcn_mov_dpp(__builtin_bit_cast(int, x), CTRL, 0xf, 0xf, true)); }
__device__ __forceinline__ float row16_sum(float v) { v += dppf<0xB1>(v); v += dppf<0x4E>(v); v += dppf<0x141>(v); v += dppf<0x140>(v); return v; }
__device__ __forceinline__ float wave_sum(float v) { v = row16_sum(v); v += swz_xor16(v); return sum_xor32(v); }
struct TrDesc { const float* W; bf16* WT; int K, N, item, remap; };
__device__ __forceinline__ void transpose_load(const TrDesc& d, f32x4 (&w)[8], int lane) {
    const int nblk = d.N / 32, kb = d.item / nblk, nb = d.item % nblk, k0 = 64 * kb, n0 = 32 * nb;
#pragma unroll
    for (int i = 0; i < 8; ++i) w[i] = __builtin_nontemporal_load((const f32x4*)(d.W + (size_t)(k0 + (lane >> 3) + 8 * i) * d.N + n0 + (lane & 7) * 4));
}
__device__ __forceinline__ void transpose_finish(const TrDesc& d, const f32x4 (&w)[8], LAS float* scr, int lane) {
    const int nblk = d.N / 32, kb = d.item / nblk, nb = d.item % nblk, k0 = 64 * kb, n0 = 32 * nb;
    int d0 = n0; if (d.remap) { const int isup = n0 >= DFF, c0 = n0 - isup * DFF; d0 = (c0 >> 7) * 256 + isup * 128 + (c0 & 127); }
#pragma unroll
    for (int i = 0; i < 8; ++i) { LAS float* q = scr + ((lane >> 3) + 8 * i) * 33 + (lane & 7) * 4; q[0] = w[i].x; q[1] = w[i].y; q[2] = w[i].z; q[3] = w[i].w; }
    LDS_WAIT(); asm volatile("" ::: "memory");
    const int c = lane & 7;
#pragma unroll
    for (int j = 0; j < 4; ++j) { const int n = (lane >> 3) + 8 * j; const LAS float* s = scr + (8 * c) * 33 + n;
        v4u o; o.x = pk2(s[0 * 33], s[1 * 33]); o.y = pk2(s[2 * 33], s[3 * 33]); o.z = pk2(s[4 * 33], s[5 * 33]); o.w = pk2(s[6 * 33], s[7 * 33]);
        *(GAS v4u*)(d.WT + (size_t)(d0 + n) * d.K + k0 + 8 * c) = o; }
    LDS_WAIT(); asm volatile("" ::: "memory");
}
__device__ __forceinline__ void transpose_item(const float* W, int K, int N, bf16* WT, LAS float* scr, int item, int lane, int remap = 0) {
    TrDesc d; d.W = W; d.WT = WT; d.K = K; d.N = N; d.item = item; d.remap = remap;
    f32x4 w[8]; transpose_load(d, w, lane); transpose_finish(d, w, scr, lane);
}
__device__ __forceinline__ float silu_f(float v) { return v / (1.f + __expf(-v)); }

__device__ __forceinline__ void p0a_prologue(Frame& F) {
    PHASE_IDS();
    LAS float* scr = (LAS float*)(F.lds + RING_OFF + wave * 16384);
    constexpr int I_ABIN = (DM / 64) * (AB_IN / 32), I_ABOUT = (AB_OUT / 64) * (DM / 32), I_CIN = (DM / 64) * (C_IN / 32), I_COUT = (DM / 64) * (DM / 32),
                  I_UP = (DM / 64) * (UPW / 32), I_DOWN = (DFF / 64) * (DM / 32);
    const int nffn = (F.G == 256) ? 1 : 4;
    const int ncin = (F.G == 256) ? 0 : 2;
    const int NT_ITEMS = 2 * I_ABIN + 2 * I_ABOUT + ncin * I_CIN + 2 * I_COUT + nffn * I_UP + nffn * I_DOWN;
    bf16* wabin = (bf16*)(F.ws + WS_WABIN); bf16* wabout = (bf16*)(F.ws + WS_WABOUT); bf16* wcin = (bf16*)(F.ws + WS_WCIN); bf16* wcout = (bf16*)(F.ws + WS_WCOUT);
    bf16* wup = (bf16*)(F.ws + WS_WUP); bf16* wdown = (bf16*)(F.ws + WS_WDOWN);
    auto decode = [&](int r) -> TrDesc {
        TrDesc d; d.remap = 0;
        if (r < 2 * I_ABIN) { const int j = r / I_ABIN; d.W = F.ab_w_in + (size_t)j * DM * AB_IN; d.K = DM; d.N = AB_IN; d.WT = wabin + (size_t)j * AB_IN * DM; d.item = r % I_ABIN; return d; } r -= 2 * I_ABIN;
        if (r < 2 * I_ABOUT) { const int j = r / I_ABOUT; d.W = F.ab_w_out + (size_t)j * AB_OUT * DM; d.K = AB_OUT; d.N = DM; d.WT = wabout + (size_t)j * DM * AB_OUT; d.item = r % I_ABOUT; return d; } r -= 2 * I_ABOUT;
        if (r < ncin * I_CIN) { const int j = r / I_CIN; d.W = F.c_w_in + (size_t)j * DM * C_IN; d.K = DM; d.N = C_IN; d.WT = wcin + (size_t)j * C_IN * DM; d.item = r % I_CIN; return d; } r -= ncin * I_CIN;
        if (r < 2 * I_COUT) { const int j = r / I_COUT; d.W = F.c_w_out + (size_t)j * DM * DM; d.K = DM; d.N = DM; d.WT = wcout + (size_t)j * DM * DM; d.item = r % I_COUT; return d; } r -= 2 * I_COUT;
        if (r < nffn * I_UP) { const int j = r / I_UP; d.W = F.w_up + (size_t)j * DM * UPW; d.K = DM; d.N = UPW; d.WT = wup + (size_t)j * UPW * DM; d.item = r % I_UP; d.remap = 1; return d; } r -= nffn * I_UP;
        { const int j = r / I_DOWN; d.W = F.w_down + (size_t)j * DFF * DM; d.K = DFF; d.N = DM; d.WT = wdown + (size_t)j * DM * DFF; d.item = r % I_DOWN; return d; }
    };
    {
        const int n_my = (NT_ITEMS - gw + F.NGW - 1) / F.NGW;
        f32x4 wa[8], wb[8];
        TrDesc da = decode(gw), db;
        transpose_load(da, wa, lane);
        for (int j = 0; j < n_my; j += 2) {
            db = decode(gw + min(j + 1, n_my - 1) * F.NGW); transpose_load(db, wb, lane);
            transpose_finish(da, wa, scr, lane);
            da = decode(gw + min(j + 2, n_my - 1) * F.NGW); transpose_load(da, wa, lane);
            if (j + 1 < n_my) transpose_finish(db, wb, scr, lane);
        }
    }
    float* part = (float*)(F.ws + WS_PART);
    constexpr int NCH = MODW / 256, NKC = 16, KCH = DM / NKC;
    for (int it = gw; it < DEPTH * NCH * NKC; it += F.NGW) {
        const int nch = it % NCH, kc = (it / NCH) % NKC, l = it / (NKC * NCH), k0 = kc * KCH;
        const float c0a = silu_f(F.c[k0 + lane]), c0b = silu_f(F.c[k0 + 64 + lane]), c1a = silu_f(F.c[DM + k0 + lane]), c1b = silu_f(F.c[DM + k0 + 64 + lane]);
        const float* wp = F.ada_w + ((size_t)l * DM + k0) * MODW + nch * 256 + 4 * lane;
        f32x4 a0 = {0.f, 0.f, 0.f, 0.f}, a1 = {0.f, 0.f, 0.f, 0.f};
#pragma unroll 16
        for (int k = 0; k < 64; ++k) { const f32x4 w = __builtin_nontemporal_load((const f32x4*)(wp + (size_t)k * MODW)); const float s0 = __builtin_bit_cast(float, __builtin_amdgcn_readlane(__builtin_bit_cast(int, c0a), k)), s1 = __builtin_bit_cast(float, __builtin_amdgcn_readlane(__builtin_bit_cast(int, c1a), k)); a0 += w * s0; a1 += w * s1; }
#pragma unroll 16
        for (int k = 0; k < 64; ++k) { const f32x4 w = __builtin_nontemporal_load((const f32x4*)(wp + (size_t)(64 + k) * MODW)); const float s0 = __builtin_bit_cast(float, __builtin_amdgcn_readlane(__builtin_bit_cast(int, c0b), k)), s1 = __builtin_bit_cast(float, __builtin_amdgcn_readlane(__builtin_bit_cast(int, c1b), k)); a0 += w * s0; a1 += w * s1; }
        float* pp = part + (((size_t)l * NKC + kc) * BATCH) * MODW + nch * 256 + 4 * lane;
        *(f32x4*)pp = a0; *(f32x4*)(pp + MODW) = a1;
    }
}
template <class Dec>
__device__ __forceinline__ void transpose_stream(int it0, int stride, int n_items, LAS float* scr, int lane, Dec decode) {
    if (it0 >= n_items) return;
    const int n_my = (n_items - it0 + stride - 1) / stride;
    f32x4 wa[8], wb[8];
    TrDesc da = decode(it0), db;
    transpose_load(da, wa, lane);
    for (int j = 0; j < n_my; j += 2) {
        db = decode(it0 + min(j + 1, n_my - 1) * stride); transpose_load(db, wb, lane);
        transpose_finish(da, wa, scr, lane);
        da = decode(it0 + min(j + 2, n_my - 1) * stride); transpose_load(da, wa, lane);
        if (j + 1 < n_my) transpose_finish(db, wb, scr, lane);
    }
}
__device__ __forceinline__ void tail_convert_ffn(Frame& F, int ln, int first, int nidle) {
    PHASE_IDS();
    if ((int)blockIdx.x < first) return;
    LAS float* scr = (LAS float*)(F.lds + RING_OFF + wave * 16384);
    constexpr int I_UP = (DM / 64) * (UPW / 32), I_DOWN = (DFF / 64) * (DM / 32);
    bf16* wup = (bf16*)(F.ws + WS_WUP) + (size_t)ln * UPW * DM; bf16* wdown = (bf16*)(F.ws + WS_WDOWN) + (size_t)ln * DM * DFF;
    const float* su = F.w_up + (size_t)ln * DM * UPW; const float* sd = F.w_down + (size_t)ln * DFF * DM;
    transpose_stream(((int)blockIdx.x - first) * NWAVES + wave, nidle * NWAVES, I_UP + I_DOWN, scr, lane, [&](int it) -> TrDesc {
        TrDesc d; if (it < I_UP) { d.W = su; d.WT = wup; d.K = DM; d.N = UPW; d.item = it; d.remap = 1; } else { d.W = sd; d.WT = wdown; d.K = DFF; d.N = DM; d.item = it - I_UP; d.remap = 0; } return d; });
}
__device__ __forceinline__ void tail_convert_cin(Frame& F, int j, int first, int nidle) {
    PHASE_IDS();
    if ((int)blockIdx.x < first) return;
    LAS float* scr = (LAS float*)(F.lds + RING_OFF + wave * 16384);
    constexpr int I_CIN = (DM / 64) * (C_IN / 32);
    bf16* wcin = (bf16*)(F.ws + WS_WCIN) + (size_t)j * C_IN * DM; const float* sc = F.c_w_in + (size_t)j * DM * C_IN;
    transpose_stream(((int)blockIdx.x - first) * NWAVES + wave, nidle * NWAVES, I_CIN, scr, lane, [&](int it) -> TrDesc {
        TrDesc d; d.W = sc; d.WT = wcin; d.K = DM; d.N = C_IN; d.item = it; d.remap = 0; return d; });
}
__device__ __forceinline__ void p0b_modreduce(Frame& F) {
    PHASE_IDS();
    const float* part = (const float*)(F.ws + WS_PART); float* mod = (float*)(F.ws + WS_MOD);
    for (int i = blockIdx.x * (NWAVES * 64) + tid; i < DEPTH * BATCH * MODW; i += F.G * NWAVES * 64) {
        const int n = i % MODW, b = (i / MODW) % BATCH, l = i / (MODW * BATCH);
        float s = F.ada_b[l * MODW + n];
#pragma unroll
        for (int kc = 0; kc < 16; ++kc) s += part[(((size_t)l * 16 + kc) * BATCH + b) * MODW + n];
        mod[i] = s;
    }
}
__device__ __forceinline__ void rows_pre(Frame& F, const float* x, const float* ng, const float* scale, const float* shift, bf16* H, _Float16* XB  ) {
    PHASE_IDS();
    for (int m = gw; m < M; m += F.NGW) {
        const int b = m / SEQ; f32x4 v[8]; float ss = 0.f;
#pragma unroll
        for (int j = 0; j < 8; ++j) { v[j] = *(const f32x4*)(x + (size_t)m * DM + 4 * lane + 256 * j); ss += (v[j].x * v[j].x + v[j].y * v[j].y) + (v[j].z * v[j].z + v[j].w * v[j].w); }
        const float r = 1.f / sqrtf(wave_sum(ss) * (1.f / DM) + EPS);
#pragma unroll
        for (int j = 0; j < 8; ++j) { const int c = 4 * lane + 256 * j;
            const f32x4 g = *(const f32x4*)(ng + c), sc = *(const f32x4*)(scale + (size_t)b * MODW + c), sh = *(const f32x4*)(shift + (size_t)b * MODW + c);
            const f32x4 h = (v[j] * r) * g * (sc + 1.f) + sh;
            v2u o; o.x = pk2(h.x, h.y); o.y = pk2(h.z, h.w); *(v2u*)(H + (size_t)m * DM + c) = o;
            if (XB) { typedef _Float16 xh4 __attribute__((ext_vector_type(4))); const xh4 q = {(_Float16)v[j].x, (_Float16)v[j].y, (_Float16)v[j].z, (_Float16)v[j].w}; *(xh4*)(XB + (size_t)m * DM + c) = q; } }
    }
}
__device__ __forceinline__ void rows_post(Frame& F, const bf16* Y, const float* xs, float* xd, const float* gate, const float* nga,
                                          const float* ngb, const float* scale, const float* shift, bf16* H, bool doH) {
    PHASE_IDS();
    for (int m0 = gw; m0 < M; m0 += 2 * F.NGW) {
        const int m1 = m0 + F.NGW;
        const bool two = m1 < M; const int mm[2] = {m0, two ? m1 : m0};
        v2u yw[2][8]; f32x4 xv[2][8];
#pragma unroll
        for (int q = 0; q < 2; ++q)
#pragma unroll
            for (int j = 0; j < 8; ++j) { yw[q][j] = *(const v2u*)(Y + (size_t)mm[q] * DM + 4 * lane + 256 * j); xv[q][j] = *(const f32x4*)(xs + (size_t)mm[q] * DM + 4 * lane + 256 * j); }
        f32x4 v[2][8]; float ss[2] = {0.f, 0.f};
#pragma unroll
        for (int q = 0; q < 2; ++q)
#pragma unroll
            for (int j = 0; j < 8; ++j) { v[q][j] = (f32x4){bf_lo(yw[q][j].x), bf_hi(yw[q][j].x), bf_lo(yw[q][j].y), bf_hi(yw[q][j].y)};
                ss[q] += (v[q][j].x * v[q][j].x + v[q][j].y * v[q][j].y) + (v[q][j].z * v[q][j].z + v[q][j].w * v[q][j].w); }
        float r[2], ss2[2] = {0.f, 0.f};
#pragma unroll
        for (int q = 0; q < 2; ++q) r[q] = 1.f / sqrtf(wave_sum(ss[q]) * (1.f / DM) + EPS);
#pragma unroll
        for (int q = 0; q < 2; ++q) { const int b = mm[q] / SEQ;
#pragma unroll
            for (int j = 0; j < 8; ++j) { const int c = 4 * lane + 256 * j;
                const f32x4 g = *(const f32x4*)(gate + (size_t)b * MODW + c), na = *(const f32x4*)(nga + c);
                v[q][j] = xv[q][j] + g * ((v[q][j] * r[q]) * na);
                ss2[q] += (v[q][j].x * v[q][j].x + v[q][j].y * v[q][j].y) + (v[q][j].z * v[q][j].z + v[q][j].w * v[q][j].w);
                if (q == 0 || two) *(f32x4*)(xd + (size_t)mm[q] * DM + c) = v[q][j]; } }
        if (doH) {
#pragma unroll
            for (int q = 0; q < 2; ++q) { const int b = mm[q] / SEQ; const float r2 = 1.f / sqrtf(wave_sum(ss2[q]) * (1.f / DM) + EPS);
#pragma unroll
                for (int j = 0; j < 8; ++j) { const int c = 4 * lane + 256 * j;
                    const f32x4 g = *(const f32x4*)(ngb + c), sc = *(const f32x4*)(scale + (size_t)b * MODW + c), sh = *(const f32x4*)(shift + (size_t)b * MODW + c);
                    const f32x4 h = (v[q][j] * r2) * g * (sc + 1.f) + sh;
                    v2u o; o.x = pk2(h.x, h.y); o.y = pk2(h.z, h.w); if (q == 0 || two) *(v2u*)(H + (size_t)mm[q] * DM + c) = o; } }
        }
    }
}
__device__ __forceinline__ void rows_subln(Frame& F, const bf16* A0, const bf16* A1, const float* lamp, const float* sg, float lambda_init, bf16* O) {
    PHASE_IDS();
    const float l0 = lamp[lane] * lamp[128 + lane] + lamp[64 + lane] * lamp[128 + 64 + lane];
    const float l1 = lamp[256 + lane] * lamp[384 + lane] + lamp[256 + 64 + lane] * lamp[384 + 64 + lane];
    const float lam = __expf(wave_sum(l0)) - __expf(wave_sum(l1)) + lambda_init;
    const f32x4 g = *(const f32x4*)(sg + 4 * lane) * (1.f - lambda_init);
    for (int m0 = gw; m0 < M; m0 += 2 * F.NGW) {
        const int m1 = m0 + F.NGW; const bool two = m1 < M; const int mm[2] = {m0, two ? m1 : m0};
        v2u a0[2][8], a1[2][8];
#pragma unroll
        for (int q = 0; q < 2; ++q)
#pragma unroll
            for (int j = 0; j < 8; ++j) { const size_t off = (size_t)mm[q] * DM + 4 * lane + 256 * j; a0[q][j] = *(const v2u*)(A0 + off); a1[q][j] = *(const v2u*)(A1 + off); }
#pragma unroll
        for (int q = 0; q < 2; ++q)
#pragma unroll
            for (int j = 0; j < 8; ++j) { const size_t off = (size_t)mm[q] * DM + 4 * lane + 256 * j;
                const f32x4 x0 = {bf_lo(a0[q][j].x), bf_hi(a0[q][j].x), bf_lo(a0[q][j].y), bf_hi(a0[q][j].y)}, x1 = {bf_lo(a1[q][j].x), bf_hi(a1[q][j].x), bf_lo(a1[q][j].y), bf_hi(a1[q][j].y)};
                const f32x4 d = x0 - x1 * lam;
                const float ss = wave_sum((d.x * d.x + d.y * d.y) + (d.z * d.z + d.w * d.w));
                const float r = 1.f / sqrtf(ss * (1.f / 256.f) + EPS);
                const f32x4 h = (d * r) * g;
                v2u o; o.x = pk2(h.x, h.y); o.y = pk2(h.z, h.w); if (q == 0 || two) *(v2u*)(O + off) = o; }
    }
}
__device__ __forceinline__ void rows_bmerge(Frame& F, const bf16* OB, const float* LSE, bf16* O) {
    PHASE_IDS();
    const int hb = lane >> 4;
    for (int m0 = gw; m0 < M; m0 += 2 * F.NGW) {
        const int m1 = m0 + F.NGW; const bool two = m1 < M; const int mm[2] = {m0, two ? m1 : m0};
        float e[2][3]; v4u v[2][3];
#pragma unroll
        for (int q = 0; q < 2; ++q) { const int m = mm[q];
            e[q][0] = LSE[(size_t)m * 4 + hb]; e[q][1] = LSE[((size_t)M + m) * 4 + hb]; e[q][2] = LSE[((size_t)2 * M + m) * 4 + hb];
            const bf16* p = OB + (size_t)m * 512 + 8 * lane;
            v[q][0] = *(const v4u*)p; v[q][1] = *(const v4u*)(p + (size_t)M * 512); v[q][2] = *(const v4u*)(p + (size_t)2 * M * 512); }
#pragma unroll
        for (int q = 0; q < 2; ++q) {
            const float mx = fmaxf(e[q][0], fmaxf(e[q][1], e[q][2]));
            float w0 = __expf(e[q][0] - mx), w1 = __expf(e[q][1] - mx), w2 = __expf(e[q][2] - mx); const float inv = 1.f / (w0 + w1 + w2); w0 *= inv; w1 *= inv; w2 *= inv;
            v4u o;
#pragma unroll
            for (int c = 0; c < 4; ++c) { const float lo = bf_lo(v[q][0][c]) * w0 + bf_lo(v[q][1][c]) * w1 + bf_lo(v[q][2][c]) * w2, hi2 = bf_hi(v[q][0][c]) * w0 + bf_hi(v[q][1][c]) * w1 + bf_hi(v[q][2][c]) * w2; o[c] = pk2(lo, hi2); }
            if (q == 0 || two) *(v4u*)(O + (size_t)mm[q] * AB_OUT + 512 + 8 * lane) = o; }
    }
}
__device__ __forceinline__ float gelu_tanh(float v) {
    const float u = 0.7978845608028654f * (v + 0.044715f * v * v * v);
    const float e = __expf(2.f * u);
    const float t = 1.f - 2.f / (e + 1.f);
    return 0.5f * v * (1.f + t);
}
__device__ __forceinline__ void actfix_panel(Frame& F, int pm, const float* cw, const float* cb, bf16* ACT) {
    PHASE_IDS();
    const float* HG = (const float*)(F.ws + WS_HG); const float* HU = (const float*)(F.ws + WS_HU);
    constexpr int NC4 = DFF / 4;
    for (int it = tid; it < 2 * NC4; it += NWAVES * 64) {
        const int c = (it % NC4) * 4, side = it / NC4;
        const f32x4 z = {0.f, 0.f, 0.f, 0.f}; f32x4 gp, gc, gn, up; size_t row;
        if (side == 0) { gp = (pm % (SEQ / 256) == 0) ? z : *(const f32x4*)(HG + ((size_t)(pm - 1) * 4 + 3) * DFF + c); gc = *(const f32x4*)(HG + ((size_t)pm * 4 + 0) * DFF + c);
            gn = *(const f32x4*)(HG + ((size_t)pm * 4 + 1) * DFF + c); up = *(const f32x4*)(HU + ((size_t)pm * 2 + 0) * DFF + c); row = (size_t)pm * 256; }
        else { gp = *(const f32x4*)(HG + ((size_t)pm * 4 + 2) * DFF + c); gc = *(const f32x4*)(HG + ((size_t)pm * 4 + 3) * DFF + c);
            gn = (pm % (SEQ / 256) == SEQ / 256 - 1) ? z : *(const f32x4*)(HG + ((size_t)(pm + 1) * 4 + 0) * DFF + c); up = *(const f32x4*)(HU + ((size_t)pm * 2 + 1) * DFF + c); row = (size_t)pm * 256 + 255; }
        const f32x4 w0 = *(const f32x4*)(cw + c), w1 = *(const f32x4*)(cw + DFF + c), w2 = *(const f32x4*)(cw + 2 * DFF + c), bb = *(const f32x4*)(cb + c);
        float r[4];
#pragma unroll
        for (int i = 0; i < 4; ++i) r[i] = pg8::gelu_tanh_mul(fmaf(w0[i], gp[i], fmaf(w1[i], gc[i], fmaf(w2[i], gn[i], bb[i]))), up[i]);
        v2u o; o.x = pk2(r[0], r[1]); o.y = pk2(r[2], r[3]); *(v2u*)(ACT + row * DFF + c) = o;
    }
    asm volatile("s_waitcnt vmcnt(0)" ::: "memory"); __syncthreads();
}
__device__ __forceinline__ float alibi16(int i) { return exp2f(-0.5f * (float)(i + 1)); }
__device__ __forceinline__ void phase_attn_ab(Frame& F, int jl) {
    const bf16* P = (const bf16*)(F.ws + WS_PROJ); bf16* O = (bf16*)(F.ws + WS_O); bf16* OB = (bf16*)(F.ws + WS_ATT); float* LSE = (float*)(F.ws + WS_LSE);
    for (int u = blockIdx.x; u < 512; u += F.G) {
        att::UnitArgs a;
        if (u < 128) {
            const int qb = u % 16, qh = (u / 16) % 4, b = u / 64, q0 = qb * 256; const size_t row0 = (size_t)b * SEQ;
            a.Q = (const GAS bf16*)P + (row0 + q0) * AB_IN + qh * 128; a.ldq = AB_IN;
            a.K = (const GAS bf16*)P + row0 * AB_IN + 512 + (qh >> 1) * 128; a.V = (const GAS bf16*)P + row0 * AB_IN + 768 + (qh >> 1) * 128; a.ldk = AB_IN;
            a.q0 = q0; a.L = SEQ; a.kt0 = q0 / 64 - 2; a.nt = 8;
            a.nsl = -alibi16(qh) / att::SCALE; a.radius = 128.f; a.m_init = F.a_sink[jl * 4 + qh] / att::SCALE; a.l_init = 1.f;
            a.Of = nullptr; a.Ob = (GAS bf16*)O + (row0 + q0) * AB_OUT + qh * 128; a.ldo = AB_OUT; a.lse = nullptr; a.ldl = 0;
        } else {
            const int v = (u - 128) % 128, gi = (u - 128) / 128, dil = gi == 0 ? 1 : (gi == 1 ? 4 : 16), L = SEQ / dil;
            int qb, r, hb, b;
            if (gi == 0) { qb = v % 16; r = 0; hb = (v / 16) % 4; b = v / 64; }
            else if (gi == 1) { qb = v % 4; r = (v / 4) % 4; hb = (v / 16) % 4; b = v / 64; }
            else { qb = 0; r = v % 16; hb = (v / 16) % 4; b = v / 64; }
            const int q0 = qb * 256; const size_t seq0 = (size_t)b * SEQ + r, rowq = seq0 + (size_t)dil * q0;
            a.Q = (const GAS bf16*)P + rowq * AB_IN + 1024 + gi * 512 + hb * 128; a.ldq = (long)dil * AB_IN;
            a.K = (const GAS bf16*)P + seq0 * AB_IN + 2560 + hb * 128; a.V = (const GAS bf16*)P + seq0 * AB_IN + 3072 + hb * 128; a.ldk = (long)dil * AB_IN;
            a.q0 = q0; a.L = L; a.kt0 = q0 / 64 - 1; a.nt = 6;
            a.nsl = -alibi16(4 + gi * 4 + hb) * (float)dil / att::SCALE; a.radius = 64.f; a.m_init = att::M_INIT; a.l_init = 0.f;
            a.Of = nullptr; a.Ob = (GAS bf16*)OB + ((size_t)gi * M + rowq) * 512 + hb * 128; a.ldo = (long)dil * 512;
            a.lse = (GAS float*)LSE + ((size_t)gi * M + rowq) * 4 + hb; a.ldl = (long)dil * 4;
        }
        att::attn_unit<true, 1>(a, F.ldsg + RING_OFF, F.lds + RING_OFF, F.wave);
    }
}
__device__ __forceinline__ void phase_cnorm(Frame& F) {
    PHASE_IDS();
    const bf16* P = (const bf16*)(F.ws + WS_PROJ); float* NRM = (float*)(F.ws + WS_NRM);
    for (int it = gw; it < 2048; it += F.NGW) {
        const int tile = it & 63, j = (it >> 6) & 1, h = (it >> 7) & 7, b = (it >> 10) & 1;
        const bf16* base = P + ((size_t)b * SEQ + 64 * tile + (lane >> 4)) * C_IN + h * 256 + j * 128 + (lane & 15) * 8;
        float mq = 0.f, mk = 0.f, ms = 3.0e38f;
        v4u wqa[16], wka[16];
#pragma unroll
        for (int i = 0; i < 16; ++i) { wqa[i] = *(const v4u*)(base + (size_t)(4 * i) * C_IN); wka[i] = *(const v4u*)(base + (size_t)(4 * i) * C_IN + 2048); }
#pragma unroll
        for (int i = 0; i < 16; ++i) {
            const v4u wq = wqa[i], wk = wka[i];
            float sq = 0.f, sk = 0.f, dt = 0.f;
#pragma unroll
            for (int q = 0; q < 4; ++q) { const float a = bf_lo(wq[q]), c = bf_hi(wq[q]), e = bf_lo(wk[q]), g = bf_hi(wk[q]); sq += a * a + c * c; sk += e * e + g * g; dt += a * e + c * g; }
            sq = row16_sum(sq); sk = row16_sum(sk); dt = row16_sum(dt);
            mq = fmaxf(mq, sq); mk = fmaxf(mk, sk); ms = fminf(ms, dt);
        }
#define X32_(op, x) do { auto rr_ = __builtin_amdgcn_permlane32_swap(__builtin_bit_cast(unsigned, x), __builtin_bit_cast(unsigned, x), false, false); x = op(__builtin_bit_cast(float, rr_[0]), __builtin_bit_cast(float, rr_[1])); } while (0)
        mq = fmaxf(mq, swz_xor16(mq)); X32_(fmaxf, mq); mk = fmaxf(mk, swz_xor16(mk)); X32_(fmaxf, mk); ms = fminf(ms, swz_xor16(ms)); X32_(fminf, ms);
#undef X32_
        if (lane == 0) { NRM[it] = sqrtf(mq); NRM[2048 + it] = sqrtf(mk); NRM[4096 + it] = att::SCALE * ms; }
    }
}
__device__ __forceinline__ void phase_attn_c(Frame& F, gu32* ctr) {
    PHASE_IDS();
    const bf16* P = (const bf16*)(F.ws + WS_PROJ); bf16* AT = (bf16*)(F.ws + WS_ATT); const float* NRM = (const float*)(F.ws + WS_NRM);
    volatile LAS unsigned* slot = (volatile LAS unsigned*)(F.lds + MISC_OFF) + 16;
    for (;;) {
        if (tid == 0) *slot = __hip_atomic_fetch_add(ctr, 1u, __ATOMIC_RELAXED, __HIP_MEMORY_SCOPE_AGENT);
        __syncthreads();
        const int i = __builtin_amdgcn_readfirstlane((int)*slot);
        __syncthreads();
        if (i >= 1024) break;
        const int h = 7 - (i >> 7), qb = i & 31, j = (i >> 5) & 1, b = (i >> 6) & 1, q0 = qb * 128; const size_t row0 = (size_t)b * SEQ;
        const float slope = exp2f(-(float)(h + 1));
        const float* QN = NRM + ((b * 8 + h) * 2 + j) * 64; const float* KN = QN + 2048; const float* SS = QN + 4096;
        const float qn = fmaxf(QN[2 * qb], QN[2 * qb + 1]);
        const float smin = fminf(SS[2 * qb], SS[2 * qb + 1]) - 0.05f;
        const int klo = 64 * lane, d1 = klo - (q0 + 127), d2 = q0 - (klo + 63), dmin = d1 > 0 ? d1 : (d2 > 0 ? d2 : 0);
        const float bound = att::SCALE * 1.02f * qn * KN[lane] - slope * (float)dmin;
        const unsigned long long need = __ballot((bound - smin > -25.f) || (dmin == 0));
        const int t_lo = (int)__builtin_ctzll(need), t_hi = 64 - (int)__builtin_clzll(need);
        att::PairArgs a;
        a.Q = (const GAS bf16*)P + (row0 + q0) * C_IN + h * 256 + j * 128; a.ldq = C_IN;
        a.K = (const GAS bf16*)P + row0 * C_IN + 2048 + h * 256 + j * 128; a.V = (const GAS bf16*)P + row0 * C_IN + 4096 + h * 256; a.ldk = C_IN;
        a.q0 = q0; a.kt0 = t_lo; a.nt = t_hi - t_lo; a.nsl = -slope / att::SCALE;
        { float km = (lane >= t_lo && lane < t_hi) ? KN[lane] : 0.f;
#pragma unroll
          for (int o = 32; o > 0; o >>= 1) km = fmaxf(km, __shfl_xor(km, o));
          a.m0 = 1.02f * qn * km; }
        a.O = (GAS bf16*)AT + ((size_t)j * M + row0 + q0) * DM + h * 256; a.ldo = DM;
        att::attn_split_unit(a, F.ldsg + RING_OFF, (float*)(F.ldsg + BND_OFF), F.wave, F.lds + RING_OFF);
    }
}

#ifndef ENC_DUP
#define ENC_DUP 0
#endif
#define DUP(bit) for (int rep_ = 0; rep_ < (((ENC_DUP) & (bit)) ? 2 : 1); ++rep_)
constexpr int CW_QUEUE = 8192;
struct Args { const float* in[16]; float* out; unsigned char* ws; };
__global__ void __launch_bounds__(NWAVES * 64, 2) enc_fwd(Args args) {
    extern __shared__ __attribute__((aligned(16))) unsigned char lds[];
    Frame F;
    F.lds = (LAS unsigned char*)lds; F.ldsg = (char*)lds;
    F.wave = __builtin_amdgcn_readfirstlane((int)threadIdx.x >> 6);
    F.G = gridDim.x; F.gw = blockIdx.x * NWAVES + F.wave; F.NGW = F.G * NWAVES;
    F.x = args.in[0]; F.c = args.in[1]; F.ada_w = args.in[2]; F.ada_b = args.in[3]; F.norm_g = args.in[4]; F.ab_w_in = args.in[5]; F.ab_w_out = args.in[6]; F.a_sink = args.in[7];
    F.c_w_in = args.in[8]; F.c_w_out = args.in[9]; F.c_lambda = args.in[10]; F.c_subln_g = args.in[11]; F.w_up = args.in[12]; F.conv_w = args.in[13]; F.conv_b = args.in[14]; F.w_down = args.in[15];
    F.out = args.out; F.ws = args.ws;
    gu32* ctl = (gu32*)(F.ws + WS_CTL);
    for (int u = (int)threadIdx.x; u < (LDS_BYTES - LDSCTL_OFF) / 4; u += NWAVES * 64) ((LAS unsigned*)(F.lds + LDSCTL_OFF))[u] = 0u;
    __syncthreads();
    (void)xcd_barrier_post((unsigned*)(ctl + CW_BAR), (volatile LAS unsigned*)(F.lds + MISC_OFF) + 8);
#if ENC_PROBE
#define PH(k) do { const long long n_ = __builtin_readcyclecounter(); if (blockIdx.x == 0 && F.wave == 0 && lane_now() == 0) ((volatile long long*)(F.ldsg + BND_OFF - 512))[16 + (k)] += n_ - ph_t_; ph_t_ = n_; } while (0)
#define PHSET(k) ph_cur_ = (k)
    long long ph_t_ = __builtin_readcyclecounter(); int ph_cur_ = 0;
#else
#define PH(k) do {} while (0)
#define PHSET(k) do {} while (0)
#endif
#define GB() do { PH(ph_cur_); unsigned char* wsb_ = args.ws; asm volatile("" : "+s"(wsb_)); XcdBarrier bar_; bar_.bar = (unsigned*)(wsb_ + WS_CTL) + CW_BAR; bar_.x = xb_xcc_id(); \
        bar_.st = (volatile LAS unsigned*)(F.lds + MISC_OFF) + 8; bar_.tid = F.wave * 64 + lane_now(); xcd_barrier(bar_); PH(12); } while (0)
    float* mod = (float*)(F.ws + WS_MOD);
    bf16* H = (bf16*)(F.ws + WS_H); bf16* PROJ = (bf16*)(F.ws + WS_PROJ); bf16* O = (bf16*)(F.ws + WS_O); bf16* Y = (bf16*)(F.ws + WS_Y);
    bf16* ACT = (bf16*)(F.ws + WS_ACT); float* AT = (float*)(F.ws + WS_ATT);

    PHSET(0); DUP(1) p0a_prologue(F);
    GB();
    PHSET(1); p0b_modreduce(F);
    GB();
    rows_pre(F, F.x, F.norm_g, mod + 1 * DM, mod + 0 * DM, H, (F.G == 256) ? (_Float16*)(F.ws + 760 * MiB) : nullptr);
    GB();

    for (int s = 0; s < 8; ++s) {
        const int l = s >> 1, sub = s & 1, jl = l >> 1, even = !(l & 1);
        const float* modl = mod + (size_t)l * BATCH * MODW;
        PHSET(sub == 0 ? 2 : 10);
        if (sub == 0) {
            pg8::Gemm g; int N;
            if (even) { N = AB_IN; g.Bt = (const bf16*)(F.ws + WS_WABIN) + (size_t)jl * AB_IN * DM; } else { N = C_IN; g.Bt = (const bf16*)(F.ws + WS_WCIN) + (size_t)jl * C_IN * DM; }
            g.A = H; g.M = M; g.N = N; g.K = DM;
            pg8::StaticOrder S; S.init(M, N, F.G, (int)blockIdx.x);
            pg8::EpiBf16<0> E{PROJ, N, nullptr, 0, 0, 1.f};
            DUP(4) pg8::gemm_phase<pg8::EpiBf16<0>, pg8::StaticOrder, true, true>(F.lds + RING_OFF, g, S, E, F.wave);
            constexpr int NUAB = (M / 256) * (AB_IN / 256), NFAB = NUAB % 256;
            if (even && F.G == 256) tail_convert_cin(F, jl, NFAB, 256 - NFAB);
        } else {
            pg8::Gemm g; g.A = H; g.Bt = (const bf16*)(F.ws + WS_WUP) + (size_t)l * UPW * DM; g.M = M; g.N = UPW; g.K = DM;
            pg8::StaticOrder S; S.init(M, UPW, F.G, (int)blockIdx.x);
            pg8::EpiAct E{ACT, DFF, F.conv_w + (size_t)l * 3 * DFF, F.conv_b + (size_t)l * DFF, (float*)(F.ws + WS_HG), (float*)(F.ws + WS_HU), (LAS float*)(F.lds + BND_OFF)};
            DUP(4) pg8::gemm_phase<pg8::EpiAct, pg8::StaticOrder, true, true>(F.lds + RING_OFF, g, S, E, F.wave);
            constexpr int NU = (M / 256) * (UPW / 256), NFULL = NU % 256;
            if (F.G == 256 && l + 1 < DEPTH) tail_convert_ffn(F, l + 1, NFULL, 256 - NFULL);
        }
        GB();
        if (sub == 0) {
            if (even) { PHSET(3); DUP(16) phase_attn_ab(F, jl); GB(); PHSET(4); rows_bmerge(F, (const bf16*)AT, (const float*)(F.ws + WS_LSE), O); }
            else { PHSET(5); phase_cnorm(F); GB(); PHSET(6); phase_attn_c(F, ctl + CW_QUEUE + 64 * jl); GB();
                PHSET(7); rows_subln(F, (const bf16*)AT, (const bf16*)AT + (size_t)M * DM, F.c_lambda + (size_t)jl * 4 * 128, F.c_subln_g + (size_t)jl * 256, 0.8f - 0.6f * __expf(-0.3f * (float)l), O); }
            GB();
        }
        PHSET(sub == 0 ? 8 : 11);
        {
            pg8::Gemm g; int K;
            if (sub == 0) { if (even) { K = AB_OUT; g.Bt = (const bf16*)(F.ws + WS_WABOUT) + (size_t)jl * DM * AB_OUT; } else { K = DM; g.Bt = (const bf16*)(F.ws + WS_WCOUT) + (size_t)jl * DM * DM; } g.A = O; }
            else { K = DFF; g.Bt = (const bf16*)(F.ws + WS_WDOWN) + (size_t)l * DM * DFF; g.A = ACT; }
            g.M = M; g.N = DM; g.K = K;
            pg8::StaticOrder S; S.init(M, DM, F.G, (int)blockIdx.x);
            if (sub == 1) { pg8::Unit u0; if (S.next(0, u0)) actfix_panel(F, u0.pm, F.conv_w + (size_t)l * 3 * DFF, F.conv_b + (size_t)l * DFF, ACT); }
            const float* xs = (s == 0) ? F.x : F.out;
            const int ln = (sub == 1 && l + 1 < DEPTH) ? l + 1 : l; const float* modn = mod + (size_t)ln * BATCH * MODW;
            const float* gate = modl + (sub == 0 ? 2 : 5) * DM; const float* nga = F.norm_g + ((size_t)l * 4 + (sub == 0 ? 1 : 3)) * DM;
            const float* ngb = (sub == 0) ? F.norm_g + ((size_t)l * 4 + 2) * DM : F.norm_g + ((size_t)ln * 4 + 0) * DM;
            const float* scl = (sub == 0) ? modl + 4 * DM : modn + 1 * DM; const float* shf = (sub == 0) ? modl + 3 * DM : modn + 0 * DM;
            const bool doH = (sub == 0) || (l + 1 < DEPTH);
            if (F.G == 256) {
                float* xch = (float*)(F.ws + WS_XCH) + (size_t)s * 4 * (M / 256) * 8 * 256;       unsigned* cnt = (unsigned*)(ctl + CW_CNT) + (size_t)s * 2 * (M / 256) * 64;
                _Float16* XB = (_Float16*)(F.ws + 760 * MiB);
                pg8::EpiPost E{xs, F.out, doH ? H : nullptr, DM, XB, (s == 7) ? nullptr : XB, gate, nga, ngb, scl, shf, MODW, SEQ, xch, xch + (M / 256) * 8 * 256, cnt, cnt + (M / 256) * 64, EPS};
                pg8::gemm_phase<pg8::EpiPost, pg8::StaticOrder, false, true>(F.lds + RING_OFF, g, S, E, F.wave);
            } else {
                pg8::EpiBf16<0> E{Y, DM, nullptr, 0, 0, 1.f};
                pg8::gemm_phase<pg8::EpiBf16<0>, pg8::StaticOrder, false, true>(F.lds + RING_OFF, g, S, E, F.wave);
                GB();
                rows_post(F, Y, xs, F.out, gate, nga, ngb, scl, shf, H, doH);
            }
        }
        if (s < 7) GB(); else PH(ph_cur_);
    }
#if ENC_PROBE
    if (blockIdx.x == 0 && F.wave == 0 && lane_now() == 0) {
        const long long tot_ = ((volatile long long*)(F.ldsg + BND_OFF - 512))[(ENC_PROBE) - 1]; const long long s_ = __builtin_readcyclecounter(); const long long cap_ = tot_ < 20000000ll ? tot_ : 20000000ll;
        while (__builtin_readcyclecounter() - s_ < cap_) __builtin_amdgcn_s_sleep(8); }
#endif
#undef GB
}

extern "C" void kernel_launch(void* const* d_in, const int* in_sizes, int n_in, void* d_out, int out_size, void* d_ws, size_t ws_size, hipStream_t stream) {
    static int grid = 0;
    if (grid == 0) {
        if (n_in != 16 || in_sizes[0] != M * DM || out_size != M * DM || ws_size < WS_END) { fprintf(stderr, "kernel_launch: unexpected shapes (n_in %d, in0 %d, out %d, ws %zu < %zu)\n", n_in, n_in > 0 ? in_sizes[0] : -1, out_size, ws_size, (size_t)WS_END); grid = -1; return; }
        int dev = 0, cus = 0, per_cu = 0;
        if (hipGetDevice(&dev) != hipSuccess || hipDeviceGetAttribute(&cus, hipDeviceAttributeMultiprocessorCount, dev) != hipSuccess) { grid = -1; return; }
        if (hipFuncSetAttribute((const void*)enc_fwd, hipFuncAttributeMaxDynamicSharedMemorySize, LDS_BYTES) != hipSuccess) { fprintf(stderr, "kernel_launch: hipFuncSetAttribute failed\n"); grid = -1; return; }
        if (hipOccupancyMaxActiveBlocksPerMultiprocessor(&per_cu, (const void*)enc_fwd, NWAVES * 64, LDS_BYTES) != hipSuccess || per_cu < 1) { fprintf(stderr, "kernel_launch: occupancy query says %d\n", per_cu); }
        (void)hipGetLastError();
        grid = cus;
    }
    if (grid < 0) return;
    (void)hipMemsetAsync((char*)d_ws + WS_CTL, 0, CTL_ZERO_BYTES, stream);
    Args a{};
    for (int i = 0; i < 16; ++i) a.in[i] = (const float*)d_in[i];
    a.out = (float*)d_out; a.ws = (unsigned char*)d_ws;
    hipLaunchKernelGGL(enc_fwd, dim3(grid), dim3(NWAVES * 64), LDS_BYTES, stream, a);
}
```
